# Optimizing an MI355X kernel written in HIP

```python
import jax
import jax.numpy as jnp
from jax import lax
import numpy as np

D_MODEL = 1024
BATCH = 16
SEQ = 4096
DEPTH = 2

CTX_LEN = 256
GRID_W = 64
N_MOD = 6
NORM_EPS = 1e-6
F32 = jnp.float32

SSD_HEADS = 8
SSD_HEAD_DIM = 64
SSD_D_INNER = SSD_HEADS * SSD_HEAD_DIM
SSD_GROUPS = 2
SSD_STATE = 64
SSD_XBC = SSD_D_INNER + 2 * SSD_GROUPS * SSD_STATE
SSD_CONV_K = 3
SSD_CHUNK = 128

GLA_HEADS = 4
GLA_KEY_DIM = 64
GLA_VAL_DIM = 64
GLA_QK_W = GLA_HEADS * GLA_KEY_DIM
GLA_V_W = GLA_HEADS * GLA_VAL_DIM
GLA_GATE_RANK = 16
GLA_TAU = 16.0
GLA_CHUNK = 64

MLA_HEADS = 4
MLA_Q_RANK = 192
MLA_KV_RANK = 128
MLA_NOPE = 64
MLA_ROPE = 32
MLA_V = 64
MLA_QK = MLA_NOPE + MLA_ROPE
Q_BLOCK = 128
ROPE_BASE = 10000.0

MIX_WIDTH = SSD_D_INNER + GLA_V_W + MLA_HEADS * MLA_V

N_EXPERTS = 32
TOP_K = 4
EXPERT_FF = 1024
SWIGLU_ALPHA = 1.702
SWIGLU_LIMIT = 7.0

IN_SIZES = (SSD_D_INNER, SSD_XBC, 2 * SSD_HEADS, GLA_QK_W, GLA_QK_W, GLA_V_W, GLA_V_W,
            2 * GLA_GATE_RANK, MLA_Q_RANK, MLA_KV_RANK, MLA_ROPE)
IN_WIDTH = sum(IN_SIZES)

kernel_name = "hybrid_ssd_gla_mla_moe_dit_block"


def _rms(t):
    t = t.astype(F32)
    return t * lax.rsqrt(jnp.mean(t * t, axis=-1, keepdims=True) + NORM_EPS)


def rms_norm(t, w):
    return (_rms(t) * w.astype(F32)).astype(t.dtype)


def modulate(t, shift, scale):
    return t * (1.0 + scale) + shift


def split_cols(t, sizes):
    offsets, acc = [], 0
    for s in sizes[:-1]:
        acc += s
        offsets.append(acc)
    return jnp.split(t, offsets, axis=-1)


def flip(t):
    return jnp.flip(t, axis=1)


def depthwise_conv(t, w, b):
    pad = w.shape[0] // 2
    y = lax.conv_general_dilated(t, w[:, None, :].astype(t.dtype), (1,), [(pad, pad)],
                                 dimension_numbers=('NWC', 'WIO', 'NWC'),
                                 feature_group_count=t.shape[-1])
    return y + b.astype(t.dtype)


def axial_rope_tables(length):
    rows = length // GRID_W
    row = jnp.repeat(jnp.arange(rows, dtype=F32), GRID_W)
    col = jnp.tile(jnp.arange(GRID_W, dtype=F32), rows)
    half = MLA_ROPE // 2
    inv_freq = 1.0 / (ROPE_BASE ** (jnp.arange(0, half, 2, dtype=F32) / half))
    ang = jnp.stack([row[:, None] * inv_freq, col[:, None] * inv_freq], axis=1)
    return jnp.cos(ang), jnp.sin(ang)


def apply_axial_rope(t, cos, sin):
    shp = t.shape
    t32 = t.astype(F32).reshape(shp[:-1] + (2, 2, MLA_ROPE // 4))
    t1, t2 = t32[..., 0, :], t32[..., 1, :]
    cs, sn = cos[None, :, None], sin[None, :, None]
    out = jnp.stack([t1 * cs - t2 * sn, t2 * cs + t1 * sn], axis=-2)
    return out.reshape(shp).astype(t.dtype)


def chunk_recurrence(decay, inc, h0):
    def step(h, di):
        d, i = di
        return d * h + i, h
    h_final, h_enter = lax.scan(step, h0, (jnp.moveaxis(decay, 1, 0), jnp.moveaxis(inc, 1, 0)))
    return h_final, jnp.moveaxis(h_enter, 0, 1)


def ssd_chunked(xs, dt, a_coef, bm, cm, h0, with_output):
    b, L, H, P = xs.shape
    N = bm.shape[-1]
    Q = SSD_CHUNK
    nc = L // Q
    xc = xs.reshape(b, nc, Q, H, P)
    dtc = dt.reshape(b, nc, Q, H)
    bc = bm.reshape(b, nc, Q, H, N)
    cc = cm.reshape(b, nc, Q, H, N)
    a_cum = jnp.cumsum(dtc * a_coef, axis=2)
    a_last = a_cum[:, :, -1]
    states = jnp.einsum('bcshn,bcsh,bcshp->bchpn', bc, jnp.exp(a_last[:, :, None] - a_cum) * dtc, xc)
    h_final, h_enter = chunk_recurrence(jnp.exp(a_last)[..., None, None], states, h0)
    if not with_output:
        return None, h_final
    tril = jnp.tril(jnp.ones((Q, Q), bool))
    seg = a_cum[:, :, :, None, :] - a_cum[:, :, None, :, :]
    decay = jnp.exp(jnp.where(tril[:, :, None], seg, -jnp.inf))
    scores = jnp.einsum('bclhn,bcshn->bclsh', cc, bc) * decay * dtc[:, :, None]
    y = (jnp.einsum('bclsh,bcshp->bclhp', scores, xc)
         + jnp.einsum('bclhn,bchpn->bclhp', cc, h_enter) * jnp.exp(a_cum)[..., None])
    return y.reshape(b, L, H, P), h_final


def gla_chunked(q, k, v, g, s0, with_output):
    b, L, H, K = q.shape
    V = v.shape[-1]
    Q = GLA_CHUNK
    nc = L // Q
    qc = q.reshape(b, nc, Q, H, K)
    kc = k.reshape(b, nc, Q, H, K)
    vc = v.reshape(b, nc, Q, H, V)
    g_cum = jnp.cumsum(g.reshape(b, nc, Q, H, K), axis=2)
    g_last = g_cum[:, :, -1]
    inc = jnp.einsum('bcshk,bcshv->bchkv', kc * jnp.exp(g_last[:, :, None] - g_cum), vc)
    s_final, s_enter = chunk_recurrence(jnp.exp(g_last)[..., None], inc, s0)
    if not with_output:
        return None, s_final
    q_dec = qc * jnp.exp(g_cum)
    k_inv = kc * jnp.exp(-g_cum)
    tril = jnp.tril(jnp.ones((Q, Q), bool))
    att = jnp.where(tril[:, :, None], jnp.einsum('bclhk,bcshk->bclsh', q_dec, k_inv), 0.0)
    o = (jnp.einsum('bclsh,bcshv->bclhv', att, vc)
         + jnp.einsum('bclhk,bchkv->bclhv', q_dec, s_enter))
    return o.reshape(b, L, H, V), s_final


def ssd_mixer(cols_ctx, cols_lat, conv_w, conv_b, a_log, dt_bias, d_skip, norm_w, need_ctx_out):
    a_coef = -jnp.exp(a_log.astype(F32))
    dt_bias = dt_bias.astype(F32)
    d_skip = d_skip.astype(F32)[:, None]
    rep = SSD_HEADS // SSD_GROUPS

    def prep(z, xbc, dt_raw):
        b, L, _ = xbc.shape
        xbc = jax.nn.silu(depthwise_conv(xbc, conv_w, conv_b)).astype(F32)
        xs, bm, cm = jnp.split(xbc, [SSD_D_INNER, SSD_D_INNER + SSD_GROUPS * SSD_STATE], axis=-1)
        bm = jnp.repeat(bm.reshape(b, L, SSD_GROUPS, SSD_STATE), rep, axis=2)
        cm = jnp.repeat(cm.reshape(b, L, SSD_GROUPS, SSD_STATE), rep, axis=2)
        dt = jax.nn.softplus(dt_raw.astype(F32).reshape(b, L, 2, SSD_HEADS) + dt_bias)
        return z, xs.reshape(b, L, SSD_HEADS, SSD_HEAD_DIM), bm, cm, dt

    def bidir(xs, bm, cm, dt, h_fwd, h_bwd, with_output):
        y_f, hf = ssd_chunked(xs, dt[:, :, 0], a_coef[0], bm, cm, h_fwd, with_output)
        y_b, hb = ssd_chunked(flip(xs), flip(dt[:, :, 1]), a_coef[1], flip(bm), flip(cm), h_bwd, with_output)
        y = y_f + flip(y_b) + d_skip * xs if with_output else None
        return y, hf, hb

    def finish(y, z):
        b, L = y.shape[:2]
        gtd = y.reshape(b, L, SSD_D_INNER) * jax.nn.silu(z.astype(F32))
        gtd = _rms(gtd.reshape(b, L, SSD_GROUPS, SSD_D_INNER // SSD_GROUPS)).reshape(b, L, SSD_D_INNER)
        return gtd * norm_w.astype(F32)

    z_c, x_c, b_c, c_c, dt_c = prep(*cols_ctx)
    z_l, x_l, b_l, c_l, dt_l = prep(*cols_lat)
    h0 = jnp.zeros((x_c.shape[0], SSD_HEADS, SSD_HEAD_DIM, SSD_STATE), F32)
    y_c, h_f, h_b = bidir(x_c, b_c, c_c, dt_c, h0, h0, need_ctx_out)
    y_l, _, _ = bidir(x_l, b_l, c_l, dt_l, h_f, h_b, True)
    out_c = finish(y_c, z_c) if need_ctx_out else None
    return out_c, finish(y_l, z_l)


def gla_mixer(cols_ctx, cols_lat, g_up_w, g_up_b, norm_w, need_ctx_out):
    g_up_w = g_up_w.astype(F32)
    g_up_b = g_up_b.astype(F32)

    def prep(q, k, v, r, g_lr):
        b, L, _ = q.shape
        heads = lambda t, d: t.astype(F32).reshape(b, L, GLA_HEADS, d)
        g = jnp.einsum('blxr,xrk->blxk', g_lr.astype(F32).reshape(b, L, 2, GLA_GATE_RANK), g_up_w) + g_up_b
        g = (jax.nn.log_sigmoid(g) / GLA_TAU).reshape(b, L, 2, GLA_HEADS, GLA_KEY_DIM)
        return (heads(q, GLA_KEY_DIM) * (GLA_KEY_DIM ** -0.5), heads(k, GLA_KEY_DIM),
                heads(v, GLA_VAL_DIM), r, g)

    def bidir(q, k, v, g, s_f, s_b, with_output):
        o_f, sf = gla_chunked(q, k, v, g[:, :, 0], s_f, with_output)
        o_b, sb = gla_chunked(flip(q), flip(k), flip(v), flip(g[:, :, 1]), s_b, with_output)
        o = o_f + flip(o_b) if with_output else None
        return o, sf, sb

    def finish(o, r):
        b, L = o.shape[:2]
        return (_rms(o) * norm_w.astype(F32)).reshape(b, L, GLA_V_W) * jax.nn.silu(r.astype(F32))

    q_c, k_c, v_c, r_c, g_c = prep(*cols_ctx)
    q_l, k_l, v_l, r_l, g_l = prep(*cols_lat)
    s0 = jnp.zeros((q_c.shape[0], GLA_HEADS, GLA_KEY_DIM, GLA_VAL_DIM), F32)
    o_c, s_f, s_b = bidir(q_c, k_c, v_c, g_c, s0, s0, need_ctx_out)
    o_l, _, _ = bidir(q_l, k_l, v_l, g_l, s_f, s_b, True)
    out_c = finish(o_c, r_c) if need_ctx_out else None
    return out_c, finish(o_l, r_l)


def attend(q, k, v):
    s = jnp.einsum('bqhd,bkhd->bhqk', q, k, preferred_element_type=F32) * (MLA_QK ** -0.5)
    p = jax.nn.softmax(s, axis=-1)
    return jnp.einsum('bhqk,bkhv->bqhv', p.astype(v.dtype), v)


def blocked_attention(q, k, v):
    b, L, H, dq = q.shape
    nb = L // Q_BLOCK
    qb = q.reshape(b, nb, Q_BLOCK, H, dq).swapaxes(0, 1)
    ob = lax.map(lambda qi: attend(qi, k, v), qb)
    return ob.swapaxes(0, 1).reshape(b, L, H, v.shape[-1])


def mla_mixer(cols_ctx, cols_lat, q_norm_w, w_uq, kv_norm_w, w_ukv, cos, sin, need_ctx_out):
    def queries(cq):
        b, L, _ = cq.shape
        return (rms_norm(cq, q_norm_w) @ w_uq).reshape(b, L, MLA_HEADS, MLA_QK)

    def keys_values(ckv, kpe):
        b, L, _ = ckv.shape
        kv = (rms_norm(ckv, kv_norm_w) @ w_ukv).reshape(b, L, MLA_HEADS, MLA_NOPE + MLA_V)
        k_nope, v = jnp.split(kv, [MLA_NOPE], axis=-1)
        k = jnp.concatenate([k_nope, jnp.broadcast_to(kpe[:, :, None, :], (b, L, MLA_HEADS, MLA_ROPE))], axis=-1)
        return k, v

    cq_c, ckv_c, kpe_c = cols_ctx
    cq_l, ckv_l, kpe_l = cols_lat
    k_c, v_c = keys_values(ckv_c, kpe_c)
    k_l, v_l = keys_values(ckv_l, apply_axial_rope(kpe_l[:, :, None, :], cos, sin)[:, :, 0])
    q_l = queries(cq_l)
    q_l = jnp.concatenate([q_l[..., :MLA_NOPE], apply_axial_rope(q_l[..., MLA_NOPE:], cos, sin)], axis=-1)
    k_all = jnp.concatenate([k_c, k_l], axis=1)
    v_all = jnp.concatenate([v_c, v_l], axis=1)
    b, L = q_l.shape[:2]
    out_l = blocked_attention(q_l, k_all, v_all).reshape(b, L, MLA_HEADS * MLA_V).astype(F32)
    out_c = None
    if need_ctx_out:
        lc = cq_c.shape[1]
        out_c = attend(queries(cq_c), k_c, v_c).reshape(b, lc, MLA_HEADS * MLA_V).astype(F32)
    return out_c, out_l


def moe_ffn(t, router_w, router_b, w1, b1, w2, b2):
    logits = jnp.dot(t, router_w, preferred_element_type=F32) + router_b.astype(F32)
    top_val, top_idx = lax.top_k(logits, TOP_K)
    top_w = jax.nn.softmax(top_val, axis=-1)
    gate = jnp.einsum('tk,tke->te', top_w, jax.nn.one_hot(top_idx, N_EXPERTS, dtype=F32))
    out = jnp.zeros(t.shape, F32)
    for e in range(N_EXPERTS):
        hdn = t @ w1[e] + b1[e]
        glu = jnp.minimum(hdn[:, 0::2], SWIGLU_LIMIT).astype(F32)
        lin = jnp.clip(hdn[:, 1::2], -SWIGLU_LIMIT, SWIGLU_LIMIT).astype(F32)
        act = (glu * jax.nn.sigmoid(SWIGLU_ALPHA * glu) * (lin + 1.0)).astype(t.dtype)
        out = out + gate[:, e:e + 1] * (act @ w2[e] + b2[e]).astype(F32)
    return out.astype(t.dtype)


def setup_inputs(seed: int = 0) -> dict:
    key = jax.random.key(seed)
    ks = jax.random.split(key, 32)
    nrm = lambda i, shape, std: jax.random.normal(ks[i], shape, F32) * std
    gain = lambda i, shape: 1.0 + 0.05 * jax.random.normal(ks[i], shape, F32)
    dt0 = jnp.exp(jax.random.uniform(ks[9], (DEPTH, 2, SSD_HEADS), F32, np.log(1e-3), np.log(1e-1)))
    return {
        "x": nrm(0, (BATCH, SEQ, D_MODEL), 1.0),
        "c": nrm(1, (BATCH, D_MODEL), 1.0),
        "ctx": nrm(2, (BATCH, CTX_LEN, D_MODEL), 1.0),
        "c_ctx": nrm(3, (D_MODEL,), 1.0),
        "w_mod": nrm(4, (DEPTH, D_MODEL, N_MOD * D_MODEL), 0.5 * D_MODEL ** -0.5),
        "b_mod": nrm(5, (DEPTH, N_MOD * D_MODEL), 0.02),
        "norm1_w": gain(6, (DEPTH, D_MODEL)),
        "w_in": nrm(7, (DEPTH, D_MODEL, IN_WIDTH), D_MODEL ** -0.5),
        "ssd_conv_w": nrm(8, (DEPTH, SSD_CONV_K, SSD_XBC), SSD_CONV_K ** -0.5),
        "ssd_conv_b": nrm(10, (DEPTH, SSD_XBC), 0.02),
        "ssd_a_log": jnp.log(jax.random.uniform(ks[11], (DEPTH, 2, SSD_HEADS), F32, 1.0, 16.0)),
        "ssd_dt_bias": dt0 + jnp.log(-jnp.expm1(-dt0)),
        "ssd_d": gain(12, (DEPTH, SSD_HEADS)),
        "ssd_norm_w": gain(13, (DEPTH, SSD_D_INNER)),
        "gla_g_up_w": nrm(14, (DEPTH, 2, GLA_GATE_RANK, GLA_QK_W), GLA_GATE_RANK ** -0.5),
        "gla_g_up_b": nrm(15, (DEPTH, 2, GLA_QK_W), 0.1),
        "gla_norm_w": gain(16, (DEPTH, GLA_VAL_DIM)),
        "mla_q_norm_w": gain(17, (DEPTH, MLA_Q_RANK)),
        "mla_w_uq": nrm(18, (DEPTH, MLA_Q_RANK, MLA_HEADS * MLA_QK), MLA_Q_RANK ** -0.5),
        "mla_kv_norm_w": gain(19, (DEPTH, MLA_KV_RANK)),
        "mla_w_ukv": nrm(20, (DEPTH, MLA_KV_RANK, MLA_HEADS * (MLA_NOPE + MLA_V)), MLA_KV_RANK ** -0.5),
        "w_out": nrm(21, (DEPTH, MIX_WIDTH, D_MODEL), MIX_WIDTH ** -0.5),
        "norm2_w": gain(22, (DEPTH, D_MODEL)),
        "router_w": nrm(23, (DEPTH, D_MODEL, N_EXPERTS), D_MODEL ** -0.5),
        "router_b": nrm(24, (DEPTH, N_EXPERTS), 0.01),
        "expert_w1": nrm(25, (DEPTH, N_EXPERTS, D_MODEL, 2 * EXPERT_FF), D_MODEL ** -0.5),
        "expert_b1": nrm(26, (DEPTH, N_EXPERTS, 2 * EXPERT_FF), 0.01),
        "expert_w2": nrm(27, (DEPTH, N_EXPERTS, EXPERT_FF, D_MODEL), EXPERT_FF ** -0.5),
        "expert_b2": nrm(28, (DEPTH, N_EXPERTS, D_MODEL), 0.01),
        "final_norm_w": gain(29, (D_MODEL,)),
    }


def reference(x, c, ctx, c_ctx, w_mod, b_mod, norm1_w, w_in, ssd_conv_w, ssd_conv_b, ssd_a_log,
              ssd_dt_bias, ssd_d, ssd_norm_w, gla_g_up_w, gla_g_up_b, gla_norm_w, mla_q_norm_w,
              mla_w_uq, mla_kv_norm_w, mla_w_ukv, w_out, norm2_w, router_w, router_b, expert_w1,
              expert_b1, expert_w2, expert_b2, final_norm_w):
    seq_len = x.shape[1]
    cos, sin = axial_rope_tables(seq_len)
    silu_c = jax.nn.silu(c)
    silu_cc = jax.nn.silu(c_ctx)
    h_lat, h_ctx = x, ctx
    for l in range(DEPTH):
        need_ctx_out = l < DEPTH - 1
        mod_l = (silu_c @ w_mod[l] + b_mod[l]).reshape(-1, N_MOD, 1, D_MODEL)
        mod_c = (silu_cc @ w_mod[l] + b_mod[l]).reshape(N_MOD, D_MODEL)
        act_dtype = h_lat.dtype

        u_l = modulate(rms_norm(h_lat, norm1_w[l]), mod_l[:, 0], mod_l[:, 1])
        u_c = modulate(rms_norm(h_ctx, norm1_w[l]), mod_c[0], mod_c[1])
        cols_l = split_cols(u_l @ w_in[l], IN_SIZES)
        cols_c = split_cols(u_c @ w_in[l], IN_SIZES)
        ssd_c, ssd_l = ssd_mixer(cols_c[0:3], cols_l[0:3], ssd_conv_w[l], ssd_conv_b[l], ssd_a_log[l],
                                 ssd_dt_bias[l], ssd_d[l], ssd_norm_w[l], need_ctx_out)
        gla_c, gla_l = gla_mixer(cols_c[3:8], cols_l[3:8], gla_g_up_w[l], gla_g_up_b[l], gla_norm_w[l],
                                 need_ctx_out)
        mla_c, mla_l = mla_mixer(cols_c[8:11], cols_l[8:11], mla_q_norm_w[l], mla_w_uq[l], mla_kv_norm_w[l],
                                 mla_w_ukv[l], cos, sin, need_ctx_out)
        mix_l = jnp.concatenate([ssd_l, gla_l, mla_l], axis=-1).astype(act_dtype) @ w_out[l]
        h_lat = h_lat + mod_l[:, 2] * mix_l
        if need_ctx_out:
            mix_c = jnp.concatenate([ssd_c, gla_c, mla_c], axis=-1).astype(act_dtype) @ w_out[l]
            h_ctx = h_ctx + mod_c[2] * mix_c

        v_l = modulate(rms_norm(h_lat, norm2_w[l]), mod_l[:, 3], mod_l[:, 4])
        b, L, d = v_l.shape
        if need_ctx_out:
            v_c = modulate(rms_norm(h_ctx, norm2_w[l]), mod_c[3], mod_c[4])
            lc = v_c.shape[1]
            f = moe_ffn(jnp.concatenate([v_c.reshape(-1, d), v_l.reshape(-1, d)], axis=0), router_w[l],
                        router_b[l], expert_w1[l], expert_b1[l], expert_w2[l], expert_b2[l])
            h_ctx = h_ctx + mod_c[5] * f[:b * lc].reshape(b, lc, d)
            h_lat = h_lat + mod_l[:, 5] * f[b * lc:].reshape(b, L, d)
        else:
            f = moe_ffn(v_l.reshape(-1, d), router_w[l], router_b[l], expert_w1[l], expert_b1[l],
                        expert_w2[l], expert_b2[l])
            h_lat = h_lat + mod_l[:, 5] * f.reshape(b, L, d)
    return rms_norm(h_lat, final_norm_w)
```

```cpp
#include <hip/hip_runtime.h>
#include <cstdio>
#include <cstdint>
namespace pg8 {
#define PG8_LAS __attribute__((address_space(3)))
typedef unsigned short bf16_t;
typedef short bf16x8 __attribute__((ext_vector_type(8)));
typedef float f32x4 __attribute__((ext_vector_type(4)));
typedef unsigned u32x4 __attribute__((ext_vector_type(4)));
constexpr int BM = 256, BK = 64, HALF = 128, HTB = HALF * BK * 2  , STAGE_BYTES = 8 * HTB, NXCD = 8,
#ifndef PG8_WGM
#define PG8_WGM 8
#endif
    WGM = PG8_WGM;

__host__ __device__ __forceinline__ int lds_byte(int r, int c) { const int st = (r >> 4) * 2 + (c >> 5), rr = r & 15, cc = c & 31, ob = rr * 64 + cc * 2; return st * 1024 + (ob ^ (((ob >> 9) & 1) << 5)); }
__host__ __device__ __forceinline__ void stage_rc(int b, int& R, int& C) { const int st = b / 1024, sb = b % 1024, swz = sb ^ (((sb >> 9) & 1) << 5); R = (st >> 1) * 16 + swz / 64; C = (st & 1) * 32 + (swz % 64) / 2; }
__host__ __device__ __forceinline__ int perm32(int rho) { const int n = rho >> 4, i = rho & 15; return 8 * (i >> 2) + 4 * n + (i & 3); }

struct Unit { int pm, pn; };
struct Gemm { const bf16_t* A; const bf16_t* Bt; int M, N, K; };

struct StaticOrder {
    int nM, nN, nwg, G, c;
    __host__ __device__ void init(int M, int N, int G_, int c_) { nM = M / BM; nN = N / BM; nwg = nM * nN; G = G_; c = c_; }
    __host__ __device__ bool next(int i, Unit& u) const {
        const long L = (long)i * G + c; if (L >= nwg) return false;
        int wgid = (int)L; { const int q = nwg / NXCD, r = nwg % NXCD, xcd = wgid % NXCD, off = wgid / NXCD; wgid = (xcd < r ? xcd * (q + 1) : r * (q + 1) + (xcd - r) * q) + off; }
        const int nig = WGM * nN, gid = wgid / nig, fm = gid * WGM, gsz = (nM - fm) < WGM ? (nM - fm) : WGM;
        u.pm = fm + ((wgid % nig) % gsz); u.pn = (wgid % nig) / gsz; return true;
    }
    __device__ __forceinline__ void a_ready(const Unit&) const {}
    __device__ __forceinline__ void done(const Unit&) const {}
};

__device__ __forceinline__ unsigned cvt_pk_bf16(float lo, float hi) { unsigned r; asm volatile("v_cvt_pk_bf16_f32 %0, %1, %2" : "=v"(r) : "v"(lo), "v"(hi)); return r; }
typedef float f32x2 __attribute__((ext_vector_type(2)));
struct EpiBf16 {
    static constexpr bool PERM = true, AFTER_DRAIN = false;
    bf16_t* O; int ldc; const float* bias; int split_cols; size_t split_stride;
    __device__ __forceinline__ void operator()(const f32x4 (&acc)[2][2][4][2], const Unit& u, int wr, int wc, int fr, int fq) const {
        const int row0 = u.pm * BM + wr * 64 + fr; int colt = u.pn * BM; bf16_t* base = O;
        if (split_cols) { const int t = colt / split_cols; base += (size_t)t * split_stride; colt -= t * split_cols; }
        const int col0 = colt + wc * 32 + 8 * fq, bcol0 = u.pn * BM + wc * 32 + 8 * fq;
        f32x4 bv[2][2];
#pragma unroll
        for (int bj = 0; bj < 2; ++bj)
#pragma unroll
            for (int n = 0; n < 2; ++n) bv[bj][n] = bias ? *(const f32x4*)(bias + bcol0 + bj * HALF + 4 * n) : (f32x4){0.f, 0.f, 0.f, 0.f};
#pragma unroll
        for (int ai = 0; ai < 2; ++ai)
#pragma unroll
            for (int m = 0; m < 4; ++m) { bf16_t* rowp = base + (size_t)(row0 + ai * HALF + m * 16) * ldc + col0;
#pragma unroll
                for (int bj = 0; bj < 2; ++bj) { const f32x4 v0 = acc[ai][bj][m][0] + bv[bj][0], v1 = acc[ai][bj][m][1] + bv[bj][1];
                    u32x4 w; w.x = cvt_pk_bf16(v0[0], v0[1]); w.y = cvt_pk_bf16(v0[2], v0[3]); w.z = cvt_pk_bf16(v1[0], v1[1]); w.w = cvt_pk_bf16(v1[2], v1[3]);
                    *(u32x4*)(rowp + bj * HALF) = w; } }
    }
};
struct EpiSwiglu {
    static constexpr bool PERM = true, AFTER_DRAIN = false;
    bf16_t* O; const float* bias;
    __device__ __forceinline__ void operator()(const f32x4 (&acc)[2][2][4][2], const Unit& u, int wr, int wc, int fr, int fq) const {
        const int row0 = u.pm * BM + wr * 64 + fr;
        const int hc0 = (u.pn & 7) * BM + wc * 32 + 8 * fq, bcol0 = u.pn * BM + wc * 32 + 8 * fq;
        f32x4 bv[2][2];
#pragma unroll
        for (int bj = 0; bj < 2; ++bj)
#pragma unroll
            for (int n = 0; n < 2; ++n) bv[bj][n] = *(const f32x4*)(bias + bcol0 + bj * HALF + 4 * n);
#pragma unroll
        for (int ai = 0; ai < 2; ++ai)
#pragma unroll
            for (int m = 0; m < 4; ++m) { bf16_t* rowp = O + (size_t)(row0 + ai * HALF + m * 16) * 1024 + (hc0 >> 1);
#pragma unroll
                for (int bj = 0; bj < 2; ++bj) { const f32x4 v0 = acc[ai][bj][m][0] + bv[bj][0], v1 = acc[ai][bj][m][1] + bv[bj][1];
                    float a[4];
#pragma unroll
                    for (int q = 0; q < 4; ++q) { const float gl = fminf(q < 2 ? v0[2 * q] : v1[2 * q - 4], 7.0f); float li = q < 2 ? v0[2 * q + 1] : v1[2 * q - 3]; li = fminf(fmaxf(li, -7.0f), 7.0f);
                        a[q] = gl * __builtin_amdgcn_rcpf(1.0f + __builtin_amdgcn_exp2f(-2.4554669595930156f * gl)) * (li + 1.0f); }
                    typedef unsigned u32x2 __attribute__((ext_vector_type(2)));
                    u32x2 w; w.x = cvt_pk_bf16(a[0], a[1]); w.y = cvt_pk_bf16(a[2], a[3]);
                    *(u32x2*)(rowp + bj * (HALF / 2)) = w; } }
    }
};
struct EpiResid {
    static constexpr bool PERM = false, AFTER_DRAIN = false;
    const float* x; const float* ctx; const bf16_t* H; bf16_t* Hout; const float* mod; int layer;
    __device__ __forceinline__ void operator()(const f32x4 (&acc)[2][2][4][2], const Unit& u, int wr, int wc, int fr, int fq) const {
        typedef unsigned u32x2 __attribute__((ext_vector_type(2)));
        const int b = u.pm / 17, tin = u.pm - b * 17; const float* gate = mod + (size_t)(tin == 0 ? 16 : b) * 6144 + 2048;
        const float* base = tin == 0 ? ctx + (size_t)b * 256 * 1024 : x + ((size_t)b * 4096 + (size_t)(tin - 1) * 256) * 1024;
        const bf16_t* hb = H + (size_t)u.pm * 256 * 1024; bf16_t* outp = Hout + (size_t)u.pm * 256 * 1024;
        const int rl0 = wr * 64 + fr, col0 = u.pn * BM + wc * 32 + 4 * fq;
        f32x4 gv[2][2];
#pragma unroll
        for (int bj = 0; bj < 2; ++bj)
#pragma unroll
            for (int n = 0; n < 2; ++n) gv[bj][n] = *(const f32x4*)(gate + col0 + bj * HALF + n * 16);
#pragma unroll
        for (int ai = 0; ai < 2; ++ai)
#pragma unroll
            for (int m = 0; m < 4; ++m) { const size_t off = (size_t)(rl0 + ai * HALF + m * 16) * 1024 + col0;
#pragma unroll
                for (int bj = 0; bj < 2; ++bj)
#pragma unroll
                    for (int n = 0; n < 2; ++n) { f32x4 bs;
                        if (layer == 0) bs = *(const f32x4*)(base + off + bj * HALF + n * 16);
                        else { const u32x2 hw = *(const u32x2*)(hb + off + bj * HALF + n * 16); bs = (f32x4){__uint_as_float(hw.x << 16), __uint_as_float(hw.x & 0xffff0000u), __uint_as_float(hw.y << 16), __uint_as_float(hw.y & 0xffff0000u)}; }
                        const f32x4 o = bs + gv[bj][n] * acc[ai][bj][m][n]; u32x2 w; w.x = cvt_pk_bf16(o[0], o[1]); w.y = cvt_pk_bf16(o[2], o[3]); *(u32x2*)(outp + off + bj * HALF + n * 16) = w; } }
    }
};
struct MapOrder : StaticOrder {
    int skipctx;
    __device__ __forceinline__ bool next(int i, Unit& u) const { if (!StaticOrder::next(i, u)) return false; if (skipctx) u.pm = (u.pm >> 4) * 17 + 1 + (u.pm & 15); return true; }
};
struct MoeOrder {
    const int* toff; int npn, G, c;
    __device__ __forceinline__ bool next(int i, Unit& u) const {
        const int nt = toff[32], nwg = nt * npn; const long L = (long)i * G + c; if (L >= (long)nwg) return false;
        int wgid = (int)L; { const int q = nwg / NXCD, r = nwg % NXCD, xcd = wgid % NXCD, off = wgid / NXCD; wgid = (xcd < r ? xcd * (q + 1) : r * (q + 1) + (xcd - r) * q) + off; }
#ifndef MOE_WGM
#define MOE_WGM 8
#endif
        const int nig = MOE_WGM * npn, gid = wgid / nig, fm = gid * MOE_WGM, gsz = (nt - fm) < MOE_WGM ? (nt - fm) : MOE_WGM;
        const int pm = fm + ((wgid % nig) % gsz), pnl = (wgid % nig) / gsz; int e = 0;
        for (int q = 1; q < 32; ++q) e += (toff[q] <= pm) ? 1 : 0;
        u.pm = pm; u.pn = e * npn + pnl; return true;
    }
    __device__ __forceinline__ void a_ready(const Unit&) const {}
    __device__ __forceinline__ void done(const Unit&) const {}
};
template <class Epi, class Sched, bool ALIGN_EPI = false, bool SP2 = false>
__device__ __forceinline__ void gemm_phase(PG8_LAS unsigned char* lds, const Gemm g, const Sched& S, const Epi& E, const int tid) {
    const int  wid = __builtin_amdgcn_readfirstlane(tid >> 6), lane = tid & 63, wr = wid >> 2, wc = wid & 3, fr = lane & 15, fq = lane >> 4;
    const int K = g.K, nt = K / BK;
    unsigned voffA[2], voffB[2];
#pragma unroll
    for (int i = 0; i < 2; ++i) { int R, C; stage_rc(tid * 16 + i * 8192, R, C); const int Rb = Epi::PERM ? ((R & ~31) + perm32(R & 31)) : R;
        voffA[i] = (unsigned)(R * K + C) * 2u; voffB[i] = (unsigned)(Rb * K + C) * 2u; }
    const size_t kstep = (size_t)(BK * 2);
    const size_t hstep = (size_t)HALF * K * 2;
    const size_t tstep = 2 * hstep;
    const unsigned ldsw = (unsigned)wid * 1024u;
    const int aoff = lds_byte(wr * 64 + fr, fq * 8), boff = lds_byte(wc * 32 + fr, fq * 8);
#define PG8_SA(b, h) (((b) * 2 + (h)) * HTB)
#define PG8_SB(b, h) ((4 + (b) * 2 + (h)) * HTB)
#define PG8_STAGE(bufoff, gbase, voff) do { _Pragma("unroll") for (int _i = 0; _i < 2; ++_i) \
        __builtin_amdgcn_global_load_lds((const unsigned*)((const char*)(gbase) + (voff)[_i]), (PG8_LAS unsigned*)(lds + (bufoff) + ldsw + _i * 8192), 16, 0, 0); } while (0)
#define PG8_LDA(dst, b, h) do { _Pragma("unroll") for (int m = 0; m < 4; ++m) _Pragma("unroll") for (int k = 0; k < 2; ++k) dst[m][k] = *(const PG8_LAS bf16x8*)(lds + PG8_SA(b, h) + aoff + m * 2048 + k * 1024); } while (0)
#define PG8_LDB(dst, b, h) do { _Pragma("unroll") for (int n = 0; n < 2; ++n) _Pragma("unroll") for (int k = 0; k < 2; ++k) dst[n][k] = *(const PG8_LAS bf16x8*)(lds + PG8_SB(b, h) + boff + n * 2048 + k * 1024); } while (0)
#define PG8_MMA(ai, bj, At, Bt) do { __builtin_amdgcn_s_setprio(1); _Pragma("unroll") for (int m = 0; m < 4; ++m) _Pragma("unroll") for (int n = 0; n < 2; ++n) _Pragma("unroll") for (int k = 0; k < 2; ++k) \
        acc[ai][bj][m][n] = __builtin_amdgcn_mfma_f32_16x16x32_bf16(Bt[n][k], At[m][k], acc[ai][bj][m][n], 0, 0, 0); __builtin_amdgcn_s_setprio(0); } while (0)
#define PG8_WAIT_V(n) asm volatile("s_waitcnt vmcnt(" #n ")" ::: "memory")
#define PG8_WAIT_L(n) asm volatile("s_waitcnt lgkmcnt(" #n ")" ::: "memory")
#define PG8_BAR __builtin_amdgcn_s_barrier()
#define PG8_SCHED __builtin_amdgcn_sched_barrier(0)
    Unit cur, nxt; int ui = 0;
    if (!S.next(0, cur)) return;
    f32x4 acc[2][2][4][2];
#pragma unroll
    for (int a = 0; a < 2; ++a)
#pragma unroll
        for (int b = 0; b < 2; ++b)
#pragma unroll
            for (int m = 0; m < 4; ++m)
#pragma unroll
                for (int n = 0; n < 2; ++n) acc[a][b][m][n] = (f32x4){0.f, 0.f, 0.f, 0.f};
    bf16x8 At[4][2], B0[2][2], B1[2][2];
    const char* cA = (const char*)g.A + (size_t)cur.pm * tstep; const char* cB = (const char*)g.Bt + (size_t)cur.pn * tstep;
    S.a_ready(cur);
    if constexpr (SP2) {
        PG8_STAGE(PG8_SB(0, 0), cB, voffB); PG8_STAGE(PG8_SB(0, 1), cB + hstep, voffB); PG8_STAGE(PG8_SA(0, 0), cA, voffA); PG8_STAGE(PG8_SA(0, 1), cA + hstep, voffA);
        if (wr == 1) PG8_BAR;
        PG8_WAIT_V(2); PG8_BAR;
        PG8_STAGE(PG8_SB(1, 0), cB + kstep, voffB); PG8_STAGE(PG8_SA(1, 0), cA + kstep, voffA); PG8_STAGE(PG8_SB(1, 1), cB + hstep + kstep, voffB);
        PG8_WAIT_V(6); PG8_BAR;
    } else {
        PG8_STAGE(PG8_SB(0, 0), cB, voffB); PG8_STAGE(PG8_SA(0, 0), cA, voffA); PG8_STAGE(PG8_SB(0, 1), cB + hstep, voffB); PG8_STAGE(PG8_SA(0, 1), cA + hstep, voffA);
        if (wr == 1) PG8_BAR;
        PG8_WAIT_V(4); PG8_BAR;
        PG8_STAGE(PG8_SB(1, 0), cB + kstep, voffB); PG8_STAGE(PG8_SA(1, 0), cA + kstep, voffA); PG8_STAGE(PG8_SB(1, 1), cB + hstep + kstep, voffB);
        PG8_WAIT_V(6); PG8_BAR;
    }
    for (;;) {
        const bool has_next = S.next(ui + 1, nxt);
        const char* nA = has_next ? (const char*)g.A + (size_t)nxt.pm * tstep : cA; const char* nB = has_next ? (const char*)g.Bt + (size_t)nxt.pn * tstep : cB;
        for (int t = 0; t < nt; t += 2) {
            const bool last = (t == nt - 2);
            const char* a1 = cA + (size_t)(t + 1) * kstep;
            const char* a2 = last ? nA : cA + (size_t)(t + 2) * kstep; const char* b2 = last ? nB : cB + (size_t)(t + 2) * kstep;
            const char* a3 = a2 + kstep; const char* b3 = b2 + kstep;
            if (last && has_next) S.a_ready(nxt);
            if constexpr (SP2) {
            PG8_LDB(B0, 0, 0); PG8_LDB(B1, 0, 1); PG8_SCHED; PG8_LDA(At, 0, 0); PG8_STAGE(PG8_SA(1, 1), a1 + hstep, voffA);
            PG8_WAIT_V(8); PG8_WAIT_L(0); PG8_BAR; PG8_MMA(0, 0, At, B0); PG8_MMA(0, 1, At, B1); PG8_BAR; PG8_SCHED;
            PG8_LDA(At, 0, 1); PG8_STAGE(PG8_SB(0, 0), b2, voffB); PG8_STAGE(PG8_SB(0, 1), b2 + hstep, voffB); PG8_STAGE(PG8_SA(0, 0), a2, voffA);
            PG8_WAIT_V(8); PG8_WAIT_L(0); PG8_BAR; PG8_MMA(1, 0, At, B0); PG8_MMA(1, 1, At, B1); PG8_BAR; PG8_SCHED;
            PG8_LDB(B0, 1, 0); PG8_LDB(B1, 1, 1); PG8_SCHED; PG8_LDA(At, 1, 0); PG8_STAGE(PG8_SA(0, 1), a2 + hstep, voffA);
            PG8_WAIT_V(8); PG8_WAIT_L(0); PG8_BAR; PG8_MMA(0, 0, At, B0); PG8_MMA(0, 1, At, B1); PG8_BAR; PG8_SCHED;
            PG8_LDA(At, 1, 1); PG8_STAGE(PG8_SB(1, 0), b3, voffB); PG8_STAGE(PG8_SB(1, 1), b3 + hstep, voffB); PG8_STAGE(PG8_SA(1, 0), a3, voffA);
            PG8_WAIT_V(8); PG8_WAIT_L(0); PG8_BAR; PG8_MMA(1, 0, At, B0); PG8_MMA(1, 1, At, B1); PG8_BAR; PG8_SCHED;
            } else {
            PG8_LDB(B0, 0, 0); PG8_SCHED; PG8_LDA(At, 0, 0); PG8_STAGE(PG8_SA(1, 1), a1 + hstep, voffA);
            PG8_WAIT_L(8); PG8_BAR; PG8_WAIT_L(0); PG8_MMA(0, 0, At, B0); PG8_BAR; PG8_SCHED;
            PG8_LDB(B1, 0, 1); PG8_STAGE(PG8_SB(0, 0), b2, voffB);
            PG8_BAR; PG8_WAIT_L(0); PG8_MMA(0, 1, At, B1); PG8_BAR;
            PG8_LDA(At, 0, 1); PG8_STAGE(PG8_SA(0, 0), a2, voffA);
            PG8_BAR; PG8_WAIT_L(0); PG8_MMA(1, 0, At, B0); PG8_BAR; PG8_SCHED;
            PG8_STAGE(PG8_SB(0, 1), b2 + hstep, voffB);
            PG8_WAIT_V(6); PG8_BAR; PG8_MMA(1, 1, At, B1); PG8_BAR;
            PG8_LDB(B0, 1, 0); PG8_SCHED; PG8_LDA(At, 1, 0); PG8_STAGE(PG8_SA(0, 1), a2 + hstep, voffA);
            PG8_WAIT_L(8); PG8_BAR; PG8_WAIT_L(0); PG8_MMA(0, 0, At, B0); PG8_BAR; PG8_SCHED;
            PG8_LDB(B1, 1, 1); PG8_STAGE(PG8_SB(1, 0), b3, voffB);
            PG8_BAR; PG8_WAIT_L(0); PG8_MMA(0, 1, At, B1); PG8_BAR;
            PG8_LDA(At, 1, 1); PG8_STAGE(PG8_SA(1, 0), a3, voffA);
            PG8_BAR; PG8_WAIT_L(0); PG8_MMA(1, 0, At, B0); PG8_BAR; PG8_SCHED;
            PG8_STAGE(PG8_SB(1, 1), b3 + hstep, voffB);
            PG8_WAIT_V(6); PG8_BAR; PG8_MMA(1, 1, At, B1); PG8_BAR;
            }
        }
        if constexpr (ALIGN_EPI) { if (wr == 0) PG8_BAR; }
        if constexpr (!Epi::AFTER_DRAIN) { E(acc, cur, wr, wc, fr, fq); S.done(cur); }
        if (!has_next) break;
#pragma unroll
        for (int a = 0; a < 2; ++a)
#pragma unroll
            for (int b = 0; b < 2; ++b)
#pragma unroll
                for (int m = 0; m < 4; ++m)
#pragma unroll
                    for (int n = 0; n < 2; ++n) acc[a][b][m][n] = (f32x4){0.f, 0.f, 0.f, 0.f};
        cur = nxt; cA = nA; cB = nB; ++ui;
        if constexpr (ALIGN_EPI) { if (wr == 1) PG8_BAR; }
    }
    PG8_WAIT_V(0);
    if constexpr (!ALIGN_EPI) { if (wr == 0) PG8_BAR; }
    PG8_BAR;
    if constexpr (Epi::AFTER_DRAIN) { E.fused(acc, cur, wr, wc, fr, fq, lds, wid, lane); S.done(cur); }
#undef PG8_SA
#undef PG8_SB
#undef PG8_STAGE
#undef PG8_LDA
#undef PG8_LDB
#undef PG8_MMA
#undef PG8_WAIT_V
#undef PG8_WAIT_L
#undef PG8_BAR
#undef PG8_SCHED
}
template <class Epi, class Sched>
__device__ __forceinline__ void gemm_phase_gather(PG8_LAS unsigned char* lds, const Gemm g, const Sched& S, const Epi& E, const int tid, const int* tok) {
    const int wid = __builtin_amdgcn_readfirstlane(tid >> 6), lane = tid & 63, wr = wid >> 2, wc = wid & 3, fr = lane & 15, fq = lane >> 4;
    const int K = g.K, nt = K / BK;
    unsigned voffB[2];
#pragma unroll
    for (int i = 0; i < 2; ++i) { int R, C; stage_rc(tid * 16 + i * 8192, R, C); const int Rb = Epi::PERM ? ((R & ~31) + perm32(R & 31)) : R; voffB[i] = (unsigned)(Rb * K + C) * 2u; }
#define PG8_RA(i) ({ int R_, C_; stage_rc(tid * 16 + (i) * 8192, R_, C_); R_; })
#define PG8_CA2(i) ({ int R_, C_; stage_rc(tid * 16 + (i) * 8192, R_, C_); (unsigned)C_ * 2u; })
    const size_t kstep = (size_t)(BK * 2);
    const size_t hstep = (size_t)HALF * K * 2;
    const size_t tstep = 2 * hstep;
    const unsigned ldsw = (unsigned)wid * 1024u;
    const int aoff = lds_byte(wr * 64 + fr, fq * 8), boff = lds_byte(wc * 32 + fr, fq * 8);
#define PG8_SA(b, h) (((b) * 2 + (h)) * HTB)
#define PG8_SB(b, h) ((4 + (b) * 2 + (h)) * HTB)
#define PG8_STAGE(bufoff, gbase, voff) do { _Pragma("unroll") for (int _i = 0; _i < 2; ++_i) \
        __builtin_amdgcn_global_load_lds((const unsigned*)((const char*)(gbase) + (voff)[_i]), (PG8_LAS unsigned*)(lds + (bufoff) + ldsw + _i * 8192), 16, 0, 0); } while (0)
#define PG8_STAGE_A(bufoff, kptr, hf, nx) do { _Pragma("unroll") for (int _i = 0; _i < 2; ++_i) { const unsigned _o = (nx) ? (unsigned)idN[(hf) * 2 + _i] : gC[hf][_i]; \
        __builtin_amdgcn_global_load_lds((const unsigned*)((const char*)(kptr) + _o), (PG8_LAS unsigned*)(lds + (bufoff) + ldsw + _i * 8192), 16, 0, 0); } } while (0)
#define PG8_LDA(dst, b, h) do { _Pragma("unroll") for (int m = 0; m < 4; ++m) _Pragma("unroll") for (int k = 0; k < 2; ++k) dst[m][k] = *(const PG8_LAS bf16x8*)(lds + PG8_SA(b, h) + aoff + m * 2048 + k * 1024); } while (0)
#define PG8_LDB(dst, b, h) do { _Pragma("unroll") for (int n = 0; n < 2; ++n) _Pragma("unroll") for (int k = 0; k < 2; ++k) dst[n][k] = *(const PG8_LAS bf16x8*)(lds + PG8_SB(b, h) + boff + n * 2048 + k * 1024); } while (0)
#define PG8_MMA(ai, bj, At, Bt) do { __builtin_amdgcn_s_setprio(1); _Pragma("unroll") for (int m = 0; m < 4; ++m) _Pragma("unroll") for (int n = 0; n < 2; ++n) _Pragma("unroll") for (int k = 0; k < 2; ++k) \
        acc[ai][bj][m][n] = __builtin_amdgcn_mfma_f32_16x16x32_bf16(Bt[n][k], At[m][k], acc[ai][bj][m][n], 0, 0, 0); __builtin_amdgcn_s_setprio(0); } while (0)
#define PG8_WAIT_V(n) asm volatile("s_waitcnt vmcnt(" #n ")" ::: "memory")
#define PG8_WAIT_L(n) asm volatile("s_waitcnt lgkmcnt(" #n ")" ::: "memory")
#define PG8_BAR __builtin_amdgcn_s_barrier()
#define PG8_SCHED __builtin_amdgcn_sched_barrier(0)
    Unit cur, nxt; int ui = 0;
    if (!S.next(0, cur)) return;
    f32x4 acc[2][2][4][2];
#pragma unroll
    for (int a = 0; a < 2; ++a)
#pragma unroll
        for (int b = 0; b < 2; ++b)
#pragma unroll
            for (int m = 0; m < 4; ++m)
#pragma unroll
                for (int n = 0; n < 2; ++n) acc[a][b][m][n] = (f32x4){0.f, 0.f, 0.f, 0.f};
    bf16x8 At[4][2], B0[2][2], B1[2][2];
    unsigned gC[2][2]; int idN[4];
#pragma unroll
    for (int hf = 0; hf < 2; ++hf)
#pragma unroll
        for (int i = 0; i < 2; ++i) { gC[hf][i] = (unsigned)tok[cur.pm * BM + hf * HALF + PG8_RA(i)] * (unsigned)(K * 2) + PG8_CA2(i); idN[hf * 2 + i] = (int)gC[hf][i]; }
    const char* cA = (const char*)g.A; const char* cB = (const char*)g.Bt + (size_t)cur.pn * tstep;
    PG8_STAGE(PG8_SB(0, 0), cB, voffB); PG8_STAGE(PG8_SB(0, 1), cB + hstep, voffB); PG8_STAGE_A(PG8_SA(0, 0), cA, 0, false); PG8_STAGE_A(PG8_SA(0, 1), cA, 1, false);
    if (wr == 1) PG8_BAR;
    PG8_WAIT_V(2); PG8_BAR;
    PG8_STAGE(PG8_SB(1, 0), cB + kstep, voffB); PG8_STAGE_A(PG8_SA(1, 0), cA + kstep, 0, false); PG8_STAGE(PG8_SB(1, 1), cB + hstep + kstep, voffB);
    PG8_WAIT_V(6); PG8_BAR;
    for (;;) {
        const bool has_next = S.next(ui + 1, nxt);
        const char* nB = has_next ? (const char*)g.Bt + (size_t)nxt.pn * tstep : cB;
        if (has_next) {
            const int* p0 = tok + nxt.pm * BM + PG8_RA(0); const int* p1 = tok + nxt.pm * BM + PG8_RA(1); const int* p2 = p0 + HALF; const int* p3 = p1 + HALF;
            asm volatile("global_load_dword %0, %4, off\n\tglobal_load_dword %1, %5, off\n\tglobal_load_dword %2, %6, off\n\tglobal_load_dword %3, %7, off\n\ts_waitcnt vmcnt(0)"
                         : "=&v"(idN[0]), "=&v"(idN[1]), "=&v"(idN[2]), "=&v"(idN[3]) : "v"(p0), "v"(p1), "v"(p2), "v"(p3) : "memory");
        }
        for (int t = 0; t < nt; t += 2) {
            const bool last = (t == nt - 2); const bool nx = last && has_next;
            if (nx) {
#pragma unroll
                for (int j = 0; j < 4; ++j) idN[j] = (int)((unsigned)idN[j] * (unsigned)(K * 2) + PG8_CA2(j & 1));
            }
            const char* a1 = cA + (size_t)(t + 1) * kstep;
            const char* a2 = last ? cA : cA + (size_t)(t + 2) * kstep; const char* b2 = last ? nB : cB + (size_t)(t + 2) * kstep;
            const char* a3 = a2 + kstep; const char* b3 = b2 + kstep;
            PG8_LDB(B0, 0, 0); PG8_LDB(B1, 0, 1); PG8_SCHED; PG8_LDA(At, 0, 0); PG8_STAGE_A(PG8_SA(1, 1), a1, 1, false);
            PG8_WAIT_V(8); PG8_WAIT_L(0); PG8_BAR; PG8_MMA(0, 0, At, B0); PG8_MMA(0, 1, At, B1); PG8_BAR; PG8_SCHED;
            PG8_LDA(At, 0, 1); PG8_STAGE(PG8_SB(0, 0), b2, voffB); PG8_STAGE(PG8_SB(0, 1), b2 + hstep, voffB); PG8_STAGE_A(PG8_SA(0, 0), a2, 0, nx);
            PG8_WAIT_V(8); PG8_WAIT_L(0); PG8_BAR; PG8_MMA(1, 0, At, B0); PG8_MMA(1, 1, At, B1); PG8_BAR; PG8_SCHED;
            PG8_LDB(B0, 1, 0); PG8_LDB(B1, 1, 1); PG8_SCHED; PG8_LDA(At, 1, 0); PG8_STAGE_A(PG8_SA(0, 1), a2, 1, nx);
            PG8_WAIT_V(8); PG8_WAIT_L(0); PG8_BAR; PG8_MMA(0, 0, At, B0); PG8_MMA(0, 1, At, B1); PG8_BAR; PG8_SCHED;
            PG8_LDA(At, 1, 1); PG8_STAGE(PG8_SB(1, 0), b3, voffB); PG8_STAGE(PG8_SB(1, 1), b3 + hstep, voffB); PG8_STAGE_A(PG8_SA(1, 0), a3, 0, nx);
            PG8_WAIT_V(8); PG8_WAIT_L(0); PG8_BAR; PG8_MMA(1, 0, At, B0); PG8_MMA(1, 1, At, B1); PG8_BAR; PG8_SCHED;
        }
        if (wr == 0) PG8_BAR;
        E(acc, cur, wr, wc, fr, fq);
        if (!has_next) break;
#pragma unroll
        for (int a = 0; a < 2; ++a)
#pragma unroll
            for (int b = 0; b < 2; ++b)
#pragma unroll
                for (int m = 0; m < 4; ++m)
#pragma unroll
                    for (int n = 0; n < 2; ++n) acc[a][b][m][n] = (f32x4){0.f, 0.f, 0.f, 0.f};
        cur = nxt; cB = nB; ++ui;
#pragma unroll
        for (int hf = 0; hf < 2; ++hf)
#pragma unroll
            for (int i = 0; i < 2; ++i) gC[hf][i] = (unsigned)idN[hf * 2 + i];
        if (wr == 1) PG8_BAR;
    }
    PG8_WAIT_V(0);
    PG8_BAR;
#undef PG8_SA
#undef PG8_SB
#undef PG8_STAGE
#undef PG8_STAGE_A
#undef PG8_RA
#undef PG8_CA2
#undef PG8_LDA
#undef PG8_LDB
#undef PG8_MMA
#undef PG8_WAIT_V
#undef PG8_WAIT_L
#undef PG8_BAR
#undef PG8_SCHED
}
}
constexpr int DM = 1024, NBATCH = 16, SEQL = 4096, CTXL = 256, SB = CTXL + SEQL  , TT = NBATCH * SB  , NRT = TT / 256  ;
constexpr int INW = 2704, INWP = 2816;
constexpr int C_Z = 0, C_XBC = 512, C_DT = 1280, C_GQ = 1296, C_GK = 1552, C_GV = 1808, C_GR = 2064, C_GLR = 2320, C_CQ = 2352, C_CKV = 2544, C_KPE = 2672;
constexpr float EPS = 1e-6f;
constexpr int NWAVES = 8, NTHREADS = 512;
enum { I_X = 0, I_C, I_CTX, I_CCTX, I_WMOD, I_BMOD, I_NORM1, I_WIN, I_CONVW, I_CONVB, I_ALOG, I_DTB, I_SSDD, I_SSDNW, I_GUPW, I_GUPB, I_GLANW, I_QNW, I_WUQ, I_KVNW, I_WUKV, I_WOUT, I_NORM2,
       I_RW, I_RB, I_W1, I_B1, I_W2, I_B2, I_FINW, N_IN };
constexpr size_t MiB = 1u << 20;
constexpr size_t WS_CTL = 0, CTL_ZERO_BYTES = 1 * MiB;
constexpr size_t WS_MOD = 1 * MiB;
constexpr size_t WS_ROPE = 1 * MiB + 960 * 1024;
constexpr size_t WS_META = 1 * MiB + 980 * 1024;
constexpr size_t WS_WUQT = 2 * MiB;
constexpr size_t WS_WUKVT = 2 * MiB + 512 * 1024;
constexpr size_t WS_WOUTT = 4 * MiB;
constexpr size_t WS_WINT = 8 * MiB;
constexpr size_t WS_W1T = 20 * MiB;
constexpr size_t WS_W2T = 148 * MiB;
constexpr size_t WS_H = 212 * MiB;
constexpr size_t WS_ACT1 = 484 * MiB;
constexpr size_t WS_ARENA = 620 * MiB;
constexpr size_t WS_COLS = WS_ARENA;
constexpr size_t WS_XBC = WS_ARENA + 374 * MiB;
constexpr size_t WS_DT = WS_ARENA + 476 * MiB;
constexpr size_t WS_G = WS_ARENA + 481 * MiB;
constexpr size_t WS_AQ = WS_ARENA + 617 * MiB;
constexpr size_t WS_AKV = WS_ARENA + 651 * MiB;
constexpr size_t WS_QRAW = WS_ARENA + 685 * MiB;
constexpr size_t WS_KV = WS_ARENA + 753 * MiB;
constexpr size_t WS_KVT = WS_ARENA + 821 * MiB;
constexpr size_t WS_QF = WS_ARENA + 889 * MiB;
constexpr size_t WS_KF = WS_ARENA + 940 * MiB;
constexpr size_t WS_YF = WS_ARENA + 991 * MiB;
constexpr size_t WS_YB = WS_ARENA + 1059 * MiB;
constexpr size_t WS_OF = WS_ARENA + 1127 * MiB;
constexpr size_t WS_OB = WS_ARENA + 1161 * MiB;
constexpr size_t WS_MODP = WS_ARENA;
constexpr int MAXSLOT = 1120 * 256;
constexpr size_t WS_XG = WS_ARENA;
constexpr size_t WS_ACTB = WS_ARENA + 560 * MiB;
constexpr size_t WS_TOKE = WS_ARENA + 1120 * MiB;
constexpr size_t WS_TOKP = WS_ARENA + 1122 * MiB;
constexpr size_t WS_TOKW = WS_ARENA + 1124 * MiB;
constexpr size_t WS_WGCNT = WS_ARENA + 1126 * MiB;
constexpr size_t WS_TOKS = WS_ARENA + 1128 * MiB;
constexpr size_t WS_STOK = WS_ARENA + 1130 * MiB;
constexpr size_t WS_END = WS_ARENA + 1428 * MiB;
constexpr int CW_BAR = 4096;
constexpr int CW_AQ = 8192;
constexpr int CW_ASM = 8192 + 1024;
constexpr int RING_BYTES = 131072, LDSCTL_OFF = RING_BYTES, LDS_BYTES = 147456;
constexpr int MISC_BAR = 8;
constexpr int MISC_Q = 16;
constexpr int MISC_CNT = 32;
constexpr int MISC_SB = 64;

#define GAS __attribute__((address_space(1)))
#define LAS __attribute__((address_space(3)))
typedef unsigned short bf16;
typedef unsigned v4u __attribute__((ext_vector_type(4)));
typedef unsigned v2u __attribute__((ext_vector_type(2)));
typedef float f32x4 __attribute__((ext_vector_type(4)));
typedef short bf16x8 __attribute__((ext_vector_type(8)));
#define LDS_WAIT() asm volatile("s_waitcnt lgkmcnt(0)" ::: "memory")

__device__ __forceinline__ float bf2f(unsigned v) { return __uint_as_float(v << 16); }
__device__ __forceinline__ float bflo(unsigned w) { return __uint_as_float(w << 16); }
__device__ __forceinline__ float bfhi(unsigned w) { return __uint_as_float(w & 0xffff0000u); }
__device__ __forceinline__ unsigned f2bf(float f) { unsigned u = __float_as_uint(f); return (u + 0x7fffu + ((u >> 16) & 1u)) >> 16; }
typedef float f32x2_t __attribute__((ext_vector_type(2))); typedef __bf16 bf16x2_t __attribute__((ext_vector_type(2)));
__device__ __forceinline__ unsigned pk2(float lo, float hi) { const f32x2_t v = {lo, hi}; const bf16x2_t b = __builtin_convertvector(v, bf16x2_t); return __builtin_bit_cast(unsigned, b); }
__device__ __forceinline__ float wave_sum(float v) {
#pragma unroll
    for (int o = 1; o < 64; o <<= 1) v += __shfl_xor(v, o);
    return v;
}
__device__ __forceinline__ float wave_max(float v) {
#pragma unroll
    for (int o = 1; o < 64; o <<= 1) v = fmaxf(v, __shfl_xor(v, o));
    return v;
}
__device__ __forceinline__ float siluf(float x) { return x / (1.0f + expf(-x)); }
__device__ __forceinline__ float fsilu(float x) { return x * __builtin_amdgcn_rcpf(1.0f + __expf(-x)); }
__device__ __forceinline__ float fsoftplus(float x) { const float e = __expf(-fabsf(x)); const float l1p = e < 0.03125f ? e * (1.0f - e * (0.5f - e * (0.33333334f - 0.25f * e))) : __logf(1.0f + e); return fmaxf(x, 0.f) + l1p; }
__device__ __forceinline__ float softplusf(float x) { return fmaxf(x, 0.f) + log1pf(expf(-fabsf(x))); }

struct Args { const float* in[N_IN]; float* out; unsigned char* ws; int ph_lo, ph_hi; };
constexpr int PTR_OFF = LDSCTL_OFF + 1024;

__device__ __forceinline__ void transpose_item(const float* W, int K, int N, bf16* WT, int Kp, int nblk, int item, LAS float* scr, int lane) {
    const int kb = item / nblk, nb = item - kb * nblk, k0 = 64 * kb, n0 = 32 * nb;
    const int n = n0 + (lane & 31);
#pragma unroll 8
    for (int i = 0; i < 32; ++i) { const int kk = 2 * i + (lane >> 5), k = k0 + kk; scr[kk * 33 + (lane & 31)] = (k < K && n < N) ? W[(size_t)k * N + n] : 0.f; }
    LDS_WAIT(); asm volatile("" ::: "memory");
    const int c = lane & 7;
#pragma unroll
    for (int j = 0; j < 4; ++j) { const int nn = (lane >> 3) + 8 * j; const LAS float* s = scr + (8 * c) * 33 + nn;
        v4u o; o.x = pk2(s[0 * 33], s[1 * 33]); o.y = pk2(s[2 * 33], s[3 * 33]); o.z = pk2(s[4 * 33], s[5 * 33]); o.w = pk2(s[6 * 33], s[7 * 33]);
        *(v4u*)(WT + (size_t)(n0 + nn) * Kp + k0 + 8 * c) = o; }
    LDS_WAIT(); asm volatile("" ::: "memory");
}
__device__ __forceinline__ void norm_mod_row(const float* hrow, const float* nw, const float* shift, const float* scale, bf16* orow, int lane) {
    const f32x4* xr = (const f32x4*)hrow + lane; f32x4 v[4]; float ss = 0.f;
#pragma unroll
    for (int q = 0; q < 4; ++q) { v[q] = xr[64 * q]; ss += (v[q].x * v[q].x + v[q].y * v[q].y) + (v[q].z * v[q].z + v[q].w * v[q].w); }
    const float rstd = rsqrtf(wave_sum(ss) * (1.0f / 1024.0f) + EPS);
#pragma unroll
    for (int q = 0; q < 4; ++q) { const int j4 = lane + 64 * q; const f32x4 w = ((const f32x4*)nw)[j4], sh = ((const f32x4*)shift)[j4], sc = ((const f32x4*)scale)[j4];
        const f32x4 o = (v[q] * rstd * w) * (sc + 1.0f) + sh; v2u p; p.x = pk2(o.x, o.y); p.y = pk2(o.z, o.w); ((v2u*)orow)[j4] = p; }
}
__device__ __forceinline__ const float* h0_row(const float* x, const float* ctx, int m) { const int b = m / SB, s = m - b * SB; return s < CTXL ? ctx + ((size_t)b * CTXL + s) * DM : x + ((size_t)b * SEQL + (s - CTXL)) * DM; }
#define XB_TMO      128
#define XB_XCNT(j)  (256  + 64 * (j))
#define XB_XSUB(j)  (1280 + 64 * (j))
#define XB_XGEN(j)  (2304 + 64 * (j))
#define XB_TOP      3328
#define XB_TOPGEN   3392
#define XCD_BAR_WORDS 3456
#define XB_SPIN_CAP (1u << 22)

__device__ __forceinline__ unsigned xb_ld(unsigned* p)              { return __hip_atomic_load(p, __ATOMIC_RELAXED, __HIP_MEMORY_SCOPE_AGENT); }
__device__ __forceinline__ unsigned xb_add(unsigned* p, unsigned v) { return __hip_atomic_fetch_add(p, v, __ATOMIC_RELAXED, __HIP_MEMORY_SCOPE_AGENT); }
__device__ __forceinline__ unsigned xb_xcc_id() { return (unsigned)__builtin_amdgcn_s_getreg((3 << 11) | 20) & 0xFu; }
#define XB_SPIN(cond, bar) do { unsigned _sp = 0; while (cond) { __builtin_amdgcn_s_sleep(1); \
    if ((++_sp & 255u) == 0u) { if (xb_ld(&(bar)[XB_TMO])) break; if (_sp > XB_SPIN_CAP) { atomicAdd(&(bar)[XB_TMO], 1u); break; } } } } while (0)

struct XcdBarrier {
    unsigned* bar; unsigned x;
    volatile LAS unsigned* st;
};

__device__ __forceinline__ XcdBarrier xcd_barrier_post(unsigned* bar, volatile LAS unsigned* st) {
    XcdBarrier b; b.bar = bar; b.x = xb_xcc_id(); b.st = st;
    if (threadIdx.x == 0) (void)xb_add(&bar[XB_XCNT(b.x)], 1u);
    return b;
}
__device__ __forceinline__ void xcd_barrier_complete(unsigned* bar, unsigned x, unsigned& nloc, unsigned& nx) {
    const unsigned G = gridDim.x * gridDim.y * gridDim.z;
    unsigned sum, cnt, mine, sp = 0u;
    for (;;) {
        sum = 0u; cnt = 0u; mine = 0u;
#pragma unroll
        for (unsigned j = 0; j < 16; ++j) { const unsigned c = xb_ld(&bar[XB_XCNT(j)]); sum += c; cnt += (c > 0u) ? 1u : 0u; mine = (j == x) ? c : mine; }
        if (sum == G) break;
        __builtin_amdgcn_s_sleep(1);
        if ((++sp & 255u) == 0u) { if (xb_ld(&bar[XB_TMO])) break; if (sp > XB_SPIN_CAP) { atomicAdd(&bar[XB_TMO], 1u); break; } }
    }
    nloc = mine > 0u ? mine : 1u; nx = cnt > 0u ? cnt : 1u;
}

__device__ __forceinline__ void xcd_barrier(const XcdBarrier& b) {
    asm volatile("s_waitcnt vmcnt(0)" ::: "memory");
    __syncthreads();
    if (threadIdx.x == 0) {
        unsigned* bar = b.bar;
        __builtin_amdgcn_s_waitcnt(0);
        unsigned nloc = b.st[0], nx = b.st[1];
        if (nloc == 0u) { xcd_barrier_complete(bar, b.x, nloc, nx); b.st[0] = nloc; b.st[1] = nx; }
        const unsigned old = xb_add(&bar[XB_XSUB(b.x)], 1u);
        const unsigned gen = old / nloc;
        if (old + 1u == (gen + 1u) * nloc) {
            __builtin_amdgcn_fence(__ATOMIC_RELEASE, "agent");
            asm volatile("s_waitcnt vmcnt(0)" ::: "memory");
            const unsigned og = xb_add(&bar[XB_TOP], 1u);
            const unsigned tg = og / nx;
            if (og + 1u == (tg + 1u) * nx) xb_add(&bar[XB_TOPGEN], 1u);
            else XB_SPIN(xb_ld(&bar[XB_TOPGEN]) == tg, bar);
            __builtin_amdgcn_fence(__ATOMIC_ACQUIRE, "agent");
            xb_add(&bar[XB_XGEN(b.x)], 1u);
            asm volatile("s_waitcnt vmcnt(0)" ::: "memory");
        } else {
            XB_SPIN(xb_ld(&bar[XB_XGEN(b.x)]) == gen, bar);
            __builtin_amdgcn_fence(__ATOMIC_ACQUIRE, "agent");
            asm volatile("s_waitcnt vmcnt(0)" ::: "memory");
        }
    }
    __syncthreads();
}
struct Ctx { LAS unsigned char* lds; volatile LAS unsigned* MISC; GAS unsigned char* ws; int tid, lane, wave, G, bid; };
__device__ __forceinline__ const float* in_ptr(const Ctx& C, int i) {
    const volatile LAS unsigned* P = (const volatile LAS unsigned*)(C.lds + PTR_OFF) + 2 * i;
    const unsigned lo = __builtin_amdgcn_readfirstlane(P[0]), hi = __builtin_amdgcn_readfirstlane(P[1]);
    return (const float*)(const GAS float*)(((unsigned long long)hi << 32) | lo);
}
#define IN_(i) in_ptr(C, (i))

__device__ __forceinline__ void ph_g0(const Args& A, const Ctx& C) { const float* const p_I_C = IN_(I_C); const float* const p_I_CCTX = IN_(I_CCTX); const float* const p_I_WIN = IN_(I_WIN); const float* const p_I_WMOD = IN_(I_WMOD); const float* const p_I_WOUT = IN_(I_WOUT); const float* const p_I_WUKV = IN_(I_WUKV); const float* const p_I_WUQ = IN_(I_WUQ);
    if (C.bid < 192) {
        const int l = C.bid / 96, rem = C.bid % 96, cb = rem >> 3, s = rem & 7, i0 = s * 128;
        LAS float* sc = (LAS float*)C.lds;
        for (int idx = C.tid; idx < 17 * 128; idx += NTHREADS) { const int r = idx >> 7, i = idx & 127; const float cv = r < 16 ? p_I_C[r * 1024 + i0 + i] : p_I_CCTX[i0 + i]; sc[idx] = siluf(cv); }
        __syncthreads();
        const int j = cb * 512 + C.tid; float acc[17];
#pragma unroll
        for (int r = 0; r < 17; ++r) acc[r] = 0.f;
        const float* wm = p_I_WMOD + ((size_t)l * 1024 + i0) * 6144 + j;
        for (int i = 0; i < 128; ++i) { const float w = wm[(size_t)i * 6144];
#pragma unroll
            for (int r = 0; r < 17; ++r) acc[r] += sc[r * 128 + i] * w; }
        float* mp = (float*)(C.ws + WS_MODP) + ((size_t)(s * 2 + l) * 17) * 6144 + j;
#pragma unroll
        for (int r = 0; r < 17; ++r) mp[(size_t)r * 6144] = acc[r];
        __syncthreads();
    }
    if (C.bid == C.G - 1) {
        const int pos = C.tid >> 3, i = C.tid & 7;
        double f = 1.0; if (i >= 2) f *= 0.1; if (i >= 4) f *= 0.1; if (i >= 6) f *= 0.1; if (i & 1) f *= 0.31622776601683794;
        const double ang = (double)pos * f;
        const double n = __builtin_rint(ang * 0.63661977236758134);
        double r = __builtin_fma(-n, 1.5707963267948966, ang); r = __builtin_fma(-n, 6.123233995736766e-17, r);
        const double r2 = r * r;
        double sn = 1.0 / 355687428096000.0;
        sn = sn * r2 - 1.0 / 1307674368000.0; sn = sn * r2 + 1.0 / 6227020800.0; sn = sn * r2 - 1.0 / 39916800.0; sn = sn * r2 + 1.0 / 362880.0; sn = sn * r2 - 1.0 / 5040.0; sn = sn * r2 + 1.0 / 120.0; sn = sn * r2 - 1.0 / 6.0; sn = sn * r2 + 1.0; sn *= r;
        double cs = 1.0 / 20922789888000.0;
        cs = cs * r2 - 1.0 / 87178291200.0; cs = cs * r2 + 1.0 / 479001600.0; cs = cs * r2 - 1.0 / 3628800.0; cs = cs * r2 + 1.0 / 40320.0; cs = cs * r2 - 1.0 / 720.0; cs = cs * r2 + 1.0 / 24.0; cs = cs * r2 - 0.5; cs = cs * r2 + 1.0;
        const int q = ((int)n) & 3;
        const double c_ = q == 0 ? cs : q == 1 ? -sn : q == 2 ? -cs : sn;
        const double s_ = q == 0 ? sn : q == 1 ? cs : q == 2 ? -sn : -cs;
        float* rt = (float*)(C.ws + WS_ROPE); rt[C.tid * 2] = (float)c_; rt[C.tid * 2 + 1] = (float)s_;
    }
    LAS float* scr = (LAS float*)(C.lds + C.wave * 16384);
    const int gw = C.bid * NWAVES + C.wave, NGW = C.G * NWAVES;
    for (int it = gw; it < 4096; it += NGW) {
        const int l = it >> 11; int r = it & 2047;
        if (r < 1408) { transpose_item(p_I_WIN + (size_t)l * 1024 * INW, 1024, INW, (bf16*)(C.ws + WS_WINT) + (size_t)l * INWP * 1024, 1024, 88, r, scr, C.lane); continue; } r -= 1408;
        if (r < 512) { transpose_item(p_I_WOUT + (size_t)l * 1024 * 1024, 1024, 1024, (bf16*)(C.ws + WS_WOUTT) + (size_t)l * 1024 * 1024, 1024, 32, r, scr, C.lane); continue; } r -= 512;
        if (r < 64) { transpose_item(p_I_WUQ + (size_t)l * 192 * 384, 192, 384, (bf16*)(C.ws + WS_WUQT) + (size_t)l * 512 * 256, 256, 16, r, scr, C.lane); continue; } r -= 64;
        transpose_item(p_I_WUKV + (size_t)l * 128 * 512, 128, 512, (bf16*)(C.ws + WS_WUKVT) + (size_t)l * 512 * 256, 256, 16, r, scr, C.lane);
    }
}
__device__ __forceinline__ void convert_experts(const Args& A, const Ctx& C, int l) { const float* const p_I_W1 = IN_(I_W1); const float* const p_I_W2 = IN_(I_W2);
    LAS unsigned* T = (LAS unsigned*)C.lds;
    const int tid = C.tid, n4 = (tid & 63) * 4, kq = tid >> 6;
    for (int it = C.bid; it < 4096 + 2048; it += C.G) {
        const float* W; bf16* WT; int N, kb, nb;
        if (it < 4096) { const int e = it >> 7, r = it & 127; kb = r >> 3; nb = r & 7; N = 2048; W = p_I_W1 + ((size_t)l * 32 + e) * 1024 * 2048; WT = (bf16*)(C.ws + WS_W1T) + (size_t)e * 2048 * 1024; }
        else { const int i2 = it - 4096, e = i2 >> 6, r = i2 & 63; kb = r >> 2; nb = r & 3; N = 1024; W = p_I_W2 + ((size_t)l * 32 + e) * 1024 * 1024; WT = (bf16*)(C.ws + WS_W2T) + (size_t)e * 1024 * 1024; }
        const float* src = W + (size_t)(kb * 64) * N + nb * 256 + n4;
        f32x4 a[4], b[4];
#pragma unroll
        for (int i = 0; i < 4; ++i) { const int kp = kq + 8 * i; a[i] = *(const f32x4*)(src + (size_t)(2 * kp) * N); b[i] = *(const f32x4*)(src + (size_t)(2 * kp + 1) * N); }
        __syncthreads();
#pragma unroll
        for (int i = 0; i < 4; ++i) { const int kp = kq + 8 * i; T[(n4 + 0) * 33 + kp] = pk2(a[i].x, b[i].x); T[(n4 + 1) * 33 + kp] = pk2(a[i].y, b[i].y); T[(n4 + 2) * 33 + kp] = pk2(a[i].z, b[i].z); T[(n4 + 3) * 33 + kp] = pk2(a[i].w, b[i].w); }
        __syncthreads();
        const int c = tid & 7, r0 = tid >> 3;
#pragma unroll
        for (int ps = 0; ps < 4; ++ps) { const int n = r0 + 64 * ps; const LAS unsigned* t = T + n * 33 + 4 * c; v4u o; o.x = t[0]; o.y = t[1]; o.z = t[2]; o.w = t[3];
            *(v4u*)(WT + (size_t)(nb * 256 + n) * 1024 + kb * 64 + 8 * c) = o; }
    }
    __syncthreads();
}
__device__ __forceinline__ void ph_g1(const Args& A, const Ctx& C) { const float* const p_I_BMOD = IN_(I_BMOD);
    const float* mp = (const float*)(C.ws + WS_MODP); float* mod = (float*)(C.ws + WS_MOD);
    for (int idx = C.bid * NTHREADS + C.tid; idx < 2 * 17 * 6144; idx += C.G * NTHREADS) {
        const int l = idx / (17 * 6144), j = idx % 6144; float s = p_I_BMOD[l * 6144 + j];
#pragma unroll
        for (int p = 0; p < 8; ++p) s += mp[(size_t)p * (2 * 17 * 6144) + idx];
        mod[idx] = s;
    }
}
__device__ __forceinline__ void ph_g2(const Args& A, const Ctx& C) { const float* const p_I_CTX = IN_(I_CTX); const float* const p_I_NORM1 = IN_(I_NORM1); const float* const p_I_X = IN_(I_X);
    const int gw = C.bid * NWAVES + C.wave, NGW = C.G * NWAVES, lane = C.lane; const float* mod = (const float*)(C.ws + WS_MOD); bf16* uo = (bf16*)(C.ws + WS_ACT1);
    f32x4 nw[4];
#pragma unroll
    for (int q = 0; q < 4; ++q) nw[q] = ((const f32x4*)p_I_NORM1)[lane + 64 * q];
    f32x4 cv[2][4], nv[2][4];
#define G2_LOAD(m_, v_) do { _Pragma("unroll") for (int r = 0; r < 2; ++r) { const int mm = (m_) + r * NGW; if (mm < TT) { const f32x4* xr = (const f32x4*)h0_row(p_I_X, p_I_CTX, mm) + lane; \
        _Pragma("unroll") for (int q = 0; q < 4; ++q) v_[r][q] = xr[64 * q]; } } } while (0)
    G2_LOAD(gw, cv);
    for (int m = gw; m < TT; m += 2 * NGW) {
        if (m + 2 * NGW < TT) G2_LOAD(m + 2 * NGW, nv);
        float ss[2];
#pragma unroll
        for (int r = 0; r < 2; ++r) { ss[r] = 0.f;
#pragma unroll
            for (int q = 0; q < 4; ++q) ss[r] += (cv[r][q].x * cv[r][q].x + cv[r][q].y * cv[r][q].y) + (cv[r][q].z * cv[r][q].z + cv[r][q].w * cv[r][q].w); }
#pragma unroll
        for (int o = 1; o < 64; o <<= 1) { ss[0] += __shfl_xor(ss[0], o); ss[1] += __shfl_xor(ss[1], o); }
#pragma unroll
        for (int r = 0; r < 2; ++r) { const int mm = m + r * NGW; if (mm < TT) { const int b = mm / SB, s = mm - b * SB; const float* mr = mod + (size_t)(s < CTXL ? 16 : b) * 6144; const float rstd = rsqrtf(ss[r] * (1.0f / 1024.0f) + EPS);
#pragma unroll
            for (int q = 0; q < 4; ++q) { const int j4 = lane + 64 * q; const f32x4 sh = ((const f32x4*)mr)[j4], sc = ((const f32x4*)(mr + 1024))[j4];
                const f32x4 o = (cv[r][q] * rstd * nw[q]) * (sc + 1.0f) + sh; v2u p; p.x = pk2(o.x, o.y); p.y = pk2(o.z, o.w); ((v2u*)(uo + (size_t)mm * DM))[j4] = p; } } }
#pragma unroll
        for (int r = 0; r < 2; ++r)
#pragma unroll
            for (int q = 0; q < 4; ++q) cv[r][q] = nv[r][q];
    }
#undef G2_LOAD
}
__device__ __forceinline__ void ph_prep(const Args& A, const Ctx& C, int l, int rep) { const float* const p_I_CONVB = IN_(I_CONVB); const float* const p_I_CONVW = IN_(I_CONVW); const float* const p_I_DTB = IN_(I_DTB); const float* const p_I_GUPB = IN_(I_GUPB); const float* const p_I_GUPW = IN_(I_GUPW); const float* const p_I_KVNW = IN_(I_KVNW); const float* const p_I_QNW = IN_(I_QNW);
    LAS float* gws = (LAS float*)C.lds;
    LAS float* cws = (LAS float*)(C.lds + 32768);
    for (int idx = C.tid; idx < 8192; idx += NTHREADS) gws[idx] = p_I_GUPW[l * 8192 + idx];
    for (int idx = C.tid; idx < 2304; idx += NTHREADS) cws[idx] = p_I_CONVW[l * 2304 + idx];
    for (int idx = C.tid; idx < 768; idx += NTHREADS) cws[2304 + idx] = p_I_CONVB[l * 768 + idx];
    __syncthreads();
    const bf16* cols = (const bf16*)(C.ws + WS_COLS);
    bf16* xbc = (bf16*)(C.ws + WS_XBC); float* dt = (float*)(C.ws + WS_DT); bf16* gg = (bf16*)(C.ws + WS_G); bf16* aq = (bf16*)(C.ws + WS_AQ); bf16* akv = (bf16*)(C.ws + WS_AKV);
    const int gw = C.bid * NWAVES + C.wave, NGW = C.G * NWAVES, lane = C.lane;
    const float dtb = lane < 16 ? p_I_DTB[l * 16 + lane] : 0.f;
    const f32x4 gb0 = *(const f32x4*)(p_I_GUPB + l * 512 + lane * 4), gb1 = *(const f32x4*)(p_I_GUPB + l * 512 + 256 + lane * 4);
    const f32x4 qnw = lane < 48 ? *(const f32x4*)(p_I_QNW + l * 192 + lane * 4) : (f32x4){0.f, 0.f, 0.f, 0.f}, kvnw = lane < 32 ? *(const f32x4*)(p_I_KVNW + l * 128 + lane * 4) : (f32x4){0.f, 0.f, 0.f, 0.f};
    v2u cx0[3], cxm[3], cxp[3], ccq, cckv; v4u cgl[4]; unsigned cdt;
    v2u nx0[3], nxm[3], nxp[3], ncq, nckv; v4u ngl[4]; unsigned ndt;
#define PREP_LOAD(m_, x0_, xm_, xp_, cq_, ckv_, gl_, dt_) do { const int b_ = (m_) / SB, s_ = (m_) - b_ * SB; const bool hp_ = (s_ != 0 && s_ != CTXL), hn_ = (s_ != CTXL - 1 && s_ != SB - 1); \
        const bf16* r_ = cols + (size_t)(m_) * INWP; \
        _Pragma("unroll") for (int ch = 0; ch < 3; ++ch) { const int c_ = ch * 256 + lane * 4; x0_[ch] = *(const v2u*)(r_ + C_XBC + c_); xm_[ch] = (v2u){0u, 0u}; xp_[ch] = (v2u){0u, 0u}; \
            if (hp_) xm_[ch] = *(const v2u*)(r_ - INWP + C_XBC + c_); if (hn_) xp_[ch] = *(const v2u*)(r_ + INWP + C_XBC + c_); } \
        dt_ = r_[C_DT + (lane & 15)]; { const v4u* g_ = (const v4u*)(r_ + C_GLR); gl_[0] = g_[0]; gl_[1] = g_[1]; gl_[2] = g_[2]; gl_[3] = g_[3]; } \
        cq_ = *(const v2u*)(r_ + C_CQ + (lane < 48 ? lane : 0) * 4); ckv_ = *(const v2u*)(r_ + C_CKV + (lane & 31) * 4); } while (0)
    if (gw < TT) PREP_LOAD(gw, cx0, cxm, cxp, ccq, cckv, cgl, cdt);
    for (int m = gw; m < TT; m += NGW) {
        const int mn = m + NGW;
        if (mn < TT) PREP_LOAD(mn, nx0, nxm, nxp, ncq, nckv, ngl, ndt);
#pragma unroll
        for (int ch = 0; ch < 3; ++ch) { const int c = ch * 256 + lane * 4; const v2u x0 = cx0[ch], xm = cxm[ch], xp = cxp[ch];
            const f32x4 w0 = *(const LAS f32x4*)(cws + c), w1 = *(const LAS f32x4*)(cws + 768 + c), w2 = *(const LAS f32x4*)(cws + 1536 + c), bb = *(const LAS f32x4*)(cws + 2304 + c);
            f32x4 v; v.x = w0.x * bflo(xm.x) + w1.x * bflo(x0.x) + w2.x * bflo(xp.x) + bb.x; v.y = w0.y * bfhi(xm.x) + w1.y * bfhi(x0.x) + w2.y * bfhi(xp.x) + bb.y;
            v.z = w0.z * bflo(xm.y) + w1.z * bflo(x0.y) + w2.z * bflo(xp.y) + bb.z; v.w = w0.w * bfhi(xm.y) + w1.w * bfhi(x0.y) + w2.w * bfhi(xp.y) + bb.w;
            v2u o; o.x = pk2(fsilu(v.x), fsilu(v.y)); o.y = pk2(fsilu(v.z), fsilu(v.w)); *(v2u*)(xbc + (size_t)m * 768 + c) = o; __builtin_amdgcn_sched_barrier(0); }
        if (lane < 16) dt[(size_t)m * 16 + lane] = fsoftplus(bf2f(cdt) + dtb);
#pragma unroll
        for (int dir = 0; dir < 2; ++dir) { const v4u q0 = cgl[2 * dir], q1 = cgl[2 * dir + 1];
            const unsigned gw32[8] = {q0.x, q0.y, q0.z, q0.w, q1.x, q1.y, q1.z, q1.w};
            f32x4 acc = dir ? gb1 : gb0;
#pragma unroll
            for (int r = 0; r < 16; ++r) { const unsigned w = gw32[r >> 1]; const float gv = (r & 1) ? bfhi(w) : bflo(w); acc += gv * *(const LAS f32x4*)(gws + (dir * 16 + r) * 256 + lane * 4); }
            f32x4 o; o.x = -fsoftplus(-acc.x) * 0.0625f; o.y = -fsoftplus(-acc.y) * 0.0625f; o.z = -fsoftplus(-acc.z) * 0.0625f; o.w = -fsoftplus(-acc.w) * 0.0625f;
            v2u ob; ob.x = pk2(o.x, o.y); ob.y = pk2(o.z, o.w); *(v2u*)(gg + (size_t)m * 512 + dir * 256 + lane * 4) = ob; __builtin_amdgcn_sched_barrier(0); }
        { float v0 = 0.f, v1 = 0.f, v2 = 0.f, v3 = 0.f, u0 = 0.f, u1 = 0.f, u2 = 0.f, u3 = 0.f;
          if (lane < 48) { v0 = bflo(ccq.x); v1 = bfhi(ccq.x); v2 = bflo(ccq.y); v3 = bfhi(ccq.y); }
          if (lane < 32) { u0 = bflo(cckv.x); u1 = bfhi(cckv.x); u2 = bflo(cckv.y); u3 = bfhi(cckv.y); }
          float sa = (v0 * v0 + v1 * v1) + (v2 * v2 + v3 * v3), sb = (u0 * u0 + u1 * u1) + (u2 * u2 + u3 * u3);
#pragma unroll
          for (int o = 1; o < 64; o <<= 1) { sa += __shfl_xor(sa, o); sb += __shfl_xor(sb, o); }
          const float ra = rsqrtf(sa * (1.0f / 192.0f) + EPS), rb = rsqrtf(sb * (1.0f / 128.0f) + EPS);
          v2u oa; oa.x = pk2(v0 * ra * qnw.x, v1 * ra * qnw.y); oa.y = pk2(v2 * ra * qnw.z, v3 * ra * qnw.w); *(v2u*)(aq + (size_t)m * 256 + lane * 4) = oa;
          v2u ob; ob.x = pk2(u0 * rb * kvnw.x, u1 * rb * kvnw.y); ob.y = pk2(u2 * rb * kvnw.z, u3 * rb * kvnw.w); *(v2u*)(akv + (size_t)m * 256 + lane * 4) = ob; }
#pragma unroll
        for (int ch = 0; ch < 3; ++ch) { cx0[ch] = nx0[ch]; cxm[ch] = nxm[ch]; cxp[ch] = nxp[ch]; }
        ccq = ncq; cckv = nckv; cdt = ndt;
#pragma unroll
        for (int q = 0; q < 4; ++q) cgl[q] = ngl[q];
    }
#undef PREP_LOAD
    __syncthreads();
    if (rep == 0) convert_experts(A, C, l);
}
struct AsmRow { v2u x, kk; float cs, sn; unsigned t1, t2, u1, u2; };
__device__ __forceinline__ void assemble_rows8(const Ctx& C, int m0) {
    const bf16* qraw = (const bf16*)(C.ws + WS_QRAW); const bf16* kv = (const bf16*)(C.ws + WS_KV); const bf16* cols = (const bf16*)(C.ws + WS_COLS);
    bf16* qf = (bf16*)(C.ws + WS_QF); bf16* kf = (bf16*)(C.ws + WS_KF); const float* rope = (const float*)(C.ws + WS_ROPE);
    const float QS = 0.10206207261596575f * 1.4426950408889634f;
    const int lane = C.lane, h = lane >> 4, d = (lane & 15) * 4, a = (lane >> 3) & 1, i = lane & 7;
    auto ld = [&](int m, AsmRow& r) {
        const int b = m / SB, s = m - b * SB; const bool lat = s >= CTXL; const int sp = s - CTXL, pos = a == 0 ? sp >> 6 : sp & 63;
        const bf16* q = qraw + (size_t)m * 512; const bf16* k = kv + (size_t)m * 512; const bf16* kpe = cols + (size_t)m * INWP + C_KPE;
        r.x = *(const v2u*)(q + h * 96 + d); r.kk = *(const v2u*)(k + h * 128 + d);
        r.cs = 1.f; r.sn = 0.f; if (lat) { const float2 t = *(const float2*)(rope + (pos * 8 + i) * 2); r.cs = t.x; r.sn = t.y; }
        r.t1 = q[h * 96 + 64 + a * 16 + i]; r.t2 = q[h * 96 + 64 + a * 16 + 8 + i];
        r.u1 = 0; r.u2 = 0; if (lane < 16) { r.u1 = kpe[a * 16 + i]; r.u2 = kpe[a * 16 + 8 + i]; } };
    auto fin = [&](int m, const AsmRow& r) {
        bf16* qo = qf + (size_t)m * 384; bf16* ko = kf + (size_t)m * 384;
        v2u o; o.x = pk2(bflo(r.x.x) * QS, bfhi(r.x.x) * QS); o.y = pk2(bflo(r.x.y) * QS, bfhi(r.x.y) * QS);
        *(v2u*)(qo + h * 96 + d) = o; *(v2u*)(ko + h * 96 + d) = r.kk;
        const float t1 = bf2f(r.t1), t2 = bf2f(r.t2);
        qo[h * 96 + 64 + a * 16 + i] = (bf16)f2bf((t1 * r.cs - t2 * r.sn) * QS); qo[h * 96 + 64 + a * 16 + 8 + i] = (bf16)f2bf((t2 * r.cs + t1 * r.sn) * QS);
        if (lane < 16) { const float u1 = bf2f(r.u1), u2 = bf2f(r.u2); const bf16 o1 = (bf16)f2bf(u1 * r.cs - u2 * r.sn), o2 = (bf16)f2bf(u2 * r.cs + u1 * r.sn);
#pragma unroll
            for (int hh = 0; hh < 4; ++hh) { ko[hh * 96 + 64 + a * 16 + i] = o1; ko[hh * 96 + 64 + a * 16 + 8 + i] = o2; } } };
#pragma unroll
    for (int g = 0; g < 2; ++g) { AsmRow r0, r1, r2, r3; const int m = m0 + 4 * g;
        ld(m, r0); ld(m + 1, r1); ld(m + 2, r2); ld(m + 3, r3);
        fin(m, r0); fin(m + 1, r1); fin(m + 2, r2); fin(m + 3, r3); }
}
__device__ __forceinline__ void ph_assemble(const Args& A, const Ctx& C, int l, int rep) {
    unsigned* head = (unsigned*)C.ws + CW_ASM + 64 * (2 * l + rep);
    for (;;) {
        unsigned blk = 0; if (C.lane == 0) blk = __hip_atomic_fetch_add(head, 1u, __ATOMIC_RELAXED, __HIP_MEMORY_SCOPE_AGENT);
        blk = __builtin_amdgcn_readfirstlane(blk);
        if (blk >= (unsigned)(TT / 8)) break;
        assemble_rows8(C, (int)blk * 8);
    }
}
constexpr int AT_KP = 224, AT_VP = 160, AT_KB = 64 * AT_KP  , AT_VB = 64 * AT_VP  ;
typedef short at_v4i16 __attribute__((ext_vector_type(4)));
__device__ __forceinline__ bf16x8 at_tr_frag(const LAS unsigned char* tile, int k0a, int k0b, int c0, int lane) {
    const int i = lane & 15, q = i >> 2, p = i & 3;
    const at_v4i16 lo = __builtin_amdgcn_ds_read_tr16_b64_v4i16((LAS at_v4i16*)(tile + (k0a + q) * AT_VP + (c0 + 4 * p) * 2));
    const at_v4i16 hi = __builtin_amdgcn_ds_read_tr16_b64_v4i16((LAS at_v4i16*)(tile + (k0b + q) * AT_VP + (c0 + 4 * p) * 2));
    bf16x8 r; r[0] = lo[0]; r[1] = lo[1]; r[2] = lo[2]; r[3] = lo[3]; r[4] = hi[0]; r[5] = hi[1]; r[6] = hi[2]; r[7] = hi[3]; return r;
}
__device__ __forceinline__ float xmax4(float x) {
    const auto r = __builtin_amdgcn_permlane16_swap(__float_as_uint(x), __float_as_uint(x), false, false); const float m = fmaxf(__uint_as_float(r[0]), __uint_as_float(r[1]));
    const auto q = __builtin_amdgcn_permlane32_swap(__float_as_uint(m), __float_as_uint(m), false, false); return fmaxf(__uint_as_float(q[0]), __uint_as_float(q[1]));
}
constexpr int AT_T = 128, AT_KB2 = AT_T * AT_KP  , AT_VB2 = AT_T * AT_VP  ;
template <int VAR>
__device__ __forceinline__ void attn_unit(const Ctx& C, int b, int h, int qt) {
    const bf16* qfp = (const bf16*)(C.ws + WS_QF); const bf16* kfp = (const bf16*)(C.ws + WS_KF); const bf16* kvp = (const bf16*)(C.ws + WS_KV); bf16* mix = (bf16*)(C.ws + (VAR ? WS_H : WS_ACT1));
    LAS unsigned char* lds = C.lds;
    const int tid = C.tid, lane = C.lane, wave = C.wave, fr = lane & 15, fq = lane >> 4;
    const size_t mb = (size_t)b * SB;
    const int nkt = (qt == 0 ? CTXL : SB) / AT_T;
    const size_t mq = mb + (size_t)qt * 256 + wave * 32;
    bf16x8 qf[2][3];
#pragma unroll
    for (int qb = 0; qb < 2; ++qb)
#pragma unroll
        for (int ks = 0; ks < 3; ++ks) qf[qb][ks] = *(const bf16x8*)(qfp + (mq + qb * 16 + fr) * 384 + h * 96 + ks * 32 + fq * 8);
    f32x4 ot[2][4];
#pragma unroll
    for (int qb = 0; qb < 2; ++qb)
#pragma unroll
        for (int d = 0; d < 4; ++d) ot[qb][d] = (f32x4){0.f, 0.f, 0.f, 0.f};
    float mrun[2] = {0.f, 0.f};
    f32x4 lacc[2]; lacc[0] = (f32x4){0.f, 0.f, 0.f, 0.f}; lacc[1] = lacc[0];
    const bf16x8 ones = __builtin_bit_cast(bf16x8, ((v4u){0x3f803f80u, 0x3f803f80u, 0x3f803f80u, 0x3f803f80u}));
    const bf16* kg[3]; int kl[3];
#pragma unroll
    for (int j = 0; j < 3; ++j) { const int id = tid + 512 * j, r = id / 12, cc = id - r * 12; kg[j] = kfp + (mb + r) * 384 + h * 96 + cc * 8; kl[j] = r * AT_KP + cc * 16; }
    const bf16* vg = kvp + (mb + (tid >> 3)) * 512 + h * 128 + 64 + (tid & 7) * 8; const int vl = (tid >> 3) * AT_VP + (tid & 7) * 16;
    v4u rk[3], rv[2];
#pragma unroll
    for (int j = 0; j < 3; ++j) rk[j] = *(const v4u*)kg[j];
    rv[0] = *(const v4u*)vg; rv[1] = *(const v4u*)(vg + 64 * 512);
    __syncthreads();
    if (wave < 4) __builtin_amdgcn_s_setprio(1);
#pragma unroll
    for (int j = 0; j < 3; ++j) *(LAS v4u*)(lds + kl[j]) = rk[j];
    *(LAS v4u*)(lds + 2 * AT_KB2 + vl) = rv[0]; *(LAS v4u*)(lds + 2 * AT_KB2 + 64 * AT_VP + vl) = rv[1];
    __syncthreads();
    for (int kt = 0; kt < nkt; ++kt) {
        const int cur = kt & 1; const bool more = kt + 1 < nkt;
#ifndef AT_STAGGER
#define AT_STAGGER 0
#endif
        if (AT_STAGGER && wave >= 4) __builtin_amdgcn_s_sleep(AT_STAGGER);
        if (more && VAR != 4) { const size_t ko = (size_t)(kt + 1) * AT_T;
#pragma unroll
            for (int j = 0; j < 3; ++j) rk[j] = *(const v4u*)(kg[j] + ko * 384);
            rv[0] = *(const v4u*)(vg + ko * 512); rv[1] = *(const v4u*)(vg + (ko + 64) * 512); }
#pragma unroll
        for (int hf = 0; hf < 2; ++hf) {
        const LAS unsigned char* kb_ = lds + cur * AT_KB2 + hf * 64 * AT_KP; const LAS unsigned char* vb_ = lds + 2 * AT_KB2 + cur * AT_VB2 + hf * 64 * AT_VP;
        f32x4 sa[2][4];
#pragma unroll
        for (int kb = 0; kb < 4; ++kb) {
            if (VAR == 3) { sa[0][kb] = (f32x4){-mrun[0], -mrun[0], -mrun[0], -mrun[0]}; sa[1][kb] = (f32x4){-mrun[1], -mrun[1], -mrun[1], -mrun[1]}; continue; }
            bf16x8 kfr[3];
#pragma unroll
            for (int ks = 0; ks < 3; ++ks) kfr[ks] = *(const LAS bf16x8*)(kb_ + (kb * 16 + fr) * AT_KP + ks * 64 + fq * 16);
#pragma unroll
            for (int qb = 0; qb < 2; ++qb) { const float nm = -mrun[qb]; f32x4 acc = (f32x4){nm, nm, nm, nm};
#pragma unroll
                for (int ks = 0; ks < 3; ++ks) acc = __builtin_amdgcn_mfma_f32_16x16x32_bf16(kfr[ks], qf[qb][ks], acc, 0, 0, 0);
                sa[qb][kb] = acc; }
        }
        bf16x8 pf[2][2];
#pragma unroll
        for (int qb = 0; qb < 2; ++qb) {
            if (VAR == 1) { pf[qb][0] = __builtin_bit_cast(bf16x8, ((v4u){pk2(sa[qb][0].x, sa[qb][0].y), pk2(sa[qb][0].z, sa[qb][0].w), pk2(sa[qb][1].x, sa[qb][1].y), pk2(sa[qb][1].z, sa[qb][1].w)})); pf[qb][1] = __builtin_bit_cast(bf16x8, ((v4u){pk2(sa[qb][2].x, sa[qb][2].y), pk2(sa[qb][2].z, sa[qb][2].w), pk2(sa[qb][3].x, sa[qb][3].y), pk2(sa[qb][3].z, sa[qb][3].w)})); continue; }
            float mx = fmaxf(fmaxf(sa[qb][0].x, sa[qb][0].y), fmaxf(sa[qb][0].z, sa[qb][0].w));
#pragma unroll
            for (int kb = 1; kb < 4; ++kb) mx = fmaxf(fmaxf(mx, fmaxf(sa[qb][kb].x, sa[qb][kb].y)), fmaxf(sa[qb][kb].z, sa[qb][kb].w));
            mx = fmaxf(mx, __shfl_xor(mx, 16)); mx = fmaxf(mx, __shfl_xor(mx, 32));
            if (__any(mx > 0.f)) {
                const float delta = fmaxf(mx, 0.f), alpha = __builtin_amdgcn_exp2f(-delta); mrun[qb] += delta; lacc[qb] *= alpha;
#pragma unroll
                for (int d = 0; d < 4; ++d) ot[qb][d] *= alpha;
#pragma unroll
                for (int kb = 0; kb < 4; ++kb) sa[qb][kb] -= delta;
            }
            unsigned pw[8];
#pragma unroll
            for (int kb = 0; kb < 4; ++kb) { const float p0 = __builtin_amdgcn_exp2f(sa[qb][kb].x), p1 = __builtin_amdgcn_exp2f(sa[qb][kb].y), p2 = __builtin_amdgcn_exp2f(sa[qb][kb].z), p3 = __builtin_amdgcn_exp2f(sa[qb][kb].w);
                pw[kb * 2] = pk2(p0, p1); pw[kb * 2 + 1] = pk2(p2, p3); }
#pragma unroll
            for (int kk = 0; kk < 2; ++kk) { const v4u w = (v4u){pw[kk * 4], pw[kk * 4 + 1], pw[kk * 4 + 2], pw[kk * 4 + 3]}; pf[qb][kk] = __builtin_bit_cast(bf16x8, w); }
        }
        if (VAR == 2) { ot[0][0] += __builtin_bit_cast(f32x4, pf[0][0]) + __builtin_bit_cast(f32x4, pf[0][1]); ot[1][0] += __builtin_bit_cast(f32x4, pf[1][0]) + __builtin_bit_cast(f32x4, pf[1][1]); lacc[0] += 1.0f; lacc[1] += 1.0f; continue; }
#pragma unroll
        for (int kk = 0; kk < 2; ++kk) { lacc[0] = __builtin_amdgcn_mfma_f32_16x16x32_bf16(ones, pf[0][kk], lacc[0], 0, 0, 0); lacc[1] = __builtin_amdgcn_mfma_f32_16x16x32_bf16(ones, pf[1][kk], lacc[1], 0, 0, 0); }
#pragma unroll
        for (int d = 0; d < 4; ++d)
#pragma unroll
            for (int kk = 0; kk < 2; ++kk) {
                const bf16x8 vf = at_tr_frag(vb_, kk * 32 + 4 * fq, kk * 32 + 16 + 4 * fq, d * 16, lane);
#pragma unroll
                for (int qb = 0; qb < 2; ++qb) ot[qb][d] = __builtin_amdgcn_mfma_f32_16x16x32_bf16(vf, pf[qb][kk], ot[qb][d], 0, 0, 0);
            }
        }
        if (more && VAR != 4) { const int nx = cur ^ 1;
#pragma unroll
            for (int j = 0; j < 3; ++j) *(LAS v4u*)(lds + nx * AT_KB2 + kl[j]) = rk[j];
            *(LAS v4u*)(lds + 2 * AT_KB2 + nx * AT_VB2 + vl) = rv[0]; *(LAS v4u*)(lds + 2 * AT_KB2 + nx * AT_VB2 + 64 * AT_VP + vl) = rv[1]; }
        __syncthreads();
    }
    __builtin_amdgcn_s_setprio(0);
#pragma unroll
    for (int qb = 0; qb < 2; ++qb) {
        const float inv = 1.0f / lacc[qb].x;
        bf16* orow = mix + (mq + qb * 16 + fr) * DM + 768 + h * 64 + 4 * fq;
#pragma unroll
        for (int d = 0; d < 4; ++d) { v2u o; o.x = pk2(ot[qb][d].x * inv, ot[qb][d].y * inv); o.y = pk2(ot[qb][d].z * inv, ot[qb][d].w * inv); *(v2u*)(orow + d * 16) = o; }
    }
}
__device__ __forceinline__ void attn_queue(const Ctx& C, int l, int rep) {
    unsigned* head = (unsigned*)C.ws + CW_AQ + 64 * (2 * l + rep);
    const int nunits = 1024 + (l == 0 ? 64 : 0);
    for (;;) {
        __syncthreads();
        if (C.tid == 0) C.MISC[MISC_Q] = __hip_atomic_fetch_add(head, 1u, __ATOMIC_RELAXED, __HIP_MEMORY_SCOPE_AGENT);
        __syncthreads();
        const int u = (int)C.MISC[MISC_Q];
        if (u >= nunits) break;
        const int ub = u < 1024 ? u >> 6 : (u - 1024) >> 2, uh = u < 1024 ? (u >> 4) & 3 : (u - 1024) & 3, uq = u < 1024 ? 1 + (u & 15) : 0;
#ifdef ATT_VAR
        if (rep == 0) attn_unit<0>(C, ub, uh, uq); else attn_unit<ATT_VAR>(C, ub, uh, uq);
#else
        attn_unit<0>(C, ub, uh, uq);
#endif
    }
}
#ifndef XSTATE
#define XSTATE 1
#endif
#ifndef XINTRA
#define XINTRA 1
#endif
constexpr int CH = 64, NCH = SB / CH  , NCTXCH = CTXL / CH  ;
constexpr int TP = 160;
constexpr int TILE_B = 64 * TP;
typedef short v4i16_t __attribute__((ext_vector_type(4)));
__device__ __forceinline__ bf16x8 tr_frag(const LAS unsigned char* tile, int k0a, int k0b, int c0, int lane) {
#ifdef TR_SLOW
    const int col = c0 + (lane & 15); const LAS unsigned short* t = (const LAS unsigned short*)tile; bf16x8 r;
#pragma unroll
    for (int e = 0; e < 4; ++e) { r[e] = (short)t[(k0a + e) * (TP / 2) + col]; r[4 + e] = (short)t[(k0b + e) * (TP / 2) + col]; }
    return r;
#else
    const int i = lane & 15, q = i >> 2, p = i & 3;
    const v4i16_t lo = __builtin_amdgcn_ds_read_tr16_b64_v4i16((LAS v4i16_t*)(tile + (k0a + q) * TP + (c0 + 4 * p) * 2));
    const v4i16_t hi = __builtin_amdgcn_ds_read_tr16_b64_v4i16((LAS v4i16_t*)(tile + (k0b + q) * TP + (c0 + 4 * p) * 2));
    bf16x8 r; r[0] = lo[0]; r[1] = lo[1]; r[2] = lo[2]; r[3] = lo[3]; r[4] = hi[0]; r[5] = hi[1]; r[6] = hi[2]; r[7] = hi[3]; return r;
#endif
}
__device__ __forceinline__ bf16x8 tr_frag_g4(const LAS unsigned char* tile, int k0a, int k0b, int g, int lane) {
    const int i = lane & 15, q = i >> 2, p = i & 3;
    const v4i16_t lo = __builtin_amdgcn_ds_read_tr16_b64_v4i16((LAS v4i16_t*)(tile + (k0a + q) * TP + (16 * p + 4 * g) * 2));
    const v4i16_t hi = __builtin_amdgcn_ds_read_tr16_b64_v4i16((LAS v4i16_t*)(tile + (k0b + q) * TP + (16 * p + 4 * g) * 2));
    bf16x8 r; r[0] = lo[0]; r[1] = lo[1]; r[2] = lo[2]; r[3] = lo[3]; r[4] = hi[0]; r[5] = hi[1]; r[6] = hi[2]; r[7] = hi[3]; return r;
}
__device__ __forceinline__ bf16x8 row_frag(const LAS unsigned char* tile, int row, int col) { return *(const LAS bf16x8*)(tile + row * TP + col * 2); }
__device__ __forceinline__ v4u scale8(v4u x, float s) { v4u o; o.x = pk2(bflo(x.x) * s, bfhi(x.x) * s); o.y = pk2(bflo(x.y) * s, bfhi(x.y) * s); o.z = pk2(bflo(x.z) * s, bfhi(x.z) * s); o.w = pk2(bflo(x.w) * s, bfhi(x.w) * s); return o; }
__device__ __forceinline__ v4u scale8v(v4u x, f32x4 a, f32x4 b) { v4u o; o.x = pk2(bflo(x.x) * a.x, bfhi(x.x) * a.y); o.y = pk2(bflo(x.y) * a.z, bfhi(x.y) * a.w); o.z = pk2(bflo(x.z) * b.x, bfhi(x.z) * b.y); o.w = pk2(bflo(x.w) * b.z, bfhi(x.w) * b.w); return o; }
__device__ __forceinline__ f32x4 exp4(f32x4 a) { return (f32x4){__expf(a.x), __expf(a.y), __expf(a.z), __expf(a.w)}; }
constexpr size_t WS_SST = WS_ARENA + 1200 * MiB;
constexpr size_t WS_GST = WS_ARENA + 1336 * MiB;
constexpr size_t WS_SEN = WS_ARENA + 991 * MiB;
constexpr size_t WS_GEN = WS_ARENA + 1127 * MiB;
constexpr size_t WS_SDEC = WS_ARENA + 1404 * MiB;
constexpr size_t WS_GDEC = WS_ARENA + 1405 * MiB;
static_assert(WS_GDEC + 5 * MiB <= WS_ARENA + 1428 * MiB, "arena");

template <bool SSD>
__device__ __forceinline__ void chunk_cums(const Ctx& C, int l, size_t m0, int h0, int nh, LAS float* cums, const float* alog) {
    if (SSD) {
        const int w = C.wave; if (w < 2 * nh) { const int hl = w >> 1, d = w & 1, h = h0 + hl, s = d == 0 ? C.lane : 63 - C.lane;
            const float dtv = ((const float*)(C.ws + WS_DT))[(m0 + s) * 16 + d * 8 + h]; float v = dtv * -expf(alog[l * 16 + d * 8 + h]);
#pragma unroll
            for (int o = 1; o < 64; o <<= 1) { const float t = __shfl_up(v, o); if (C.lane >= o) v += t; }
            cums[(d * nh + hl) * 64 + s] = v; cums[((2 + d) * nh + hl) * 64 + s] = dtv; }
    } else {
        if (C.tid < 128) { const int d = C.tid >> 6, k = C.tid & 63; const float* gp = (const float*)(C.ws + WS_G) + m0 * 512 + d * 256 + h0 * 64 + k; float acc = 0.f;
#pragma unroll 16
            for (int i = 0; i < 64; ++i) { const int s = d == 0 ? i : 63 - i; acc += gp[(size_t)s * 512]; cums[d * 4096 + s * 64 + k] = acc; } }
    }
}
template <bool SSD>
__device__ __forceinline__ void chunk_s1(const Ctx& C, int l, int unit, const float* alog) {
    constexpr int NH = SSD ? 8 : 4;
    const int b = unit / (NCH * NH), rem = unit - b * (NCH * NH), c = rem / NH, h = rem - c * NH; const size_t m0 = (size_t)b * SB + c * CH;
    LAS unsigned char* VT = C.lds; LAS unsigned char* KSF = C.lds + TILE_B; LAS unsigned char* KSB = C.lds + 2 * TILE_B; LAS float* cums = (LAS float*)(C.lds + 3 * TILE_B);
    __syncthreads();
    chunk_cums<SSD>(C, l, m0, h, 1, cums, alog);
    __syncthreads();
    { const int s = C.tid >> 3, sub = C.tid & 7; const size_t m = m0 + s;
      v4u vv, kk; v4u kf, kb;
      if (SSD) { const bf16* r = (const bf16*)(C.ws + WS_XBC) + m * 768; vv = *(const v4u*)(r + h * 64 + sub * 8); kk = *(const v4u*)(r + 512 + (h >> 2) * 64 + sub * 8);
          const float wf = cums[128 + s] * __expf(cums[63] - cums[s]), wb = cums[192 + s] * __expf(cums[64] - cums[64 + s]);
          kf = scale8(kk, wf); kb = scale8(kk, wb);
      } else { const bf16* r = (const bf16*)(C.ws + WS_COLS) + m * INWP + h * 64 + sub * 8; vv = *(const v4u*)(r + C_GV); kk = *(const v4u*)(r + C_GK);
          const LAS float* cf = cums + s * 64 + sub * 8; const LAS float* cb = cums + 4096 + s * 64 + sub * 8; const LAS float* cfl = cums + 63 * 64 + sub * 8; const LAS float* cbl = cums + 4096 + sub * 8;
          kf = scale8v(kk, exp4(*(const LAS f32x4*)cfl - *(const LAS f32x4*)cf), exp4(*(const LAS f32x4*)(cfl + 4) - *(const LAS f32x4*)(cf + 4)));
          kb = scale8v(kk, exp4(*(const LAS f32x4*)cbl - *(const LAS f32x4*)cb), exp4(*(const LAS f32x4*)(cbl + 4) - *(const LAS f32x4*)(cb + 4))); }
      *(LAS v4u*)(VT + s * TP + sub * 16) = vv; *(LAS v4u*)(KSF + s * TP + sub * 16) = kf; *(LAS v4u*)(KSB + s * TP + sub * 16) = kb; }
    __syncthreads();
    { const int w = C.wave, d = w >> 2, kb_ = w & 3, lane = C.lane, fr = lane & 15, fq = lane >> 4; const LAS unsigned char* KS = d ? KSB : KSF;
      f32x4 acc[4];
#pragma unroll
      for (int vb = 0; vb < 4; ++vb) acc[vb] = (f32x4){0.f, 0.f, 0.f, 0.f};
#pragma unroll
      for (int ks = 0; ks < 2; ++ks) { const bf16x8 a = tr_frag(KS, ks * 32 + 8 * fq, ks * 32 + 8 * fq + 4, kb_ * 16, lane);
#pragma unroll
          for (int vb = 0; vb < 4; ++vb) { const bf16x8 bo = tr_frag(VT, ks * 32 + 8 * fq, ks * 32 + 8 * fq + 4, vb * 16, lane); acc[vb] = __builtin_amdgcn_mfma_f32_16x16x32_bf16(a, bo, acc[vb], 0, 0, 0); } }
      bf16* st = (bf16*)(C.ws + (SSD ? WS_SST : WS_GST)) + ((((size_t)b * NCH + c) * 2 + d) * NH + h) * 4096;
#pragma unroll
      for (int vb = 0; vb < 4; ++vb) { v2u o; o.x = pk2(acc[vb].x, acc[vb].y); o.y = pk2(acc[vb].z, acc[vb].w); *(v2u*)(st + (vb * 16 + fr) * 64 + kb_ * 16 + 4 * fq) = o; } }
    if (SSD) { if (C.tid < 2) ((float*)(C.ws + WS_SDEC))[(((size_t)b * NCH + c) * 2 + C.tid) * 8 + h] = __expf(C.tid == 0 ? cums[63] : cums[64]); }
    else { if (C.tid < 128) { const int d = C.tid >> 6, k = C.tid & 63; ((float*)(C.ws + WS_GDEC))[((((size_t)b * NCH + c) * 2 + d) * 4 + h) * 64 + k] = __expf(d == 0 ? cums[63 * 64 + k] : cums[4096 + k]); } }
}
template <bool SSD>
__device__ __forceinline__ void chunk_s2(const Ctx& C, int chain) {
    constexpr int NH = SSD ? 8 : 4;
    const int b = chain / (2 * NH), d = (chain / NH) & 1, h = chain % NH;
    const bf16* st = (const bf16*)(C.ws + (SSD ? WS_SST : WS_GST)); bf16* en = (bf16*)(C.ws + (SSD ? WS_SEN : WS_GEN)); const float* dec = (const float*)(C.ws + (SSD ? WS_SDEC : WS_GDEC));
    const int v = C.tid >> 3, k0 = (C.tid & 7) * 8;
    float run[8];
#pragma unroll
    for (int j = 0; j < 8; ++j) run[j] = 0.f;
    auto chunk_at = [&](int i) { return d == 0 ? i : (i < NCTXCH ? NCTXCH - 1 - i : NCH + NCTXCH - 1 - i); };
    v4u nxt = *(const v4u*)(st + ((((size_t)b * NCH + chunk_at(0)) * 2 + d) * NH + h) * 4096 + v * 64 + k0);
    for (int i = 0; i < NCH; ++i) {
        const int c = chunk_at(i); const size_t base = (((size_t)b * NCH + c) * 2 + d) * NH + h; bf16* p = en + base * 4096 + v * 64 + k0;
        const v4u inc = nxt; if (i + 1 < NCH) nxt = *(const v4u*)(st + ((((size_t)b * NCH + chunk_at(i + 1)) * 2 + d) * NH + h) * 4096 + v * 64 + k0);
        f32x4 d0, d1; if (SSD) { const float dd = dec[base]; d0 = (f32x4){dd, dd, dd, dd}; d1 = d0; } else { d0 = *(const f32x4*)(dec + base * 64 + k0); d1 = *(const f32x4*)(dec + base * 64 + k0 + 4); }
        v4u o; o.x = pk2(run[0], run[1]); o.y = pk2(run[2], run[3]); o.z = pk2(run[4], run[5]); o.w = pk2(run[6], run[7]); *(v4u*)p = o;
        run[0] = d0.x * run[0] + bflo(inc.x); run[1] = d0.y * run[1] + bfhi(inc.x); run[2] = d0.z * run[2] + bflo(inc.y); run[3] = d0.w * run[3] + bfhi(inc.y);
        run[4] = d1.x * run[4] + bflo(inc.z); run[5] = d1.y * run[5] + bfhi(inc.z); run[6] = d1.z * run[6] + bflo(inc.w); run[7] = d1.w * run[7] + bfhi(inc.w);
    }
}
template <bool SSD>
__device__ __forceinline__ void chunk_s2_wave(const Ctx& C, int chain) {
    constexpr int NH = SSD ? 8 : 4;
    const int b = chain / (2 * NH), d = (chain / NH) & 1, h = chain % NH, lane = C.lane;
    const bf16* st = (const bf16*)(C.ws + (SSD ? WS_SST : WS_GST)); bf16* en = (bf16*)(C.ws + (SSD ? WS_SEN : WS_GEN)); const float* dec = (const float*)(C.ws + (SSD ? WS_SDEC : WS_GDEC));
    const int k0 = (lane & 7) * 8;
    float run[64];
#pragma unroll
    for (int e = 0; e < 64; ++e) run[e] = 0.f;
    auto chunk_at = [&](int i) { return d == 0 ? i : (i < NCTXCH ? NCTXCH - 1 - i : NCH + NCTXCH - 1 - i); };
    auto base_at = [&](int i) { return (((size_t)b * NCH + chunk_at(i)) * 2 + d) * NH + h; };
    v4u q0[8], q1[8], q2[8]; f32x4 a0, b0, a1, b1, a2, b2;
    auto ld = [&](int i, v4u (&q)[8], f32x4& da, f32x4& db) { const size_t base = base_at(i);
#pragma unroll
        for (int j = 0; j < 8; ++j) q[j] = *(const v4u*)(st + base * 4096 + j * 512 + lane * 8);
        if (SSD) { const float dd = dec[base]; da = (f32x4){dd, dd, dd, dd}; db = da; } else { da = *(const f32x4*)(dec + base * 64 + k0); db = *(const f32x4*)(dec + base * 64 + k0 + 4); } };
    auto step = [&](int i, const v4u (&inc)[8], const f32x4& d0, const f32x4& d1, v4u (&pq)[8], f32x4& pa, f32x4& pb) {
        if (i + 2 < NCH) ld(i + 2, pq, pa, pb);
        bf16* p = en + base_at(i) * 4096 + lane * 8;
#pragma unroll
        for (int j = 0; j < 8; ++j) { float* r = run + j * 8;
            v4u o; o.x = pk2(r[0], r[1]); o.y = pk2(r[2], r[3]); o.z = pk2(r[4], r[5]); o.w = pk2(r[6], r[7]); *(v4u*)(p + j * 512) = o;
            r[0] = d0.x * r[0] + bflo(inc[j].x); r[1] = d0.y * r[1] + bfhi(inc[j].x); r[2] = d0.z * r[2] + bflo(inc[j].y); r[3] = d0.w * r[3] + bfhi(inc[j].y);
            r[4] = d1.x * r[4] + bflo(inc[j].z); r[5] = d1.y * r[5] + bfhi(inc[j].z); r[6] = d1.z * r[6] + bflo(inc[j].w); r[7] = d1.w * r[7] + bfhi(inc[j].w); } };
    ld(0, q0, a0, b0); ld(1, q1, a1, b1);
    for (int i = 0; i < NCH; i += 3) {
        step(i, q0, a0, b0, q2, a2, b2);
        if (i + 1 < NCH) step(i + 1, q1, a1, b1, q0, a0, b0);
        if (i + 2 < NCH) step(i + 2, q2, a2, b2, q1, a1, b1);
    }
}
template <bool SSD>
__device__ __forceinline__ void chunk_s2_slice(const Ctx& C, int chain, int sl) {
    constexpr int NH = SSD ? 8 : 4;
    static_assert(NCH % 4 == 0, "ring of four");
    const int b = chain / (2 * NH), d = (chain / NH) & 1, h = chain % NH, lane = C.lane;
    const bf16* st = (const bf16*)(C.ws + (SSD ? WS_SST : WS_GST)) + sl * 1024 + lane * 8; bf16* en = (bf16*)(C.ws + (SSD ? WS_SEN : WS_GEN)) + sl * 1024 + lane * 8; const float* dec = (const float*)(C.ws + (SSD ? WS_SDEC : WS_GDEC));
    const int k0 = (lane & 7) * 8;
    float run[16];
#pragma unroll
    for (int e = 0; e < 16; ++e) run[e] = 0.f;
    auto chunk_at = [&](int i) { return d == 0 ? i : (i < NCTXCH ? NCTXCH - 1 - i : NCH + NCTXCH - 1 - i); };
    auto base_at = [&](int i) { return (((size_t)b * NCH + chunk_at(i)) * 2 + d) * NH + h; };
    v4u q0[2], q1[2], q2[2], q3[2]; f32x4 a0, b0, a1, b1, a2, b2, a3, b3;
    auto ld = [&](int i, v4u (&q)[2], f32x4& da, f32x4& db) { const size_t base = base_at(i);
        q[0] = *(const v4u*)(st + base * 4096); q[1] = *(const v4u*)(st + base * 4096 + 512);
        if (SSD) { const float dd = dec[base]; da = (f32x4){dd, dd, dd, dd}; db = da; } else { da = *(const f32x4*)(dec + base * 64 + k0); db = *(const f32x4*)(dec + base * 64 + k0 + 4); } };
    auto step = [&](int i, const v4u (&inc)[2], const f32x4& d0, const f32x4& d1, v4u (&pq)[2], f32x4& pa, f32x4& pb) {
        if (i + 3 < NCH) ld(i + 3, pq, pa, pb);
        bf16* p = en + base_at(i) * 4096;
#pragma unroll
        for (int j = 0; j < 2; ++j) { float* r = run + j * 8;
            v4u o; o.x = pk2(r[0], r[1]); o.y = pk2(r[2], r[3]); o.z = pk2(r[4], r[5]); o.w = pk2(r[6], r[7]); *(v4u*)(p + j * 512) = o;
            r[0] = d0.x * r[0] + bflo(inc[j].x); r[1] = d0.y * r[1] + bfhi(inc[j].x); r[2] = d0.z * r[2] + bflo(inc[j].y); r[3] = d0.w * r[3] + bfhi(inc[j].y);
            r[4] = d1.x * r[4] + bflo(inc[j].z); r[5] = d1.y * r[5] + bfhi(inc[j].z); r[6] = d1.z * r[6] + bflo(inc[j].w); r[7] = d1.w * r[7] + bfhi(inc[j].w); } };
    ld(0, q0, a0, b0); ld(1, q1, a1, b1); ld(2, q2, a2, b2);
    for (int i = 0; i < NCH; i += 4) {
        step(i, q0, a0, b0, q3, a3, b3);
        step(i + 1, q1, a1, b1, q0, a0, b0);
        step(i + 2, q2, a2, b2, q1, a1, b1);
        step(i + 3, q3, a3, b3, q2, a2, b2);
    }
}
__device__ __forceinline__ bf16x8 pack_p(f32x4 a, f32x4 b) { const v4u w = (v4u){pk2(a.x, a.y), pk2(a.z, a.w), pk2(b.x, b.y), pk2(b.z, b.w)}; return __builtin_bit_cast(bf16x8, w); }
__device__ __forceinline__ void ssd_s3(const Ctx& C, int l, int unit, const float* alog, const float* dskip, const float* normw) {
    const int b = unit / (NCH * 2), rem = unit - b * (NCH * 2), c = rem >> 1, g = rem & 1; const size_t m0 = (size_t)b * SB + c * CH;
    LAS unsigned char* XT = C.lds;
    LAS unsigned char* KR = C.lds + 4 * TILE_B; LAS unsigned char* QR = C.lds + 5 * TILE_B;
    LAS float* cums = (LAS float*)(C.lds + 6 * TILE_B);
    LAS float* ssx = cums + 1024;
    __syncthreads();
    chunk_cums<true>(C, l, m0, g * 4, 4, cums, alog);
    { const int s = C.tid >> 3, sub = C.tid & 7; const bf16* r = (const bf16*)(C.ws + WS_XBC) + (m0 + s) * 768;
#pragma unroll
      for (int hl = 0; hl < 4; ++hl) *(LAS v4u*)(XT + hl * TILE_B + s * TP + sub * 16) = *(const v4u*)(r + (g * 4 + hl) * 64 + sub * 8);
      *(LAS v4u*)(KR + s * TP + sub * 16) = *(const v4u*)(r + 512 + g * 64 + sub * 8); *(LAS v4u*)(QR + s * TP + sub * 16) = *(const v4u*)(r + 640 + g * 64 + sub * 8); }
    const int w = C.wave, hl = w >> 1, lh = w & 1, h = g * 4 + hl, lane = C.lane, fr = lane & 15, fq = lane >> 4;
    bf16x8 hst[2][4][2];
    { const bf16* stb = (const bf16*)(C.ws + WS_SEN) + (((size_t)b * NCH + c) * 2 * 8 + h) * 4096;
#pragma unroll
      for (int d = 0; d < 2; ++d)
#pragma unroll
          for (int vb = 0; vb < 4; ++vb)
#pragma unroll
              for (int ks = 0; ks < 2; ++ks) hst[d][vb][ks] = *(const bf16x8*)(stb + (size_t)d * 8 * 4096 + (vb * 16 + fr) * 64 + ks * 32 + fq * 8);
 }
    __syncthreads();
    const LAS float* cf = cums + hl * 64; const LAS float* cb = cums + 256 + hl * 64; const LAS float* df = cums + 512 + hl * 64; const LAS float* db = cums + 768 + hl * 64;
    const LAS unsigned char* VT = XT + hl * TILE_B;
    bf16x8 cq[2][2];
#pragma unroll
    for (int lb = 0; lb < 2; ++lb)
#pragma unroll
        for (int ks = 0; ks < 2; ++ks) cq[lb][ks] = row_frag(QR, (2 * lh + lb) * 16 + fr, ks * 32 + fq * 8);
    f32x4 ao[2][4];
#pragma unroll
    for (int lb = 0; lb < 2; ++lb)
#pragma unroll
        for (int vb = 0; vb < 4; ++vb) ao[lb][vb] = (f32x4){0.f, 0.f, 0.f, 0.f};
    if (XINTRA) {
        f32x4 ap[2][4];
#pragma unroll
        for (int sb = 0; sb < 4; ++sb) { const bf16x8 k0f = row_frag(KR, sb * 16 + fr, fq * 8), k1f = row_frag(KR, sb * 16 + fr, 32 + fq * 8);
#pragma unroll
            for (int lb = 0; lb < 2; ++lb) { f32x4 a = (f32x4){0.f, 0.f, 0.f, 0.f}; a = __builtin_amdgcn_mfma_f32_16x16x32_bf16(k0f, cq[lb][0], a, 0, 0, 0); a = __builtin_amdgcn_mfma_f32_16x16x32_bf16(k1f, cq[lb][1], a, 0, 0, 0); ap[lb][sb] = a; } }
#pragma unroll
        for (int lb = 0; lb < 2; ++lb) { const int lrow = (2 * lh + lb) * 16 + fr; const float cfl = cf[lrow], cbl = cb[lrow];
#pragma unroll
            for (int sb = 0; sb < 4; ++sb) { const int s0 = sb * 16 + 4 * fq; const f32x4 cfs = *(const LAS f32x4*)(cf + s0), cbs = *(const LAS f32x4*)(cb + s0), dfs = *(const LAS f32x4*)(df + s0), dbs = *(const LAS f32x4*)(db + s0);
                f32x4 m;
                m.x = (s0 + 0 <= lrow ? dfs.x * __expf(fminf(cfl - cfs.x, 0.f)) : 0.f) + (s0 + 0 >= lrow ? dbs.x * __expf(fminf(cbl - cbs.x, 0.f)) : 0.f);
                m.y = (s0 + 1 <= lrow ? dfs.y * __expf(fminf(cfl - cfs.y, 0.f)) : 0.f) + (s0 + 1 >= lrow ? dbs.y * __expf(fminf(cbl - cbs.y, 0.f)) : 0.f);
                m.z = (s0 + 2 <= lrow ? dfs.z * __expf(fminf(cfl - cfs.z, 0.f)) : 0.f) + (s0 + 2 >= lrow ? dbs.z * __expf(fminf(cbl - cbs.z, 0.f)) : 0.f);
                m.w = (s0 + 3 <= lrow ? dfs.w * __expf(fminf(cfl - cfs.w, 0.f)) : 0.f) + (s0 + 3 >= lrow ? dbs.w * __expf(fminf(cbl - cbs.w, 0.f)) : 0.f);
                ap[lb][sb] *= m; } }
#pragma unroll
        for (int kk = 0; kk < 2; ++kk) { bf16x8 pf[2]; pf[0] = pack_p(ap[0][2 * kk], ap[0][2 * kk + 1]); pf[1] = pack_p(ap[1][2 * kk], ap[1][2 * kk + 1]);
#pragma unroll
            for (int vb = 0; vb < 4; ++vb) { const bf16x8 xa = tr_frag(VT, kk * 32 + 4 * fq, kk * 32 + 16 + 4 * fq, vb * 16, lane);
                ao[0][vb] = __builtin_amdgcn_mfma_f32_16x16x32_bf16(xa, pf[0], ao[0][vb], 0, 0, 0); ao[1][vb] = __builtin_amdgcn_mfma_f32_16x16x32_bf16(xa, pf[1], ao[1][vb], 0, 0, 0); } }
    }
    v2u zz_[2][4];
    { const bf16* colz = (const bf16*)(C.ws + WS_COLS);
#pragma unroll
      for (int lb = 0; lb < 2; ++lb)
#pragma unroll
          for (int vb = 0; vb < 4; ++vb) zz_[lb][vb] = *(const v2u*)(colz + (m0 + (2 * lh + lb) * 16 + fr) * INWP + C_Z + h * 64 + vb * 16 + 4 * fq); }
    if (XSTATE) {
#pragma unroll
        for (int d = 0; d < 2; ++d) { bf16x8 cs[2][2];
#pragma unroll
            for (int lb = 0; lb < 2; ++lb) { const int lrow = (2 * lh + lb) * 16 + fr; const float e = __expf(d == 0 ? cf[lrow] : cb[lrow]);
#pragma unroll
                for (int ks = 0; ks < 2; ++ks) cs[lb][ks] = __builtin_bit_cast(bf16x8, scale8(__builtin_bit_cast(v4u, cq[lb][ks]), e)); }
#pragma unroll
            for (int vb = 0; vb < 4; ++vb)
#pragma unroll
                for (int ks = 0; ks < 2; ++ks) { const bf16x8 ha = hst[d][vb][ks];
                    ao[0][vb] = __builtin_amdgcn_mfma_f32_16x16x32_bf16(ha, cs[0][ks], ao[0][vb], 0, 0, 0); ao[1][vb] = __builtin_amdgcn_mfma_f32_16x16x32_bf16(ha, cs[1][ks], ao[1][vb], 0, 0, 0); } }
    }
    const float dsk = dskip[l * 8 + h]; const bf16* cols = (const bf16*)(C.ws + WS_COLS);
    float ssl[2];
#pragma unroll
    for (int lb = 0; lb < 2; ++lb) { const int lrow = (2 * lh + lb) * 16 + fr; float ss = 0.f;
#pragma unroll
        for (int vb = 0; vb < 4; ++vb) { const int p0 = vb * 16 + 4 * fq; const v2u xx = *(const LAS v2u*)(VT + lrow * TP + p0 * 2); const v2u zz = zz_[lb][vb];
            f32x4 y = ao[lb][vb]; y.x = (y.x + dsk * bflo(xx.x)) * fsilu(bflo(zz.x)); y.y = (y.y + dsk * bfhi(xx.x)) * fsilu(bfhi(zz.x)); y.z = (y.z + dsk * bflo(xx.y)) * fsilu(bflo(zz.y)); y.w = (y.w + dsk * bfhi(xx.y)) * fsilu(bfhi(zz.y));
            ao[lb][vb] = y; ss += (y.x * y.x + y.y * y.y) + (y.z * y.z + y.w * y.w); }
        ss += __shfl_xor(ss, 16); ss += __shfl_xor(ss, 32); ssl[lb] = ss; if (fq == 0) ssx[hl * 64 + lrow] = ss; }
    __syncthreads();
    bf16* mix = (bf16*)(C.ws + WS_ACT1);
#pragma unroll
    for (int lb = 0; lb < 2; ++lb) { const int lrow = (2 * lh + lb) * 16 + fr; const float tot = (ssx[lrow] + ssx[64 + lrow]) + (ssx[128 + lrow] + ssx[192 + lrow]); const float rstd = rsqrtf(tot * (1.0f / 256.0f) + EPS);
#pragma unroll
        for (int vb = 0; vb < 4; ++vb) { const int p0 = vb * 16 + 4 * fq; const f32x4 nw = *(const f32x4*)(normw + l * 512 + h * 64 + p0); const f32x4 y = ao[lb][vb];
            v2u o; o.x = pk2(y.x * rstd * nw.x, y.y * rstd * nw.y); o.y = pk2(y.z * rstd * nw.z, y.w * rstd * nw.w); *(v2u*)(mix + (m0 + lrow) * DM + h * 64 + p0) = o; } }
}
__device__ __forceinline__ void gla_s3(const Ctx& C, int l, int unit, const float* normw) {
    const int b = unit / (NCH * 4), rem = unit - b * (NCH * 4), c = rem >> 2, h = rem & 3; const size_t m0 = (size_t)b * SB + c * CH;
    LAS unsigned char* VT = C.lds; LAS unsigned char* KIF = C.lds + TILE_B; LAS unsigned char* KIB = C.lds + 2 * TILE_B; LAS unsigned char* QSF = C.lds + 3 * TILE_B; LAS unsigned char* QSB = C.lds + 4 * TILE_B;
    LAS float* cums = (LAS float*)(C.lds + 5 * TILE_B);
    LAS float* ssx = cums + 8192;
    __syncthreads();
    chunk_cums<false>(C, l, m0, h, 1, cums, nullptr);
    __syncthreads();
    { const int s = C.tid >> 3, sub = C.tid & 7; const bf16* r = (const bf16*)(C.ws + WS_COLS) + (m0 + s) * INWP + h * 64 + sub * 8;
      const v4u vv = *(const v4u*)(r + C_GV), kk = *(const v4u*)(r + C_GK), qq = scale8(*(const v4u*)(r + C_GQ), 0.125f);
      const LAS float* cf = cums + s * 64 + sub * 8; const LAS float* cb = cums + 4096 + s * 64 + sub * 8;
      const f32x4 f0 = *(const LAS f32x4*)cf, f1 = *(const LAS f32x4*)(cf + 4), b0 = *(const LAS f32x4*)cb, b1 = *(const LAS f32x4*)(cb + 4);
      *(LAS v4u*)(VT + s * TP + sub * 16) = vv;
      *(LAS v4u*)(KIF + s * TP + sub * 16) = scale8v(kk, exp4(-f0), exp4(-f1)); *(LAS v4u*)(KIB + s * TP + sub * 16) = scale8v(kk, exp4(-b0), exp4(-b1));
      *(LAS v4u*)(QSF + s * TP + sub * 16) = scale8v(qq, exp4(f0), exp4(f1)); *(LAS v4u*)(QSB + s * TP + sub * 16) = scale8v(qq, exp4(b0), exp4(b1)); }
    __syncthreads();
    const int w = C.wave, lb = w & 3, vh = w >> 2, lane = C.lane, fr = lane & 15, fq = lane >> 4; const int lrow = lb * 16 + fr;
    bf16x8 qf[2][2];
#pragma unroll
    for (int ks = 0; ks < 2; ++ks) { qf[0][ks] = row_frag(QSF, lrow, ks * 32 + fq * 8); qf[1][ks] = row_frag(QSB, lrow, ks * 32 + fq * 8); }
    f32x4 ao[2];
    ao[0] = (f32x4){0.f, 0.f, 0.f, 0.f}; ao[1] = ao[0];
    {   f32x4 ap[4];
#pragma unroll
        for (int sb = 0; sb < 4; ++sb) { f32x4 af = (f32x4){0.f, 0.f, 0.f, 0.f}, ab = af;
#pragma unroll
            for (int ks = 0; ks < 2; ++ks) { af = __builtin_amdgcn_mfma_f32_16x16x32_bf16(row_frag(KIF, sb * 16 + fr, ks * 32 + fq * 8), qf[0][ks], af, 0, 0, 0); ab = __builtin_amdgcn_mfma_f32_16x16x32_bf16(row_frag(KIB, sb * 16 + fr, ks * 32 + fq * 8), qf[1][ks], ab, 0, 0, 0); }
            const int s0 = sb * 16 + 4 * fq; f32x4 m;
            m.x = (s0 + 0 <= lrow ? af.x : 0.f) + (s0 + 0 >= lrow ? ab.x : 0.f); m.y = (s0 + 1 <= lrow ? af.y : 0.f) + (s0 + 1 >= lrow ? ab.y : 0.f);
            m.z = (s0 + 2 <= lrow ? af.z : 0.f) + (s0 + 2 >= lrow ? ab.z : 0.f); m.w = (s0 + 3 <= lrow ? af.w : 0.f) + (s0 + 3 >= lrow ? ab.w : 0.f);
            ap[sb] = m; }
#pragma unroll
        for (int kk = 0; kk < 2; ++kk) { const bf16x8 pf = pack_p(ap[2 * kk], ap[2 * kk + 1]);
#pragma unroll
            for (int vi = 0; vi < 2; ++vi) ao[vi] = __builtin_amdgcn_mfma_f32_16x16x32_bf16(tr_frag(VT, kk * 32 + 4 * fq, kk * 32 + 16 + 4 * fq, (2 * vh + vi) * 16, lane), pf, ao[vi], 0, 0, 0); }
    }
    {   const bf16* stb = (const bf16*)(C.ws + WS_GEN) + (((size_t)b * NCH + c) * 2 * 4 + h) * 4096;
#pragma unroll
        for (int d = 0; d < 2; ++d) { const bf16* sp = stb + (size_t)d * 4 * 4096;
#pragma unroll
            for (int vi = 0; vi < 2; ++vi)
#pragma unroll
                for (int ks = 0; ks < 2; ++ks) ao[vi] = __builtin_amdgcn_mfma_f32_16x16x32_bf16(*(const bf16x8*)(sp + ((2 * vh + vi) * 16 + fr) * 64 + ks * 32 + fq * 8), qf[d][ks], ao[vi], 0, 0, 0); } }
    float ss = 0.f;
#pragma unroll
    for (int vi = 0; vi < 2; ++vi) ss += (ao[vi].x * ao[vi].x + ao[vi].y * ao[vi].y) + (ao[vi].z * ao[vi].z + ao[vi].w * ao[vi].w);
    ss += __shfl_xor(ss, 16); ss += __shfl_xor(ss, 32); if (fq == 0) ssx[vh * 64 + lrow] = ss;
    __syncthreads();
    const float rstd = rsqrtf((ssx[lrow] + ssx[64 + lrow]) * (1.0f / 64.0f) + EPS);
    const bf16* cols = (const bf16*)(C.ws + WS_COLS); bf16* mix = (bf16*)(C.ws + WS_ACT1);
#pragma unroll
    for (int vi = 0; vi < 2; ++vi) { const int v0 = (2 * vh + vi) * 16 + 4 * fq; const f32x4 nw = *(const f32x4*)(normw + l * 64 + v0); const v2u rr = *(const v2u*)(cols + (m0 + lrow) * INWP + C_GR + h * 64 + v0);
        v2u o; o.x = pk2(ao[vi].x * rstd * nw.x * fsilu(bflo(rr.x)), ao[vi].y * rstd * nw.y * fsilu(bfhi(rr.x))); o.y = pk2(ao[vi].z * rstd * nw.z * fsilu(bflo(rr.y)), ao[vi].w * rstd * nw.w * fsilu(bfhi(rr.y)));
        *(v2u*)(mix + (m0 + lrow) * DM + 512 + h * 64 + v0) = o; }
}


__device__ __forceinline__ void ssd_s1_bc(const Ctx& C, int l, int unit, const float* alog) {
    const int b = unit / NCH, c = unit - b * NCH; const size_t m0 = (size_t)b * SB + c * CH;
    LAS unsigned char* XT = C.lds; LAS unsigned char* BT = C.lds + 8 * TILE_B; LAS float* wtab = (LAS float*)(C.lds + 10 * TILE_B);
    const int w = C.wave, lane = C.lane, fr = lane & 15, fq = lane >> 4;
    __syncthreads();
#pragma unroll
    for (int d = 0; d < 2; ++d) { const int s = d == 0 ? lane : 63 - lane;
        const float dtv = ((const float*)(C.ws + WS_DT))[(m0 + s) * 16 + d * 8 + w]; float v = dtv * -expf(alog[l * 16 + d * 8 + w]);
#pragma unroll
        for (int o = 1; o < 64; o <<= 1) { const float t = __shfl_up(v, o); if (lane >= o) v += t; }
        const float tot = __shfl(v, 63);
        wtab[(d * 8 + w) * 64 + s] = dtv * __expf(tot - v);
        if (lane == 63) ((float*)(C.ws + WS_SDEC))[(((size_t)b * NCH + c) * 2 + d) * 8 + w] = __expf(tot); }
    { const int s = C.tid >> 3, sub = C.tid & 7; const bf16* r = (const bf16*)(C.ws + WS_XBC) + (m0 + s) * 768;
#pragma unroll
      for (int hl = 0; hl < 8; ++hl) *(LAS v4u*)(XT + hl * TILE_B + s * TP + sub * 16) = *(const v4u*)(r + hl * 64 + sub * 8);
      *(LAS v4u*)(BT + s * TP + sub * 16) = *(const v4u*)(r + 512 + sub * 8); *(LAS v4u*)(BT + TILE_B + s * TP + sub * 16) = *(const v4u*)(r + 576 + sub * 8); }
    __syncthreads();
    const LAS unsigned char* XH = XT + w * TILE_B; const LAS unsigned char* BG = BT + (w >> 2) * TILE_B;
    bf16x8 bo[4][2];
#pragma unroll
    for (int pb = 0; pb < 4; ++pb)
#pragma unroll
        for (int ks = 0; ks < 2; ++ks) bo[pb][ks] = tr_frag(XH, ks * 32 + 8 * fq, ks * 32 + 8 * fq + 4, pb * 16, lane);
#pragma unroll 1
    for (int d = 0; d < 2; ++d) {
        f32x4 acc[4][4];
#pragma unroll
        for (int nb = 0; nb < 4; ++nb)
#pragma unroll
            for (int pb = 0; pb < 4; ++pb) acc[nb][pb] = (f32x4){0.f, 0.f, 0.f, 0.f};
#pragma unroll
        for (int ks = 0; ks < 2; ++ks) { const LAS float* wp = wtab + (d * 8 + w) * 64 + ks * 32 + 8 * fq; const f32x4 w0 = *(const LAS f32x4*)wp, w1 = *(const LAS f32x4*)(wp + 4);
#pragma unroll
            for (int nb = 0; nb < 4; ++nb) { const bf16x8 a = __builtin_bit_cast(bf16x8, scale8v(__builtin_bit_cast(v4u, tr_frag_g4(BG, ks * 32 + 8 * fq, ks * 32 + 8 * fq + 4, nb, lane)), w0, w1));
#pragma unroll
                for (int pb = 0; pb < 4; ++pb) acc[nb][pb] = __builtin_amdgcn_mfma_f32_16x16x32_bf16(a, bo[pb][ks], acc[nb][pb], 0, 0, 0); } }
        bf16* st = (bf16*)(C.ws + WS_SST) + ((((size_t)b * NCH + c) * 2 + d) * 8 + w) * 4096;
#pragma unroll
        for (int pb = 0; pb < 4; ++pb) { v4u o0, o1; o0.x = pk2(acc[0][pb].x, acc[0][pb].y); o0.y = pk2(acc[0][pb].z, acc[0][pb].w); o0.z = pk2(acc[1][pb].x, acc[1][pb].y); o0.w = pk2(acc[1][pb].z, acc[1][pb].w);
            o1.x = pk2(acc[2][pb].x, acc[2][pb].y); o1.y = pk2(acc[2][pb].z, acc[2][pb].w); o1.z = pk2(acc[3][pb].x, acc[3][pb].y); o1.w = pk2(acc[3][pb].z, acc[3][pb].w);
            bf16* rp = st + (pb * 16 + fr) * 64 + 16 * fq; *(v4u*)rp = o0; *(v4u*)(rp + 8) = o1; }
    }
}
constexpr size_t WS_GC0 = WS_H + ((size_t)136 << 20), WS_GC1 = WS_H + ((size_t)170 << 20);
__device__ __forceinline__ void gla_s1_pair(const Ctx& C, int l, int unit) {
    const int b = unit / (NCH * 2), rem = unit - b * (NCH * 2), c = rem >> 1, hp = rem & 1; const size_t m0 = (size_t)b * SB + c * CH;
    LAS unsigned char* VT = C.lds; LAS unsigned char* KS = C.lds + 2 * TILE_B; LAS float* GS = (LAS float*)(C.lds + 6 * TILE_B);
    const int w = C.wave, lane = C.lane, fr = lane & 15, fq = lane >> 4;
    const int s = C.tid >> 3, sub = C.tid & 7; const size_t m = m0 + s;
    __syncthreads();
    v4u kk[2];
    { const bf16* gr = (const bf16*)(C.ws + WS_G) + m * 512 + hp * 128 + sub * 8; const bf16* cr = (const bf16*)(C.ws + WS_COLS) + m * INWP + hp * 128 + sub * 8;
#pragma unroll
      for (int hd = 0; hd < 4; ++hd) { const int hl = hd >> 1, d = hd & 1; const v4u g = *(const v4u*)(gr + d * 256 + hl * 64); *(LAS f32x4*)(GS + hd * 4096 + s * 64 + sub * 8) = (f32x4){bflo(g.x), bfhi(g.x), bflo(g.y), bfhi(g.y)}; *(LAS f32x4*)(GS + hd * 4096 + s * 64 + sub * 8 + 4) = (f32x4){bflo(g.z), bfhi(g.z), bflo(g.w), bfhi(g.w)}; }
#pragma unroll
      for (int hl = 0; hl < 2; ++hl) { kk[hl] = *(const v4u*)(cr + C_GK + hl * 64); *(LAS v4u*)(VT + hl * TILE_B + s * TP + sub * 16) = *(const v4u*)(cr + C_GV + hl * 64); } }
    __syncthreads();
    if (C.tid < 256) { const int hd = C.tid >> 6, hl = hd >> 1, d = hd & 1, k = C.tid & 63, h = hp * 2 + hl; LAS float* col = GS + hd * 4096 + k; bf16* gc = (bf16*)(C.ws + (d ? WS_GC1 : WS_GC0)) + m0 * 256 + h * 64 + k; float r = 0.f;
#pragma unroll 8
        for (int i = 0; i < 64; ++i) { const int ss = d == 0 ? i : 63 - i; r += col[ss * 64]; col[ss * 64] = r; gc[(size_t)ss * 256] = (bf16)f2bf(r); }
        ((float*)(C.ws + WS_GDEC))[((((size_t)b * NCH + c) * 2 + d) * 4 + h) * 64 + k] = __expf(r); }
    __syncthreads();
#pragma unroll
    for (int hd = 0; hd < 4; ++hd) { const int hl = hd >> 1, d = hd & 1; const LAS float* cs = GS + hd * 4096 + s * 64 + sub * 8; const LAS float* cl = GS + hd * 4096 + (d == 0 ? 63 : 0) * 64 + sub * 8;
        *(LAS v4u*)(KS + hd * TILE_B + s * TP + sub * 16) = scale8v(kk[hl], exp4(*(const LAS f32x4*)cl - *(const LAS f32x4*)cs), exp4(*(const LAS f32x4*)(cl + 4) - *(const LAS f32x4*)(cs + 4))); }
    __syncthreads();
    const int hd = w >> 1, half = w & 1, hl = hd >> 1, d = hd & 1, h = hp * 2 + hl; const LAS unsigned char* KH = KS + hd * TILE_B; const LAS unsigned char* VH = VT + hl * TILE_B;
    f32x4 acc[2][4];
#pragma unroll
    for (int kb = 0; kb < 2; ++kb)
#pragma unroll
        for (int vb = 0; vb < 4; ++vb) acc[kb][vb] = (f32x4){0.f, 0.f, 0.f, 0.f};
#pragma unroll
    for (int ks = 0; ks < 2; ++ks) { bf16x8 bo[4];
#pragma unroll
        for (int vb = 0; vb < 4; ++vb) bo[vb] = tr_frag(VH, ks * 32 + 8 * fq, ks * 32 + 8 * fq + 4, vb * 16, lane);
#pragma unroll
        for (int kb = 0; kb < 2; ++kb) { const bf16x8 a = tr_frag(KH, ks * 32 + 8 * fq, ks * 32 + 8 * fq + 4, (2 * half + kb) * 16, lane);
#pragma unroll
            for (int vb = 0; vb < 4; ++vb) acc[kb][vb] = __builtin_amdgcn_mfma_f32_16x16x32_bf16(a, bo[vb], acc[kb][vb], 0, 0, 0); } }
    bf16* st = (bf16*)(C.ws + WS_GST) + ((((size_t)b * NCH + c) * 2 + d) * 4 + h) * 4096;
#pragma unroll
    for (int kb = 0; kb < 2; ++kb)
#pragma unroll
        for (int vb = 0; vb < 4; ++vb) { v2u o; o.x = pk2(acc[kb][vb].x, acc[kb][vb].y); o.y = pk2(acc[kb][vb].z, acc[kb][vb].w); *(v2u*)(st + (vb * 16 + fr) * 64 + (2 * half + kb) * 16 + 4 * fq) = o; }
}
__device__ __forceinline__ void gla_s3_pair(const Ctx& C, int l, int unit, const float* normw) {
    const int b = unit / (NCH * 2), rem = unit - b * (NCH * 2), c = rem >> 1, hp = rem & 1; const size_t m0 = (size_t)b * SB + c * CH;
    LAS unsigned char* VT = C.lds; LAS unsigned char* QS = C.lds + 2 * TILE_B; LAS unsigned char* KI = C.lds + 6 * TILE_B;
    const int w = C.wave, lane = C.lane, fr = lane & 15, fq = lane >> 4;
    __syncthreads();
    { const int s = C.tid >> 3, sub = C.tid & 7; const size_t m = m0 + s; const bf16* cr = (const bf16*)(C.ws + WS_COLS) + m * INWP + hp * 128 + sub * 8; const bf16* gc0 = (const bf16*)(C.ws + WS_GC0) + m * 256 + hp * 128 + sub * 8; const bf16* gc1 = (const bf16*)(C.ws + WS_GC1) + m * 256 + hp * 128 + sub * 8;
#pragma unroll
      for (int hl = 0; hl < 2; ++hl) { const v4u q8 = scale8(*(const v4u*)(cr + C_GQ + hl * 64), 0.125f), k8 = *(const v4u*)(cr + C_GK + hl * 64);
          *(LAS v4u*)(VT + hl * TILE_B + s * TP + sub * 16) = *(const v4u*)(cr + C_GV + hl * 64);
#pragma unroll
          for (int d = 0; d < 2; ++d) { const v4u cw = *(const v4u*)((d ? gc1 : gc0) + hl * 64); const f32x4 c0 = (f32x4){bflo(cw.x), bfhi(cw.x), bflo(cw.y), bfhi(cw.y)}, c1 = (f32x4){bflo(cw.z), bfhi(cw.z), bflo(cw.w), bfhi(cw.w)};
              *(LAS v4u*)(QS + (hl * 2 + d) * TILE_B + s * TP + sub * 16) = scale8v(q8, exp4(c0), exp4(c1)); *(LAS v4u*)(KI + (hl * 2 + d) * TILE_B + s * TP + sub * 16) = scale8v(k8, exp4(-c0), exp4(-c1)); } } }
    const int hl = w >> 2, lb = w & 3, h = hp * 2 + hl, lrow = lb * 16 + fr;
    bf16x8 hst[2][4][2]; v2u rr_[4];
    { const bf16* stb = (const bf16*)(C.ws + WS_GEN) + (((size_t)b * NCH + c) * 2 * 4 + h) * 4096;
#pragma unroll
      for (int d = 0; d < 2; ++d)
#pragma unroll
          for (int vb = 0; vb < 4; ++vb)
#pragma unroll
              for (int ks = 0; ks < 2; ++ks) hst[d][vb][ks] = *(const bf16x8*)(stb + (size_t)d * 4 * 4096 + (vb * 16 + fr) * 64 + ks * 32 + fq * 8);
      const bf16* colr = (const bf16*)(C.ws + WS_COLS);
#pragma unroll
      for (int vb = 0; vb < 4; ++vb) rr_[vb] = *(const v2u*)(colr + (m0 + lrow) * INWP + C_GR + h * 64 + vb * 16 + 4 * fq); }
    __syncthreads();
    const LAS unsigned char* QF_ = QS + (hl * 2) * TILE_B; const LAS unsigned char* QB_ = QF_ + TILE_B; const LAS unsigned char* KF_ = KI + (hl * 2) * TILE_B; const LAS unsigned char* KB_ = KF_ + TILE_B; const LAS unsigned char* VH = VT + hl * TILE_B;
    bf16x8 qf[2][2];
#pragma unroll
    for (int ks = 0; ks < 2; ++ks) { qf[0][ks] = row_frag(QF_, lrow, ks * 32 + fq * 8); qf[1][ks] = row_frag(QB_, lrow, ks * 32 + fq * 8); }
    f32x4 ao[4];
#pragma unroll
    for (int vb = 0; vb < 4; ++vb) ao[vb] = (f32x4){0.f, 0.f, 0.f, 0.f};
    {   f32x4 ap[4];
#pragma unroll
        for (int sb = 0; sb < 4; ++sb) { f32x4 af = (f32x4){0.f, 0.f, 0.f, 0.f}, ab = af;
#pragma unroll
            for (int ks = 0; ks < 2; ++ks) { af = __builtin_amdgcn_mfma_f32_16x16x32_bf16(row_frag(KF_, sb * 16 + fr, ks * 32 + fq * 8), qf[0][ks], af, 0, 0, 0); ab = __builtin_amdgcn_mfma_f32_16x16x32_bf16(row_frag(KB_, sb * 16 + fr, ks * 32 + fq * 8), qf[1][ks], ab, 0, 0, 0); }
            const int s0 = sb * 16 + 4 * fq; f32x4 m;
            m.x = (s0 + 0 <= lrow ? af.x : 0.f) + (s0 + 0 >= lrow ? ab.x : 0.f); m.y = (s0 + 1 <= lrow ? af.y : 0.f) + (s0 + 1 >= lrow ? ab.y : 0.f);
            m.z = (s0 + 2 <= lrow ? af.z : 0.f) + (s0 + 2 >= lrow ? ab.z : 0.f); m.w = (s0 + 3 <= lrow ? af.w : 0.f) + (s0 + 3 >= lrow ? ab.w : 0.f);
            ap[sb] = m; }
#pragma unroll
        for (int kk = 0; kk < 2; ++kk) { const bf16x8 pf = pack_p(ap[2 * kk], ap[2 * kk + 1]);
#pragma unroll
            for (int vb = 0; vb < 4; ++vb) ao[vb] = __builtin_amdgcn_mfma_f32_16x16x32_bf16(tr_frag(VH, kk * 32 + 4 * fq, kk * 32 + 16 + 4 * fq, vb * 16, lane), pf, ao[vb], 0, 0, 0); }
    }
    {
#pragma unroll
        for (int d = 0; d < 2; ++d)
#pragma unroll
            for (int vb = 0; vb < 4; ++vb)
#pragma unroll
                for (int ks = 0; ks < 2; ++ks) ao[vb] = __builtin_amdgcn_mfma_f32_16x16x32_bf16(hst[d][vb][ks], qf[d][ks], ao[vb], 0, 0, 0); }
    float ss = 0.f;
#pragma unroll
    for (int vb = 0; vb < 4; ++vb) ss += (ao[vb].x * ao[vb].x + ao[vb].y * ao[vb].y) + (ao[vb].z * ao[vb].z + ao[vb].w * ao[vb].w);
    ss += __shfl_xor(ss, 16); ss += __shfl_xor(ss, 32);
    const float rstd = rsqrtf(ss * (1.0f / 64.0f) + EPS);
    bf16* mix = (bf16*)(C.ws + WS_ACT1);
#pragma unroll
    for (int vb = 0; vb < 4; ++vb) { const int v0 = vb * 16 + 4 * fq; const f32x4 nw = *(const f32x4*)(normw + l * 64 + v0); const v2u rr = rr_[vb];
        v2u o; o.x = pk2(ao[vb].x * rstd * nw.x * fsilu(bflo(rr.x)), ao[vb].y * rstd * nw.y * fsilu(bfhi(rr.x))); o.y = pk2(ao[vb].z * rstd * nw.z * fsilu(bflo(rr.y)), ao[vb].w * rstd * nw.w * fsilu(bfhi(rr.y)));
        *(v2u*)(mix + (m0 + lrow) * DM + 512 + h * 64 + v0) = o; }
}
__device__ __forceinline__ void zero_mix(const Ctx& C, int unit, int ssd) {
    bf16* mix = (bf16*)(C.ws + WS_ACT1); const int s = C.tid >> 3, sub = C.tid & 7;
    if (ssd) { const int b = unit / (NCH * 2), rem = unit - b * (NCH * 2), c = rem >> 1, g = rem & 1; const size_t m = (size_t)b * SB + c * CH + s;
        for (int q = 0; q < 4; ++q) *(v4u*)(mix + m * DM + g * 256 + q * 64 + sub * 8) = (v4u){0u, 0u, 0u, 0u}; }
    else { const int b = unit / (NCH * 4), rem = unit - b * (NCH * 4), c = rem >> 2, h = rem & 3; const size_t m = (size_t)b * SB + c * CH + s; *(v4u*)(mix + m * DM + 512 + h * 64 + sub * 8) = (v4u){0u, 0u, 0u, 0u}; }
}
constexpr int NU_S1 = NBATCH * NCH, NU_S3S = NBATCH * NCH * 2, NU_S3G = NBATCH * NCH * 2;
__device__ __forceinline__ void ph_chunk_s1(const Ctx& C, int l) { const float* alog = IN_(I_ALOG);
    for (int u = C.bid; u < 3 * NU_S1; u += C.G) { if (u < NU_S1) ssd_s1_bc(C, l, u, alog); else gla_s1_pair(C, l, u - NU_S1); }
}
__device__ __forceinline__ void ph_s2_assemble(const Args& A, const Ctx& C, int l, int rep) {
    if (C.wave < 6) { const int id = C.bid * 6 + C.wave, chain = id >> 2, sl = id & 3;
        if (chain < NBATCH * 2 * 8) chunk_s2_slice<true>(C, chain, sl); else if (chain < NBATCH * 2 * 12) chunk_s2_slice<false>(C, chain - NBATCH * 2 * 8, sl); }
    ph_assemble(A, C, l, rep);
}
__device__ __forceinline__ void ph_chunk_s3(const Ctx& C, int l, int rep) { const float* alog = IN_(I_ALOG); const float* dskip = IN_(I_SSDD); const float* nws = IN_(I_SSDNW); const float* nwg = IN_(I_GLANW);
    for (int u = C.bid; u < NU_S3S + NU_S3G; u += C.G) {
        const int uu = u < NU_S3S ? u : u - NU_S3S, c = (uu % (NCH * 2)) >> 1; if (l == 1 && c < NCTXCH) continue;
        if (u < NU_S3S) ssd_s3(C, l, uu, alog, dskip, nws); else gla_s3_pair(C, l, uu, nwg);
    }
}
constexpr int RT_VP = 2064;
__device__ __forceinline__ void ph_route(const Args& A, const Ctx& C, int l) { const float* const p_I_NORM2 = IN_(I_NORM2); const float* const p_I_RB = IN_(I_RB); const float* const p_I_RW = IN_(I_RW);
    LAS unsigned char* VH = C.lds; LAS unsigned char* VL = C.lds + 16 * RT_VP; LAS float* PART = (LAS float*)(C.lds + 32 * RT_VP);
    if (C.tid < 32) C.MISC[MISC_CNT + C.tid] = 0u;
    const bf16* Hp = (const bf16*)(C.ws + WS_H); const float* mod = (const float*)(C.ws + WS_MOD) + (size_t)l * 17 * 6144; bf16* vout = (bf16*)(C.ws + WS_ACT1);
    int* toke = (int*)(C.ws + WS_TOKE); int* tokp = (int*)(C.ws + WS_TOKP); float* tokw = (float*)(C.ws + WS_TOKW);
    const int lane = C.lane, w = C.wave, fr = lane & 15, fq = lane >> 4; const int RPW = TT / 256;
    bf16x8 wh[4][2], wl[4][2];
#pragma unroll
    for (int ks = 0; ks < 4; ++ks)
#pragma unroll
        for (int cb = 0; cb < 2; ++cb) { float x[8];
#pragma unroll
            for (int j = 0; j < 8; ++j) x[j] = p_I_RW[(size_t)l * 32768 + (size_t)(128 * w + 32 * ks + 8 * fq + j) * 32 + cb * 16 + fr];
            unsigned hh[4], ll[4];
#pragma unroll
            for (int j = 0; j < 4; ++j) { hh[j] = pk2(x[2 * j], x[2 * j + 1]); ll[j] = pk2(x[2 * j] - bflo(hh[j]), x[2 * j + 1] - bfhi(hh[j])); }
            wh[ks][cb] = __builtin_bit_cast(bf16x8, ((v4u){hh[0], hh[1], hh[2], hh[3]})); wl[ks][cb] = __builtin_bit_cast(bf16x8, ((v4u){ll[0], ll[1], ll[2], ll[3]})); }
    const f32x4* nwp = (const f32x4*)(p_I_NORM2 + l * 1024) + lane; f32x4 nw[4];
#pragma unroll
    for (int q = 0; q < 4; ++q) nw[q] = nwp[64 * q];
    const float rbias = p_I_RB[l * 32 + (lane & 31)];
    const int bb = (C.bid * RPW) / SB;
    for (int t = 0; t < RPW / 16; ++t) {
        const int mt = C.bid * RPW + t * 16, st = mt - bb * SB;
        if (l == 1 && st < CTXL) continue;
        const float* mr = mod + (size_t)(st < CTXL ? 16 : bb) * 6144;
        __syncthreads();
        {
            f32x4 v[2][4]; float ss[2];
#pragma unroll
            for (int r = 0; r < 2; ++r) { const v2u* xr = (const v2u*)(Hp + (size_t)(mt + 2 * w + r) * DM) + lane; ss[r] = 0.f;
#pragma unroll
                for (int q = 0; q < 4; ++q) { const v2u hw = xr[64 * q]; v[r][q] = (f32x4){bflo(hw.x), bfhi(hw.x), bflo(hw.y), bfhi(hw.y)}; ss[r] += (v[r][q].x * v[r][q].x + v[r][q].y * v[r][q].y) + (v[r][q].z * v[r][q].z + v[r][q].w * v[r][q].w); } }
#pragma unroll
            for (int o = 1; o < 64; o <<= 1) { ss[0] += __shfl_xor(ss[0], o); ss[1] += __shfl_xor(ss[1], o); }
#pragma unroll
            for (int r = 0; r < 2; ++r) { const float rstd = rsqrtf(ss[r] * (1.0f / 1024.0f) + EPS); const int row = 2 * w + r;
#pragma unroll
                for (int q = 0; q < 4; ++q) { const int j4 = lane + 64 * q; const f32x4 sh = ((const f32x4*)(mr + 3 * 1024))[j4], sc = ((const f32x4*)(mr + 4 * 1024))[j4];
                    const f32x4 o = (v[r][q] * rstd * nw[q]) * (sc + 1.0f) + sh; v2u hi; hi.x = pk2(o.x, o.y); hi.y = pk2(o.z, o.w);
                    v2u lo; lo.x = pk2(o.x - bflo(hi.x), o.y - bfhi(hi.x)); lo.y = pk2(o.z - bflo(hi.y), o.w - bfhi(hi.y));
                    ((v2u*)(vout + (size_t)(mt + row) * DM))[j4] = hi; *(LAS v2u*)(VH + row * RT_VP + j4 * 8) = hi; *(LAS v2u*)(VL + row * RT_VP + j4 * 8) = lo; } }
        }
        __syncthreads();
        {
            f32x4 acc[2]; acc[0] = (f32x4){0.f, 0.f, 0.f, 0.f}; acc[1] = acc[0];
#pragma unroll
            for (int ks = 0; ks < 4; ++ks) { const bf16x8 ah = *(const LAS bf16x8*)(VH + fr * RT_VP + (128 * w + 32 * ks + 8 * fq) * 2), al = *(const LAS bf16x8*)(VL + fr * RT_VP + (128 * w + 32 * ks + 8 * fq) * 2);
#pragma unroll
                for (int cb = 0; cb < 2; ++cb) { acc[cb] = __builtin_amdgcn_mfma_f32_16x16x32_bf16(ah, wh[ks][cb], acc[cb], 0, 0, 0); acc[cb] = __builtin_amdgcn_mfma_f32_16x16x32_bf16(al, wh[ks][cb], acc[cb], 0, 0, 0); acc[cb] = __builtin_amdgcn_mfma_f32_16x16x32_bf16(ah, wl[ks][cb], acc[cb], 0, 0, 0); } }
#pragma unroll
            for (int cb = 0; cb < 2; ++cb) { PART[w * 512 + (4 * fq + 0) * 32 + cb * 16 + fr] = acc[cb].x; PART[w * 512 + (4 * fq + 1) * 32 + cb * 16 + fr] = acc[cb].y; PART[w * 512 + (4 * fq + 2) * 32 + cb * 16 + fr] = acc[cb].z; PART[w * 512 + (4 * fq + 3) * 32 + cb * 16 + fr] = acc[cb].w; }
        }
        __syncthreads();
        {
            const int row = C.tid >> 5, e = lane & 31, half = lane >> 5; float lg = rbias;
#pragma unroll
            for (int ww = 0; ww < 8; ++ww) lg += PART[ww * 512 + row * 32 + e];
            int es[4]; float vs[4];
#pragma unroll
            for (int k = 0; k < 4; ++k) { float mx = lg;
#pragma unroll
                for (int o = 1; o < 32; o <<= 1) mx = fmaxf(mx, __shfl_xor(mx, o));
                const unsigned long long bal = __ballot(lg == mx); const unsigned bits = (unsigned)(bal >> (32 * half)); const int first = __ffs((int)bits) - 1;
                es[k] = first; vs[k] = mx; if (e == first) lg = -3.0e38f; }
            const float p1 = expf(vs[1] - vs[0]), p2 = expf(vs[2] - vs[0]), p3 = expf(vs[3] - vs[0]); const float inv = 1.0f / (1.0f + p1 + p2 + p3);
            if (e < 4) { const int ek = e == 0 ? es[0] : e == 1 ? es[1] : e == 2 ? es[2] : es[3]; const float wk = (e == 0 ? 1.0f : e == 1 ? p1 : e == 2 ? p2 : p3) * inv; const size_t m = (size_t)(mt + row);
                const unsigned pos = atomicAdd((unsigned*)&C.MISC[MISC_CNT + ek], 1u);
                toke[m * 4 + e] = ek; tokp[m * 4 + e] = (int)pos; tokw[m * 4 + e] = wk; }
        }
    }
    __syncthreads();
    if (C.tid < 32) ((int*)(C.ws + WS_WGCNT))[C.bid * 32 + C.tid] = (int)C.MISC[MISC_CNT + C.tid];
}
__device__ __forceinline__ void ph_slots(const Args& A, const Ctx& C, int l) {
    LAS int* wc = (LAS int*)C.lds;
    LAS int* ps = wc + 256 * 32;
    const int* wgcnt = (const int*)(C.ws + WS_WGCNT);
    for (int idx = C.tid; idx < C.G * 32; idx += NTHREADS) wc[idx] = wgcnt[idx];
    __syncthreads();
    { const int e = C.tid & 31, part = C.tid >> 5; int tot = 0, base = 0;
#pragma unroll
      for (int k = 0; k < 16; ++k) { const int g = part * 16 + k; const int c = wc[g * 32 + e]; tot += c; base += g < C.bid ? c : 0; }
      ps[part * 32 + e] = tot; ps[512 + part * 32 + e] = base; }
    __syncthreads();
    if (C.tid < 64) {
        const int e = C.tid & 31; int tot = 0, base = 0;
#pragma unroll
        for (int k = 0; k < 16; ++k) { tot += ps[k * 32 + e]; base += ps[512 + k * 32 + e]; }
        const int padded = (tot + 255) & ~255; int incl = padded;
#pragma unroll
        for (int o = 1; o < 32; o <<= 1) { const int t = __shfl_up(incl, o); if (e >= o) incl += t; }
        const int off = incl - padded;
        if (C.tid < 32) { C.MISC[MISC_SB + e] = (unsigned)(off + base); ps[1024 + e] = tot; ps[1056 + e] = off;
            if (C.bid == 0) { int* meta = (int*)(C.ws + WS_META); meta[e] = off >> 8; if (e == 31) meta[32] = incl >> 8; } }
    }
    __syncthreads();
    const int* toke = (const int*)(C.ws + WS_TOKE); const int* tokp = (const int*)(C.ws + WS_TOKP); int* toks = (int*)(C.ws + WS_TOKS); int* stok = (int*)(C.ws + WS_STOK);
    if (C.bid < 32) { const int tot = ps[1024 + C.bid], off = ps[1056 + C.bid], p2 = tot + C.tid; if (p2 < ((tot + 255) & ~255)) stok[off + p2] = 0; }
    const int RPW = TT / 256;
    int ee[3], pp[3];
#pragma unroll
    for (int k = 0; k < 3; ++k) { const int idx = C.tid + k * NTHREADS; ee[k] = 0; pp[k] = 0; if (idx < RPW * 4) { const size_t m = (size_t)C.bid * RPW + (idx >> 2); ee[k] = toke[m * 4 + (idx & 3)]; pp[k] = tokp[m * 4 + (idx & 3)]; } }
    static_assert(RPW * 4 <= 3 * NTHREADS, "three items per thread");
#pragma unroll
    for (int k = 0; k < 3; ++k) { const int idx = C.tid + k * NTHREADS; if (idx < RPW * 4) { const int m = C.bid * RPW + (idx >> 2); const int b = m / SB, s = m - b * SB;
        if (!(l == 1 && s < CTXL)) { const int slot = (int)C.MISC[MISC_SB + ee[k]] + pp[k]; toks[(size_t)m * 4 + (idx & 3)] = slot; stok[slot] = m; } } }
}
__device__ __forceinline__ void ph_combine(const Args& A, const Ctx& C, int l) { const float* const p_I_FINW = IN_(I_FINW); const float* const p_I_NORM1 = IN_(I_NORM1); float* const p_OUT = (float*)IN_(N_IN);
    const bf16* Y = (const bf16*)(C.ws + WS_XG); bf16* Hp = (bf16*)(C.ws + WS_H); const float* modl = (const float*)(C.ws + WS_MOD) + (size_t)l * 17 * 6144;
    const int* tokp = (const int*)(C.ws + WS_TOKS); const float* tokw = (const float*)(C.ws + WS_TOKW);
    const int gw = C.bid * NWAVES + C.wave, NGW = C.G * NWAVES, lane = C.lane;
    const int NR = l == 0 ? TT : NBATCH * SEQL;
#define ROW_OF(i_) (l == 0 ? (i_) : ((i_) >> 12) * SB + CTXL + ((i_) & 4095))
    const f32x4* nwp = (const f32x4*)(l == 0 ? p_I_NORM1 + 1024 : p_I_FINW); f32x4 nw[4];
#pragma unroll
    for (int q = 0; q < 2; ++q) { nw[2 * q] = nwp[(lane + 64 * q) * 2]; nw[2 * q + 1] = nwp[(lane + 64 * q) * 2 + 1]; }
    int s0[4], s1[4], s2[4]; float w0[4], w1[4], w2[4];
    v4u y0[4][2], y1[4][2]; f32x4 h0[4], h1[4];
#define CMB_SLOTS(i_, s_, w_) do { const size_t m_ = (size_t)ROW_OF(i_); _Pragma("unroll") for (int k = 0; k < 4; ++k) { s_[k] = tokp[m_ * 4 + k]; w_[k] = tokw[m_ * 4 + k]; } } while (0)
#define CMB_DATA(i_, s_, y_, h_) do { const size_t m_ = (size_t)ROW_OF(i_); _Pragma("unroll") for (int q = 0; q < 2; ++q) { const int j8 = lane + 64 * q; \
        _Pragma("unroll") for (int k = 0; k < 4; ++k) y_[k][q] = ((const v4u*)(Y + (size_t)s_[k] * DM))[j8]; \
        { const v4u hw_ = ((const v4u*)(Hp + m_ * DM))[j8]; h_[2 * q] = (f32x4){bflo(hw_.x), bfhi(hw_.x), bflo(hw_.y), bfhi(hw_.y)}; h_[2 * q + 1] = (f32x4){bflo(hw_.z), bfhi(hw_.z), bflo(hw_.w), bfhi(hw_.w)}; } } } while (0)
    if (gw < NR) { CMB_SLOTS(gw, s0, w0); if (gw + NGW < NR) CMB_SLOTS(gw + NGW, s1, w1); CMB_DATA(gw, s0, y0, h0); }
    for (int i = gw; i < NR; i += NGW) {
        if (i + NGW < NR) CMB_DATA(i + NGW, s1, y1, h1);
        if (i + 2 * NGW < NR) CMB_SLOTS(i + 2 * NGW, s2, w2);
        const int m = ROW_OF(i); const int b = m / SB, s = m - b * SB; const int rr = s < CTXL ? 16 : b; const float* g5 = modl + (size_t)rr * 6144 + 5 * 1024;
        float hn[16]; float ss = 0.f;
#pragma unroll
        for (int q = 0; q < 2; ++q) { const int j8 = lane + 64 * q; float f[8];
#pragma unroll
            for (int k = 0; k < 8; ++k) f[k] = 0.f;
#pragma unroll
            for (int k = 0; k < 4; ++k) { const v4u y = y0[k][q]; const float wk = w0[k];
                f[0] += wk * bflo(y.x); f[1] += wk * bfhi(y.x); f[2] += wk * bflo(y.y); f[3] += wk * bfhi(y.y); f[4] += wk * bflo(y.z); f[5] += wk * bfhi(y.z); f[6] += wk * bflo(y.w); f[7] += wk * bfhi(y.w); }
            const f32x4 ha = h0[2 * q], hb = h0[2 * q + 1];
            const f32x4 ga = ((const f32x4*)g5)[j8 * 2], gb = ((const f32x4*)g5)[j8 * 2 + 1];
            hn[q * 8 + 0] = ha.x + ga.x * f[0]; hn[q * 8 + 1] = ha.y + ga.y * f[1]; hn[q * 8 + 2] = ha.z + ga.z * f[2]; hn[q * 8 + 3] = ha.w + ga.w * f[3];
            hn[q * 8 + 4] = hb.x + gb.x * f[4]; hn[q * 8 + 5] = hb.y + gb.y * f[5]; hn[q * 8 + 6] = hb.z + gb.z * f[6]; hn[q * 8 + 7] = hb.w + gb.w * f[7];
#pragma unroll
            for (int k = 0; k < 8; ++k) ss += hn[q * 8 + k] * hn[q * 8 + k]; }
        const float rstd = rsqrtf(wave_sum(ss) * (1.0f / 1024.0f) + EPS);
        if (l == 0) {
            const float* mn = (const float*)(C.ws + WS_MOD) + (size_t)17 * 6144 + (size_t)rr * 6144; bf16* uo = (bf16*)(C.ws + WS_ACT1) + (size_t)m * DM;
#pragma unroll
            for (int q = 0; q < 2; ++q) { const int j8 = lane + 64 * q;
                { v4u hw; hw.x = pk2(hn[q * 8], hn[q * 8 + 1]); hw.y = pk2(hn[q * 8 + 2], hn[q * 8 + 3]); hw.z = pk2(hn[q * 8 + 4], hn[q * 8 + 5]); hw.w = pk2(hn[q * 8 + 6], hn[q * 8 + 7]); ((v4u*)(Hp + (size_t)m * DM))[j8] = hw; }
                float o[8];
#pragma unroll
                for (int hh = 0; hh < 2; ++hh) { const f32x4 w = nw[2 * q + hh], sh = ((const f32x4*)mn)[j8 * 2 + hh], sc = ((const f32x4*)(mn + 1024))[j8 * 2 + hh];
                    o[hh * 4 + 0] = (hn[q * 8 + hh * 4 + 0] * rstd * w.x) * (sc.x + 1.0f) + sh.x; o[hh * 4 + 1] = (hn[q * 8 + hh * 4 + 1] * rstd * w.y) * (sc.y + 1.0f) + sh.y;
                    o[hh * 4 + 2] = (hn[q * 8 + hh * 4 + 2] * rstd * w.z) * (sc.z + 1.0f) + sh.z; o[hh * 4 + 3] = (hn[q * 8 + hh * 4 + 3] * rstd * w.w) * (sc.w + 1.0f) + sh.w; }
                v4u p; p.x = pk2(o[0], o[1]); p.y = pk2(o[2], o[3]); p.z = pk2(o[4], o[5]); p.w = pk2(o[6], o[7]); ((v4u*)uo)[j8] = p; }
        } else {
            float* orow = p_OUT + ((size_t)b * SEQL + (s - CTXL)) * DM;
#pragma unroll
            for (int q = 0; q < 2; ++q) { const int j8 = lane + 64 * q;
#pragma unroll
                for (int hh = 0; hh < 2; ++hh) { const f32x4 w = nw[2 * q + hh];
                    ((f32x4*)orow)[j8 * 2 + hh] = (f32x4){hn[q * 8 + hh * 4] * rstd * w.x, hn[q * 8 + hh * 4 + 1] * rstd * w.y, hn[q * 8 + hh * 4 + 2] * rstd * w.z, hn[q * 8 + hh * 4 + 3] * rstd * w.w}; } }
        }
#pragma unroll
        for (int k = 0; k < 4; ++k) { s0[k] = s1[k]; w0[k] = w1[k]; s1[k] = s2[k]; w1[k] = w2[k]; y0[k][0] = y1[k][0]; y0[k][1] = y1[k][1]; h0[k] = h1[k]; }
    }
#undef ROW_OF
#undef CMB_SLOTS
#undef CMB_DATA
}
constexpr int NLP = 12;
constexpr int N_PHASES = 3 + 2 * NLP;
#ifndef GA_
#define GA_ true
#endif
#ifndef GS_
#define GS_ true
#endif
#ifndef PHMASK
#define PHMASK 0xffff
#endif
#define PH_ON(id) (lo <= (id) && (id) < hi && ((PHMASK >> ((id) < 3 ? (id) : 3 + ((id) - 3) % NLP)) & 1))
#define FRESH() do { int t_ = C.tid; unsigned wl_ = __builtin_amdgcn_readfirstlane((unsigned)(unsigned long long)C.ws), wh_ = __builtin_amdgcn_readfirstlane((unsigned)((unsigned long long)C.ws >> 32)); \
        int g_ = __builtin_amdgcn_readfirstlane(C.G), b_ = __builtin_amdgcn_readfirstlane(C.bid); \
        asm volatile("" : "+s"(wl_), "+s"(wh_), "+s"(g_), "+s"(b_), "+v"(t_)); \
        C.tid = t_; C.G = g_; C.bid = b_; C.ws = (GAS unsigned char*)(((unsigned long long)wh_ << 32) | wl_); C.lane = C.tid & 63; C.wave = __builtin_amdgcn_readfirstlane(C.tid >> 6); ws = C.ws; } while (0)
#ifdef DBLBAR
#define PH_SEAM(id) do { if ((id) + 1 < hi) { xcd_barrier(bar); xcd_barrier(bar); } } while (0)
#else
#define PH_SEAM(id) do { if ((id) + 1 < hi) xcd_barrier(bar); } while (0)
#endif
#ifndef PHREP
#define PHREP 0ull
#endif
#if PHREP
#define REPS_(id) (((id) < 3 || (((PHREP >> (3 + ((id) - 3) % NLP)) | (PHREP >> (3 + NLP + ((id) - 3) % NLP))) & 1ull)) ? (int)((PHREP >> (id)) & 1ull) : 0)
#define PH_BEGIN(id) if (PH_ON(id)) { for (int rep_ = 0; rep_ <= REPS_(id); ++rep_) { FRESH();
#define PH_END(id) if (rep_ < REPS_(id)) xcd_barrier(bar); } PH_SEAM(id); }
#else
#define PH_BEGIN(id) if (PH_ON(id)) { const int rep_ = 0; (void)rep_; FRESH();
#define PH_END(id) PH_SEAM(id); }
#endif
template <int L> __device__ __forceinline__ void layer_phases(const Args& args, Ctx& C, const XcdBarrier& bar, const int lo, const int hi) {
    GAS unsigned char* ws = C.ws; constexpr int l = L; constexpr int pb = 3 + NLP * L;
        PH_BEGIN(pb + 0)
            pg8::Gemm g{(const bf16*)(ws + WS_ACT1), (const bf16*)(ws + WS_WINT) + (size_t)l * INWP * 1024, TT, INWP, 1024}; pg8::StaticOrder S; S.init(TT, INWP, C.G, C.bid);
            pg8::EpiBf16 E{(bf16*)(ws + WS_COLS), INWP, nullptr, 0, 0};
            pg8::gemm_phase<pg8::EpiBf16, pg8::StaticOrder, GA_, GS_>(C.lds, g, S, E, C.tid);
            PH_END(pb + 0)
        PH_BEGIN(pb + 1) ph_prep(args, C, l, rep_); PH_END(pb + 1)
        PH_BEGIN(pb + 2)
            { pg8::Gemm g{(const bf16*)(ws + WS_AQ), (const bf16*)(ws + WS_WUQT) + (size_t)l * 512 * 256, TT, 512, 256}; pg8::StaticOrder S; S.init(TT, 512, C.G, C.bid);
              pg8::EpiBf16 E{(bf16*)(ws + WS_QRAW), 512, nullptr, 0, 0}; pg8::gemm_phase<pg8::EpiBf16, pg8::StaticOrder, GA_, GS_>(C.lds, g, S, E, C.tid); }
            { pg8::Gemm g{(const bf16*)(ws + WS_AKV), (const bf16*)(ws + WS_WUKVT) + (size_t)l * 512 * 256, TT, 512, 256}; pg8::StaticOrder S; S.init(TT, 512, C.G, C.bid);
              pg8::EpiBf16 E{(bf16*)(ws + WS_KV), 512, nullptr, 0, 0}; pg8::gemm_phase<pg8::EpiBf16, pg8::StaticOrder, GA_, GS_>(C.lds, g, S, E, C.tid); }
            ph_chunk_s1(C, l);
            PH_END(pb + 2)
        PH_BEGIN(pb + 3) ph_s2_assemble(args, C, l, rep_); PH_END(pb + 3)
        PH_BEGIN(pb + 4) attn_queue(C, l, rep_); PH_END(pb + 4)
        PH_BEGIN(pb + 5) ph_chunk_s3(C, l, rep_); PH_END(pb + 5)
        PH_BEGIN(pb + 6)
            pg8::Gemm g{(const bf16*)(ws + WS_ACT1), (const bf16*)(ws + WS_WOUTT) + (size_t)l * 1024 * 1024, TT, 1024, 1024};
            pg8::MapOrder S; S.init(l == 0 ? TT : NBATCH * SEQL, 1024, C.G, C.bid); S.skipctx = l;
            pg8::EpiResid E{IN_(I_X), IN_(I_CTX), (const bf16*)(ws + WS_H), (bf16*)(ws + WS_H), (const float*)(ws + WS_MOD) + (size_t)l * 17 * 6144, l};
            pg8::gemm_phase<pg8::EpiResid, pg8::MapOrder, GA_, GS_>(C.lds, g, S, E, C.tid);
            PH_END(pb + 6)
        PH_BEGIN(pb + 7) ph_route(args, C, l); PH_END(pb + 7)
        PH_BEGIN(pb + 8) ph_slots(args, C, l); PH_END(pb + 8)
        PH_BEGIN(pb + 9)
            pg8::Gemm g{(const bf16*)(ws + WS_ACT1), (const bf16*)(ws + WS_W1T), MAXSLOT, 32 * 2048, 1024};
            pg8::MoeOrder S{(const int*)(ws + WS_META), 8, C.G, C.bid};
            pg8::EpiSwiglu E{(bf16*)(ws + WS_ACTB), IN_(I_B1) + (size_t)l * 32 * 2048};
            pg8::gemm_phase_gather<pg8::EpiSwiglu, pg8::MoeOrder>(C.lds, g, S, E, C.tid, (const int*)(ws + WS_STOK));
            PH_END(pb + 9)
        PH_BEGIN(pb + 10)
            pg8::Gemm g{(const bf16*)(ws + WS_ACTB), (const bf16*)(ws + WS_W2T), MAXSLOT, 32 * 1024, 1024};
            pg8::MoeOrder S{(const int*)(ws + WS_META), 4, C.G, C.bid};
            pg8::EpiBf16 E{(bf16*)(ws + WS_XG), 1024, IN_(I_B2) + (size_t)l * 32 * 1024, 1024, 0};
            pg8::gemm_phase<pg8::EpiBf16, pg8::MoeOrder, GA_, GS_>(C.lds, g, S, E, C.tid);
            PH_END(pb + 10)
        PH_BEGIN(pb + 11) ph_combine(args, C, l); PH_END(pb + 11)
}
__global__ void __launch_bounds__(NTHREADS, 2) fwd_kernel(Args args) {
    extern __shared__ __attribute__((aligned(16))) unsigned char lds_raw[];
    Ctx C;
    C.lds = (LAS unsigned char*)lds_raw; C.MISC = (volatile LAS unsigned*)(C.lds + LDSCTL_OFF); C.ws = (GAS unsigned char*)args.ws;
    C.tid = threadIdx.x; C.lane = C.tid & 63; C.wave = __builtin_amdgcn_readfirstlane(C.tid >> 6); C.G = gridDim.x; C.bid = blockIdx.x;
    for (int u = C.tid; u < (LDS_BYTES - LDSCTL_OFF) / 4; u += NTHREADS) ((LAS unsigned*)(C.lds + LDSCTL_OFF))[u] = 0u;
    __syncthreads();
    if (C.tid <= N_IN) {
        const unsigned long long* ka = (const unsigned long long*)__builtin_amdgcn_kernarg_segment_ptr();
        ((volatile LAS unsigned long long*)(C.lds + PTR_OFF))[C.tid] = ka[C.tid]; }
    __syncthreads();
    XcdBarrier bar = xcd_barrier_post((unsigned*)args.ws + CW_BAR, C.MISC + MISC_BAR);
    const int lo = args.ph_lo, hi = args.ph_hi;
    GAS unsigned char* ws = (GAS unsigned char*)args.ws;
    PH_BEGIN(0) ph_g0(args, C); PH_END(0)
    PH_BEGIN(1) ph_g1(args, C); PH_END(1)
    PH_BEGIN(2) ph_g2(args, C); PH_END(2)
    layer_phases<0>(args, C, bar, lo, hi);
    layer_phases<1>(args, C, bar, lo, hi);
}
#undef PH_ON
#undef PH_SEAM


#ifndef MK_CUTS
#define MK_CUTS 0
#endif
extern "C" void kernel_launch(void* const* d_in, const int* in_sizes, int n_in, void* d_out, int out_size, void* d_ws, size_t ws_size, hipStream_t stream) {
    static int grid = 0;
    if (grid == 0) {
        if (n_in != N_IN || ws_size < WS_END || out_size != NBATCH * SEQL * DM) { fprintf(stderr, "kernel_launch: unexpected shapes (n_in %d, ws %zu, out %d); nothing launched\n", n_in, ws_size, out_size); grid = -1; return; }
        int dev = 0, cus = 0, per_cu = 0;
        if (hipGetDevice(&dev) != hipSuccess || hipDeviceGetAttribute(&cus, hipDeviceAttributeMultiprocessorCount, dev) != hipSuccess) { grid = -1; return; }
        if (hipFuncSetAttribute((const void*)fwd_kernel, hipFuncAttributeMaxDynamicSharedMemorySize, LDS_BYTES) != hipSuccess) { fprintf(stderr, "kernel_launch: hipFuncSetAttribute failed\n"); grid = -1; return; }
        if (hipOccupancyMaxActiveBlocksPerMultiprocessor(&per_cu, (const void*)fwd_kernel, NTHREADS, LDS_BYTES) != hipSuccess || per_cu < 1)
            fprintf(stderr, "kernel_launch: note: occupancy query reports %d workgroups per CU\n", per_cu);
        (void)hipGetLastError();
        if (cus < 256) { fprintf(stderr, "kernel_launch: this kernel is laid out for 256 CUs (found %d); nothing launched\n", cus); grid = -1; return; }
        grid = 256;
    }
    if (grid < 0) return;
    if (hipMemsetAsync((char*)d_ws + WS_CTL, 0, CTL_ZERO_BYTES, stream) != hipSuccess) return;
    Args a{};
    for (int i = 0; i < N_IN; ++i) a.in[i] = (const float*)d_in[i];
    a.out = (float*)d_out; a.ws = (unsigned char*)d_ws;
#if MK_CUTS
    for (int p = 0; p < N_PHASES; ++p) { a.ph_lo = p; a.ph_hi = p + 1; hipLaunchKernelGGL(fwd_kernel, dim3(grid), dim3(NTHREADS), LDS_BYTES, stream, a); }
#else
    a.ph_lo = 0; a.ph_hi = N_PHASES;
    hipLaunchKernelGGL(fwd_kernel, dim3(grid), dim3(NTHREADS), LDS_BYTES, stream, a);
#endif
    const hipError_t le = hipPeekAtLastError();
    if (le != hipSuccess) fprintf(stderr, "kernel_launch: launch failed: %s\n", hipGetErrorName(le));
}
```

```cpp
#include <hip/hip_runtime.h>
#include <cstdio>
#include <cstdint>
namespace pg8 {
#define PG8_LAS __attribute__((address_space(3)))
typedef unsigned short bf16_t;
typedef short bf16x8 __attribute__((ext_vector_type(8)));
typedef float f32x4 __attribute__((ext_vector_type(4)));
typedef unsigned u32x4 __attribute__((ext_vector_type(4)));
constexpr int BM = 256, BK = 64, HALF = 128, HTB = HALF * BK * 2  , STAGE_BYTES = 8 * HTB, NXCD = 8,
#ifndef PG8_WGM
#define PG8_WGM 8
#endif
    WGM = PG8_WGM;

__host__ __device__ __forceinline__ int lds_byte(int r, int c) { const int st = (r >> 4) * 2 + (c >> 5), rr = r & 15, cc = c & 31, ob = rr * 64 + cc * 2; return st * 1024 + (ob ^ (((ob >> 9) & 1) << 5)); }
__host__ __device__ __forceinline__ void stage_rc(int b, int& R, int& C) { const int st = b / 1024, sb = b % 1024, swz = sb ^ (((sb >> 9) & 1) << 5); R = (st >> 1) * 16 + swz / 64; C = (st & 1) * 32 + (swz % 64) / 2; }
__host__ __device__ __forceinline__ int perm32(int rho) { const int n = rho >> 4, i = rho & 15; return 8 * (i >> 2) + 4 * n + (i & 3); }

struct Unit { int pm, pn; };
struct Gemm { const bf16_t* A; const bf16_t* Bt; int M, N, K; };

struct StaticOrder {
    int nM, nN, nwg, G, c;
    __host__ __device__ void init(int M, int N, int G_, int c_) { nM = M / BM; nN = N / BM; nwg = nM * nN; G = G_; c = c_; }
    __host__ __device__ bool next(int i, Unit& u) const {
        const long L = (long)i * G + c; if (L >= nwg) return false;
        int wgid = (int)L; { const int q = nwg / NXCD, r = nwg % NXCD, xcd = wgid % NXCD, off = wgid / NXCD; wgid = (xcd < r ? xcd * (q + 1) : r * (q + 1) + (xcd - r) * q) + off; }
        const int nig = WGM * nN, gid = wgid / nig, fm = gid * WGM, gsz = (nM - fm) < WGM ? (nM - fm) : WGM;
        u.pm = fm + ((wgid % nig) % gsz); u.pn = (wgid % nig) / gsz; return true;
    }
    __device__ __forceinline__ void a_ready(const Unit&) const {}
    __device__ __forceinline__ void done(const Unit&) const {}
};

__device__ __forceinline__ unsigned cvt_pk_bf16(float lo, float hi) { unsigned r; asm volatile("v_cvt_pk_bf16_f32 %0, %1, %2" : "=v"(r) : "v"(lo), "v"(hi)); return r; }
typedef float f32x2 __attribute__((ext_vector_type(2)));
struct EpiBf16 {
    static constexpr bool PERM = true, AFTER_DRAIN = false;
    bf16_t* O; int ldc; const float* bias; int split_cols; size_t split_stride;
    __device__ __forceinline__ void operator()(const f32x4 (&acc)[2][2][4][2], const Unit& u, int wr, int wc, int fr, int fq) const {
        const int row0 = u.pm * BM + wr * 64 + fr; int colt = u.pn * BM; bf16_t* base = O;
        if (split_cols) { const int t = colt / split_cols; base += (size_t)t * split_stride; colt -= t * split_cols; }
        const int col0 = colt + wc * 32 + 8 * fq, bcol0 = u.pn * BM + wc * 32 + 8 * fq;
        f32x4 bv[2][2];
#pragma unroll
        for (int bj = 0; bj < 2; ++bj)
#pragma unroll
            for (int n = 0; n < 2; ++n) bv[bj][n] = bias ? *(const f32x4*)(bias + bcol0 + bj * HALF + 4 * n) : (f32x4){0.f, 0.f, 0.f, 0.f};
#pragma unroll
        for (int ai = 0; ai < 2; ++ai)
#pragma unroll
            for (int m = 0; m < 4; ++m) { bf16_t* rowp = base + (size_t)(row0 + ai * HALF + m * 16) * ldc + col0;
#pragma unroll
                for (int bj = 0; bj < 2; ++bj) { const f32x4 v0 = acc[ai][bj][m][0] + bv[bj][0], v1 = acc[ai][bj][m][1] + bv[bj][1];
                    u32x4 w; w.x = cvt_pk_bf16(v0[0], v0[1]); w.y = cvt_pk_bf16(v0[2], v0[3]); w.z = cvt_pk_bf16(v1[0], v1[1]); w.w = cvt_pk_bf16(v1[2], v1[3]);
                    *(u32x4*)(rowp + bj * HALF) = w; } }
    }
};
struct EpiSwiglu {
    static constexpr bool PERM = true, AFTER_DRAIN = false;
    bf16_t* O; const float* bias;
    __device__ __forceinline__ void operator()(const f32x4 (&acc)[2][2][4][2], const Unit& u, int wr, int wc, int fr, int fq) const {
        const int row0 = u.pm * BM + wr * 64 + fr;
        const int hc0 = (u.pn & 7) * BM + wc * 32 + 8 * fq, bcol0 = u.pn * BM + wc * 32 + 8 * fq;
        f32x4 bv[2][2];
#pragma unroll
        for (int bj = 0; bj < 2; ++bj)
#pragma unroll
            for (int n = 0; n < 2; ++n) bv[bj][n] = *(const f32x4*)(bias + bcol0 + bj * HALF + 4 * n);
#pragma unroll
        for (int ai = 0; ai < 2; ++ai)
#pragma unroll
            for (int m = 0; m < 4; ++m) { bf16_t* rowp = O + (size_t)(row0 + ai * HALF + m * 16) * 1024 + (hc0 >> 1);
#pragma unroll
                for (int bj = 0; bj < 2; ++bj) { const f32x4 v0 = acc[ai][bj][m][0] + bv[bj][0], v1 = acc[ai][bj][m][1] + bv[bj][1];
                    float a[4];
#pragma unroll
                    for (int q = 0; q < 4; ++q) { const float gl = fminf(q < 2 ? v0[2 * q] : v1[2 * q - 4], 7.0f); float li = q < 2 ? v0[2 * q + 1] : v1[2 * q - 3]; li = fminf(fmaxf(li, -7.0f), 7.0f);
                        a[q] = gl * __builtin_amdgcn_rcpf(1.0f + __builtin_amdgcn_exp2f(-2.4554669595930156f * gl)) * (li + 1.0f); }
                    typedef unsigned u32x2 __attribute__((ext_vector_type(2)));
                    u32x2 w; w.x = cvt_pk_bf16(a[0], a[1]); w.y = cvt_pk_bf16(a[2], a[3]);
                    *(u32x2*)(rowp + bj * (HALF / 2)) = w; } }
    }
};
struct EpiResid {
    static constexpr bool PERM = false, AFTER_DRAIN = false;
    const float* x; const float* ctx; const bf16_t* H; bf16_t* Hout; const float* mod; int layer;
    __device__ __forceinline__ void operator()(const f32x4 (&acc)[2][2][4][2], const Unit& u, int wr, int wc, int fr, int fq) const {
        typedef unsigned u32x2 __attribute__((ext_vector_type(2)));
        const int b = u.pm / 17, tin = u.pm - b * 17; const float* gate = mod + (size_t)(tin == 0 ? 16 : b) * 6144 + 2048;
        const float* base = tin == 0 ? ctx + (size_t)b * 256 * 1024 : x + ((size_t)b * 4096 + (size_t)(tin - 1) * 256) * 1024;
        const bf16_t* hb = H + (size_t)u.pm * 256 * 1024; bf16_t* outp = Hout + (size_t)u.pm * 256 * 1024;
        const int rl0 = wr * 64 + fr, col0 = u.pn * BM + wc * 32 + 4 * fq;
        f32x4 gv[2][2];
#pragma unroll
        for (int bj = 0; bj < 2; ++bj)
#pragma unroll
            for (int n = 0; n < 2; ++n) gv[bj][n] = *(const f32x4*)(gate + col0 + bj * HALF + n * 16);
#pragma unroll
        for (int ai = 0; ai < 2; ++ai)
#pragma unroll
            for (int m = 0; m < 4; ++m) { const size_t off = (size_t)(rl0 + ai * HALF + m * 16) * 1024 + col0;
#pragma unroll
                for (int bj = 0; bj < 2; ++bj)
#pragma unroll
                    for (int n = 0; n < 2; ++n) { f32x4 bs;
                        if (layer == 0) bs = *(const f32x4*)(base + off + bj * HALF + n * 16);
                        else { const u32x2 hw = *(const u32x2*)(hb + off + bj * HALF + n * 16); bs = (f32x4){__uint_as_float(hw.x << 16), __uint_as_float(hw.x & 0xffff0000u), __uint_as_float(hw.y << 16), __uint_as_float(hw.y & 0xffff0000u)}; }
                        const f32x4 o = bs + gv[bj][n] * acc[ai][bj][m][n]; u32x2 w; w.x = cvt_pk_bf16(o[0], o[1]); w.y = cvt_pk_bf16(o[2], o[3]); *(u32x2*)(outp + off + bj * HALF + n * 16) = w; } }
    }
};
struct MapOrder : StaticOrder {
    int skipctx;
    __device__ __forceinline__ bool next(int i, Unit& u) const { if (!StaticOrder::next(i, u)) return false; if (skipctx) u.pm = (u.pm >> 4) * 17 + 1 + (u.pm & 15); return true; }
};
struct MoeOrder {
    const int* toff; int npn, G, c;
    __device__ __forceinline__ bool next(int i, Unit& u) const {
        const int nt = toff[32], nwg = nt * npn; const long L = (long)i * G + c; if (L >= (long)nwg) return false;
        int wgid = (int)L; { const int q = nwg / NXCD, r = nwg % NXCD, xcd = wgid % NXCD, off = wgid / NXCD; wgid = (xcd < r ? xcd * (q + 1) : r * (q + 1) + (xcd - r) * q) + off; }
#ifndef MOE_WGM
#define MOE_WGM 8
#endif
        const int nig = MOE_WGM * npn, gid = wgid / nig, fm = gid * MOE_WGM, gsz = (nt - fm) < MOE_WGM ? (nt - fm) : MOE_WGM;
        const int pm = fm + ((wgid % nig) % gsz), pnl = (wgid % nig) / gsz; int e = 0;
        for (int q = 1; q < 32; ++q) e += (toff[q] <= pm) ? 1 : 0;
        u.pm = pm; u.pn = e * npn + pnl; return true;
    }
    __device__ __forceinline__ void a_ready(const Unit&) const {}
    __device__ __forceinline__ void done(const Unit&) const {}
};
template <class Epi, class Sched, bool ALIGN_EPI = false, bool SP2 = false>
__device__ __forceinline__ void gemm_phase(PG8_LAS unsigned char* lds, const Gemm g, const Sched& S, const Epi& E, const int tid) {
    const int  wid = __builtin_amdgcn_readfirstlane(tid >> 6), lane = tid & 63, wr = wid >> 2, wc = wid & 3, fr = lane & 15, fq = lane >> 4;
    const int K = g.K, nt = K / BK;
    unsigned voffA[2], voffB[2];
#pragma unroll
    for (int i = 0; i < 2; ++i) { int R, C; stage_rc(tid * 16 + i * 8192, R, C); const int Rb = Epi::PERM ? ((R & ~31) + perm32(R & 31)) : R;
        voffA[i] = (unsigned)(R * K + C) * 2u; voffB[i] = (unsigned)(Rb * K + C) * 2u; }
    const size_t kstep = (size_t)(BK * 2);
    const size_t hstep = (size_t)HALF * K * 2;
    const size_t tstep = 2 * hstep;
    const unsigned ldsw = (unsigned)wid * 1024u;
    const int aoff = lds_byte(wr * 64 + fr, fq * 8), boff = lds_byte(wc * 32 + fr, fq * 8);
#define PG8_SA(b, h) (((b) * 2 + (h)) * HTB)
#define PG8_SB(b, h) ((4 + (b) * 2 + (h)) * HTB)
#define PG8_STAGE(bufoff, gbase, voff) do { _Pragma("unroll") for (int _i = 0; _i < 2; ++_i) \
        __builtin_amdgcn_global_load_lds((const unsigned*)((const char*)(gbase) + (voff)[_i]), (PG8_LAS unsigned*)(lds + (bufoff) + ldsw + _i * 8192), 16, 0, 0); } while (0)
#define PG8_LDA(dst, b, h) do { _Pragma("unroll") for (int m = 0; m < 4; ++m) _Pragma("unroll") for (int k = 0; k < 2; ++k) dst[m][k] = *(const PG8_LAS bf16x8*)(lds + PG8_SA(b, h) + aoff + m * 2048 + k * 1024); } while (0)
#define PG8_LDB(dst, b, h) do { _Pragma("unroll") for (int n = 0; n < 2; ++n) _Pragma("unroll") for (int k = 0; k < 2; ++k) dst[n][k] = *(const PG8_LAS bf16x8*)(lds + PG8_SB(b, h) + boff + n * 2048 + k * 1024); } while (0)
#define PG8_MMA(ai, bj, At, Bt) do { __builtin_amdgcn_s_setprio(1); _Pragma("unroll") for (int m = 0; m < 4; ++m) _Pragma("unroll") for (int n = 0; n < 2; ++n) _Pragma("unroll") for (int k = 0; k < 2; ++k) \
        acc[ai][bj][m][n] = __builtin_amdgcn_mfma_f32_16x16x32_bf16(Bt[n][k], At[m][k], acc[ai][bj][m][n], 0, 0, 0); __builtin_amdgcn_s_setprio(0); } while (0)
#define PG8_WAIT_V(n) asm volatile("s_waitcnt vmcnt(" #n ")" ::: "memory")
#define PG8_WAIT_L(n) asm volatile("s_waitcnt lgkmcnt(" #n ")" ::: "memory")
#define PG8_BAR __builtin_amdgcn_s_barrier()
#define PG8_SCHED __builtin_amdgcn_sched_barrier(0)
    Unit cur, nxt; int ui = 0;
    if (!S.next(0, cur)) return;
    f32x4 acc[2][2][4][2];
#pragma unroll
    for (int a = 0; a < 2; ++a)
#pragma unroll
        for (int b = 0; b < 2; ++b)
#pragma unroll
            for (int m = 0; m < 4; ++m)
#pragma unroll
                for (int n = 0; n < 2; ++n) acc[a][b][m][n] = (f32x4){0.f, 0.f, 0.f, 0.f};
    bf16x8 At[4][2], B0[2][2], B1[2][2];
    const char* cA = (const char*)g.A + (size_t)cur.pm * tstep; const char* cB = (const char*)g.Bt + (size_t)cur.pn * tstep;
    S.a_ready(cur);
    if constexpr (SP2) {
        PG8_STAGE(PG8_SB(0, 0), cB, voffB); PG8_STAGE(PG8_SB(0, 1), cB + hstep, voffB); PG8_STAGE(PG8_SA(0, 0), cA, voffA); PG8_STAGE(PG8_SA(0, 1), cA + hstep, voffA);
        if (wr == 1) PG8_BAR;
        PG8_WAIT_V(2); PG8_BAR;
        PG8_STAGE(PG8_SB(1, 0), cB + kstep, voffB); PG8_STAGE(PG8_SA(1, 0), cA + kstep, voffA); PG8_STAGE(PG8_SB(1, 1), cB + hstep + kstep, voffB);
        PG8_WAIT_V(6); PG8_BAR;
    } else {
        PG8_STAGE(PG8_SB(0, 0), cB, voffB); PG8_STAGE(PG8_SA(0, 0), cA, voffA); PG8_STAGE(PG8_SB(0, 1), cB + hstep, voffB); PG8_STAGE(PG8_SA(0, 1), cA + hstep, voffA);
        if (wr == 1) PG8_BAR;
        PG8_WAIT_V(4); PG8_BAR;
        PG8_STAGE(PG8_SB(1, 0), cB + kstep, voffB); PG8_STAGE(PG8_SA(1, 0), cA + kstep, voffA); PG8_STAGE(PG8_SB(1, 1), cB + hstep + kstep, voffB);
        PG8_WAIT_V(6); PG8_BAR;
    }
    for (;;) {
        const bool has_next = S.next(ui + 1, nxt);
        const char* nA = has_next ? (const char*)g.A + (size_t)nxt.pm * tstep : cA; const char* nB = has_next ? (const char*)g.Bt + (size_t)nxt.pn * tstep : cB;
        for (int t = 0; t < nt; t += 2) {
            const bool last = (t == nt - 2);
            const char* a1 = cA + (size_t)(t + 1) * kstep;
            const char* a2 = last ? nA : cA + (size_t)(t + 2) * kstep; const char* b2 = last ? nB : cB + (size_t)(t + 2) * kstep;
            const char* a3 = a2 + kstep; const char* b3 = b2 + kstep;
            if (last && has_next) S.a_ready(nxt);
            if constexpr (SP2) {
            PG8_LDB(B0, 0, 0); PG8_LDB(B1, 0, 1); PG8_SCHED; PG8_LDA(At, 0, 0); PG8_STAGE(PG8_SA(1, 1), a1 + hstep, voffA);
            PG8_WAIT_V(8); PG8_WAIT_L(0); PG8_BAR; PG8_MMA(0, 0, At, B0); PG8_MMA(0, 1, At, B1); PG8_BAR; PG8_SCHED;
            PG8_LDA(At, 0, 1); PG8_STAGE(PG8_SB(0, 0), b2, voffB); PG8_STAGE(PG8_SB(0, 1), b2 + hstep, voffB); PG8_STAGE(PG8_SA(0, 0), a2, voffA);
            PG8_WAIT_V(8); PG8_WAIT_L(0); PG8_BAR; PG8_MMA(1, 0, At, B0); PG8_MMA(1, 1, At, B1); PG8_BAR; PG8_SCHED;
            PG8_LDB(B0, 1, 0); PG8_LDB(B1, 1, 1); PG8_SCHED; PG8_LDA(At, 1, 0); PG8_STAGE(PG8_SA(0, 1), a2 + hstep, voffA);
            PG8_WAIT_V(8); PG8_WAIT_L(0); PG8_BAR; PG8_MMA(0, 0, At, B0); PG8_MMA(0, 1, At, B1); PG8_BAR; PG8_SCHED;
            PG8_LDA(At, 1, 1); PG8_STAGE(PG8_SB(1, 0), b3, voffB); PG8_STAGE(PG8_SB(1, 1), b3 + hstep, voffB); PG8_STAGE(PG8_SA(1, 0), a3, voffA);
            PG8_WAIT_V(8); PG8_WAIT_L(0); PG8_BAR; PG8_MMA(1, 0, At, B0); PG8_MMA(1, 1, At, B1); PG8_BAR; PG8_SCHED;
            } else {
            PG8_LDB(B0, 0, 0); PG8_SCHED; PG8_LDA(At, 0, 0); PG8_STAGE(PG8_SA(1, 1), a1 + hstep, voffA);
            PG8_WAIT_L(8); PG8_BAR; PG8_WAIT_L(0); PG8_MMA(0, 0, At, B0); PG8_BAR; PG8_SCHED;
            PG8_LDB(B1, 0, 1); PG8_STAGE(PG8_SB(0, 0), b2, voffB);
            PG8_BAR; PG8_WAIT_L(0); PG8_MMA(0, 1, At, B1); PG8_BAR;
            PG8_LDA(At, 0, 1); PG8_STAGE(PG8_SA(0, 0), a2, voffA);
            PG8_BAR; PG8_WAIT_L(0); PG8_MMA(1, 0, At, B0); PG8_BAR; PG8_SCHED;
            PG8_STAGE(PG8_SB(0, 1), b2 + hstep, voffB);
            PG8_WAIT_V(6); PG8_BAR; PG8_MMA(1, 1, At, B1); PG8_BAR;
            PG8_LDB(B0, 1, 0); PG8_SCHED; PG8_LDA(At, 1, 0); PG8_STAGE(PG8_SA(0, 1), a2 + hstep, voffA);
            PG8_WAIT_L(8); PG8_BAR; PG8_WAIT_L(0); PG8_MMA(0, 0, At, B0); PG8_BAR; PG8_SCHED;
            PG8_LDB(B1, 1, 1); PG8_STAGE(PG8_SB(1, 0), b3, voffB);
            PG8_BAR; PG8_WAIT_L(0); PG8_MMA(0, 1, At, B1); PG8_BAR;
            PG8_LDA(At, 1, 1); PG8_STAGE(PG8_SA(1, 0), a3, voffA);
            PG8_BAR; PG8_WAIT_L(0); PG8_MMA(1, 0, At, B0); PG8_BAR; PG8_SCHED;
            PG8_STAGE(PG8_SB(1, 1), b3 + hstep, voffB);
            PG8_WAIT_V(6); PG8_BAR; PG8_MMA(1, 1, At, B1); PG8_BAR;
            }
        }
        if constexpr (ALIGN_EPI) { if (wr == 0) PG8_BAR; }
        if constexpr (!Epi::AFTER_DRAIN) { E(acc, cur, wr, wc, fr, fq); S.done(cur); }
        if (!has_next) break;
#pragma unroll
        for (int a = 0; a < 2; ++a)
#pragma unroll
            for (int b = 0; b < 2; ++b)
#pragma unroll
                for (int m = 0; m < 4; ++m)
#pragma unroll
                    for (int n = 0; n < 2; ++n) acc[a][b][m][n] = (f32x4){0.f, 0.f, 0.f, 0.f};
        cur = nxt; cA = nA; cB = nB; ++ui;
        if constexpr (ALIGN_EPI) { if (wr == 1) PG8_BAR; }
    }
    PG8_WAIT_V(0);
    if constexpr (!ALIGN_EPI) { if (wr == 0) PG8_BAR; }
    PG8_BAR;
    if constexpr (Epi::AFTER_DRAIN) { E.fused(acc, cur, wr, wc, fr, fq, lds, wid, lane); S.done(cur); }
#undef PG8_SA
#undef PG8_SB
#undef PG8_STAGE
#undef PG8_LDA
#undef PG8_LDB
#undef PG8_MMA
#undef PG8_WAIT_V
#undef PG8_WAIT_L
#undef PG8_BAR
#undef PG8_SCHED
}
template <class Epi, class Sched>
__device__ __forceinline__ void gemm_phase_gather(PG8_LAS unsigned char* lds, const Gemm g, const Sched& S, const Epi& E, const int tid, const int* tok) {
    const int wid = __builtin_amdgcn_readfirstlane(tid >> 6), lane = tid & 63, wr = wid >> 2, wc = wid & 3, fr = lane & 15, fq = lane >> 4;
    const int K = g.K, nt = K / BK;
    unsigned voffB[2];
#pragma unroll
    for (int i = 0; i < 2; ++i) { int R, C; stage_rc(tid * 16 + i * 8192, R, C); const int Rb = Epi::PERM ? ((R & ~31) + perm32(R & 31)) : R; voffB[i] = (unsigned)(Rb * K + C) * 2u; }
#define PG8_RA(i) ({ int R_, C_; stage_rc(tid * 16 + (i) * 8192, R_, C_); R_; })
#define PG8_CA2(i) ({ int R_, C_; stage_rc(tid * 16 + (i) * 8192, R_, C_); (unsigned)C_ * 2u; })
    const size_t kstep = (size_t)(BK * 2);
    const size_t hstep = (size_t)HALF * K * 2;
    const size_t tstep = 2 * hstep;
    const unsigned ldsw = (unsigned)wid * 1024u;
    const int aoff = lds_byte(wr * 64 + fr, fq * 8), boff = lds_byte(wc * 32 + fr, fq * 8);
#define PG8_SA(b, h) (((b) * 2 + (h)) * HTB)
#define PG8_SB(b, h) ((4 + (b) * 2 + (h)) * HTB)
#define PG8_STAGE(bufoff, gbase, voff) do { _Pragma("unroll") for (int _i = 0; _i < 2; ++_i) \
        __builtin_amdgcn_global_load_lds((const unsigned*)((const char*)(gbase) + (voff)[_i]), (PG8_LAS unsigned*)(lds + (bufoff) + ldsw + _i * 8192), 16, 0, 0); } while (0)
#define PG8_STAGE_A(bufoff, kptr, hf, nx) do { _Pragma("unroll") for (int _i = 0; _i < 2; ++_i) { const unsigned _o = (nx) ? (unsigned)idN[(hf) * 2 + _i] : gC[hf][_i]; \
        __builtin_amdgcn_global_load_lds((const unsigned*)((const char*)(kptr) + _o), (PG8_LAS unsigned*)(lds + (bufoff) + ldsw + _i * 8192), 16, 0, 0); } } while (0)
#define PG8_LDA(dst, b, h) do { _Pragma("unroll") for (int m = 0; m < 4; ++m) _Pragma("unroll") for (int k = 0; k < 2; ++k) dst[m][k] = *(const PG8_LAS bf16x8*)(lds + PG8_SA(b, h) + aoff + m * 2048 + k * 1024); } while (0)
#define PG8_LDB(dst, b, h) do { _Pragma("unroll") for (int n = 0; n < 2; ++n) _Pragma("unroll") for (int k = 0; k < 2; ++k) dst[n][k] = *(const PG8_LAS bf16x8*)(lds + PG8_SB(b, h) + boff + n * 2048 + k * 1024); } while (0)
#define PG8_MMA(ai, bj, At, Bt) do { __builtin_amdgcn_s_setprio(1); _Pragma("unroll") for (int m = 0; m < 4; ++m) _Pragma("unroll") for (int n = 0; n < 2; ++n) _Pragma("unroll") for (int k = 0; k < 2; ++k) \
        acc[ai][bj][m][n] = __builtin_amdgcn_mfma_f32_16x16x32_bf16(Bt[n][k], At[m][k], acc[ai][bj][m][n], 0, 0, 0); __builtin_amdgcn_s_setprio(0); } while (0)
#define PG8_WAIT_V(n) asm volatile("s_waitcnt vmcnt(" #n ")" ::: "memory")
#define PG8_WAIT_L(n) asm volatile("s_waitcnt lgkmcnt(" #n ")" ::: "memory")
#define PG8_BAR __builtin_amdgcn_s_barrier()
#define PG8_SCHED __builtin_amdgcn_sched_barrier(0)
    Unit cur, nxt; int ui = 0;
    if (!S.next(0, cur)) return;
    f32x4 acc[2][2][4][2];
#pragma unroll
    for (int a = 0; a < 2; ++a)
#pragma unroll
        for (int b = 0; b < 2; ++b)
#pragma unroll
            for (int m = 0; m < 4; ++m)
#pragma unroll
                for (int n = 0; n < 2; ++n) acc[a][b][m][n] = (f32x4){0.f, 0.f, 0.f, 0.f};
    bf16x8 At[4][2], B0[2][2], B1[2][2];
    unsigned gC[2][2]; int idN[4];
#pragma unroll
    for (int hf = 0; hf < 2; ++hf)
#pragma unroll
        for (int i = 0; i < 2; ++i) { gC[hf][i] = (unsigned)tok[cur.pm * BM + hf * HALF + PG8_RA(i)] * (unsigned)(K * 2) + PG8_CA2(i); idN[hf * 2 + i] = (int)gC[hf][i]; }
    const char* cA = (const char*)g.A; const char* cB = (const char*)g.Bt + (size_t)cur.pn * tstep;
    PG8_STAGE(PG8_SB(0, 0), cB, voffB); PG8_STAGE(PG8_SB(0, 1), cB + hstep, voffB); PG8_STAGE_A(PG8_SA(0, 0), cA, 0, false); PG8_STAGE_A(PG8_SA(0, 1), cA, 1, false);
    if (wr == 1) PG8_BAR;
    PG8_WAIT_V(2); PG8_BAR;
    PG8_STAGE(PG8_SB(1, 0), cB + kstep, voffB); PG8_STAGE_A(PG8_SA(1, 0), cA + kstep, 0, false); PG8_STAGE(PG8_SB(1, 1), cB + hstep + kstep, voffB);
    PG8_WAIT_V(6); PG8_BAR;
    for (;;) {
        const bool has_next = S.next(ui + 1, nxt);
        const char* nB = has_next ? (const char*)g.Bt + (size_t)nxt.pn * tstep : cB;
        if (has_next) {
            const int* p0 = tok + nxt.pm * BM + PG8_RA(0); const int* p1 = tok + nxt.pm * BM + PG8_RA(1); const int* p2 = p0 + HALF; const int* p3 = p1 + HALF;
            asm volatile("global_load_dword %0, %4, off\n\tglobal_load_dword %1, %5, off\n\tglobal_load_dword %2, %6, off\n\tglobal_load_dword %3, %7, off\n\ts_waitcnt vmcnt(0)"
                         : "=&v"(idN[0]), "=&v"(idN[1]), "=&v"(idN[2]), "=&v"(idN[3]) : "v"(p0), "v"(p1), "v"(p2), "v"(p3) : "memory");
        }
        for (int t = 0; t < nt; t += 2) {
            const bool last = (t == nt - 2); const bool nx = last && has_next;
            if (nx) {
#pragma unroll
                for (int j = 0; j < 4; ++j) idN[j] = (int)((unsigned)idN[j] * (unsigned)(K * 2) + PG8_CA2(j & 1));
            }
            const char* a1 = cA + (size_t)(t + 1) * kstep;
            const char* a2 = last ? cA : cA + (size_t)(t + 2) * kstep; const char* b2 = last ? nB : cB + (size_t)(t + 2) * kstep;
            const char* a3 = a2 + kstep; const char* b3 = b2 + kstep;
            PG8_LDB(B0, 0, 0); PG8_LDB(B1, 0, 1); PG8_SCHED; PG8_LDA(At, 0, 0); PG8_STAGE_A(PG8_SA(1, 1), a1, 1, false);
            PG8_WAIT_V(8); PG8_WAIT_L(0); PG8_BAR; PG8_MMA(0, 0, At, B0); PG8_MMA(0, 1, At, B1); PG8_BAR; PG8_SCHED;
            PG8_LDA(At, 0, 1); PG8_STAGE(PG8_SB(0, 0), b2, voffB); PG8_STAGE(PG8_SB(0, 1), b2 + hstep, voffB); PG8_STAGE_A(PG8_SA(0, 0), a2, 0, nx);
            PG8_WAIT_V(8); PG8_WAIT_L(0); PG8_BAR; PG8_MMA(1, 0, At, B0); PG8_MMA(1, 1, At, B1); PG8_BAR; PG8_SCHED;
            PG8_LDB(B0, 1, 0); PG8_LDB(B1, 1, 1); PG8_SCHED; PG8_LDA(At, 1, 0); PG8_STAGE_A(PG8_SA(0, 1), a2, 1, nx);
            PG8_WAIT_V(8); PG8_WAIT_L(0); PG8_BAR; PG8_MMA(0, 0, At, B0); PG8_MMA(0, 1, At, B1); PG8_BAR; PG8_SCHED;
            PG8_LDA(At, 1, 1); PG8_STAGE(PG8_SB(1, 0), b3, voffB); PG8_STAGE(PG8_SB(1, 1), b3 + hstep, voffB); PG8_STAGE_A(PG8_SA(1, 0), a3, 0, nx);
            PG8_WAIT_V(8); PG8_WAIT_L(0); PG8_BAR; PG8_MMA(1, 0, At, B0); PG8_MMA(1, 1, At, B1); PG8_BAR; PG8_SCHED;
        }
        if (wr == 0) PG8_BAR;
        E(acc, cur, wr, wc, fr, fq);
        if (!has_next) break;
#pragma unroll
        for (int a = 0; a < 2; ++a)
#pragma unroll
            for (int b = 0; b < 2; ++b)
#pragma unroll
                for (int m = 0; m < 4; ++m)
#pragma unroll
                    for (int n = 0; n < 2; ++n) acc[a][b][m][n] = (f32x4){0.f, 0.f, 0.f, 0.f};
        cur = nxt; cB = nB; ++ui;
#pragma unroll
        for (int hf = 0; hf < 2; ++hf)
#pragma unroll
            for (int i = 0; i < 2; ++i) gC[hf][i] = (unsigned)idN[hf * 2 + i];
        if (wr == 1) PG8_BAR;
    }
    PG8_WAIT_V(0);
    PG8_BAR;
#undef PG8_SA
#undef PG8_SB
#undef PG8_STAGE
#undef PG8_STAGE_A
#undef PG8_RA
#undef PG8_CA2
#undef PG8_LDA
#undef PG8_LDB
#undef PG8_MMA
#undef PG8_WAIT_V
#undef PG8_WAIT_L
#undef PG8_BAR
#undef PG8_SCHED
}
}
constexpr int DM = 1024, NBATCH = 16, SEQL = 4096, CTXL = 256, SB = CTXL + SEQL  , TT = NBATCH * SB  , NRT = TT / 256  ;
constexpr int INW = 2704, INWP = 2816;
constexpr int C_Z = 0, C_XBC = 512, C_DT = 1280, C_GQ = 1296, C_GK = 1552, C_GV = 1808, C_GR = 2064, C_GLR = 2320, C_CQ = 2352, C_CKV = 2544, C_KPE = 2672;
constexpr float EPS = 1e-6f;
constexpr int NWAVES = 8, NTHREADS = 512;
enum { I_X = 0, I_C, I_CTX, I_CCTX, I_WMOD, I_BMOD, I_NORM1, I_WIN, I_CONVW, I_CONVB, I_ALOG, I_DTB, I_SSDD, I_SSDNW, I_GUPW, I_GUPB, I_GLANW, I_QNW, I_WUQ, I_KVNW, I_WUKV, I_WOUT, I_NORM2,
       I_RW, I_RB, I_W1, I_B1, I_W2, I_B2, I_FINW, N_IN };
constexpr size_t MiB = 1u << 20;
constexpr size_t WS_CTL = 0, CTL_ZERO_BYTES = 1 * MiB;
constexpr size_t WS_MOD = 1 * MiB;
constexpr size_t WS_ROPE = 1 * MiB + 960 * 1024;
constexpr size_t WS_META = 1 * MiB + 980 * 1024;
constexpr size_t WS_WUQT = 2 * MiB;
constexpr size_t WS_WUKVT = 2 * MiB + 512 * 1024;
constexpr size_t WS_WOUTT = 4 * MiB;
constexpr size_t WS_WINT = 8 * MiB;
constexpr size_t WS_W1T = 20 * MiB;
constexpr size_t WS_W2T = 148 * MiB;
constexpr size_t WS_H = 212 * MiB;
constexpr size_t WS_ACT1 = 484 * MiB;
constexpr size_t WS_ARENA = 620 * MiB;
constexpr size_t WS_COLS = WS_ARENA;
constexpr size_t WS_XBC = WS_ARENA + 374 * MiB;
constexpr size_t WS_DT = WS_ARENA + 476 * MiB;
constexpr size_t WS_G = WS_ARENA + 481 * MiB;
constexpr size_t WS_AQ = WS_ARENA + 617 * MiB;
constexpr size_t WS_AKV = WS_ARENA + 651 * MiB;
constexpr size_t WS_QRAW = WS_ARENA + 685 * MiB;
constexpr size_t WS_KV = WS_ARENA + 753 * MiB;
constexpr size_t WS_KVT = WS_ARENA + 821 * MiB;
constexpr size_t WS_QF = WS_ARENA + 889 * MiB;
constexpr size_t WS_KF = WS_ARENA + 940 * MiB;
constexpr size_t WS_YF = WS_ARENA + 991 * MiB;
constexpr size_t WS_YB = WS_ARENA + 1059 * MiB;
constexpr size_t WS_OF = WS_ARENA + 1127 * MiB;
constexpr size_t WS_OB = WS_ARENA + 1161 * MiB;
constexpr size_t WS_MODP = WS_ARENA;
constexpr int MAXSLOT = 1120 * 256;
constexpr size_t WS_XG = WS_ARENA;
constexpr size_t WS_ACTB = WS_ARENA + 560 * MiB;
constexpr size_t WS_TOKE = WS_ARENA + 1120 * MiB;
constexpr size_t WS_TOKP = WS_ARENA + 1122 * MiB;
constexpr size_t WS_TOKW = WS_ARENA + 1124 * MiB;
constexpr size_t WS_WGCNT = WS_ARENA + 1126 * MiB;
constexpr size_t WS_TOKS = WS_ARENA + 1128 * MiB;
constexpr size_t WS_STOK = WS_ARENA + 1130 * MiB;
constexpr size_t WS_END = WS_ARENA + 1428 * MiB;
constexpr int CW_BAR = 4096;
constexpr int CW_AQ = 8192;
constexpr int CW_ASM = 8192 + 1024;
constexpr int RING_BYTES = 131072, LDSCTL_OFF = RING_BYTES, LDS_BYTES = 147456;
constexpr int MISC_BAR = 8;
constexpr int MISC_Q = 16;
constexpr int MISC_CNT = 32;
constexpr int MISC_SB = 64;

#define GAS __attribute__((address_space(1)))
#define LAS __attribute__((address_space(3)))
typedef unsigned short bf16;
typedef unsigned v4u __attribute__((ext_vector_type(4)));
typedef unsigned v2u __attribute__((ext_vector_type(2)));
typedef float f32x4 __attribute__((ext_vector_type(4)));
typedef short bf16x8 __attribute__((ext_vector_type(8)));
#define LDS_WAIT() asm volatile("s_waitcnt lgkmcnt(0)" ::: "memory")

__device__ __forceinline__ float bf2f(unsigned v) { return __uint_as_float(v << 16); }
__device__ __forceinline__ float bflo(unsigned w) { return __uint_as_float(w << 16); }
__device__ __forceinline__ float bfhi(unsigned w) { return __uint_as_float(w & 0xffff0000u); }
__device__ __forceinline__ unsigned f2bf(float f) { unsigned u = __float_as_uint(f); return (u + 0x7fffu + ((u >> 16) & 1u)) >> 16; }
typedef float f32x2_t __attribute__((ext_vector_type(2))); typedef __bf16 bf16x2_t __attribute__((ext_vector_type(2)));
__device__ __forceinline__ unsigned pk2(float lo, float hi) { const f32x2_t v = {lo, hi}; const bf16x2_t b = __builtin_convertvector(v, bf16x2_t); return __builtin_bit_cast(unsigned, b); }
__device__ __forceinline__ float wave_sum(float v) {
#pragma unroll
    for (int o = 1; o < 64; o <<= 1) v += __shfl_xor(v, o);
    return v;
}
__device__ __forceinline__ float wave_max(float v) {
#pragma unroll
    for (int o = 1; o < 64; o <<= 1) v = fmaxf(v, __shfl_xor(v, o));
    return v;
}
__device__ __forceinline__ float siluf(float x) { return x / (1.0f + expf(-x)); }
__device__ __forceinline__ float fsilu(float x) { return x * __builtin_amdgcn_rcpf(1.0f + __expf(-x)); }
__device__ __forceinline__ float fsoftplus(float x) { const float e = __expf(-fabsf(x)); const float l1p = e < 0.03125f ? e * (1.0f - e * (0.5f - e * (0.33333334f - 0.25f * e))) : __logf(1.0f + e); return fmaxf(x, 0.f) + l1p; }
__device__ __forceinline__ float softplusf(float x) { return fmaxf(x, 0.f) + log1pf(expf(-fabsf(x))); }

struct Args { const float* in[N_IN]; float* out; unsigned char* ws; int ph_lo, ph_hi; };
constexpr int PTR_OFF = LDSCTL_OFF + 1024;

__device__ __forceinline__ void transpose_item(const float* W, int K, int N, bf16* WT, int Kp, int nblk, int item, LAS float* scr, int lane) {
    const int kb = item / nblk, nb = item - kb * nblk, k0 = 64 * kb, n0 = 32 * nb;
    const int n = n0 + (lane & 31);
#pragma unroll 8
    for (int i = 0; i < 32; ++i) { const int kk = 2 * i + (lane >> 5), k = k0 + kk; scr[kk * 33 + (lane & 31)] = (k < K && n < N) ? W[(size_t)k * N + n] : 0.f; }
    LDS_WAIT(); asm volatile("" ::: "memory");
    const int c = lane & 7;
#pragma unroll
    for (int j = 0; j < 4; ++j) { const int nn = (lane >> 3) + 8 * j; const LAS float* s = scr + (8 * c) * 33 + nn;
        v4u o; o.x = pk2(s[0 * 33], s[1 * 33]); o.y = pk2(s[2 * 33], s[3 * 33]); o.z = pk2(s[4 * 33], s[5 * 33]); o.w = pk2(s[6 * 33], s[7 * 33]);
        *(v4u*)(WT + (size_t)(n0 + nn) * Kp + k0 + 8 * c) = o; }
    LDS_WAIT(); asm volatile("" ::: "memory");
}
__device__ __forceinline__ void norm_mod_row(const float* hrow, const float* nw, const float* shift, const float* scale, bf16* orow, int lane) {
    const f32x4* xr = (const f32x4*)hrow + lane; f32x4 v[4]; float ss = 0.f;
#pragma unroll
    for (int q = 0; q < 4; ++q) { v[q] = xr[64 * q]; ss += (v[q].x * v[q].x + v[q].y * v[q].y) + (v[q].z * v[q].z + v[q].w * v[q].w); }
    const float rstd = rsqrtf(wave_sum(ss) * (1.0f / 1024.0f) + EPS);
#pragma unroll
    for (int q = 0; q < 4; ++q) { const int j4 = lane + 64 * q; const f32x4 w = ((const f32x4*)nw)[j4], sh = ((const f32x4*)shift)[j4], sc = ((const f32x4*)scale)[j4];
        const f32x4 o = (v[q] * rstd * w) * (sc + 1.0f) + sh; v2u p; p.x = pk2(o.x, o.y); p.y = pk2(o.z, o.w); ((v2u*)orow)[j4] = p; }
}
__device__ __forceinline__ const float* h0_row(const float* x, const float* ctx, int m) { const int b = m / SB, s = m - b * SB; return s < CTXL ? ctx + ((size_t)b * CTXL + s) * DM : x + ((size_t)b * SEQL + (s - CTXL)) * DM; }
#define XB_TMO      128
#define XB_XCNT(j)  (256  + 64 * (j))
#define XB_XSUB(j)  (1280 + 64 * (j))
#define XB_XGEN(j)  (2304 + 64 * (j))
#define XB_TOP      3328
#define XB_TOPGEN   3392
#define XCD_BAR_WORDS 3456
#define XB_SPIN_CAP (1u << 22)

__device__ __forceinline__ unsigned xb_ld(unsigned* p)              { return __hip_atomic_load(p, __ATOMIC_RELAXED, __HIP_MEMORY_SCOPE_AGENT); }
__device__ __forceinline__ unsigned xb_add(unsigned* p, unsigned v) { return __hip_atomic_fetch_add(p, v, __ATOMIC_RELAXED, __HIP_MEMORY_SCOPE_AGENT); }
__device__ __forceinline__ unsigned xb_xcc_id() { return (unsigned)__builtin_amdgcn_s_getreg((3 << 11) | 20) & 0xFu; }
#define XB_SPIN(cond, bar) do { unsigned _sp = 0; while (cond) { __builtin_amdgcn_s_sleep(1); \
    if ((++_sp & 255u) == 0u) { if (xb_ld(&(bar)[XB_TMO])) break; if (_sp > XB_SPIN_CAP) { atomicAdd(&(bar)[XB_TMO], 1u); break; } } } } while (0)

struct XcdBarrier {
    unsigned* bar; unsigned x;
    volatile LAS unsigned* st;
};

__device__ __forceinline__ XcdBarrier xcd_barrier_post(unsigned* bar, volatile LAS unsigned* st) {
    XcdBarrier b; b.bar = bar; b.x = xb_xcc_id(); b.st = st;
    if (threadIdx.x == 0) (void)xb_add(&bar[XB_XCNT(b.x)], 1u);
    return b;
}
__device__ __forceinline__ void xcd_barrier_complete(unsigned* bar, unsigned x, unsigned& nloc, unsigned& nx) {
    const unsigned G = gridDim.x * gridDim.y * gridDim.z;
    unsigned sum, cnt, mine, sp = 0u;
    for (;;) {
        sum = 0u; cnt = 0u; mine = 0u;
#pragma unroll
        for (unsigned j = 0; j < 16; ++j) { const unsigned c = xb_ld(&bar[XB_XCNT(j)]); sum += c; cnt += (c > 0u) ? 1u : 0u; mine = (j == x) ? c : mine; }
        if (sum == G) break;
        __builtin_amdgcn_s_sleep(1);
        if ((++sp & 255u) == 0u) { if (xb_ld(&bar[XB_TMO])) break; if (sp > XB_SPIN_CAP) { atomicAdd(&bar[XB_TMO], 1u); break; } }
    }
    nloc = mine > 0u ? mine : 1u; nx = cnt > 0u ? cnt : 1u;
}

__device__ __forceinline__ void xcd_barrier(const XcdBarrier& b) {
    asm volatile("s_waitcnt vmcnt(0)" ::: "memory");
    __syncthreads();
    if (threadIdx.x == 0) {
        unsigned* bar = b.bar;
        __builtin_amdgcn_s_waitcnt(0);
        unsigned nloc = b.st[0], nx = b.st[1];
        if (nloc == 0u) { xcd_barrier_complete(bar, b.x, nloc, nx); b.st[0] = nloc; b.st[1] = nx; }
        const unsigned old = xb_add(&bar[XB_XSUB(b.x)], 1u);
        const unsigned gen = old / nloc;
        if (old + 1u == (gen + 1u) * nloc) {
            __builtin_amdgcn_fence(__ATOMIC_RELEASE, "agent");
            asm volatile("s_waitcnt vmcnt(0)" ::: "memory");
            const unsigned og = xb_add(&bar[XB_TOP], 1u);
            const unsigned tg = og / nx;
            if (og + 1u == (tg + 1u) * nx) xb_add(&bar[XB_TOPGEN], 1u);
            else XB_SPIN(xb_ld(&bar[XB_TOPGEN]) == tg, bar);
            __builtin_amdgcn_fence(__ATOMIC_ACQUIRE, "agent");
            xb_add(&bar[XB_XGEN(b.x)], 1u);
            asm volatile("s_waitcnt vmcnt(0)" ::: "memory");
        } else {
            XB_SPIN(xb_ld(&bar[XB_XGEN(b.x)]) == gen, bar);
            __builtin_amdgcn_fence(__ATOMIC_ACQUIRE, "agent");
            asm volatile("s_waitcnt vmcnt(0)" ::: "memory");
        }
    }
    __syncthreads();
}
struct Ctx { LAS unsigned char* lds; volatile LAS unsigned* MISC; GAS unsigned char* ws; int tid, lane, wave, G, bid; };
__device__ __forceinline__ const float* in_ptr(const Ctx& C, int i) {
    const volatile LAS unsigned* P = (const volatile LAS unsigned*)(C.lds + PTR_OFF) + 2 * i;
    const unsigned lo = __builtin_amdgcn_readfirstlane(P[0]), hi = __builtin_amdgcn_readfirstlane(P[1]);
    return (const float*)(const GAS float*)(((unsigned long long)hi << 32) | lo);
}
#define IN_(i) in_ptr(C, (i))

__device__ __forceinline__ void ph_g0(const Args& A, const Ctx& C) { const float* const p_I_C = IN_(I_C); const float* const p_I_CCTX = IN_(I_CCTX); const float* const p_I_WIN = IN_(I_WIN); const float* const p_I_WMOD = IN_(I_WMOD); const float* const p_I_WOUT = IN_(I_WOUT); const float* const p_I_WUKV = IN_(I_WUKV); const float* const p_I_WUQ = IN_(I_WUQ);
    if (C.bid < 192) {
        const int l = C.bid / 96, rem = C.bid % 96, cb = rem >> 3, s = rem & 7, i0 = s * 128;
        LAS float* sc = (LAS float*)C.lds;
        for (int idx = C.tid; idx < 17 * 128; idx += NTHREADS) { const int r = idx >> 7, i = idx & 127; const float cv = r < 16 ? p_I_C[r * 1024 + i0 + i] : p_I_CCTX[i0 + i]; sc[idx] = siluf(cv); }
        __syncthreads();
        const int j = cb * 512 + C.tid; float acc[17];
#pragma unroll
        for (int r = 0; r < 17; ++r) acc[r] = 0.f;
        const float* wm = p_I_WMOD + ((size_t)l * 1024 + i0) * 6144 + j;
        for (int i = 0; i < 128; ++i) { const float w = wm[(size_t)i * 6144];
#pragma unroll
            for (int r = 0; r < 17; ++r) acc[r] += sc[r * 128 + i] * w; }
        float* mp = (float*)(C.ws + WS_MODP) + ((size_t)(s * 2 + l) * 17) * 6144 + j;
#pragma unroll
        for (int r = 0; r < 17; ++r) mp[(size_t)r * 6144] = acc[r];
        __syncthreads();
    }
    if (C.bid == C.G - 1) {
        const int pos = C.tid >> 3, i = C.tid & 7;
        double f = 1.0; if (i >= 2) f *= 0.1; if (i >= 4) f *= 0.1; if (i >= 6) f *= 0.1; if (i & 1) f *= 0.31622776601683794;
        const double ang = (double)pos * f;
        const double n = __builtin_rint(ang * 0.63661977236758134);
        double r = __builtin_fma(-n, 1.5707963267948966, ang); r = __builtin_fma(-n, 6.123233995736766e-17, r);
        const double r2 = r * r;
        double sn = 1.0 / 355687428096000.0;
        sn = sn * r2 - 1.0 / 1307674368000.0; sn = sn * r2 + 1.0 / 6227020800.0; sn = sn * r2 - 1.0 / 39916800.0; sn = sn * r2 + 1.0 / 362880.0; sn = sn * r2 - 1.0 / 5040.0; sn = sn * r2 + 1.0 / 120.0; sn = sn * r2 - 1.0 / 6.0; sn = sn * r2 + 1.0; sn *= r;
        double cs = 1.0 / 20922789888000.0;
        cs = cs * r2 - 1.0 / 87178291200.0; cs = cs * r2 + 1.0 / 479001600.0; cs = cs * r2 - 1.0 / 3628800.0; cs = cs * r2 + 1.0 / 40320.0; cs = cs * r2 - 1.0 / 720.0; cs = cs * r2 + 1.0 / 24.0; cs = cs * r2 - 0.5; cs = cs * r2 + 1.0;
        const int q = ((int)n) & 3;
        const double c_ = q == 0 ? cs : q == 1 ? -sn : q == 2 ? -cs : sn;
        const double s_ = q == 0 ? sn : q == 1 ? cs : q == 2 ? -sn : -cs;
        float* rt = (float*)(C.ws + WS_ROPE); rt[C.tid * 2] = (float)c_; rt[C.tid * 2 + 1] = (float)s_;
    }
    LAS float* scr = (LAS float*)(C.lds + C.wave * 16384);
    const int gw = C.bid * NWAVES + C.wave, NGW = C.G * NWAVES;
    for (int it = gw; it < 4096; it += NGW) {
        const int l = it >> 11; int r = it & 2047;
        if (r < 1408) { transpose_item(p_I_WIN + (size_t)l * 1024 * INW, 1024, INW, (bf16*)(C.ws + WS_WINT) + (size_t)l * INWP * 1024, 1024, 88, r, scr, C.lane); continue; } r -= 1408;
        if (r < 512) { transpose_item(p_I_WOUT + (size_t)l * 1024 * 1024, 1024, 1024, (bf16*)(C.ws + WS_WOUTT) + (size_t)l * 1024 * 1024, 1024, 32, r, scr, C.lane); continue; } r -= 512;
        if (r < 64) { transpose_item(p_I_WUQ + (size_t)l * 192 * 384, 192, 384, (bf16*)(C.ws + WS_WUQT) + (size_t)l * 512 * 256, 256, 16, r, scr, C.lane); continue; } r -= 64;
        transpose_item(p_I_WUKV + (size_t)l * 128 * 512, 128, 512, (bf16*)(C.ws + WS_WUKVT) + (size_t)l * 512 * 256, 256, 16, r, scr, C.lane);
    }
}
__device__ __forceinline__ void convert_experts(const Args& A, const Ctx& C, int l) { const float* const p_I_W1 = IN_(I_W1); const float* const p_I_W2 = IN_(I_W2);
    LAS unsigned* T = (LAS unsigned*)C.lds;
    const int tid = C.tid, n4 = (tid & 63) * 4, kq = tid >> 6;
    for (int it = C.bid; it < 4096 + 2048; it += C.G) {
        const float* W; bf16* WT; int N, kb, nb;
        if (it < 4096) { const int e = it >> 7, r = it & 127; kb = r >> 3; nb = r & 7; N = 2048; W = p_I_W1 + ((size_t)l * 32 + e) * 1024 * 2048; WT = (bf16*)(C.ws + WS_W1T) + (size_t)e * 2048 * 1024; }
        else { const int i2 = it - 4096, e = i2 >> 6, r = i2 & 63; kb = r >> 2; nb = r & 3; N = 1024; W = p_I_W2 + ((size_t)l * 32 + e) * 1024 * 1024; WT = (bf16*)(C.ws + WS_W2T) + (size_t)e * 1024 * 1024; }
        const float* src = W + (size_t)(kb * 64) * N + nb * 256 + n4;
        f32x4 a[4], b[4];
#pragma unroll
        for (int i = 0; i < 4; ++i) { const int kp = kq + 8 * i; a[i] = *(const f32x4*)(src + (size_t)(2 * kp) * N); b[i] = *(const f32x4*)(src + (size_t)(2 * kp + 1) * N); }
        __syncthreads();
#pragma unroll
        for (int i = 0; i < 4; ++i) { const int kp = kq + 8 * i; T[(n4 + 0) * 33 + kp] = pk2(a[i].x, b[i].x); T[(n4 + 1) * 33 + kp] = pk2(a[i].y, b[i].y); T[(n4 + 2) * 33 + kp] = pk2(a[i].z, b[i].z); T[(n4 + 3) * 33 + kp] = pk2(a[i].w, b[i].w); }
        __syncthreads();
        const int c = tid & 7, r0 = tid >> 3;
#pragma unroll
        for (int ps = 0; ps < 4; ++ps) { const int n = r0 + 64 * ps; const LAS unsigned* t = T + n * 33 + 4 * c; v4u o; o.x = t[0]; o.y = t[1]; o.z = t[2]; o.w = t[3];
            *(v4u*)(WT + (size_t)(nb * 256 + n) * 1024 + kb * 64 + 8 * c) = o; }
    }
    __syncthreads();
}
__device__ __forceinline__ void ph_g1(const Args& A, const Ctx& C) { const float* const p_I_BMOD = IN_(I_BMOD);
    const float* mp = (const float*)(C.ws + WS_MODP); float* mod = (float*)(C.ws + WS_MOD);
    for (int idx = C.bid * NTHREADS + C.tid; idx < 2 * 17 * 6144; idx += C.G * NTHREADS) {
        const int l = idx / (17 * 6144), j = idx % 6144; float s = p_I_BMOD[l * 6144 + j];
#pragma unroll
        for (int p = 0; p < 8; ++p) s += mp[(size_t)p * (2 * 17 * 6144) + idx];
        mod[idx] = s;
    }
}
__device__ __forceinline__ void ph_g2(const Args& A, const Ctx& C) { const float* const p_I_CTX = IN_(I_CTX); const float* const p_I_NORM1 = IN_(I_NORM1); const float* const p_I_X = IN_(I_X);
    const int gw = C.bid * NWAVES + C.wave, NGW = C.G * NWAVES, lane = C.lane; const float* mod = (const float*)(C.ws + WS_MOD); bf16* uo = (bf16*)(C.ws + WS_ACT1);
    f32x4 nw[4];
#pragma unroll
    for (int q = 0; q < 4; ++q) nw[q] = ((const f32x4*)p_I_NORM1)[lane + 64 * q];
    f32x4 cv[2][4], nv[2][4];
#define G2_LOAD(m_, v_) do { _Pragma("unroll") for (int r = 0; r < 2; ++r) { const int mm = (m_) + r * NGW; if (mm < TT) { const f32x4* xr = (const f32x4*)h0_row(p_I_X, p_I_CTX, mm) + lane; \
        _Pragma("unroll") for (int q = 0; q < 4; ++q) v_[r][q] = xr[64 * q]; } } } while (0)
    G2_LOAD(gw, cv);
    for (int m = gw; m < TT; m += 2 * NGW) {
        if (m + 2 * NGW < TT) G2_LOAD(m + 2 * NGW, nv);
        float ss[2];
#pragma unroll
        for (int r = 0; r < 2; ++r) { ss[r] = 0.f;
#pragma unroll
            for (int q = 0; q < 4; ++q) ss[r] += (cv[r][q].x * cv[r][q].x + cv[r][q].y * cv[r][q].y) + (cv[r][q].z * cv[r][q].z + cv[r][q].w * cv[r][q].w); }
#pragma unroll
        for (int o = 1; o < 64; o <<= 1) { ss[0] += __shfl_xor(ss[0], o); ss[1] += __shfl_xor(ss[1], o); }
#pragma unroll
        for (int r = 0; r < 2; ++r) { const int mm = m + r * NGW; if (mm < TT) { const int b = mm / SB, s = mm - b * SB; const float* mr = mod + (size_t)(s < CTXL ? 16 : b) * 6144; const float rstd = rsqrtf(ss[r] * (1.0f / 1024.0f) + EPS);
#pragma unroll
            for (int q = 0; q < 4; ++q) { const int j4 = lane + 64 * q; const f32x4 sh = ((const f32x4*)mr)[j4], sc = ((const f32x4*)(mr + 1024))[j4];
                const f32x4 o = (cv[r][q] * rstd * nw[q]) * (sc + 1.0f) + sh; v2u p; p.x = pk2(o.x, o.y); p.y = pk2(o.z, o.w); ((v2u*)(uo + (size_t)mm * DM))[j4] = p; } } }
#pragma unroll
        for (int r = 0; r < 2; ++r)
#pragma unroll
            for (int q = 0; q < 4; ++q) cv[r][q] = nv[r][q];
    }
#undef G2_LOAD
}
__device__ __forceinline__ void ph_prep(const Args& A, const Ctx& C, int l, int rep) { const float* const p_I_CONVB = IN_(I_CONVB); const float* const p_I_CONVW = IN_(I_CONVW); const float* const p_I_DTB = IN_(I_DTB); const float* const p_I_GUPB = IN_(I_GUPB); const float* const p_I_GUPW = IN_(I_GUPW); const float* const p_I_KVNW = IN_(I_KVNW); const float* const p_I_QNW = IN_(I_QNW);
    LAS float* gws = (LAS float*)C.lds;
    LAS float* cws = (LAS float*)(C.lds + 32768);
    for (int idx = C.tid; idx < 8192; idx += NTHREADS) gws[idx] = p_I_GUPW[l * 8192 + idx];
    for (int idx = C.tid; idx < 2304; idx += NTHREADS) cws[idx] = p_I_CONVW[l * 2304 + idx];
    for (int idx = C.tid; idx < 768; idx += NTHREADS) cws[2304 + idx] = p_I_CONVB[l * 768 + idx];
    __syncthreads();
    const bf16* cols = (const bf16*)(C.ws + WS_COLS);
    bf16* xbc = (bf16*)(C.ws + WS_XBC); float* dt = (float*)(C.ws + WS_DT); bf16* gg = (bf16*)(C.ws + WS_G); bf16* aq = (bf16*)(C.ws + WS_AQ); bf16* akv = (bf16*)(C.ws + WS_AKV);
    const int gw = C.bid * NWAVES + C.wave, NGW = C.G * NWAVES, lane = C.lane;
    const float dtb = lane < 16 ? p_I_DTB[l * 16 + lane] : 0.f;
    const f32x4 gb0 = *(const f32x4*)(p_I_GUPB + l * 512 + lane * 4), gb1 = *(const f32x4*)(p_I_GUPB + l * 512 + 256 + lane * 4);
    const f32x4 qnw = lane < 48 ? *(const f32x4*)(p_I_QNW + l * 192 + lane * 4) : (f32x4){0.f, 0.f, 0.f, 0.f}, kvnw = lane < 32 ? *(const f32x4*)(p_I_KVNW + l * 128 + lane * 4) : (f32x4){0.f, 0.f, 0.f, 0.f};
    v2u cx0[3], cxm[3], cxp[3], ccq, cckv; v4u cgl[4]; unsigned cdt;
    v2u nx0[3], nxm[3], nxp[3], ncq, nckv; v4u ngl[4]; unsigned ndt;
#define PREP_LOAD(m_, x0_, xm_, xp_, cq_, ckv_, gl_, dt_) do { const int b_ = (m_) / SB, s_ = (m_) - b_ * SB; const bool hp_ = (s_ != 0 && s_ != CTXL), hn_ = (s_ != CTXL - 1 && s_ != SB - 1); \
        const bf16* r_ = cols + (size_t)(m_) * INWP; \
        _Pragma("unroll") for (int ch = 0; ch < 3; ++ch) { const int c_ = ch * 256 + lane * 4; x0_[ch] = *(const v2u*)(r_ + C_XBC + c_); xm_[ch] = (v2u){0u, 0u}; xp_[ch] = (v2u){0u, 0u}; \
            if (hp_) xm_[ch] = *(const v2u*)(r_ - INWP + C_XBC + c_); if (hn_) xp_[ch] = *(const v2u*)(r_ + INWP + C_XBC + c_); } \
        dt_ = r_[C_DT + (lane & 15)]; { const v4u* g_ = (const v4u*)(r_ + C_GLR); gl_[0] = g_[0]; gl_[1] = g_[1]; gl_[2] = g_[2]; gl_[3] = g_[3]; } \
        cq_ = *(const v2u*)(r_ + C_CQ + (lane < 48 ? lane : 0) * 4); ckv_ = *(const v2u*)(r_ + C_CKV + (lane & 31) * 4); } while (0)
    if (gw < TT) PREP_LOAD(gw, cx0, cxm, cxp, ccq, cckv, cgl, cdt);
    for (int m = gw; m < TT; m += NGW) {
        const int mn = m + NGW;
        if (mn < TT) PREP_LOAD(mn, nx0, nxm, nxp, ncq, nckv, ngl, ndt);
#pragma unroll
        for (int ch = 0; ch < 3; ++ch) { const int c = ch * 256 + lane * 4; const v2u x0 = cx0[ch], xm = cxm[ch], xp = cxp[ch];
            const f32x4 w0 = *(const LAS f32x4*)(cws + c), w1 = *(const LAS f32x4*)(cws + 768 + c), w2 = *(const LAS f32x4*)(cws + 1536 + c), bb = *(const LAS f32x4*)(cws + 2304 + c);
            f32x4 v; v.x = w0.x * bflo(xm.x) + w1.x * bflo(x0.x) + w2.x * bflo(xp.x) + bb.x; v.y = w0.y * bfhi(xm.x) + w1.y * bfhi(x0.x) + w2.y * bfhi(xp.x) + bb.y;
            v.z = w0.z * bflo(xm.y) + w1.z * bflo(x0.y) + w2.z * bflo(xp.y) + bb.z; v.w = w0.w * bfhi(xm.y) + w1.w * bfhi(x0.y) + w2.w * bfhi(xp.y) + bb.w;
            v2u o; o.x = pk2(fsilu(v.x), fsilu(v.y)); o.y = pk2(fsilu(v.z), fsilu(v.w)); *(v2u*)(xbc + (size_t)m * 768 + c) = o; __builtin_amdgcn_sched_barrier(0); }
        if (lane < 16) dt[(size_t)m * 16 + lane] = fsoftplus(bf2f(cdt) + dtb);
#pragma unroll
        for (int dir = 0; dir < 2; ++dir) { const v4u q0 = cgl[2 * dir], q1 = cgl[2 * dir + 1];
            const unsigned gw32[8] = {q0.x, q0.y, q0.z, q0.w, q1.x, q1.y, q1.z, q1.w};
            f32x4 acc = dir ? gb1 : gb0;
#pragma unroll
            for (int r = 0; r < 16; ++r) { const unsigned w = gw32[r >> 1]; const float gv = (r & 1) ? bfhi(w) : bflo(w); acc += gv * *(const LAS f32x4*)(gws + (dir * 16 + r) * 256 + lane * 4); }
            f32x4 o; o.x = -fsoftplus(-acc.x) * 0.0625f; o.y = -fsoftplus(-acc.y) * 0.0625f; o.z = -fsoftplus(-acc.z) * 0.0625f; o.w = -fsoftplus(-acc.w) * 0.0625f;
            v2u ob; ob.x = pk2(o.x, o.y); ob.y = pk2(o.z, o.w); *(v2u*)(gg + (size_t)m * 512 + dir * 256 + lane * 4) = ob; __builtin_amdgcn_sched_barrier(0); }
        { float v0 = 0.f, v1 = 0.f, v2 = 0.f, v3 = 0.f, u0 = 0.f, u1 = 0.f, u2 = 0.f, u3 = 0.f;
          if (lane < 48) { v0 = bflo(ccq.x); v1 = bfhi(ccq.x); v2 = bflo(ccq.y); v3 = bfhi(ccq.y); }
          if (lane < 32) { u0 = bflo(cckv.x); u1 = bfhi(cckv.x); u2 = bflo(cckv.y); u3 = bfhi(cckv.y); }
          float sa = (v0 * v0 + v1 * v1) + (v2 * v2 + v3 * v3), sb = (u0 * u0 + u1 * u1) + (u2 * u2 + u3 * u3);
#pragma unroll
          for (int o = 1; o < 64; o <<= 1) { sa += __shfl_xor(sa, o); sb += __shfl_xor(sb, o); }
          const float ra = rsqrtf(sa * (1.0f / 192.0f) + EPS), rb = rsqrtf(sb * (1.0f / 128.0f) + EPS);
          v2u oa; oa.x = pk2(v0 * ra * qnw.x, v1 * ra * qnw.y); oa.y = pk2(v2 * ra * qnw.z, v3 * ra * qnw.w); *(v2u*)(aq + (size_t)m * 256 + lane * 4) = oa;
          v2u ob; ob.x = pk2(u0 * rb * kvnw.x, u1 * rb * kvnw.y); ob.y = pk2(u2 * rb * kvnw.z, u3 * rb * kvnw.w); *(v2u*)(akv + (size_t)m * 256 + lane * 4) = ob; }
#pragma unroll
        for (int ch = 0; ch < 3; ++ch) { cx0[ch] = nx0[ch]; cxm[ch] = nxm[ch]; cxp[ch] = nxp[ch]; }
        ccq = ncq; cckv = nckv; cdt = ndt;
#pragma unroll
        for (int q = 0; q < 4; ++q) cgl[q] = ngl[q];
    }
#undef PREP_LOAD
    __syncthreads();
    if (rep == 0) convert_experts(A, C, l);
}
struct AsmRow { v2u x, kk; float cs, sn; unsigned t1, t2, u1, u2; };
__device__ __forceinline__ void assemble_rows8(const Ctx& C, int m0) {
    const bf16* qraw = (const bf16*)(C.ws + WS_QRAW); const bf16* kv = (const bf16*)(C.ws + WS_KV); const bf16* cols = (const bf16*)(C.ws + WS_COLS);
    bf16* qf = (bf16*)(C.ws + WS_QF); bf16* kf = (bf16*)(C.ws + WS_KF); const float* rope = (const float*)(C.ws + WS_ROPE);
    const float QS = 0.10206207261596575f * 1.4426950408889634f;
    const int lane = C.lane, h = lane >> 4, d = (lane & 15) * 4, a = (lane >> 3) & 1, i = lane & 7;
    auto ld = [&](int m, AsmRow& r) {
        const int b = m / SB, s = m - b * SB; const bool lat = s >= CTXL; const int sp = s - CTXL, pos = a == 0 ? sp >> 6 : sp & 63;
        const bf16* q = qraw + (size_t)m * 512; const bf16* k = kv + (size_t)m * 512; const bf16* kpe = cols + (size_t)m * INWP + C_KPE;
        r.x = *(const v2u*)(q + h * 96 + d); r.kk = *(const v2u*)(k + h * 128 + d);
        r.cs = 1.f; r.sn = 0.f; if (lat) { const float2 t = *(const float2*)(rope + (pos * 8 + i) * 2); r.cs = t.x; r.sn = t.y; }
        r.t1 = q[h * 96 + 64 + a * 16 + i]; r.t2 = q[h * 96 + 64 + a * 16 + 8 + i];
        r.u1 = 0; r.u2 = 0; if (lane < 16) { r.u1 = kpe[a * 16 + i]; r.u2 = kpe[a * 16 + 8 + i]; } };
    auto fin = [&](int m, const AsmRow& r) {
        bf16* qo = qf + (size_t)m * 384; bf16* ko = kf + (size_t)m * 384;
        v2u o; o.x = pk2(bflo(r.x.x) * QS, bfhi(r.x.x) * QS); o.y = pk2(bflo(r.x.y) * QS, bfhi(r.x.y) * QS);
        *(v2u*)(qo + h * 96 + d) = o; *(v2u*)(ko + h * 96 + d) = r.kk;
        const float t1 = bf2f(r.t1), t2 = bf2f(r.t2);
        qo[h * 96 + 64 + a * 16 + i] = (bf16)f2bf((t1 * r.cs - t2 * r.sn) * QS); qo[h * 96 + 64 + a * 16 + 8 + i] = (bf16)f2bf((t2 * r.cs + t1 * r.sn) * QS);
        if (lane < 16) { const float u1 = bf2f(r.u1), u2 = bf2f(r.u2); const bf16 o1 = (bf16)f2bf(u1 * r.cs - u2 * r.sn), o2 = (bf16)f2bf(u2 * r.cs + u1 * r.sn);
#pragma unroll
            for (int hh = 0; hh < 4; ++hh) { ko[hh * 96 + 64 + a * 16 + i] = o1; ko[hh * 96 + 64 + a * 16 + 8 + i] = o2; } } };
#pragma unroll
    for (int g = 0; g < 2; ++g) { AsmRow r0, r1, r2, r3; const int m = m0 + 4 * g;
        ld(m, r0); ld(m + 1, r1); ld(m + 2, r2); ld(m + 3, r3);
        fin(m, r0); fin(m + 1, r1); fin(m + 2, r2); fin(m + 3, r3); }
}
__device__ __forceinline__ void ph_assemble(const Args& A, const Ctx& C, int l, int rep) {
    unsigned* head = (unsigned*)C.ws + CW_ASM + 64 * (2 * l + rep);
    for (;;) {
        unsigned blk = 0; if (C.lane == 0) blk = __hip_atomic_fetch_add(head, 1u, __ATOMIC_RELAXED, __HIP_MEMORY_SCOPE_AGENT);
        blk = __builtin_amdgcn_readfirstlane(blk);
        if (blk >= (unsigned)(TT / 8)) break;
        assemble_rows8(C, (int)blk * 8);
    }
}
constexpr int AT_KP = 224, AT_VP = 160, AT_KB = 64 * AT_KP  , AT_VB = 64 * AT_VP  ;
typedef short at_v4i16 __attribute__((ext_vector_type(4)));
__device__ __forceinline__ bf16x8 at_tr_frag(const LAS unsigned char* tile, int k0a, int k0b, int c0, int lane) {
    const int i = lane & 15, q = i >> 2, p = i & 3;
    const at_v4i16 lo = __builtin_amdgcn_ds_read_tr16_b64_v4i16((LAS at_v4i16*)(tile + (k0a + q) * AT_VP + (c0 + 4 * p) * 2));
    const at_v4i16 hi = __builtin_amdgcn_ds_read_tr16_b64_v4i16((LAS at_v4i16*)(tile + (k0b + q) * AT_VP + (c0 + 4 * p) * 2));
    bf16x8 r; r[0] = lo[0]; r[1] = lo[1]; r[2] = lo[2]; r[3] = lo[3]; r[4] = hi[0]; r[5] = hi[1]; r[6] = hi[2]; r[7] = hi[3]; return r;
}
__device__ __forceinline__ float xmax4(float x) {
    const auto r = __builtin_amdgcn_permlane16_swap(__float_as_uint(x), __float_as_uint(x), false, false); const float m = fmaxf(__uint_as_float(r[0]), __uint_as_float(r[1]));
    const auto q = __builtin_amdgcn_permlane32_swap(__float_as_uint(m), __float_as_uint(m), false, false); return fmaxf(__uint_as_float(q[0]), __uint_as_float(q[1]));
}
constexpr int AT_T = 128, AT_KB2 = AT_T * AT_KP  , AT_VB2 = AT_T * AT_VP  ;
template <int VAR>
__device__ __forceinline__ void attn_unit(const Ctx& C, int b, int h, int qt) {
    const bf16* qfp = (const bf16*)(C.ws + WS_QF); const bf16* kfp = (const bf16*)(C.ws + WS_KF); const bf16* kvp = (const bf16*)(C.ws + WS_KV); bf16* mix = (bf16*)(C.ws + (VAR ? WS_H : WS_ACT1));
    LAS unsigned char* lds = C.lds;
    const int tid = C.tid, lane = C.lane, wave = C.wave, fr = lane & 15, fq = lane >> 4;
    const size_t mb = (size_t)b * SB;
    const int nkt = (qt == 0 ? CTXL : SB) / AT_T;
    const size_t mq = mb + (size_t)qt * 256 + wave * 32;
    bf16x8 qf[2][3];
#pragma unroll
    for (int qb = 0; qb < 2; ++qb)
#pragma unroll
        for (int ks = 0; ks < 3; ++ks) qf[qb][ks] = *(const bf16x8*)(qfp + (mq + qb * 16 + fr) * 384 + h * 96 + ks * 32 + fq * 8);
    f32x4 ot[2][4];
#pragma unroll
    for (int qb = 0; qb < 2; ++qb)
#pragma unroll
        for (int d = 0; d < 4; ++d) ot[qb][d] = (f32x4){0.f, 0.f, 0.f, 0.f};
    float mrun[2] = {0.f, 0.f};
    f32x4 lacc[2]; lacc[0] = (f32x4){0.f, 0.f, 0.f, 0.f}; lacc[1] = lacc[0];
    const bf16x8 ones = __builtin_bit_cast(bf16x8, ((v4u){0x3f803f80u, 0x3f803f80u, 0x3f803f80u, 0x3f803f80u}));
    const bf16* kg[3]; int kl[3];
#pragma unroll
    for (int j = 0; j < 3; ++j) { const int id = tid + 512 * j, r = id / 12, cc = id - r * 12; kg[j] = kfp + (mb + r) * 384 + h * 96 + cc * 8; kl[j] = r * AT_KP + cc * 16; }
    const bf16* vg = kvp + (mb + (tid >> 3)) * 512 + h * 128 + 64 + (tid & 7) * 8; const int vl = (tid >> 3) * AT_VP + (tid & 7) * 16;
    v4u rk[3], rv[2];
#pragma unroll
    for (int j = 0; j < 3; ++j) rk[j] = *(const v4u*)kg[j];
    rv[0] = *(const v4u*)vg; rv[1] = *(const v4u*)(vg + 64 * 512);
    __syncthreads();
    if (wave < 4) __builtin_amdgcn_s_setprio(1);
#pragma unroll
    for (int j = 0; j < 3; ++j) *(LAS v4u*)(lds + kl[j]) = rk[j];
    *(LAS v4u*)(lds + 2 * AT_KB2 + vl) = rv[0]; *(LAS v4u*)(lds + 2 * AT_KB2 + 64 * AT_VP + vl) = rv[1];
    __syncthreads();
    for (int kt = 0; kt < nkt; ++kt) {
        const int cur = kt & 1; const bool more = kt + 1 < nkt;
#ifndef AT_STAGGER
#define AT_STAGGER 0
#endif
        if (AT_STAGGER && wave >= 4) __builtin_amdgcn_s_sleep(AT_STAGGER);
        if (more && VAR != 4) { const size_t ko = (size_t)(kt + 1) * AT_T;
#pragma unroll
            for (int j = 0; j < 3; ++j) rk[j] = *(const v4u*)(kg[j] + ko * 384);
            rv[0] = *(const v4u*)(vg + ko * 512); rv[1] = *(const v4u*)(vg + (ko + 64) * 512); }
#pragma unroll
        for (int hf = 0; hf < 2; ++hf) {
        const LAS unsigned char* kb_ = lds + cur * AT_KB2 + hf * 64 * AT_KP; const LAS unsigned char* vb_ = lds + 2 * AT_KB2 + cur * AT_VB2 + hf * 64 * AT_VP;
        f32x4 sa[2][4];
#pragma unroll
        for (int kb = 0; kb < 4; ++kb) {
            if (VAR == 3) { sa[0][kb] = (f32x4){-mrun[0], -mrun[0], -mrun[0], -mrun[0]}; sa[1][kb] = (f32x4){-mrun[1], -mrun[1], -mrun[1], -mrun[1]}; continue; }
            bf16x8 kfr[3];
#pragma unroll
            for (int ks = 0; ks < 3; ++ks) kfr[ks] = *(const LAS bf16x8*)(kb_ + (kb * 16 + fr) * AT_KP + ks * 64 + fq * 16);
#pragma unroll
            for (int qb = 0; qb < 2; ++qb) { const float nm = -mrun[qb]; f32x4 acc = (f32x4){nm, nm, nm, nm};
#pragma unroll
                for (int ks = 0; ks < 3; ++ks) acc = __builtin_amdgcn_mfma_f32_16x16x32_bf16(kfr[ks], qf[qb][ks], acc, 0, 0, 0);
                sa[qb][kb] = acc; }
        }
        bf16x8 pf[2][2];
#pragma unroll
        for (int qb = 0; qb < 2; ++qb) {
            if (VAR == 1) { pf[qb][0] = __builtin_bit_cast(bf16x8, ((v4u){pk2(sa[qb][0].x, sa[qb][0].y), pk2(sa[qb][0].z, sa[qb][0].w), pk2(sa[qb][1].x, sa[qb][1].y), pk2(sa[qb][1].z, sa[qb][1].w)})); pf[qb][1] = __builtin_bit_cast(bf16x8, ((v4u){pk2(sa[qb][2].x, sa[qb][2].y), pk2(sa[qb][2].z, sa[qb][2].w), pk2(sa[qb][3].x, sa[qb][3].y), pk2(sa[qb][3].z, sa[qb][3].w)})); continue; }
            float mx = fmaxf(fmaxf(sa[qb][0].x, sa[qb][0].y), fmaxf(sa[qb][0].z, sa[qb][0].w));
#pragma unroll
            for (int kb = 1; kb < 4; ++kb) mx = fmaxf(fmaxf(mx, fmaxf(sa[qb][kb].x, sa[qb][kb].y)), fmaxf(sa[qb][kb].z, sa[qb][kb].w));
            mx = fmaxf(mx, __shfl_xor(mx, 16)); mx = fmaxf(mx, __shfl_xor(mx, 32));
            if (__any(mx > 0.f)) {
                const float delta = fmaxf(mx, 0.f), alpha = __builtin_amdgcn_exp2f(-delta); mrun[qb] += delta; lacc[qb] *= alpha;
#pragma unroll
                for (int d = 0; d < 4; ++d) ot[qb][d] *= alpha;
#pragma unroll
                for (int kb = 0; kb < 4; ++kb) sa[qb][kb] -= delta;
            }
            unsigned pw[8];
#pragma unroll
            for (int kb = 0; kb < 4; ++kb) { const float p0 = __builtin_amdgcn_exp2f(sa[qb][kb].x), p1 = __builtin_amdgcn_exp2f(sa[qb][kb].y), p2 = __builtin_amdgcn_exp2f(sa[qb][kb].z), p3 = __builtin_amdgcn_exp2f(sa[qb][kb].w);
                pw[kb * 2] = pk2(p0, p1); pw[kb * 2 + 1] = pk2(p2, p3); }
#pragma unroll
            for (int kk = 0; kk < 2; ++kk) { const v4u w = (v4u){pw[kk * 4], pw[kk * 4 + 1], pw[kk * 4 + 2], pw[kk * 4 + 3]}; pf[qb][kk] = __builtin_bit_cast(bf16x8, w); }
        }
        if (VAR == 2) { ot[0][0] += __builtin_bit_cast(f32x4, pf[0][0]) + __builtin_bit_cast(f32x4, pf[0][1]); ot[1][0] += __builtin_bit_cast(f32x4, pf[1][0]) + __builtin_bit_cast(f32x4, pf[1][1]); lacc[0] += 1.0f; lacc[1] += 1.0f; continue; }
#pragma unroll
        for (int kk = 0; kk < 2; ++kk) { lacc[0] = __builtin_amdgcn_mfma_f32_16x16x32_bf16(ones, pf[0][kk], lacc[0], 0, 0, 0); lacc[1] = __builtin_amdgcn_mfma_f32_16x16x32_bf16(ones, pf[1][kk], lacc[1], 0, 0, 0); }
#pragma unroll
        for (int d = 0; d < 4; ++d)
#pragma unroll
            for (int kk = 0; kk < 2; ++kk) {
                const bf16x8 vf = at_tr_frag(vb_, kk * 32 + 4 * fq, kk * 32 + 16 + 4 * fq, d * 16, lane);
#pragma unroll
                for (int qb = 0; qb < 2; ++qb) ot[qb][d] = __builtin_amdgcn_mfma_f32_16x16x32_bf16(vf, pf[qb][kk], ot[qb][d], 0, 0, 0);
            }
        }
        if (more && VAR != 4) { const int nx = cur ^ 1;
#pragma unroll
            for (int j = 0; j < 3; ++j) *(LAS v4u*)(lds + nx * AT_KB2 + kl[j]) = rk[j];
            *(LAS v4u*)(lds + 2 * AT_KB2 + nx * AT_VB2 + vl) = rv[0]; *(LAS v4u*)(lds + 2 * AT_KB2 + nx * AT_VB2 + 64 * AT_VP + vl) = rv[1]; }
        __syncthreads();
    }
    __builtin_amdgcn_s_setprio(0);
#pragma unroll
    for (int qb = 0; qb < 2; ++qb) {
        const float inv = 1.0f / lacc[qb].x;
        bf16* orow = mix + (mq + qb * 16 + fr) * DM + 768 + h * 64 + 4 * fq;
#pragma unroll
        for (int d = 0; d < 4; ++d) { v2u o; o.x = pk2(ot[qb][d].x * inv, ot[qb][d].y * inv); o.y = pk2(ot[qb][d].z * inv, ot[qb][d].w * inv); *(v2u*)(orow + d * 16) = o; }
    }
}
__device__ __forceinline__ void attn_queue(const Ctx& C, int l, int rep) {
    unsigned* head = (unsigned*)C.ws + CW_AQ + 64 * (8 * l + rep);
    const int nunits = 1024 + (l == 0 ? 64 : 0);
    for (;;) {
        __syncthreads();
        if (C.tid == 0) C.MISC[MISC_Q] = __hip_atomic_fetch_add(head, 1u, __ATOMIC_RELAXED, __HIP_MEMORY_SCOPE_AGENT);
        __syncthreads();
        const int u = (int)C.MISC[MISC_Q];
        if (u >= nunits) break;
        const int ub = u < 1024 ? u >> 6 : (u - 1024) >> 2, uh = u < 1024 ? (u >> 4) & 3 : (u - 1024) & 3, uq = u < 1024 ? 1 + (u & 15) : 0;
#ifdef ATT_VAR
        if (rep == 0) attn_unit<0>(C, ub, uh, uq); else attn_unit<ATT_VAR>(C, ub, uh, uq);
#else
        attn_unit<0>(C, ub, uh, uq);
#endif
    }
}
#ifndef XSTATE
#define XSTATE 1
#endif
#ifndef XINTRA
#define XINTRA 1
#endif
constexpr int CH = 64, NCH = SB / CH  , NCTXCH = CTXL / CH  ;
constexpr int TP = 160;
constexpr int TILE_B = 64 * TP;
typedef short v4i16_t __attribute__((ext_vector_type(4)));
__device__ __forceinline__ bf16x8 tr_frag(const LAS unsigned char* tile, int k0a, int k0b, int c0, int lane) {
#ifdef TR_SLOW
    const int col = c0 + (lane & 15); const LAS unsigned short* t = (const LAS unsigned short*)tile; bf16x8 r;
#pragma unroll
    for (int e = 0; e < 4; ++e) { r[e] = (short)t[(k0a + e) * (TP / 2) + col]; r[4 + e] = (short)t[(k0b + e) * (TP / 2) + col]; }
    return r;
#else
    const int i = lane & 15, q = i >> 2, p = i & 3;
    const v4i16_t lo = __builtin_amdgcn_ds_read_tr16_b64_v4i16((LAS v4i16_t*)(tile + (k0a + q) * TP + (c0 + 4 * p) * 2));
    const v4i16_t hi = __builtin_amdgcn_ds_read_tr16_b64_v4i16((LAS v4i16_t*)(tile + (k0b + q) * TP + (c0 + 4 * p) * 2));
    bf16x8 r; r[0] = lo[0]; r[1] = lo[1]; r[2] = lo[2]; r[3] = lo[3]; r[4] = hi[0]; r[5] = hi[1]; r[6] = hi[2]; r[7] = hi[3]; return r;
#endif
}
__device__ __forceinline__ bf16x8 tr_frag_g4(const LAS unsigned char* tile, int k0a, int k0b, int g, int lane) {
    const int i = lane & 15, q = i >> 2, p = i & 3;
    const v4i16_t lo = __builtin_amdgcn_ds_read_tr16_b64_v4i16((LAS v4i16_t*)(tile + (k0a + q) * TP + (16 * p + 4 * g) * 2));
    const v4i16_t hi = __builtin_amdgcn_ds_read_tr16_b64_v4i16((LAS v4i16_t*)(tile + (k0b + q) * TP + (16 * p + 4 * g) * 2));
    bf16x8 r; r[0] = lo[0]; r[1] = lo[1]; r[2] = lo[2]; r[3] = lo[3]; r[4] = hi[0]; r[5] = hi[1]; r[6] = hi[2]; r[7] = hi[3]; return r;
}
__device__ __forceinline__ bf16x8 row_frag(const LAS unsigned char* tile, int row, int col) { return *(const LAS bf16x8*)(tile + row * TP + col * 2); }
__device__ __forceinline__ v4u scale8(v4u x, float s) { v4u o; o.x = pk2(bflo(x.x) * s, bfhi(x.x) * s); o.y = pk2(bflo(x.y) * s, bfhi(x.y) * s); o.z = pk2(bflo(x.z) * s, bfhi(x.z) * s); o.w = pk2(bflo(x.w) * s, bfhi(x.w) * s); return o; }
__device__ __forceinline__ v4u scale8v(v4u x, f32x4 a, f32x4 b) { v4u o; o.x = pk2(bflo(x.x) * a.x, bfhi(x.x) * a.y); o.y = pk2(bflo(x.y) * a.z, bfhi(x.y) * a.w); o.z = pk2(bflo(x.z) * b.x, bfhi(x.z) * b.y); o.w = pk2(bflo(x.w) * b.z, bfhi(x.w) * b.w); return o; }
__device__ __forceinline__ f32x4 exp4(f32x4 a) { return (f32x4){__expf(a.x), __expf(a.y), __expf(a.z), __expf(a.w)}; }
constexpr size_t WS_SST = WS_ARENA + 1200 * MiB;
constexpr size_t WS_GST = WS_ARENA + 1336 * MiB;
constexpr size_t WS_SEN = WS_ARENA + 991 * MiB;
constexpr size_t WS_GEN = WS_ARENA + 1127 * MiB;
constexpr size_t WS_SDEC = WS_ARENA + 1404 * MiB;
constexpr size_t WS_GDEC = WS_ARENA + 1405 * MiB;
static_assert(WS_GDEC + 5 * MiB <= WS_ARENA + 1428 * MiB, "arena");

template <bool SSD>
__device__ __forceinline__ void chunk_cums(const Ctx& C, int l, size_t m0, int h0, int nh, LAS float* cums, const float* alog) {
    if (SSD) {
        const int w = C.wave; if (w < 2 * nh) { const int hl = w >> 1, d = w & 1, h = h0 + hl, s = d == 0 ? C.lane : 63 - C.lane;
            const float dtv = ((const float*)(C.ws + WS_DT))[(m0 + s) * 16 + d * 8 + h]; float v = dtv * -expf(alog[l * 16 + d * 8 + h]);
#pragma unroll
            for (int o = 1; o < 64; o <<= 1) { const float t = __shfl_up(v, o); if (C.lane >= o) v += t; }
            cums[(d * nh + hl) * 64 + s] = v; cums[((2 + d) * nh + hl) * 64 + s] = dtv; }
    } else {
        if (C.tid < 128) { const int d = C.tid >> 6, k = C.tid & 63; const float* gp = (const float*)(C.ws + WS_G) + m0 * 512 + d * 256 + h0 * 64 + k; float acc = 0.f;
#pragma unroll 16
            for (int i = 0; i < 64; ++i) { const int s = d == 0 ? i : 63 - i; acc += gp[(size_t)s * 512]; cums[d * 4096 + s * 64 + k] = acc; } }
    }
}
template <bool SSD>
__device__ __forceinline__ void chunk_s1(const Ctx& C, int l, int unit, const float* alog) {
    constexpr int NH = SSD ? 8 : 4;
    const int b = unit / (NCH * NH), rem = unit - b * (NCH * NH), c = rem / NH, h = rem - c * NH; const size_t m0 = (size_t)b * SB + c * CH;
    LAS unsigned char* VT = C.lds; LAS unsigned char* KSF = C.lds + TILE_B; LAS unsigned char* KSB = C.lds + 2 * TILE_B; LAS float* cums = (LAS float*)(C.lds + 3 * TILE_B);
    __syncthreads();
    chunk_cums<SSD>(C, l, m0, h, 1, cums, alog);
    __syncthreads();
    { const int s = C.tid >> 3, sub = C.tid & 7; const size_t m = m0 + s;
      v4u vv, kk; v4u kf, kb;
      if (SSD) { const bf16* r = (const bf16*)(C.ws + WS_XBC) + m * 768; vv = *(const v4u*)(r + h * 64 + sub * 8); kk = *(const v4u*)(r + 512 + (h >> 2) * 64 + sub * 8);
          const float wf = cums[128 + s] * __expf(cums[63] - cums[s]), wb = cums[192 + s] * __expf(cums[64] - cums[64 + s]);
          kf = scale8(kk, wf); kb = scale8(kk, wb);
      } else { const bf16* r = (const bf16*)(C.ws + WS_COLS) + m * INWP + h * 64 + sub * 8; vv = *(const v4u*)(r + C_GV); kk = *(const v4u*)(r + C_GK);
          const LAS float* cf = cums + s * 64 + sub * 8; const LAS float* cb = cums + 4096 + s * 64 + sub * 8; const LAS float* cfl = cums + 63 * 64 + sub * 8; const LAS float* cbl = cums + 4096 + sub * 8;
          kf = scale8v(kk, exp4(*(const LAS f32x4*)cfl - *(const LAS f32x4*)cf), exp4(*(const LAS f32x4*)(cfl + 4) - *(const LAS f32x4*)(cf + 4)));
          kb = scale8v(kk, exp4(*(const LAS f32x4*)cbl - *(const LAS f32x4*)cb), exp4(*(const LAS f32x4*)(cbl + 4) - *(const LAS f32x4*)(cb + 4))); }
      *(LAS v4u*)(VT + s * TP + sub * 16) = vv; *(LAS v4u*)(KSF + s * TP + sub * 16) = kf; *(LAS v4u*)(KSB + s * TP + sub * 16) = kb; }
    __syncthreads();
    { const int w = C.wave, d = w >> 2, kb_ = w & 3, lane = C.lane, fr = lane & 15, fq = lane >> 4; const LAS unsigned char* KS = d ? KSB : KSF;
      f32x4 acc[4];
#pragma unroll
      for (int vb = 0; vb < 4; ++vb) acc[vb] = (f32x4){0.f, 0.f, 0.f, 0.f};
#pragma unroll
      for (int ks = 0; ks < 2; ++ks) { const bf16x8 a = tr_frag(KS, ks * 32 + 8 * fq, ks * 32 + 8 * fq + 4, kb_ * 16, lane);
#pragma unroll
          for (int vb = 0; vb < 4; ++vb) { const bf16x8 bo = tr_frag(VT, ks * 32 + 8 * fq, ks * 32 + 8 * fq + 4, vb * 16, lane); acc[vb] = __builtin_amdgcn_mfma_f32_16x16x32_bf16(a, bo, acc[vb], 0, 0, 0); } }
      bf16* st = (bf16*)(C.ws + (SSD ? WS_SST : WS_GST)) + ((((size_t)b * NCH + c) * 2 + d) * NH + h) * 4096;
#pragma unroll
      for (int vb = 0; vb < 4; ++vb) { v2u o; o.x = pk2(acc[vb].x, acc[vb].y); o.y = pk2(acc[vb].z, acc[vb].w); *(v2u*)(st + (vb * 16 + fr) * 64 + kb_ * 16 + 4 * fq) = o; } }
    if (SSD) { if (C.tid < 2) ((float*)(C.ws + WS_SDEC))[(((size_t)b * NCH + c) * 2 + C.tid) * 8 + h] = __expf(C.tid == 0 ? cums[63] : cums[64]); }
    else { if (C.tid < 128) { const int d = C.tid >> 6, k = C.tid & 63; ((float*)(C.ws + WS_GDEC))[((((size_t)b * NCH + c) * 2 + d) * 4 + h) * 64 + k] = __expf(d == 0 ? cums[63 * 64 + k] : cums[4096 + k]); } }
}
template <bool SSD>
__device__ __forceinline__ void chunk_s2(const Ctx& C, int chain) {
    constexpr int NH = SSD ? 8 : 4;
    const int b = chain / (2 * NH), d = (chain / NH) & 1, h = chain % NH;
    const bf16* st = (const bf16*)(C.ws + (SSD ? WS_SST : WS_GST)); bf16* en = (bf16*)(C.ws + (SSD ? WS_SEN : WS_GEN)); const float* dec = (const float*)(C.ws + (SSD ? WS_SDEC : WS_GDEC));
    const int v = C.tid >> 3, k0 = (C.tid & 7) * 8;
    float run[8];
#pragma unroll
    for (int j = 0; j < 8; ++j) run[j] = 0.f;
    auto chunk_at = [&](int i) { return d == 0 ? i : (i < NCTXCH ? NCTXCH - 1 - i : NCH + NCTXCH - 1 - i); };
    v4u nxt = *(const v4u*)(st + ((((size_t)b * NCH + chunk_at(0)) * 2 + d) * NH + h) * 4096 + v * 64 + k0);
    for (int i = 0; i < NCH; ++i) {
        const int c = chunk_at(i); const size_t base = (((size_t)b * NCH + c) * 2 + d) * NH + h; bf16* p = en + base * 4096 + v * 64 + k0;
        const v4u inc = nxt; if (i + 1 < NCH) nxt = *(const v4u*)(st + ((((size_t)b * NCH + chunk_at(i + 1)) * 2 + d) * NH + h) * 4096 + v * 64 + k0);
        f32x4 d0, d1; if (SSD) { const float dd = dec[base]; d0 = (f32x4){dd, dd, dd, dd}; d1 = d0; } else { d0 = *(const f32x4*)(dec + base * 64 + k0); d1 = *(const f32x4*)(dec + base * 64 + k0 + 4); }
        v4u o; o.x = pk2(run[0], run[1]); o.y = pk2(run[2], run[3]); o.z = pk2(run[4], run[5]); o.w = pk2(run[6], run[7]); *(v4u*)p = o;
        run[0] = d0.x * run[0] + bflo(inc.x); run[1] = d0.y * run[1] + bfhi(inc.x); run[2] = d0.z * run[2] + bflo(inc.y); run[3] = d0.w * run[3] + bfhi(inc.y);
        run[4] = d1.x * run[4] + bflo(inc.z); run[5] = d1.y * run[5] + bfhi(inc.z); run[6] = d1.z * run[6] + bflo(inc.w); run[7] = d1.w * run[7] + bfhi(inc.w);
    }
}
template <bool SSD>
__device__ __forceinline__ void chunk_s2_wave(const Ctx& C, int chain) {
    constexpr int NH = SSD ? 8 : 4;
    const int b = chain / (2 * NH), d = (chain / NH) & 1, h = chain % NH, lane = C.lane;
    const bf16* st = (const bf16*)(C.ws + (SSD ? WS_SST : WS_GST)); bf16* en = (bf16*)(C.ws + (SSD ? WS_SEN : WS_GEN)); const float* dec = (const float*)(C.ws + (SSD ? WS_SDEC : WS_GDEC));
    const int k0 = (lane & 7) * 8;
    float run[64];
#pragma unroll
    for (int e = 0; e < 64; ++e) run[e] = 0.f;
    auto chunk_at = [&](int i) { return d == 0 ? i : (i < NCTXCH ? NCTXCH - 1 - i : NCH + NCTXCH - 1 - i); };
    auto base_at = [&](int i) { return (((size_t)b * NCH + chunk_at(i)) * 2 + d) * NH + h; };
    v4u q0[8], q1[8], q2[8]; f32x4 a0, b0, a1, b1, a2, b2;
    auto ld = [&](int i, v4u (&q)[8], f32x4& da, f32x4& db) { const size_t base = base_at(i);
#pragma unroll
        for (int j = 0; j < 8; ++j) q[j] = *(const v4u*)(st + base * 4096 + j * 512 + lane * 8);
        if (SSD) { const float dd = dec[base]; da = (f32x4){dd, dd, dd, dd}; db = da; } else { da = *(const f32x4*)(dec + base * 64 + k0); db = *(const f32x4*)(dec + base * 64 + k0 + 4); } };
    auto step = [&](int i, const v4u (&inc)[8], const f32x4& d0, const f32x4& d1, v4u (&pq)[8], f32x4& pa, f32x4& pb) {
        if (i + 2 < NCH) ld(i + 2, pq, pa, pb);
        bf16* p = en + base_at(i) * 4096 + lane * 8;
#pragma unroll
        for (int j = 0; j < 8; ++j) { float* r = run + j * 8;
            v4u o; o.x = pk2(r[0], r[1]); o.y = pk2(r[2], r[3]); o.z = pk2(r[4], r[5]); o.w = pk2(r[6], r[7]); *(v4u*)(p + j * 512) = o;
            r[0] = d0.x * r[0] + bflo(inc[j].x); r[1] = d0.y * r[1] + bfhi(inc[j].x); r[2] = d0.z * r[2] + bflo(inc[j].y); r[3] = d0.w * r[3] + bfhi(inc[j].y);
            r[4] = d1.x * r[4] + bflo(inc[j].z); r[5] = d1.y * r[5] + bfhi(inc[j].z); r[6] = d1.z * r[6] + bflo(inc[j].w); r[7] = d1.w * r[7] + bfhi(inc[j].w); } };
    ld(0, q0, a0, b0); ld(1, q1, a1, b1);
    for (int i = 0; i < NCH; i += 3) {
        step(i, q0, a0, b0, q2, a2, b2);
        if (i + 1 < NCH) step(i + 1, q1, a1, b1, q0, a0, b0);
        if (i + 2 < NCH) step(i + 2, q2, a2, b2, q1, a1, b1);
    }
}
template <bool SSD>
__device__ __forceinline__ void chunk_s2_slice(const Ctx& C, int chain, int sl) {
    constexpr int NH = SSD ? 8 : 4;
    static_assert(NCH % 4 == 0, "ring of four");
    const int b = chain / (2 * NH), d = (chain / NH) & 1, h = chain % NH, lane = C.lane;
    const bf16* st = (const bf16*)(C.ws + (SSD ? WS_SST : WS_GST)) + sl * 1024 + lane * 8; bf16* en = (bf16*)(C.ws + (SSD ? WS_SEN : WS_GEN)) + sl * 1024 + lane * 8; const float* dec = (const float*)(C.ws + (SSD ? WS_SDEC : WS_GDEC));
    const int k0 = (lane & 7) * 8;
    float run[16];
#pragma unroll
    for (int e = 0; e < 16; ++e) run[e] = 0.f;
    auto chunk_at = [&](int i) { return d == 0 ? i : (i < NCTXCH ? NCTXCH - 1 - i : NCH + NCTXCH - 1 - i); };
    auto base_at = [&](int i) { return (((size_t)b * NCH + chunk_at(i)) * 2 + d) * NH + h; };
    v4u q0[2], q1[2], q2[2], q3[2]; f32x4 a0, b0, a1, b1, a2, b2, a3, b3;
    auto ld = [&](int i, v4u (&q)[2], f32x4& da, f32x4& db) { const size_t base = base_at(i);
        q[0] = *(const v4u*)(st + base * 4096); q[1] = *(const v4u*)(st + base * 4096 + 512);
        if (SSD) { const float dd = dec[base]; da = (f32x4){dd, dd, dd, dd}; db = da; } else { da = *(const f32x4*)(dec + base * 64 + k0); db = *(const f32x4*)(dec + base * 64 + k0 + 4); } };
    auto step = [&](int i, const v4u (&inc)[2], const f32x4& d0, const f32x4& d1, v4u (&pq)[2], f32x4& pa, f32x4& pb) {
        if (i + 3 < NCH) ld(i + 3, pq, pa, pb);
        bf16* p = en + base_at(i) * 4096;
#pragma unroll
        for (int j = 0; j < 2; ++j) { float* r = run + j * 8;
            v4u o; o.x = pk2(r[0], r[1]); o.y = pk2(r[2], r[3]); o.z = pk2(r[4], r[5]); o.w = pk2(r[6], r[7]); *(v4u*)(p + j * 512) = o;
            r[0] = d0.x * r[0] + bflo(inc[j].x); r[1] = d0.y * r[1] + bfhi(inc[j].x); r[2] = d0.z * r[2] + bflo(inc[j].y); r[3] = d0.w * r[3] + bfhi(inc[j].y);
            r[4] = d1.x * r[4] + bflo(inc[j].z); r[5] = d1.y * r[5] + bfhi(inc[j].z); r[6] = d1.z * r[6] + bflo(inc[j].w); r[7] = d1.w * r[7] + bfhi(inc[j].w); } };
    ld(0, q0, a0, b0); ld(1, q1, a1, b1); ld(2, q2, a2, b2);
    for (int i = 0; i < NCH; i += 4) {
        step(i, q0, a0, b0, q3, a3, b3);
        step(i + 1, q1, a1, b1, q0, a0, b0);
        step(i + 2, q2, a2, b2, q1, a1, b1);
        step(i + 3, q3, a3, b3, q2, a2, b2);
    }
}
__device__ __forceinline__ bf16x8 pack_p(f32x4 a, f32x4 b) { const v4u w = (v4u){pk2(a.x, a.y), pk2(a.z, a.w), pk2(b.x, b.y), pk2(b.z, b.w)}; return __builtin_bit_cast(bf16x8, w); }
__device__ __forceinline__ void ssd_s3(const Ctx& C, int l, int unit, const float* alog, const float* dskip, const float* normw) {
    const int b = unit / (NCH * 2), rem = unit - b * (NCH * 2), c = rem >> 1, g = rem & 1; const size_t m0 = (size_t)b * SB + c * CH;
    LAS unsigned char* XT = C.lds;
    LAS unsigned char* KR = C.lds + 4 * TILE_B; LAS unsigned char* QR = C.lds + 5 * TILE_B;
    LAS float* cums = (LAS float*)(C.lds + 6 * TILE_B);
    LAS float* ssx = cums + 1024;
    __syncthreads();
    chunk_cums<true>(C, l, m0, g * 4, 4, cums, alog);
    { const int s = C.tid >> 3, sub = C.tid & 7; const bf16* r = (const bf16*)(C.ws + WS_XBC) + (m0 + s) * 768;
#pragma unroll
      for (int hl = 0; hl < 4; ++hl) *(LAS v4u*)(XT + hl * TILE_B + s * TP + sub * 16) = *(const v4u*)(r + (g * 4 + hl) * 64 + sub * 8);
      *(LAS v4u*)(KR + s * TP + sub * 16) = *(const v4u*)(r + 512 + g * 64 + sub * 8); *(LAS v4u*)(QR + s * TP + sub * 16) = *(const v4u*)(r + 640 + g * 64 + sub * 8); }
    const int w = C.wave, hl = w >> 1, lh = w & 1, h = g * 4 + hl, lane = C.lane, fr = lane & 15, fq = lane >> 4;
    bf16x8 hst[2][4][2];
    { const bf16* stb = (const bf16*)(C.ws + WS_SEN) + (((size_t)b * NCH + c) * 2 * 8 + h) * 4096;
#pragma unroll
      for (int d = 0; d < 2; ++d)
#pragma unroll
          for (int vb = 0; vb < 4; ++vb)
#pragma unroll
              for (int ks = 0; ks < 2; ++ks) hst[d][vb][ks] = *(const bf16x8*)(stb + (size_t)d * 8 * 4096 + (vb * 16 + fr) * 64 + ks * 32 + fq * 8);
 }
    __syncthreads();
    const LAS float* cf = cums + hl * 64; const LAS float* cb = cums + 256 + hl * 64; const LAS float* df = cums + 512 + hl * 64; const LAS float* db = cums + 768 + hl * 64;
    const LAS unsigned char* VT = XT + hl * TILE_B;
    bf16x8 cq[2][2];
#pragma unroll
    for (int lb = 0; lb < 2; ++lb)
#pragma unroll
        for (int ks = 0; ks < 2; ++ks) cq[lb][ks] = row_frag(QR, (2 * lh + lb) * 16 + fr, ks * 32 + fq * 8);
    f32x4 ao[2][4];
#pragma unroll
    for (int lb = 0; lb < 2; ++lb)
#pragma unroll
        for (int vb = 0; vb < 4; ++vb) ao[lb][vb] = (f32x4){0.f, 0.f, 0.f, 0.f};
    if (XINTRA) {
        f32x4 ap[2][4];
#pragma unroll
        for (int sb = 0; sb < 4; ++sb) { const bf16x8 k0f = row_frag(KR, sb * 16 + fr, fq * 8), k1f = row_frag(KR, sb * 16 + fr, 32 + fq * 8);
#pragma unroll
            for (int lb = 0; lb < 2; ++lb) { f32x4 a = (f32x4){0.f, 0.f, 0.f, 0.f}; a = __builtin_amdgcn_mfma_f32_16x16x32_bf16(k0f, cq[lb][0], a, 0, 0, 0); a = __builtin_amdgcn_mfma_f32_16x16x32_bf16(k1f, cq[lb][1], a, 0, 0, 0); ap[lb][sb] = a; } }
#pragma unroll
        for (int lb = 0; lb < 2; ++lb) { const int lrow = (2 * lh + lb) * 16 + fr; const float cfl = cf[lrow], cbl = cb[lrow];
#pragma unroll
            for (int sb = 0; sb < 4; ++sb) { const int s0 = sb * 16 + 4 * fq; const f32x4 cfs = *(const LAS f32x4*)(cf + s0), cbs = *(const LAS f32x4*)(cb + s0), dfs = *(const LAS f32x4*)(df + s0), dbs = *(const LAS f32x4*)(db + s0);
                f32x4 m;
                m.x = (s0 + 0 <= lrow ? dfs.x * __expf(fminf(cfl - cfs.x, 0.f)) : 0.f) + (s0 + 0 >= lrow ? dbs.x * __expf(fminf(cbl - cbs.x, 0.f)) : 0.f);
                m.y = (s0 + 1 <= lrow ? dfs.y * __expf(fminf(cfl - cfs.y, 0.f)) : 0.f) + (s0 + 1 >= lrow ? dbs.y * __expf(fminf(cbl - cbs.y, 0.f)) : 0.f);
                m.z = (s0 + 2 <= lrow ? dfs.z * __expf(fminf(cfl - cfs.z, 0.f)) : 0.f) + (s0 + 2 >= lrow ? dbs.z * __expf(fminf(cbl - cbs.z, 0.f)) : 0.f);
                m.w = (s0 + 3 <= lrow ? dfs.w * __expf(fminf(cfl - cfs.w, 0.f)) : 0.f) + (s0 + 3 >= lrow ? dbs.w * __expf(fminf(cbl - cbs.w, 0.f)) : 0.f);
                ap[lb][sb] *= m; } }
#pragma unroll
        for (int kk = 0; kk < 2; ++kk) { bf16x8 pf[2]; pf[0] = pack_p(ap[0][2 * kk], ap[0][2 * kk + 1]); pf[1] = pack_p(ap[1][2 * kk], ap[1][2 * kk + 1]);
#pragma unroll
            for (int vb = 0; vb < 4; ++vb) { const bf16x8 xa = tr_frag(VT, kk * 32 + 4 * fq, kk * 32 + 16 + 4 * fq, vb * 16, lane);
                ao[0][vb] = __builtin_amdgcn_mfma_f32_16x16x32_bf16(xa, pf[0], ao[0][vb], 0, 0, 0); ao[1][vb] = __builtin_amdgcn_mfma_f32_16x16x32_bf16(xa, pf[1], ao[1][vb], 0, 0, 0); } }
    }
    v2u zz_[2][4];
    { const bf16* colz = (const bf16*)(C.ws + WS_COLS);
#pragma unroll
      for (int lb = 0; lb < 2; ++lb)
#pragma unroll
          for (int vb = 0; vb < 4; ++vb) zz_[lb][vb] = *(const v2u*)(colz + (m0 + (2 * lh + lb) * 16 + fr) * INWP + C_Z + h * 64 + vb * 16 + 4 * fq); }
    if (XSTATE) {
#pragma unroll
        for (int d = 0; d < 2; ++d) { bf16x8 cs[2][2];
#pragma unroll
            for (int lb = 0; lb < 2; ++lb) { const int lrow = (2 * lh + lb) * 16 + fr; const float e = __expf(d == 0 ? cf[lrow] : cb[lrow]);
#pragma unroll
                for (int ks = 0; ks < 2; ++ks) cs[lb][ks] = __builtin_bit_cast(bf16x8, scale8(__builtin_bit_cast(v4u, cq[lb][ks]), e)); }
#pragma unroll
            for (int vb = 0; vb < 4; ++vb)
#pragma unroll
                for (int ks = 0; ks < 2; ++ks) { const bf16x8 ha = hst[d][vb][ks];
                    ao[0][vb] = __builtin_amdgcn_mfma_f32_16x16x32_bf16(ha, cs[0][ks], ao[0][vb], 0, 0, 0); ao[1][vb] = __builtin_amdgcn_mfma_f32_16x16x32_bf16(ha, cs[1][ks], ao[1][vb], 0, 0, 0); } }
    }
    const float dsk = dskip[l * 8 + h]; const bf16* cols = (const bf16*)(C.ws + WS_COLS);
    float ssl[2];
#pragma unroll
    for (int lb = 0; lb < 2; ++lb) { const int lrow = (2 * lh + lb) * 16 + fr; float ss = 0.f;
#pragma unroll
        for (int vb = 0; vb < 4; ++vb) { const int p0 = vb * 16 + 4 * fq; const v2u xx = *(const LAS v2u*)(VT + lrow * TP + p0 * 2); const v2u zz = zz_[lb][vb];
            f32x4 y = ao[lb][vb]; y.x = (y.x + dsk * bflo(xx.x)) * fsilu(bflo(zz.x)); y.y = (y.y + dsk * bfhi(xx.x)) * fsilu(bfhi(zz.x)); y.z = (y.z + dsk * bflo(xx.y)) * fsilu(bflo(zz.y)); y.w = (y.w + dsk * bfhi(xx.y)) * fsilu(bfhi(zz.y));
            ao[lb][vb] = y; ss += (y.x * y.x + y.y * y.y) + (y.z * y.z + y.w * y.w); }
        ss += __shfl_xor(ss, 16); ss += __shfl_xor(ss, 32); ssl[lb] = ss; if (fq == 0) ssx[hl * 64 + lrow] = ss; }
    __syncthreads();
    bf16* mix = (bf16*)(C.ws + WS_ACT1);
#pragma unroll
    for (int lb = 0; lb < 2; ++lb) { const int lrow = (2 * lh + lb) * 16 + fr; const float tot = (ssx[lrow] + ssx[64 + lrow]) + (ssx[128 + lrow] + ssx[192 + lrow]); const float rstd = rsqrtf(tot * (1.0f / 256.0f) + EPS);
#pragma unroll
        for (int vb = 0; vb < 4; ++vb) { const int p0 = vb * 16 + 4 * fq; const f32x4 nw = *(const f32x4*)(normw + l * 512 + h * 64 + p0); const f32x4 y = ao[lb][vb];
            v2u o; o.x = pk2(y.x * rstd * nw.x, y.y * rstd * nw.y); o.y = pk2(y.z * rstd * nw.z, y.w * rstd * nw.w); *(v2u*)(mix + (m0 + lrow) * DM + h * 64 + p0) = o; } }
}
__device__ __forceinline__ void gla_s3(const Ctx& C, int l, int unit, const float* normw) {
    const int b = unit / (NCH * 4), rem = unit - b * (NCH * 4), c = rem >> 2, h = rem & 3; const size_t m0 = (size_t)b * SB + c * CH;
    LAS unsigned char* VT = C.lds; LAS unsigned char* KIF = C.lds + TILE_B; LAS unsigned char* KIB = C.lds + 2 * TILE_B; LAS unsigned char* QSF = C.lds + 3 * TILE_B; LAS unsigned char* QSB = C.lds + 4 * TILE_B;
    LAS float* cums = (LAS float*)(C.lds + 5 * TILE_B);
    LAS float* ssx = cums + 8192;
    __syncthreads();
    chunk_cums<false>(C, l, m0, h, 1, cums, nullptr);
    __syncthreads();
    { const int s = C.tid >> 3, sub = C.tid & 7; const bf16* r = (const bf16*)(C.ws + WS_COLS) + (m0 + s) * INWP + h * 64 + sub * 8;
      const v4u vv = *(const v4u*)(r + C_GV), kk = *(const v4u*)(r + C_GK), qq = scale8(*(const v4u*)(r + C_GQ), 0.125f);
      const LAS float* cf = cums + s * 64 + sub * 8; const LAS float* cb = cums + 4096 + s * 64 + sub * 8;
      const f32x4 f0 = *(const LAS f32x4*)cf, f1 = *(const LAS f32x4*)(cf + 4), b0 = *(const LAS f32x4*)cb, b1 = *(const LAS f32x4*)(cb + 4);
      *(LAS v4u*)(VT + s * TP + sub * 16) = vv;
      *(LAS v4u*)(KIF + s * TP + sub * 16) = scale8v(kk, exp4(-f0), exp4(-f1)); *(LAS v4u*)(KIB + s * TP + sub * 16) = scale8v(kk, exp4(-b0), exp4(-b1));
      *(LAS v4u*)(QSF + s * TP + sub * 16) = scale8v(qq, exp4(f0), exp4(f1)); *(LAS v4u*)(QSB + s * TP + sub * 16) = scale8v(qq, exp4(b0), exp4(b1)); }
    __syncthreads();
    const int w = C.wave, lb = w & 3, vh = w >> 2, lane = C.lane, fr = lane & 15, fq = lane >> 4; const int lrow = lb * 16 + fr;
    bf16x8 qf[2][2];
#pragma unroll
    for (int ks = 0; ks < 2; ++ks) { qf[0][ks] = row_frag(QSF, lrow, ks * 32 + fq * 8); qf[1][ks] = row_frag(QSB, lrow, ks * 32 + fq * 8); }
    f32x4 ao[2];
    ao[0] = (f32x4){0.f, 0.f, 0.f, 0.f}; ao[1] = ao[0];
    {   f32x4 ap[4];
#pragma unroll
        for (int sb = 0; sb < 4; ++sb) { f32x4 af = (f32x4){0.f, 0.f, 0.f, 0.f}, ab = af;
#pragma unroll
            for (int ks = 0; ks < 2; ++ks) { af = __builtin_amdgcn_mfma_f32_16x16x32_bf16(row_frag(KIF, sb * 16 + fr, ks * 32 + fq * 8), qf[0][ks], af, 0, 0, 0); ab = __builtin_amdgcn_mfma_f32_16x16x32_bf16(row_frag(KIB, sb * 16 + fr, ks * 32 + fq * 8), qf[1][ks], ab, 0, 0, 0); }
            const int s0 = sb * 16 + 4 * fq; f32x4 m;
            m.x = (s0 + 0 <= lrow ? af.x : 0.f) + (s0 + 0 >= lrow ? ab.x : 0.f); m.y = (s0 + 1 <= lrow ? af.y : 0.f) + (s0 + 1 >= lrow ? ab.y : 0.f);
            m.z = (s0 + 2 <= lrow ? af.z : 0.f) + (s0 + 2 >= lrow ? ab.z : 0.f); m.w = (s0 + 3 <= lrow ? af.w : 0.f) + (s0 + 3 >= lrow ? ab.w : 0.f);
            ap[sb] = m; }
#pragma unroll
        for (int kk = 0; kk < 2; ++kk) { const bf16x8 pf = pack_p(ap[2 * kk], ap[2 * kk + 1]);
#pragma unroll
            for (int vi = 0; vi < 2; ++vi) ao[vi] = __builtin_amdgcn_mfma_f32_16x16x32_bf16(tr_frag(VT, kk * 32 + 4 * fq, kk * 32 + 16 + 4 * fq, (2 * vh + vi) * 16, lane), pf, ao[vi], 0, 0, 0); }
    }
    {   const bf16* stb = (const bf16*)(C.ws + WS_GEN) + (((size_t)b * NCH + c) * 2 * 4 + h) * 4096;
#pragma unroll
        for (int d = 0; d < 2; ++d) { const bf16* sp = stb + (size_t)d * 4 * 4096;
#pragma unroll
            for (int vi = 0; vi < 2; ++vi)
#pragma unroll
                for (int ks = 0; ks < 2; ++ks) ao[vi] = __builtin_amdgcn_mfma_f32_16x16x32_bf16(*(const bf16x8*)(sp + ((2 * vh + vi) * 16 + fr) * 64 + ks * 32 + fq * 8), qf[d][ks], ao[vi], 0, 0, 0); } }
    float ss = 0.f;
#pragma unroll
    for (int vi = 0; vi < 2; ++vi) ss += (ao[vi].x * ao[vi].x + ao[vi].y * ao[vi].y) + (ao[vi].z * ao[vi].z + ao[vi].w * ao[vi].w);
    ss += __shfl_xor(ss, 16); ss += __shfl_xor(ss, 32); if (fq == 0) ssx[vh * 64 + lrow] = ss;
    __syncthreads();
    const float rstd = rsqrtf((ssx[lrow] + ssx[64 + lrow]) * (1.0f / 64.0f) + EPS);
    const bf16* cols = (const bf16*)(C.ws + WS_COLS); bf16* mix = (bf16*)(C.ws + WS_ACT1);
#pragma unroll
    for (int vi = 0; vi < 2; ++vi) { const int v0 = (2 * vh + vi) * 16 + 4 * fq; const f32x4 nw = *(const f32x4*)(normw + l * 64 + v0); const v2u rr = *(const v2u*)(cols + (m0 + lrow) * INWP + C_GR + h * 64 + v0);
        v2u o; o.x = pk2(ao[vi].x * rstd * nw.x * fsilu(bflo(rr.x)), ao[vi].y * rstd * nw.y * fsilu(bfhi(rr.x))); o.y = pk2(ao[vi].z * rstd * nw.z * fsilu(bflo(rr.y)), ao[vi].w * rstd * nw.w * fsilu(bfhi(rr.y)));
        *(v2u*)(mix + (m0 + lrow) * DM + 512 + h * 64 + v0) = o; }
}


__device__ __forceinline__ void ssd_s1_bc(const Ctx& C, int l, int unit, const float* alog) {
    const int b = unit / NCH, c = unit - b * NCH; const size_t m0 = (size_t)b * SB + c * CH;
    LAS unsigned char* XT = C.lds; LAS unsigned char* BT = C.lds + 8 * TILE_B; LAS float* wtab = (LAS float*)(C.lds + 10 * TILE_B);
    const int w = C.wave, lane = C.lane, fr = lane & 15, fq = lane >> 4;
    __syncthreads();
#pragma unroll
    for (int d = 0; d < 2; ++d) { const int s = d == 0 ? lane : 63 - lane;
        const float dtv = ((const float*)(C.ws + WS_DT))[(m0 + s) * 16 + d * 8 + w]; float v = dtv * -expf(alog[l * 16 + d * 8 + w]);
#pragma unroll
        for (int o = 1; o < 64; o <<= 1) { const float t = __shfl_up(v, o); if (lane >= o) v += t; }
        const float tot = __shfl(v, 63);
        wtab[(d * 8 + w) * 64 + s] = dtv * __expf(tot - v);
        if (lane == 63) ((float*)(C.ws + WS_SDEC))[(((size_t)b * NCH + c) * 2 + d) * 8 + w] = __expf(tot); }
    { const int s = C.tid >> 3, sub = C.tid & 7; const bf16* r = (const bf16*)(C.ws + WS_XBC) + (m0 + s) * 768;
#pragma unroll
      for (int hl = 0; hl < 8; ++hl) *(LAS v4u*)(XT + hl * TILE_B + s * TP + sub * 16) = *(const v4u*)(r + hl * 64 + sub * 8);
      *(LAS v4u*)(BT + s * TP + sub * 16) = *(const v4u*)(r + 512 + sub * 8); *(LAS v4u*)(BT + TILE_B + s * TP + sub * 16) = *(const v4u*)(r + 576 + sub * 8); }
    __syncthreads();
    const LAS unsigned char* XH = XT + w * TILE_B; const LAS unsigned char* BG = BT + (w >> 2) * TILE_B;
    bf16x8 bo[4][2];
#pragma unroll
    for (int pb = 0; pb < 4; ++pb)
#pragma unroll
        for (int ks = 0; ks < 2; ++ks) bo[pb][ks] = tr_frag(XH, ks * 32 + 8 * fq, ks * 32 + 8 * fq + 4, pb * 16, lane);
#pragma unroll 1
    for (int d = 0; d < 2; ++d) {
        f32x4 acc[4][4];
#pragma unroll
        for (int nb = 0; nb < 4; ++nb)
#pragma unroll
            for (int pb = 0; pb < 4; ++pb) acc[nb][pb] = (f32x4){0.f, 0.f, 0.f, 0.f};
#pragma unroll
        for (int ks = 0; ks < 2; ++ks) { const LAS float* wp = wtab + (d * 8 + w) * 64 + ks * 32 + 8 * fq; const f32x4 w0 = *(const LAS f32x4*)wp, w1 = *(const LAS f32x4*)(wp + 4);
#pragma unroll
            for (int nb = 0; nb < 4; ++nb) { const bf16x8 a = __builtin_bit_cast(bf16x8, scale8v(__builtin_bit_cast(v4u, tr_frag_g4(BG, ks * 32 + 8 * fq, ks * 32 + 8 * fq + 4, nb, lane)), w0, w1));
#pragma unroll
                for (int pb = 0; pb < 4; ++pb) acc[nb][pb] = __builtin_amdgcn_mfma_f32_16x16x32_bf16(a, bo[pb][ks], acc[nb][pb], 0, 0, 0); } }
        bf16* st = (bf16*)(C.ws + WS_SST) + ((((size_t)b * NCH + c) * 2 + d) * 8 + w) * 4096;
#pragma unroll
        for (int pb = 0; pb < 4; ++pb) { v4u o0, o1; o0.x = pk2(acc[0][pb].x, acc[0][pb].y); o0.y = pk2(acc[0][pb].z, acc[0][pb].w); o0.z = pk2(acc[1][pb].x, acc[1][pb].y); o0.w = pk2(acc[1][pb].z, acc[1][pb].w);
            o1.x = pk2(acc[2][pb].x, acc[2][pb].y); o1.y = pk2(acc[2][pb].z, acc[2][pb].w); o1.z = pk2(acc[3][pb].x, acc[3][pb].y); o1.w = pk2(acc[3][pb].z, acc[3][pb].w);
            bf16* rp = st + (pb * 16 + fr) * 64 + 16 * fq; *(v4u*)rp = o0; *(v4u*)(rp + 8) = o1; }
    }
}
constexpr size_t WS_GC0 = WS_H + ((size_t)136 << 20), WS_GC1 = WS_H + ((size_t)170 << 20);
__device__ __forceinline__ void gla_s1_pair(const Ctx& C, int l, int unit) {
    const int b = unit / (NCH * 2), rem = unit - b * (NCH * 2), c = rem >> 1, hp = rem & 1; const size_t m0 = (size_t)b * SB + c * CH;
    LAS unsigned char* VT = C.lds; LAS unsigned char* KS = C.lds + 2 * TILE_B; LAS float* GS = (LAS float*)(C.lds + 6 * TILE_B);
    const int w = C.wave, lane = C.lane, fr = lane & 15, fq = lane >> 4;
    const int s = C.tid >> 3, sub = C.tid & 7; const size_t m = m0 + s;
    __syncthreads();
    v4u kk[2];
    { const bf16* gr = (const bf16*)(C.ws + WS_G) + m * 512 + hp * 128 + sub * 8; const bf16* cr = (const bf16*)(C.ws + WS_COLS) + m * INWP + hp * 128 + sub * 8;
#pragma unroll
      for (int hd = 0; hd < 4; ++hd) { const int hl = hd >> 1, d = hd & 1; const v4u g = *(const v4u*)(gr + d * 256 + hl * 64); *(LAS f32x4*)(GS + hd * 4096 + s * 64 + sub * 8) = (f32x4){bflo(g.x), bfhi(g.x), bflo(g.y), bfhi(g.y)}; *(LAS f32x4*)(GS + hd * 4096 + s * 64 + sub * 8 + 4) = (f32x4){bflo(g.z), bfhi(g.z), bflo(g.w), bfhi(g.w)}; }
#pragma unroll
      for (int hl = 0; hl < 2; ++hl) { kk[hl] = *(const v4u*)(cr + C_GK + hl * 64); *(LAS v4u*)(VT + hl * TILE_B + s * TP + sub * 16) = *(const v4u*)(cr + C_GV + hl * 64); } }
    __syncthreads();
    if (C.tid < 256) { const int hd = C.tid >> 6, hl = hd >> 1, d = hd & 1, k = C.tid & 63, h = hp * 2 + hl; LAS float* col = GS + hd * 4096 + k; bf16* gc = (bf16*)(C.ws + (d ? WS_GC1 : WS_GC0)) + m0 * 256 + h * 64 + k; float r = 0.f;
#pragma unroll 8
        for (int i = 0; i < 64; ++i) { const int ss = d == 0 ? i : 63 - i; r += col[ss * 64]; col[ss * 64] = r; gc[(size_t)ss * 256] = (bf16)f2bf(r); }
        ((float*)(C.ws + WS_GDEC))[((((size_t)b * NCH + c) * 2 + d) * 4 + h) * 64 + k] = __expf(r); }
    __syncthreads();
#pragma unroll
    for (int hd = 0; hd < 4; ++hd) { const int hl = hd >> 1, d = hd & 1; const LAS float* cs = GS + hd * 4096 + s * 64 + sub * 8; const LAS float* cl = GS + hd * 4096 + (d == 0 ? 63 : 0) * 64 + sub * 8;
        *(LAS v4u*)(KS + hd * TILE_B + s * TP + sub * 16) = scale8v(kk[hl], exp4(*(const LAS f32x4*)cl - *(const LAS f32x4*)cs), exp4(*(const LAS f32x4*)(cl + 4) - *(const LAS f32x4*)(cs + 4))); }
    __syncthreads();
    const int hd = w >> 1, half = w & 1, hl = hd >> 1, d = hd & 1, h = hp * 2 + hl; const LAS unsigned char* KH = KS + hd * TILE_B; const LAS unsigned char* VH = VT + hl * TILE_B;
    f32x4 acc[2][4];
#pragma unroll
    for (int kb = 0; kb < 2; ++kb)
#pragma unroll
        for (int vb = 0; vb < 4; ++vb) acc[kb][vb] = (f32x4){0.f, 0.f, 0.f, 0.f};
#pragma unroll
    for (int ks = 0; ks < 2; ++ks) { bf16x8 bo[4];
#pragma unroll
        for (int vb = 0; vb < 4; ++vb) bo[vb] = tr_frag(VH, ks * 32 + 8 * fq, ks * 32 + 8 * fq + 4, vb * 16, lane);
#pragma unroll
        for (int kb = 0; kb < 2; ++kb) { const bf16x8 a = tr_frag(KH, ks * 32 + 8 * fq, ks * 32 + 8 * fq + 4, (2 * half + kb) * 16, lane);
#pragma unroll
            for (int vb = 0; vb < 4; ++vb) acc[kb][vb] = __builtin_amdgcn_mfma_f32_16x16x32_bf16(a, bo[vb], acc[kb][vb], 0, 0, 0); } }
    bf16* st = (bf16*)(C.ws + WS_GST) + ((((size_t)b * NCH + c) * 2 + d) * 4 + h) * 4096;
#pragma unroll
    for (int kb = 0; kb < 2; ++kb)
#pragma unroll
        for (int vb = 0; vb < 4; ++vb) { v2u o; o.x = pk2(acc[kb][vb].x, acc[kb][vb].y); o.y = pk2(acc[kb][vb].z, acc[kb][vb].w); *(v2u*)(st + (vb * 16 + fr) * 64 + (2 * half + kb) * 16 + 4 * fq) = o; }
}
__device__ __forceinline__ void gla_s3_pair(const Ctx& C, int l, int unit, const float* normw) {
    const int b = unit / (NCH * 2), rem = unit - b * (NCH * 2), c = rem >> 1, hp = rem & 1; const size_t m0 = (size_t)b * SB + c * CH;
    LAS unsigned char* VT = C.lds; LAS unsigned char* QS = C.lds + 2 * TILE_B; LAS unsigned char* KI = C.lds + 6 * TILE_B;
    const int w = C.wave, lane = C.lane, fr = lane & 15, fq = lane >> 4;
    __syncthreads();
    { const int s = C.tid >> 3, sub = C.tid & 7; const size_t m = m0 + s; const bf16* cr = (const bf16*)(C.ws + WS_COLS) + m * INWP + hp * 128 + sub * 8; const bf16* gc0 = (const bf16*)(C.ws + WS_GC0) + m * 256 + hp * 128 + sub * 8; const bf16* gc1 = (const bf16*)(C.ws + WS_GC1) + m * 256 + hp * 128 + sub * 8;
#pragma unroll
      for (int hl = 0; hl < 2; ++hl) { const v4u q8 = scale8(*(const v4u*)(cr + C_GQ + hl * 64), 0.125f), k8 = *(const v4u*)(cr + C_GK + hl * 64);
          *(LAS v4u*)(VT + hl * TILE_B + s * TP + sub * 16) = *(const v4u*)(cr + C_GV + hl * 64);
#pragma unroll
          for (int d = 0; d < 2; ++d) { const v4u cw = *(const v4u*)((d ? gc1 : gc0) + hl * 64); const f32x4 c0 = (f32x4){bflo(cw.x), bfhi(cw.x), bflo(cw.y), bfhi(cw.y)}, c1 = (f32x4){bflo(cw.z), bfhi(cw.z), bflo(cw.w), bfhi(cw.w)};
              *(LAS v4u*)(QS + (hl * 2 + d) * TILE_B + s * TP + sub * 16) = scale8v(q8, exp4(c0), exp4(c1)); *(LAS v4u*)(KI + (hl * 2 + d) * TILE_B + s * TP + sub * 16) = scale8v(k8, exp4(-c0), exp4(-c1)); } } }
    const int hl = w >> 2, lb = w & 3, h = hp * 2 + hl, lrow = lb * 16 + fr;
    bf16x8 hst[2][4][2]; v2u rr_[4];
    { const bf16* stb = (const bf16*)(C.ws + WS_GEN) + (((size_t)b * NCH + c) * 2 * 4 + h) * 4096;
#pragma unroll
      for (int d = 0; d < 2; ++d)
#pragma unroll
          for (int vb = 0; vb < 4; ++vb)
#pragma unroll
              for (int ks = 0; ks < 2; ++ks) hst[d][vb][ks] = *(const bf16x8*)(stb + (size_t)d * 4 * 4096 + (vb * 16 + fr) * 64 + ks * 32 + fq * 8);
      const bf16* colr = (const bf16*)(C.ws + WS_COLS);
#pragma unroll
      for (int vb = 0; vb < 4; ++vb) rr_[vb] = *(const v2u*)(colr + (m0 + lrow) * INWP + C_GR + h * 64 + vb * 16 + 4 * fq); }
    __syncthreads();
    const LAS unsigned char* QF_ = QS + (hl * 2) * TILE_B; const LAS unsigned char* QB_ = QF_ + TILE_B; const LAS unsigned char* KF_ = KI + (hl * 2) * TILE_B; const LAS unsigned char* KB_ = KF_ + TILE_B; const LAS unsigned char* VH = VT + hl * TILE_B;
    bf16x8 qf[2][2];
#pragma unroll
    for (int ks = 0; ks < 2; ++ks) { qf[0][ks] = row_frag(QF_, lrow, ks * 32 + fq * 8); qf[1][ks] = row_frag(QB_, lrow, ks * 32 + fq * 8); }
    f32x4 ao[4];
#pragma unroll
    for (int vb = 0; vb < 4; ++vb) ao[vb] = (f32x4){0.f, 0.f, 0.f, 0.f};
    {   f32x4 ap[4];
#pragma unroll
        for (int sb = 0; sb < 4; ++sb) { f32x4 af = (f32x4){0.f, 0.f, 0.f, 0.f}, ab = af;
#pragma unroll
            for (int ks = 0; ks < 2; ++ks) { af = __builtin_amdgcn_mfma_f32_16x16x32_bf16(row_frag(KF_, sb * 16 + fr, ks * 32 + fq * 8), qf[0][ks], af, 0, 0, 0); ab = __builtin_amdgcn_mfma_f32_16x16x32_bf16(row_frag(KB_, sb * 16 + fr, ks * 32 + fq * 8), qf[1][ks], ab, 0, 0, 0); }
            const int s0 = sb * 16 + 4 * fq; f32x4 m;
            m.x = (s0 + 0 <= lrow ? af.x : 0.f) + (s0 + 0 >= lrow ? ab.x : 0.f); m.y = (s0 + 1 <= lrow ? af.y : 0.f) + (s0 + 1 >= lrow ? ab.y : 0.f);
            m.z = (s0 + 2 <= lrow ? af.z : 0.f) + (s0 + 2 >= lrow ? ab.z : 0.f); m.w = (s0 + 3 <= lrow ? af.w : 0.f) + (s0 + 3 >= lrow ? ab.w : 0.f);
            ap[sb] = m; }
#pragma unroll
        for (int kk = 0; kk < 2; ++kk) { const bf16x8 pf = pack_p(ap[2 * kk], ap[2 * kk + 1]);
#pragma unroll
            for (int vb = 0; vb < 4; ++vb) ao[vb] = __builtin_amdgcn_mfma_f32_16x16x32_bf16(tr_frag(VH, kk * 32 + 4 * fq, kk * 32 + 16 + 4 * fq, vb * 16, lane), pf, ao[vb], 0, 0, 0); }
    }
    {
#pragma unroll
        for (int d = 0; d < 2; ++d)
#pragma unroll
            for (int vb = 0; vb < 4; ++vb)
#pragma unroll
                for (int ks = 0; ks < 2; ++ks) ao[vb] = __builtin_amdgcn_mfma_f32_16x16x32_bf16(hst[d][vb][ks], qf[d][ks], ao[vb], 0, 0, 0); }
    float ss = 0.f;
#pragma unroll
    for (int vb = 0; vb < 4; ++vb) ss += (ao[vb].x * ao[vb].x + ao[vb].y * ao[vb].y) + (ao[vb].z * ao[vb].z + ao[vb].w * ao[vb].w);
    ss += __shfl_xor(ss, 16); ss += __shfl_xor(ss, 32);
    const float rstd = rsqrtf(ss * (1.0f / 64.0f) + EPS);
    bf16* mix = (bf16*)(C.ws + WS_ACT1);
#pragma unroll
    for (int vb = 0; vb < 4; ++vb) { const int v0 = vb * 16 + 4 * fq; const f32x4 nw = *(const f32x4*)(normw + l * 64 + v0); const v2u rr = rr_[vb];
        v2u o; o.x = pk2(ao[vb].x * rstd * nw.x * fsilu(bflo(rr.x)), ao[vb].y * rstd * nw.y * fsilu(bfhi(rr.x))); o.y = pk2(ao[vb].z * rstd * nw.z * fsilu(bflo(rr.y)), ao[vb].w * rstd * nw.w * fsilu(bfhi(rr.y)));
        *(v2u*)(mix + (m0 + lrow) * DM + 512 + h * 64 + v0) = o; }
}
__device__ __forceinline__ void zero_mix(const Ctx& C, int unit, int ssd) {
    bf16* mix = (bf16*)(C.ws + WS_ACT1); const int s = C.tid >> 3, sub = C.tid & 7;
    if (ssd) { const int b = unit / (NCH * 2), rem = unit - b * (NCH * 2), c = rem >> 1, g = rem & 1; const size_t m = (size_t)b * SB + c * CH + s;
        for (int q = 0; q < 4; ++q) *(v4u*)(mix + m * DM + g * 256 + q * 64 + sub * 8) = (v4u){0u, 0u, 0u, 0u}; }
    else { const int b = unit / (NCH * 4), rem = unit - b * (NCH * 4), c = rem >> 2, h = rem & 3; const size_t m = (size_t)b * SB + c * CH + s; *(v4u*)(mix + m * DM + 512 + h * 64 + sub * 8) = (v4u){0u, 0u, 0u, 0u}; }
}
constexpr int NU_S1 = NBATCH * NCH, NU_S3S = NBATCH * NCH * 2, NU_S3G = NBATCH * NCH * 2;
__device__ __forceinline__ void ph_chunk_s1(const Ctx& C, int l) { const float* alog = IN_(I_ALOG);
    for (int u = C.bid; u < 3 * NU_S1; u += C.G) { if (u < NU_S1) ssd_s1_bc(C, l, u, alog); else gla_s1_pair(C, l, u - NU_S1); }
}
__device__ __forceinline__ void ph_s2_assemble(const Args& A, const Ctx& C, int l, int rep) {
    if (C.wave < 6) { const int id = C.bid * 6 + C.wave, chain = id >> 2, sl = id & 3;
        if (chain < NBATCH * 2 * 8) chunk_s2_slice<true>(C, chain, sl); else if (chain < NBATCH * 2 * 12) chunk_s2_slice<false>(C, chain - NBATCH * 2 * 8, sl); }
    ph_assemble(A, C, l, rep);
}
__device__ __forceinline__ void ph_chunk_s3(const Ctx& C, int l, int rep) { const float* alog = IN_(I_ALOG); const float* dskip = IN_(I_SSDD); const float* nws = IN_(I_SSDNW); const float* nwg = IN_(I_GLANW);
    for (int u = C.bid; u < NU_S3S + NU_S3G; u += C.G) {
        const int uu = u < NU_S3S ? u : u - NU_S3S, c = (uu % (NCH * 2)) >> 1; if (l == 1 && c < NCTXCH) continue;
        if (u < NU_S3S) ssd_s3(C, l, uu, alog, dskip, nws); else gla_s3_pair(C, l, uu, nwg);
    }
}
constexpr int RT_VP = 2064;
__device__ __forceinline__ void ph_route(const Args& A, const Ctx& C, int l) { const float* const p_I_NORM2 = IN_(I_NORM2); const float* const p_I_RB = IN_(I_RB); const float* const p_I_RW = IN_(I_RW);
    LAS unsigned char* VH = C.lds; LAS unsigned char* VL = C.lds + 16 * RT_VP; LAS float* PART = (LAS float*)(C.lds + 32 * RT_VP);
    if (C.tid < 32) C.MISC[MISC_CNT + C.tid] = 0u;
    const bf16* Hp = (const bf16*)(C.ws + WS_H); const float* mod = (const float*)(C.ws + WS_MOD) + (size_t)l * 17 * 6144; bf16* vout = (bf16*)(C.ws + WS_ACT1);
    int* toke = (int*)(C.ws + WS_TOKE); int* tokp = (int*)(C.ws + WS_TOKP); float* tokw = (float*)(C.ws + WS_TOKW);
    const int lane = C.lane, w = C.wave, fr = lane & 15, fq = lane >> 4; const int RPW = TT / 256;
    bf16x8 wh[4][2], wl[4][2];
#pragma unroll
    for (int ks = 0; ks < 4; ++ks)
#pragma unroll
        for (int cb = 0; cb < 2; ++cb) { float x[8];
#pragma unroll
            for (int j = 0; j < 8; ++j) x[j] = p_I_RW[(size_t)l * 32768 + (size_t)(128 * w + 32 * ks + 8 * fq + j) * 32 + cb * 16 + fr];
            unsigned hh[4], ll[4];
#pragma unroll
            for (int j = 0; j < 4; ++j) { hh[j] = pk2(x[2 * j], x[2 * j + 1]); ll[j] = pk2(x[2 * j] - bflo(hh[j]), x[2 * j + 1] - bfhi(hh[j])); }
            wh[ks][cb] = __builtin_bit_cast(bf16x8, ((v4u){hh[0], hh[1], hh[2], hh[3]})); wl[ks][cb] = __builtin_bit_cast(bf16x8, ((v4u){ll[0], ll[1], ll[2], ll[3]})); }
    const f32x4* nwp = (const f32x4*)(p_I_NORM2 + l * 1024) + lane; f32x4 nw[4];
#pragma unroll
    for (int q = 0; q < 4; ++q) nw[q] = nwp[64 * q];
    const float rbias = p_I_RB[l * 32 + (lane & 31)];
    const int bb = (C.bid * RPW) / SB;
    for (int t = 0; t < RPW / 16; ++t) {
        const int mt = C.bid * RPW + t * 16, st = mt - bb * SB;
        if (l == 1 && st < CTXL) continue;
        const float* mr = mod + (size_t)(st < CTXL ? 16 : bb) * 6144;
        __syncthreads();
        {
            f32x4 v[2][4]; float ss[2];
#pragma unroll
            for (int r = 0; r < 2; ++r) { const v2u* xr = (const v2u*)(Hp + (size_t)(mt + 2 * w + r) * DM) + lane; ss[r] = 0.f;
#pragma unroll
                for (int q = 0; q < 4; ++q) { const v2u hw = xr[64 * q]; v[r][q] = (f32x4){bflo(hw.x), bfhi(hw.x), bflo(hw.y), bfhi(hw.y)}; ss[r] += (v[r][q].x * v[r][q].x + v[r][q].y * v[r][q].y) + (v[r][q].z * v[r][q].z + v[r][q].w * v[r][q].w); } }
#pragma unroll
            for (int o = 1; o < 64; o <<= 1) { ss[0] += __shfl_xor(ss[0], o); ss[1] += __shfl_xor(ss[1], o); }
#pragma unroll
            for (int r = 0; r < 2; ++r) { const float rstd = rsqrtf(ss[r] * (1.0f / 1024.0f) + EPS); const int row = 2 * w + r;
#pragma unroll
                for (int q = 0; q < 4; ++q) { const int j4 = lane + 64 * q; const f32x4 sh = ((const f32x4*)(mr + 3 * 1024))[j4], sc = ((const f32x4*)(mr + 4 * 1024))[j4];
                    const f32x4 o = (v[r][q] * rstd * nw[q]) * (sc + 1.0f) + sh; v2u hi; hi.x = pk2(o.x, o.y); hi.y = pk2(o.z, o.w);
                    v2u lo; lo.x = pk2(o.x - bflo(hi.x), o.y - bfhi(hi.x)); lo.y = pk2(o.z - bflo(hi.y), o.w - bfhi(hi.y));
                    ((v2u*)(vout + (size_t)(mt + row) * DM))[j4] = hi; *(LAS v2u*)(VH + row * RT_VP + j4 * 8) = hi; *(LAS v2u*)(VL + row * RT_VP + j4 * 8) = lo; } }
        }
        __syncthreads();
        {
            f32x4 acc[2]; acc[0] = (f32x4){0.f, 0.f, 0.f, 0.f}; acc[1] = acc[0];
#pragma unroll
            for (int ks = 0; ks < 4; ++ks) { const bf16x8 ah = *(const LAS bf16x8*)(VH + fr * RT_VP + (128 * w + 32 * ks + 8 * fq) * 2), al = *(const LAS bf16x8*)(VL + fr * RT_VP + (128 * w + 32 * ks + 8 * fq) * 2);
#pragma unroll
                for (int cb = 0; cb < 2; ++cb) { acc[cb] = __builtin_amdgcn_mfma_f32_16x16x32_bf16(ah, wh[ks][cb], acc[cb], 0, 0, 0); acc[cb] = __builtin_amdgcn_mfma_f32_16x16x32_bf16(al, wh[ks][cb], acc[cb], 0, 0, 0); acc[cb] = __builtin_amdgcn_mfma_f32_16x16x32_bf16(ah, wl[ks][cb], acc[cb], 0, 0, 0); } }
#pragma unroll
            for (int cb = 0; cb < 2; ++cb) { PART[w * 512 + (4 * fq + 0) * 32 + cb * 16 + fr] = acc[cb].x; PART[w * 512 + (4 * fq + 1) * 32 + cb * 16 + fr] = acc[cb].y; PART[w * 512 + (4 * fq + 2) * 32 + cb * 16 + fr] = acc[cb].z; PART[w * 512 + (4 * fq + 3) * 32 + cb * 16 + fr] = acc[cb].w; }
        }
        __syncthreads();
        {
            const int row = C.tid >> 5, e = lane & 31, half = lane >> 5; float lg = rbias;
#pragma unroll
            for (int ww = 0; ww < 8; ++ww) lg += PART[ww * 512 + row * 32 + e];
            int es[4]; float vs[4];
#pragma unroll
            for (int k = 0; k < 4; ++k) { float mx = lg;
#pragma unroll
                for (int o = 1; o < 32; o <<= 1) mx = fmaxf(mx, __shfl_xor(mx, o));
                const unsigned long long bal = __ballot(lg == mx); const unsigned bits = (unsigned)(bal >> (32 * half)); const int first = __ffs((int)bits) - 1;
                es[k] = first; vs[k] = mx; if (e == first) lg = -3.0e38f; }
            const float p1 = expf(vs[1] - vs[0]), p2 = expf(vs[2] - vs[0]), p3 = expf(vs[3] - vs[0]); const float inv = 1.0f / (1.0f + p1 + p2 + p3);
            if (e < 4) { const int ek = e == 0 ? es[0] : e == 1 ? es[1] : e == 2 ? es[2] : es[3]; const float wk = (e == 0 ? 1.0f : e == 1 ? p1 : e == 2 ? p2 : p3) * inv; const size_t m = (size_t)(mt + row);
                const unsigned pos = atomicAdd((unsigned*)&C.MISC[MISC_CNT + ek], 1u);
                toke[m * 4 + e] = ek; tokp[m * 4 + e] = (int)pos; tokw[m * 4 + e] = wk; }
        }
    }
    __syncthreads();
    if (C.tid < 32) ((int*)(C.ws + WS_WGCNT))[C.bid * 32 + C.tid] = (int)C.MISC[MISC_CNT + C.tid];
}
__device__ __forceinline__ void ph_slots(const Args& A, const Ctx& C, int l) {
    LAS int* wc = (LAS int*)C.lds;
    LAS int* ps = wc + 256 * 32;
    const int* wgcnt = (const int*)(C.ws + WS_WGCNT);
    for (int idx = C.tid; idx < C.G * 32; idx += NTHREADS) wc[idx] = wgcnt[idx];
    __syncthreads();
    { const int e = C.tid & 31, part = C.tid >> 5; int tot = 0, base = 0;
#pragma unroll
      for (int k = 0; k < 16; ++k) { const int g = part * 16 + k; const int c = wc[g * 32 + e]; tot += c; base += g < C.bid ? c : 0; }
      ps[part * 32 + e] = tot; ps[512 + part * 32 + e] = base; }
    __syncthreads();
    if (C.tid < 64) {
        const int e = C.tid & 31; int tot = 0, base = 0;
#pragma unroll
        for (int k = 0; k < 16; ++k) { tot += ps[k * 32 + e]; base += ps[512 + k * 32 + e]; }
        const int padded = (tot + 255) & ~255; int incl = padded;
#pragma unroll
        for (int o = 1; o < 32; o <<= 1) { const int t = __shfl_up(incl, o); if (e >= o) incl += t; }
        const int off = incl - padded;
        if (C.tid < 32) { C.MISC[MISC_SB + e] = (unsigned)(off + base); ps[1024 + e] = tot; ps[1056 + e] = off;
            if (C.bid == 0) { int* meta = (int*)(C.ws + WS_META); meta[e] = off >> 8; if (e == 31) meta[32] = incl >> 8; } }
    }
    __syncthreads();
    const int* toke = (const int*)(C.ws + WS_TOKE); const int* tokp = (const int*)(C.ws + WS_TOKP); int* toks = (int*)(C.ws + WS_TOKS); int* stok = (int*)(C.ws + WS_STOK);
    if (C.bid < 32) { const int tot = ps[1024 + C.bid], off = ps[1056 + C.bid], p2 = tot + C.tid; if (p2 < ((tot + 255) & ~255)) stok[off + p2] = 0; }
    const int RPW = TT / 256;
    int ee[3], pp[3];
#pragma unroll
    for (int k = 0; k < 3; ++k) { const int idx = C.tid + k * NTHREADS; ee[k] = 0; pp[k] = 0; if (idx < RPW * 4) { const size_t m = (size_t)C.bid * RPW + (idx >> 2); ee[k] = toke[m * 4 + (idx & 3)]; pp[k] = tokp[m * 4 + (idx & 3)]; } }
    static_assert(RPW * 4 <= 3 * NTHREADS, "three items per thread");
#pragma unroll
    for (int k = 0; k < 3; ++k) { const int idx = C.tid + k * NTHREADS; if (idx < RPW * 4) { const int m = C.bid * RPW + (idx >> 2); const int b = m / SB, s = m - b * SB;
        if (!(l == 1 && s < CTXL)) { const int slot = (int)C.MISC[MISC_SB + ee[k]] + pp[k]; toks[(size_t)m * 4 + (idx & 3)] = slot; stok[slot] = m; } } }
}
__device__ __forceinline__ void ph_combine(const Args& A, const Ctx& C, int l) { const float* const p_I_FINW = IN_(I_FINW); const float* const p_I_NORM1 = IN_(I_NORM1); float* const p_OUT = (float*)IN_(N_IN);
    const bf16* Y = (const bf16*)(C.ws + WS_XG); bf16* Hp = (bf16*)(C.ws + WS_H); const float* modl = (const float*)(C.ws + WS_MOD) + (size_t)l * 17 * 6144;
    const int* tokp = (const int*)(C.ws + WS_TOKS); const float* tokw = (const float*)(C.ws + WS_TOKW);
    const int gw = C.bid * NWAVES + C.wave, NGW = C.G * NWAVES, lane = C.lane;
    const int NR = l == 0 ? TT : NBATCH * SEQL;
#define ROW_OF(i_) (l == 0 ? (i_) : ((i_) >> 12) * SB + CTXL + ((i_) & 4095))
    const f32x4* nwp = (const f32x4*)(l == 0 ? p_I_NORM1 + 1024 : p_I_FINW); f32x4 nw[4];
#pragma unroll
    for (int q = 0; q < 2; ++q) { nw[2 * q] = nwp[(lane + 64 * q) * 2]; nw[2 * q + 1] = nwp[(lane + 64 * q) * 2 + 1]; }
    int s0[4], s1[4], s2[4]; float w0[4], w1[4], w2[4];
    v4u y0[4][2], y1[4][2]; f32x4 h0[4], h1[4];
#define CMB_SLOTS(i_, s_, w_) do { const size_t m_ = (size_t)ROW_OF(i_); _Pragma("unroll") for (int k = 0; k < 4; ++k) { s_[k] = tokp[m_ * 4 + k]; w_[k] = tokw[m_ * 4 + k]; } } while (0)
#define CMB_DATA(i_, s_, y_, h_) do { const size_t m_ = (size_t)ROW_OF(i_); _Pragma("unroll") for (int q = 0; q < 2; ++q) { const int j8 = lane + 64 * q; \
        _Pragma("unroll") for (int k = 0; k < 4; ++k) y_[k][q] = ((const v4u*)(Y + (size_t)s_[k] * DM))[j8]; \
        { const v4u hw_ = ((const v4u*)(Hp + m_ * DM))[j8]; h_[2 * q] = (f32x4){bflo(hw_.x), bfhi(hw_.x), bflo(hw_.y), bfhi(hw_.y)}; h_[2 * q + 1] = (f32x4){bflo(hw_.z), bfhi(hw_.z), bflo(hw_.w), bfhi(hw_.w)}; } } } while (0)
    if (gw < NR) { CMB_SLOTS(gw, s0, w0); if (gw + NGW < NR) CMB_SLOTS(gw + NGW, s1, w1); CMB_DATA(gw, s0, y0, h0); }
    for (int i = gw; i < NR; i += NGW) {
        if (i + NGW < NR) CMB_DATA(i + NGW, s1, y1, h1);
        if (i + 2 * NGW < NR) CMB_SLOTS(i + 2 * NGW, s2, w2);
        const int m = ROW_OF(i); const int b = m / SB, s = m - b * SB; const int rr = s < CTXL ? 16 : b; const float* g5 = modl + (size_t)rr * 6144 + 5 * 1024;
        float hn[16]; float ss = 0.f;
#pragma unroll
        for (int q = 0; q < 2; ++q) { const int j8 = lane + 64 * q; float f[8];
#pragma unroll
            for (int k = 0; k < 8; ++k) f[k] = 0.f;
#pragma unroll
            for (int k = 0; k < 4; ++k) { const v4u y = y0[k][q]; const float wk = w0[k];
                f[0] += wk * bflo(y.x); f[1] += wk * bfhi(y.x); f[2] += wk * bflo(y.y); f[3] += wk * bfhi(y.y); f[4] += wk * bflo(y.z); f[5] += wk * bfhi(y.z); f[6] += wk * bflo(y.w); f[7] += wk * bfhi(y.w); }
            const f32x4 ha = h0[2 * q], hb = h0[2 * q + 1];
            const f32x4 ga = ((const f32x4*)g5)[j8 * 2], gb = ((const f32x4*)g5)[j8 * 2 + 1];
            hn[q * 8 + 0] = ha.x + ga.x * f[0]; hn[q * 8 + 1] = ha.y + ga.y * f[1]; hn[q * 8 + 2] = ha.z + ga.z * f[2]; hn[q * 8 + 3] = ha.w + ga.w * f[3];
            hn[q * 8 + 4] = hb.x + gb.x * f[4]; hn[q * 8 + 5] = hb.y + gb.y * f[5]; hn[q * 8 + 6] = hb.z + gb.z * f[6]; hn[q * 8 + 7] = hb.w + gb.w * f[7];
#pragma unroll
            for (int k = 0; k < 8; ++k) ss += hn[q * 8 + k] * hn[q * 8 + k]; }
        const float rstd = rsqrtf(wave_sum(ss) * (1.0f / 1024.0f) + EPS);
        if (l == 0) {
            const float* mn = (const float*)(C.ws + WS_MOD) + (size_t)17 * 6144 + (size_t)rr * 6144; bf16* uo = (bf16*)(C.ws + WS_ACT1) + (size_t)m * DM;
#pragma unroll
            for (int q = 0; q < 2; ++q) { const int j8 = lane + 64 * q;
                { v4u hw; hw.x = pk2(hn[q * 8], hn[q * 8 + 1]); hw.y = pk2(hn[q * 8 + 2], hn[q * 8 + 3]); hw.z = pk2(hn[q * 8 + 4], hn[q * 8 + 5]); hw.w = pk2(hn[q * 8 + 6], hn[q * 8 + 7]); ((v4u*)(Hp + (size_t)m * DM))[j8] = hw; }
                float o[8];
#pragma unroll
                for (int hh = 0; hh < 2; ++hh) { const f32x4 w = nw[2 * q + hh], sh = ((const f32x4*)mn)[j8 * 2 + hh], sc = ((const f32x4*)(mn + 1024))[j8 * 2 + hh];
                    o[hh * 4 + 0] = (hn[q * 8 + hh * 4 + 0] * rstd * w.x) * (sc.x + 1.0f) + sh.x; o[hh * 4 + 1] = (hn[q * 8 + hh * 4 + 1] * rstd * w.y) * (sc.y + 1.0f) + sh.y;
                    o[hh * 4 + 2] = (hn[q * 8 + hh * 4 + 2] * rstd * w.z) * (sc.z + 1.0f) + sh.z; o[hh * 4 + 3] = (hn[q * 8 + hh * 4 + 3] * rstd * w.w) * (sc.w + 1.0f) + sh.w; }
                v4u p; p.x = pk2(o[0], o[1]); p.y = pk2(o[2], o[3]); p.z = pk2(o[4], o[5]); p.w = pk2(o[6], o[7]); ((v4u*)uo)[j8] = p; }
        } else {
            float* orow = p_OUT + ((size_t)b * SEQL + (s - CTXL)) * DM;
#pragma unroll
            for (int q = 0; q < 2; ++q) { const int j8 = lane + 64 * q;
#pragma unroll
                for (int hh = 0; hh < 2; ++hh) { const f32x4 w = nw[2 * q + hh];
                    ((f32x4*)orow)[j8 * 2 + hh] = (f32x4){hn[q * 8 + hh * 4] * rstd * w.x, hn[q * 8 + hh * 4 + 1] * rstd * w.y, hn[q * 8 + hh * 4 + 2] * rstd * w.z, hn[q * 8 + hh * 4 + 3] * rstd * w.w}; } }
        }
#pragma unroll
        for (int k = 0; k < 4; ++k) { s0[k] = s1[k]; w0[k] = w1[k]; s1[k] = s2[k]; w1[k] = w2[k]; y0[k][0] = y1[k][0]; y0[k][1] = y1[k][1]; h0[k] = h1[k]; }
    }
#undef ROW_OF
#undef CMB_SLOTS
#undef CMB_DATA
}
constexpr int NLP = 12;
constexpr int N_PHASES = 3 + 2 * NLP;
#ifndef GA_
#define GA_ true
#endif
#ifndef GS_
#define GS_ true
#endif
#ifndef PHMASK
#define PHMASK 0xffff
#endif
#define PH_ON(id) (lo <= (id) && (id) < hi && ((PHMASK >> ((id) < 3 ? (id) : 3 + ((id) - 3) % NLP)) & 1))
#define FRESH() do { int t_ = C.tid; unsigned wl_ = __builtin_amdgcn_readfirstlane((unsigned)(unsigned long long)C.ws), wh_ = __builtin_amdgcn_readfirstlane((unsigned)((unsigned long long)C.ws >> 32)); \
        int g_ = __builtin_amdgcn_readfirstlane(C.G), b_ = __builtin_amdgcn_readfirstlane(C.bid); \
        asm volatile("" : "+s"(wl_), "+s"(wh_), "+s"(g_), "+s"(b_), "+v"(t_)); \
        C.tid = t_; C.G = g_; C.bid = b_; C.ws = (GAS unsigned char*)(((unsigned long long)wh_ << 32) | wl_); C.lane = C.tid & 63; C.wave = __builtin_amdgcn_readfirstlane(C.tid >> 6); ws = C.ws; } while (0)
#ifdef DBLBAR
#define PH_SEAM(id) do { if ((id) + 1 < hi) { xcd_barrier(bar); xcd_barrier(bar); } } while (0)
#else
#define PH_SEAM(id) do { if ((id) + 1 < hi) xcd_barrier(bar); } while (0)
#endif
#ifndef PHREP
#define PHREP 0ull
#endif
#if PHREP
#ifndef PHREPN
#define PHREPN 1
#endif
#define REPS_(id) (((id) < 3 || (((PHREP >> (3 + ((id) - 3) % NLP)) | (PHREP >> (3 + NLP + ((id) - 3) % NLP))) & 1ull)) ? (int)((PHREP >> (id)) & 1ull) * PHREPN : 0)
#define PH_BEGIN(id) if (PH_ON(id)) { for (int rep_ = 0; rep_ <= REPS_(id); ++rep_) { FRESH();
#define PH_END(id) if (rep_ < REPS_(id)) xcd_barrier(bar); } PH_SEAM(id); }
#else
#define PH_BEGIN(id) if (PH_ON(id)) { const int rep_ = 0; (void)rep_; FRESH();
#define PH_END(id) PH_SEAM(id); }
#endif
template <int L> __device__ __forceinline__ void layer_phases(const Args& args, Ctx& C, const XcdBarrier& bar, const int lo, const int hi) {
    GAS unsigned char* ws = C.ws; constexpr int l = L; constexpr int pb = 3 + NLP * L;
        PH_BEGIN(pb + 0)
            pg8::Gemm g{(const bf16*)(ws + WS_ACT1), (const bf16*)(ws + WS_WINT) + (size_t)l * INWP * 1024, TT, INWP, 1024}; pg8::StaticOrder S; S.init(TT, INWP, C.G, C.bid);
            pg8::EpiBf16 E{(bf16*)(ws + WS_COLS), INWP, nullptr, 0, 0};
            pg8::gemm_phase<pg8::EpiBf16, pg8::StaticOrder, GA_, GS_>(C.lds, g, S, E, C.tid);
            PH_END(pb + 0)
        PH_BEGIN(pb + 1) ph_prep(args, C, l, rep_); PH_END(pb + 1)
        PH_BEGIN(pb + 2)
            { pg8::Gemm g{(const bf16*)(ws + WS_AQ), (const bf16*)(ws + WS_WUQT) + (size_t)l * 512 * 256, TT, 512, 256}; pg8::StaticOrder S; S.init(TT, 512, C.G, C.bid);
              pg8::EpiBf16 E{(bf16*)(ws + WS_QRAW), 512, nullptr, 0, 0}; pg8::gemm_phase<pg8::EpiBf16, pg8::StaticOrder, GA_, GS_>(C.lds, g, S, E, C.tid); }
            { pg8::Gemm g{(const bf16*)(ws + WS_AKV), (const bf16*)(ws + WS_WUKVT) + (size_t)l * 512 * 256, TT, 512, 256}; pg8::StaticOrder S; S.init(TT, 512, C.G, C.bid);
              pg8::EpiBf16 E{(bf16*)(ws + WS_KV), 512, nullptr, 0, 0}; pg8::gemm_phase<pg8::EpiBf16, pg8::StaticOrder, GA_, GS_>(C.lds, g, S, E, C.tid); }
            ph_chunk_s1(C, l);
            PH_END(pb + 2)
        PH_BEGIN(pb + 3) ph_s2_assemble(args, C, l, rep_); PH_END(pb + 3)
        PH_BEGIN(pb + 4) attn_queue(C, l, rep_); PH_END(pb + 4)
        PH_BEGIN(pb + 5) ph_chunk_s3(C, l, rep_); PH_END(pb + 5)
        PH_BEGIN(pb + 6)
            pg8::Gemm g{(const bf16*)(ws + WS_ACT1), (const bf16*)(ws + WS_WOUTT) + (size_t)l * 1024 * 1024, TT, 1024, 1024};
            pg8::MapOrder S; S.init(l == 0 ? TT : NBATCH * SEQL, 1024, C.G, C.bid); S.skipctx = l;
            pg8::EpiResid E{IN_(I_X), IN_(I_CTX), (const bf16*)(ws + WS_H), (bf16*)(ws + WS_H), (const float*)(ws + WS_MOD) + (size_t)l * 17 * 6144, l};
            pg8::gemm_phase<pg8::EpiResid, pg8::MapOrder, GA_, GS_>(C.lds, g, S, E, C.tid);
            PH_END(pb + 6)
        PH_BEGIN(pb + 7) ph_route(args, C, l); PH_END(pb + 7)
        PH_BEGIN(pb + 8) ph_slots(args, C, l); PH_END(pb + 8)
        PH_BEGIN(pb + 9)
            pg8::Gemm g{(const bf16*)(ws + WS_ACT1), (const bf16*)(ws + WS_W1T), MAXSLOT, 32 * 2048, 1024};
            pg8::MoeOrder S{(const int*)(ws + WS_META), 8, C.G, C.bid};
            pg8::EpiSwiglu E{(bf16*)(ws + WS_ACTB), IN_(I_B1) + (size_t)l * 32 * 2048};
            pg8::gemm_phase_gather<pg8::EpiSwiglu, pg8::MoeOrder>(C.lds, g, S, E, C.tid, (const int*)(ws + WS_STOK));
            PH_END(pb + 9)
        PH_BEGIN(pb + 10)
            pg8::Gemm g{(const bf16*)(ws + WS_ACTB), (const bf16*)(ws + WS_W2T), MAXSLOT, 32 * 1024, 1024};
            pg8::MoeOrder S{(const int*)(ws + WS_META), 4, C.G, C.bid};
            pg8::EpiBf16 E{(bf16*)(ws + WS_XG), 1024, IN_(I_B2) + (size_t)l * 32 * 1024, 1024, 0};
            pg8::gemm_phase<pg8::EpiBf16, pg8::MoeOrder, GA_, GS_>(C.lds, g, S, E, C.tid);
            PH_END(pb + 10)
        PH_BEGIN(pb + 11) ph_combine(args, C, l); PH_END(pb + 11)
}
__global__ void __launch_bounds__(NTHREADS, 2) fwd_kernel(Args args) {
    extern __shared__ __attribute__((aligned(16))) unsigned char lds_raw[];
    Ctx C;
    C.lds = (LAS unsigned char*)lds_raw; C.MISC = (volatile LAS unsigned*)(C.lds + LDSCTL_OFF); C.ws = (GAS unsigned char*)args.ws;
    C.tid = threadIdx.x; C.lane = C.tid & 63; C.wave = __builtin_amdgcn_readfirstlane(C.tid >> 6); C.G = gridDim.x; C.bid = blockIdx.x;
    for (int u = C.tid; u < (LDS_BYTES - LDSCTL_OFF) / 4; u += NTHREADS) ((LAS unsigned*)(C.lds + LDSCTL_OFF))[u] = 0u;
    __syncthreads();
    if (C.tid <= N_IN) {
        const unsigned long long* ka = (const unsigned long long*)__builtin_amdgcn_kernarg_segment_ptr();
        ((volatile LAS unsigned long long*)(C.lds + PTR_OFF))[C.tid] = ka[C.tid]; }
    __syncthreads();
    XcdBarrier bar = xcd_barrier_post((unsigned*)args.ws + CW_BAR, C.MISC + MISC_BAR);
    const int lo = args.ph_lo, hi = args.ph_hi;
    GAS unsigned char* ws = (GAS unsigned char*)args.ws;
    PH_BEGIN(0) ph_g0(args, C); PH_END(0)
    PH_BEGIN(1) ph_g1(args, C); PH_END(1)
    PH_BEGIN(2) ph_g2(args, C); PH_END(2)
    layer_phases<0>(args, C, bar, lo, hi);
    layer_phases<1>(args, C, bar, lo, hi);
}
#undef PH_ON
#undef PH_SEAM


#ifndef MK_CUTS
#define MK_CUTS 0
#endif
extern "C" void kernel_launch(void* const* d_in, const int* in_sizes, int n_in, void* d_out, int out_size, void* d_ws, size_t ws_size, hipStream_t stream) {
    static int grid = 0;
    if (grid == 0) {
        if (n_in != N_IN || ws_size < WS_END || out_size != NBATCH * SEQL * DM) { fprintf(stderr, "kernel_launch: unexpected shapes (n_in %d, ws %zu, out %d); nothing launched\n", n_in, ws_size, out_size); grid = -1; return; }
        int dev = 0, cus = 0, per_cu = 0;
        if (hipGetDevice(&dev) != hipSuccess || hipDeviceGetAttribute(&cus, hipDeviceAttributeMultiprocessorCount, dev) != hipSuccess) { grid = -1; return; }
        if (hipFuncSetAttribute((const void*)fwd_kernel, hipFuncAttributeMaxDynamicSharedMemorySize, LDS_BYTES) != hipSuccess) { fprintf(stderr, "kernel_launch: hipFuncSetAttribute failed\n"); grid = -1; return; }
        if (hipOccupancyMaxActiveBlocksPerMultiprocessor(&per_cu, (const void*)fwd_kernel, NTHREADS, LDS_BYTES) != hipSuccess || per_cu < 1)
            fprintf(stderr, "kernel_launch: note: occupancy query reports %d workgroups per CU\n", per_cu);
        (void)hipGetLastError();
        if (cus < 256) { fprintf(stderr, "kernel_launch: this kernel is laid out for 256 CUs (found %d); nothing launched\n", cus); grid = -1; return; }
        grid = 256;
    }
    if (grid < 0) return;
    if (hipMemsetAsync((char*)d_ws + WS_CTL, 0, CTL_ZERO_BYTES, stream) != hipSuccess) return;
    Args a{};
    for (int i = 0; i < N_IN; ++i) a.in[i] = (const float*)d_in[i];
    a.out = (float*)d_out; a.ws = (unsigned char*)d_ws;
#if MK_CUTS
    for (int p = 0; p < N_PHASES; ++p) { a.ph_lo = p; a.ph_hi = p + 1; hipLaunchKernelGGL(fwd_kernel, dim3(grid), dim3(NTHREADS), LDS_BYTES, stream, a); }
#else
    a.ph_lo = 0; a.ph_hi = N_PHASES;
    hipLaunchKernelGGL(fwd_kernel, dim3(grid), dim3(NTHREADS), LDS_BYTES, stream, a);
#endif
    const hipError_t le = hipPeekAtLastError();
    if (le != hipSuccess) fprintf(stderr, "kernel_launch: launch failed: %s\n", hipGetErrorName(le));
}
```

```cpp
#include <hip/hip_runtime.h>
#include <cstdio>
#include <cstdint>
namespace pg8 {
#define PG8_LAS __attribute__((address_space(3)))
typedef unsigned short bf16_t;
typedef short bf16x8 __attribute__((ext_vector_type(8)));
typedef float f32x4 __attribute__((ext_vector_type(4)));
typedef unsigned u32x4 __attribute__((ext_vector_type(4)));
constexpr int BM = 256, BK = 64, HALF = 128, HTB = HALF * BK * 2  , STAGE_BYTES = 8 * HTB, NXCD = 8,
#ifndef PG8_WGM
#define PG8_WGM 8
#endif
    WGM = PG8_WGM;

__host__ __device__ __forceinline__ int lds_byte(int r, int c) { const int st = (r >> 4) * 2 + (c >> 5), rr = r & 15, cc = c & 31, ob = rr * 64 + cc * 2; return st * 1024 + (ob ^ (((ob >> 9) & 1) << 5)); }
__host__ __device__ __forceinline__ void stage_rc(int b, int& R, int& C) { const int st = b / 1024, sb = b % 1024, swz = sb ^ (((sb >> 9) & 1) << 5); R = (st >> 1) * 16 + swz / 64; C = (st & 1) * 32 + (swz % 64) / 2; }
__host__ __device__ __forceinline__ int perm32(int rho) { const int n = rho >> 4, i = rho & 15; return 8 * (i >> 2) + 4 * n + (i & 3); }

struct Unit { int pm, pn; };
struct Gemm { const bf16_t* A; const bf16_t* Bt; int M, N, K; };

struct StaticOrder {
    int nM, nN, nwg, G, c;
    __host__ __device__ void init(int M, int N, int G_, int c_) { nM = M / BM; nN = N / BM; nwg = nM * nN; G = G_; c = c_; }
    __host__ __device__ bool next(int i, Unit& u) const {
        const long L = (long)i * G + c; if (L >= nwg) return false;
        int wgid = (int)L; { const int q = nwg / NXCD, r = nwg % NXCD, xcd = wgid % NXCD, off = wgid / NXCD; wgid = (xcd < r ? xcd * (q + 1) : r * (q + 1) + (xcd - r) * q) + off; }
        const int nig = WGM * nN, gid = wgid / nig, fm = gid * WGM, gsz = (nM - fm) < WGM ? (nM - fm) : WGM;
        u.pm = fm + ((wgid % nig) % gsz); u.pn = (wgid % nig) / gsz; return true;
    }
    __device__ __forceinline__ void a_ready(const Unit&) const {}
    __device__ __forceinline__ void done(const Unit&) const {}
};

__device__ __forceinline__ unsigned cvt_pk_bf16(float lo, float hi) { unsigned r; asm volatile("v_cvt_pk_bf16_f32 %0, %1, %2" : "=v"(r) : "v"(lo), "v"(hi)); return r; }
typedef float f32x2 __attribute__((ext_vector_type(2)));
struct EpiBf16 {
    static constexpr bool PERM = true, AFTER_DRAIN = false;
    bf16_t* O; int ldc; const float* bias; int split_cols; size_t split_stride;
    __device__ __forceinline__ void operator()(const f32x4 (&acc)[2][2][4][2], const Unit& u, int wr, int wc, int fr, int fq) const {
        const int row0 = u.pm * BM + wr * 64 + fr; int colt = u.pn * BM; bf16_t* base = O;
        if (split_cols) { const int t = colt / split_cols; base += (size_t)t * split_stride; colt -= t * split_cols; }
        const int col0 = colt + wc * 32 + 8 * fq, bcol0 = u.pn * BM + wc * 32 + 8 * fq;
        f32x4 bv[2][2];
#pragma unroll
        for (int bj = 0; bj < 2; ++bj)
#pragma unroll
            for (int n = 0; n < 2; ++n) bv[bj][n] = bias ? *(const f32x4*)(bias + bcol0 + bj * HALF + 4 * n) : (f32x4){0.f, 0.f, 0.f, 0.f};
#pragma unroll
        for (int ai = 0; ai < 2; ++ai)
#pragma unroll
            for (int m = 0; m < 4; ++m) { bf16_t* rowp = base + (size_t)(row0 + ai * HALF + m * 16) * ldc + col0;
#pragma unroll
                for (int bj = 0; bj < 2; ++bj) { const f32x4 v0 = acc[ai][bj][m][0] + bv[bj][0], v1 = acc[ai][bj][m][1] + bv[bj][1];
                    u32x4 w; w.x = cvt_pk_bf16(v0[0], v0[1]); w.y = cvt_pk_bf16(v0[2], v0[3]); w.z = cvt_pk_bf16(v1[0], v1[1]); w.w = cvt_pk_bf16(v1[2], v1[3]);
                    *(u32x4*)(rowp + bj * HALF) = w; } }
    }
};
struct EpiSwiglu {
    static constexpr bool PERM = true, AFTER_DRAIN = false;
    bf16_t* O; const float* bias;
    __device__ __forceinline__ void operator()(const f32x4 (&acc)[2][2][4][2], const Unit& u, int wr, int wc, int fr, int fq) const {
        const int row0 = u.pm * BM + wr * 64 + fr;
        const int hc0 = (u.pn & 7) * BM + wc * 32 + 8 * fq, bcol0 = u.pn * BM + wc * 32 + 8 * fq;
        f32x4 bv[2][2];
#pragma unroll
        for (int bj = 0; bj < 2; ++bj)
#pragma unroll
            for (int n = 0; n < 2; ++n) bv[bj][n] = *(const f32x4*)(bias + bcol0 + bj * HALF + 4 * n);
#pragma unroll
        for (int ai = 0; ai < 2; ++ai)
#pragma unroll
            for (int m = 0; m < 4; ++m) { bf16_t* rowp = O + (size_t)(row0 + ai * HALF + m * 16) * 1024 + (hc0 >> 1);
#pragma unroll
                for (int bj = 0; bj < 2; ++bj) { const f32x4 v0 = acc[ai][bj][m][0] + bv[bj][0], v1 = acc[ai][bj][m][1] + bv[bj][1];
                    float a[4];
#pragma unroll
                    for (int q = 0; q < 4; ++q) { const float gl = fminf(q < 2 ? v0[2 * q] : v1[2 * q - 4], 7.0f); float li = q < 2 ? v0[2 * q + 1] : v1[2 * q - 3]; li = fminf(fmaxf(li, -7.0f), 7.0f);
                        a[q] = gl * __builtin_amdgcn_rcpf(1.0f + __builtin_amdgcn_exp2f(-2.4554669595930156f * gl)) * (li + 1.0f); }
                    typedef unsigned u32x2 __attribute__((ext_vector_type(2)));
                    u32x2 w; w.x = cvt_pk_bf16(a[0], a[1]); w.y = cvt_pk_bf16(a[2], a[3]);
                    *(u32x2*)(rowp + bj * (HALF / 2)) = w; } }
    }
};
struct EpiResid {
    static constexpr bool PERM = false, AFTER_DRAIN = false;
    const float* x; const float* ctx; const bf16_t* H; bf16_t* Hout; const float* mod; int layer;
    __device__ __forceinline__ void operator()(const f32x4 (&acc)[2][2][4][2], const Unit& u, int wr, int wc, int fr, int fq) const {
        typedef unsigned u32x2 __attribute__((ext_vector_type(2)));
        const int b = u.pm / 17, tin = u.pm - b * 17; const float* gate = mod + (size_t)(tin == 0 ? 16 : b) * 6144 + 2048;
        const float* base = tin == 0 ? ctx + (size_t)b * 256 * 1024 : x + ((size_t)b * 4096 + (size_t)(tin - 1) * 256) * 1024;
        const bf16_t* hb = H + (size_t)u.pm * 256 * 1024; bf16_t* outp = Hout + (size_t)u.pm * 256 * 1024;
        const int rl0 = wr * 64 + fr, col0 = u.pn * BM + wc * 32 + 4 * fq;
        f32x4 gv[2][2];
#pragma unroll
        for (int bj = 0; bj < 2; ++bj)
#pragma unroll
            for (int n = 0; n < 2; ++n) gv[bj][n] = *(const f32x4*)(gate + col0 + bj * HALF + n * 16);
#pragma unroll
        for (int ai = 0; ai < 2; ++ai)
#pragma unroll
            for (int m = 0; m < 4; ++m) { const size_t off = (size_t)(rl0 + ai * HALF + m * 16) * 1024 + col0;
#pragma unroll
                for (int bj = 0; bj < 2; ++bj)
#pragma unroll
                    for (int n = 0; n < 2; ++n) { f32x4 bs;
                        if (layer == 0) bs = *(const f32x4*)(base + off + bj * HALF + n * 16);
                        else { const u32x2 hw = *(const u32x2*)(hb + off + bj * HALF + n * 16); bs = (f32x4){__uint_as_float(hw.x << 16), __uint_as_float(hw.x & 0xffff0000u), __uint_as_float(hw.y << 16), __uint_as_float(hw.y & 0xffff0000u)}; }
                        const f32x4 o = bs + gv[bj][n] * acc[ai][bj][m][n]; u32x2 w; w.x = cvt_pk_bf16(o[0], o[1]); w.y = cvt_pk_bf16(o[2], o[3]); *(u32x2*)(outp + off + bj * HALF + n * 16) = w; } }
    }
};
struct MapOrder : StaticOrder {
    int skipctx;
    __device__ __forceinline__ bool next(int i, Unit& u) const { if (!StaticOrder::next(i, u)) return false; if (skipctx) u.pm = (u.pm >> 4) * 17 + 1 + (u.pm & 15); return true; }
};
struct MoeOrder {
    const int* toff; int npn, G, c;
    __device__ __forceinline__ bool next(int i, Unit& u) const {
        const int nt = toff[32], nwg = nt * npn; const long L = (long)i * G + c; if (L >= (long)nwg) return false;
        int wgid = (int)L; { const int q = nwg / NXCD, r = nwg % NXCD, xcd = wgid % NXCD, off = wgid / NXCD; wgid = (xcd < r ? xcd * (q + 1) : r * (q + 1) + (xcd - r) * q) + off; }
#ifndef MOE_WGM
#define MOE_WGM 8
#endif
        const int nig = MOE_WGM * npn, gid = wgid / nig, fm = gid * MOE_WGM, gsz = (nt - fm) < MOE_WGM ? (nt - fm) : MOE_WGM;
        const int pm = fm + ((wgid % nig) % gsz), pnl = (wgid % nig) / gsz; int e = 0;
        for (int q = 1; q < 32; ++q) e += (toff[q] <= pm) ? 1 : 0;
        u.pm = pm; u.pn = e * npn + pnl; return true;
    }
    __device__ __forceinline__ void a_ready(const Unit&) const {}
    __device__ __forceinline__ void done(const Unit&) const {}
};
template <class Epi, class Sched, bool ALIGN_EPI = false, bool SP2 = false>
__device__ __forceinline__ void gemm_phase(PG8_LAS unsigned char* lds, const Gemm g, const Sched& S, const Epi& E, const int tid) {
    const int  wid = __builtin_amdgcn_readfirstlane(tid >> 6), lane = tid & 63, wr = wid >> 2, wc = wid & 3, fr = lane & 15, fq = lane >> 4;
    const int K = g.K, nt = K / BK;
    unsigned voffA[2], voffB[2];
#pragma unroll
    for (int i = 0; i < 2; ++i) { int R, C; stage_rc(tid * 16 + i * 8192, R, C); const int Rb = Epi::PERM ? ((R & ~31) + perm32(R & 31)) : R;
        voffA[i] = (unsigned)(R * K + C) * 2u; voffB[i] = (unsigned)(Rb * K + C) * 2u; }
    const size_t kstep = (size_t)(BK * 2);
    const size_t hstep = (size_t)HALF * K * 2;
    const size_t tstep = 2 * hstep;
    const unsigned ldsw = (unsigned)wid * 1024u;
    const int aoff = lds_byte(wr * 64 + fr, fq * 8), boff = lds_byte(wc * 32 + fr, fq * 8);
#define PG8_SA(b, h) (((b) * 2 + (h)) * HTB)
#define PG8_SB(b, h) ((4 + (b) * 2 + (h)) * HTB)
#define PG8_STAGE(bufoff, gbase, voff) do { _Pragma("unroll") for (int _i = 0; _i < 2; ++_i) \
        __builtin_amdgcn_global_load_lds((const unsigned*)((const char*)(gbase) + (voff)[_i]), (PG8_LAS unsigned*)(lds + (bufoff) + ldsw + _i * 8192), 16, 0, 0); } while (0)
#define PG8_LDA(dst, b, h) do { _Pragma("unroll") for (int m = 0; m < 4; ++m) _Pragma("unroll") for (int k = 0; k < 2; ++k) dst[m][k] = *(const PG8_LAS bf16x8*)(lds + PG8_SA(b, h) + aoff + m * 2048 + k * 1024); } while (0)
#define PG8_LDB(dst, b, h) do { _Pragma("unroll") for (int n = 0; n < 2; ++n) _Pragma("unroll") for (int k = 0; k < 2; ++k) dst[n][k] = *(const PG8_LAS bf16x8*)(lds + PG8_SB(b, h) + boff + n * 2048 + k * 1024); } while (0)
#define PG8_MMA(ai, bj, At, Bt) do { __builtin_amdgcn_s_setprio(1); _Pragma("unroll") for (int m = 0; m < 4; ++m) _Pragma("unroll") for (int n = 0; n < 2; ++n) _Pragma("unroll") for (int k = 0; k < 2; ++k) \
        acc[ai][bj][m][n] = __builtin_amdgcn_mfma_f32_16x16x32_bf16(Bt[n][k], At[m][k], acc[ai][bj][m][n], 0, 0, 0); __builtin_amdgcn_s_setprio(0); } while (0)
#define PG8_WAIT_V(n) asm volatile("s_waitcnt vmcnt(" #n ")" ::: "memory")
#define PG8_WAIT_L(n) asm volatile("s_waitcnt lgkmcnt(" #n ")" ::: "memory")
#define PG8_BAR __builtin_amdgcn_s_barrier()
#define PG8_SCHED __builtin_amdgcn_sched_barrier(0)
    Unit cur, nxt; int ui = 0;
    if (!S.next(0, cur)) return;
    f32x4 acc[2][2][4][2];
#pragma unroll
    for (int a = 0; a < 2; ++a)
#pragma unroll
        for (int b = 0; b < 2; ++b)
#pragma unroll
            for (int m = 0; m < 4; ++m)
#pragma unroll
                for (int n = 0; n < 2; ++n) acc[a][b][m][n] = (f32x4){0.f, 0.f, 0.f, 0.f};
    bf16x8 At[4][2], B0[2][2], B1[2][2];
    const char* cA = (const char*)g.A + (size_t)cur.pm * tstep; const char* cB = (const char*)g.Bt + (size_t)cur.pn * tstep;
    S.a_ready(cur);
    if constexpr (SP2) {
        PG8_STAGE(PG8_SB(0, 0), cB, voffB); PG8_STAGE(PG8_SB(0, 1), cB + hstep, voffB); PG8_STAGE(PG8_SA(0, 0), cA, voffA); PG8_STAGE(PG8_SA(0, 1), cA + hstep, voffA);
        if (wr == 1) PG8_BAR;
        PG8_WAIT_V(2); PG8_BAR;
        PG8_STAGE(PG8_SB(1, 0), cB + kstep, voffB); PG8_STAGE(PG8_SA(1, 0), cA + kstep, voffA); PG8_STAGE(PG8_SB(1, 1), cB + hstep + kstep, voffB);
        PG8_WAIT_V(6); PG8_BAR;
    } else {
        PG8_STAGE(PG8_SB(0, 0), cB, voffB); PG8_STAGE(PG8_SA(0, 0), cA, voffA); PG8_STAGE(PG8_SB(0, 1), cB + hstep, voffB); PG8_STAGE(PG8_SA(0, 1), cA + hstep, voffA);
        if (wr == 1) PG8_BAR;
        PG8_WAIT_V(4); PG8_BAR;
        PG8_STAGE(PG8_SB(1, 0), cB + kstep, voffB); PG8_STAGE(PG8_SA(1, 0), cA + kstep, voffA); PG8_STAGE(PG8_SB(1, 1), cB + hstep + kstep, voffB);
        PG8_WAIT_V(6); PG8_BAR;
    }
    for (;;) {
        const bool has_next = S.next(ui + 1, nxt);
        const char* nA = has_next ? (const char*)g.A + (size_t)nxt.pm * tstep : cA; const char* nB = has_next ? (const char*)g.Bt + (size_t)nxt.pn * tstep : cB;
        for (int t = 0; t < nt; t += 2) {
            const bool last = (t == nt - 2);
            const char* a1 = cA + (size_t)(t + 1) * kstep;
            const char* a2 = last ? nA : cA + (size_t)(t + 2) * kstep; const char* b2 = last ? nB : cB + (size_t)(t + 2) * kstep;
            const char* a3 = a2 + kstep; const char* b3 = b2 + kstep;
            if (last && has_next) S.a_ready(nxt);
            if constexpr (SP2) {
            PG8_LDB(B0, 0, 0); PG8_LDB(B1, 0, 1); PG8_SCHED; PG8_LDA(At, 0, 0); PG8_STAGE(PG8_SA(1, 1), a1 + hstep, voffA);
            PG8_WAIT_V(8); PG8_WAIT_L(0); PG8_BAR; PG8_MMA(0, 0, At, B0); PG8_MMA(0, 1, At, B1); PG8_BAR; PG8_SCHED;
            PG8_LDA(At, 0, 1); PG8_STAGE(PG8_SB(0, 0), b2, voffB); PG8_STAGE(PG8_SB(0, 1), b2 + hstep, voffB); PG8_STAGE(PG8_SA(0, 0), a2, voffA);
            PG8_WAIT_V(8); PG8_WAIT_L(0); PG8_BAR; PG8_MMA(1, 0, At, B0); PG8_MMA(1, 1, At, B1); PG8_BAR; PG8_SCHED;
            PG8_LDB(B0, 1, 0); PG8_LDB(B1, 1, 1); PG8_SCHED; PG8_LDA(At, 1, 0); PG8_STAGE(PG8_SA(0, 1), a2 + hstep, voffA);
            PG8_WAIT_V(8); PG8_WAIT_L(0); PG8_BAR; PG8_MMA(0, 0, At, B0); PG8_MMA(0, 1, At, B1); PG8_BAR; PG8_SCHED;
            PG8_LDA(At, 1, 1); PG8_STAGE(PG8_SB(1, 0), b3, voffB); PG8_STAGE(PG8_SB(1, 1), b3 + hstep, voffB); PG8_STAGE(PG8_SA(1, 0), a3, voffA);
            PG8_WAIT_V(8); PG8_WAIT_L(0); PG8_BAR; PG8_MMA(1, 0, At, B0); PG8_MMA(1, 1, At, B1); PG8_BAR; PG8_SCHED;
            } else {
            PG8_LDB(B0, 0, 0); PG8_SCHED; PG8_LDA(At, 0, 0); PG8_STAGE(PG8_SA(1, 1), a1 + hstep, voffA);
            PG8_WAIT_L(8); PG8_BAR; PG8_WAIT_L(0); PG8_MMA(0, 0, At, B0); PG8_BAR; PG8_SCHED;
            PG8_LDB(B1, 0, 1); PG8_STAGE(PG8_SB(0, 0), b2, voffB);
            PG8_BAR; PG8_WAIT_L(0); PG8_MMA(0, 1, At, B1); PG8_BAR;
            PG8_LDA(At, 0, 1); PG8_STAGE(PG8_SA(0, 0), a2, voffA);
            PG8_BAR; PG8_WAIT_L(0); PG8_MMA(1, 0, At, B0); PG8_BAR; PG8_SCHED;
            PG8_STAGE(PG8_SB(0, 1), b2 + hstep, voffB);
            PG8_WAIT_V(6); PG8_BAR; PG8_MMA(1, 1, At, B1); PG8_BAR;
            PG8_LDB(B0, 1, 0); PG8_SCHED; PG8_LDA(At, 1, 0); PG8_STAGE(PG8_SA(0, 1), a2 + hstep, voffA);
            PG8_WAIT_L(8); PG8_BAR; PG8_WAIT_L(0); PG8_MMA(0, 0, At, B0); PG8_BAR; PG8_SCHED;
            PG8_LDB(B1, 1, 1); PG8_STAGE(PG8_SB(1, 0), b3, voffB);
            PG8_BAR; PG8_WAIT_L(0); PG8_MMA(0, 1, At, B1); PG8_BAR;
            PG8_LDA(At, 1, 1); PG8_STAGE(PG8_SA(1, 0), a3, voffA);
            PG8_BAR; PG8_WAIT_L(0); PG8_MMA(1, 0, At, B0); PG8_BAR; PG8_SCHED;
            PG8_STAGE(PG8_SB(1, 1), b3 + hstep, voffB);
            PG8_WAIT_V(6); PG8_BAR; PG8_MMA(1, 1, At, B1); PG8_BAR;
            }
        }
        if constexpr (ALIGN_EPI) { if (wr == 0) PG8_BAR; }
        if constexpr (!Epi::AFTER_DRAIN) { E(acc, cur, wr, wc, fr, fq); S.done(cur); }
        if (!has_next) break;
#pragma unroll
        for (int a = 0; a < 2; ++a)
#pragma unroll
            for (int b = 0; b < 2; ++b)
#pragma unroll
                for (int m = 0; m < 4; ++m)
#pragma unroll
                    for (int n = 0; n < 2; ++n) acc[a][b][m][n] = (f32x4){0.f, 0.f, 0.f, 0.f};
        cur = nxt; cA = nA; cB = nB; ++ui;
        if constexpr (ALIGN_EPI) { if (wr == 1) PG8_BAR; }
    }
    PG8_WAIT_V(0);
    if constexpr (!ALIGN_EPI) { if (wr == 0) PG8_BAR; }
    PG8_BAR;
    if constexpr (Epi::AFTER_DRAIN) { E.fused(acc, cur, wr, wc, fr, fq, lds, wid, lane); S.done(cur); }
#undef PG8_SA
#undef PG8_SB
#undef PG8_STAGE
#undef PG8_LDA
#undef PG8_LDB
#undef PG8_MMA
#undef PG8_WAIT_V
#undef PG8_WAIT_L
#undef PG8_BAR
#undef PG8_SCHED
}
template <class Epi, class Sched>
__device__ __forceinline__ void gemm_phase_gather(PG8_LAS unsigned char* lds, const Gemm g, const Sched& S, const Epi& E, const int tid, const int* tok) {
    const int wid = __builtin_amdgcn_readfirstlane(tid >> 6), lane = tid & 63, wr = wid >> 2, wc = wid & 3, fr = lane & 15, fq = lane >> 4;
    const int K = g.K, nt = K / BK;
    unsigned voffB[2];
#pragma unroll
    for (int i = 0; i < 2; ++i) { int R, C; stage_rc(tid * 16 + i * 8192, R, C); const int Rb = Epi::PERM ? ((R & ~31) + perm32(R & 31)) : R; voffB[i] = (unsigned)(Rb * K + C) * 2u; }
#define PG8_RA(i) ({ int R_, C_; stage_rc(tid * 16 + (i) * 8192, R_, C_); R_; })
#define PG8_CA2(i) ({ int R_, C_; stage_rc(tid * 16 + (i) * 8192, R_, C_); (unsigned)C_ * 2u; })
    const size_t kstep = (size_t)(BK * 2);
    const size_t hstep = (size_t)HALF * K * 2;
    const size_t tstep = 2 * hstep;
    const unsigned ldsw = (unsigned)wid * 1024u;
    const int aoff = lds_byte(wr * 64 + fr, fq * 8), boff = lds_byte(wc * 32 + fr, fq * 8);
#define PG8_SA(b, h) (((b) * 2 + (h)) * HTB)
#define PG8_SB(b, h) ((4 + (b) * 2 + (h)) * HTB)
#define PG8_STAGE(bufoff, gbase, voff) do { _Pragma("unroll") for (int _i = 0; _i < 2; ++_i) \
        __builtin_amdgcn_global_load_lds((const unsigned*)((const char*)(gbase) + (voff)[_i]), (PG8_LAS unsigned*)(lds + (bufoff) + ldsw + _i * 8192), 16, 0, 0); } while (0)
#define PG8_STAGE_A(bufoff, kptr, hf, nx) do { _Pragma("unroll") for (int _i = 0; _i < 2; ++_i) { const unsigned _o = (nx) ? (unsigned)idN[(hf) * 2 + _i] : gC[hf][_i]; \
        __builtin_amdgcn_global_load_lds((const unsigned*)((const char*)(kptr) + _o), (PG8_LAS unsigned*)(lds + (bufoff) + ldsw + _i * 8192), 16, 0, 0); } } while (0)
#define PG8_LDA(dst, b, h) do { _Pragma("unroll") for (int m = 0; m < 4; ++m) _Pragma("unroll") for (int k = 0; k < 2; ++k) dst[m][k] = *(const PG8_LAS bf16x8*)(lds + PG8_SA(b, h) + aoff + m * 2048 + k * 1024); } while (0)
#define PG8_LDB(dst, b, h) do { _Pragma("unroll") for (int n = 0; n < 2; ++n) _Pragma("unroll") for (int k = 0; k < 2; ++k) dst[n][k] = *(const PG8_LAS bf16x8*)(lds + PG8_SB(b, h) + boff + n * 2048 + k * 1024); } while (0)
#define PG8_MMA(ai, bj, At, Bt) do { __builtin_amdgcn_s_setprio(1); _Pragma("unroll") for (int m = 0; m < 4; ++m) _Pragma("unroll") for (int n = 0; n < 2; ++n) _Pragma("unroll") for (int k = 0; k < 2; ++k) \
        acc[ai][bj][m][n] = __builtin_amdgcn_mfma_f32_16x16x32_bf16(Bt[n][k], At[m][k], acc[ai][bj][m][n], 0, 0, 0); __builtin_amdgcn_s_setprio(0); } while (0)
#define PG8_WAIT_V(n) asm volatile("s_waitcnt vmcnt(" #n ")" ::: "memory")
#define PG8_WAIT_L(n) asm volatile("s_waitcnt lgkmcnt(" #n ")" ::: "memory")
#define PG8_BAR __builtin_amdgcn_s_barrier()
#define PG8_SCHED __builtin_amdgcn_sched_barrier(0)
    Unit cur, nxt; int ui = 0;
    if (!S.next(0, cur)) return;
    f32x4 acc[2][2][4][2];
#pragma unroll
    for (int a = 0; a < 2; ++a)
#pragma unroll
        for (int b = 0; b < 2; ++b)
#pragma unroll
            for (int m = 0; m < 4; ++m)
#pragma unroll
                for (int n = 0; n < 2; ++n) acc[a][b][m][n] = (f32x4){0.f, 0.f, 0.f, 0.f};
    bf16x8 At[4][2], B0[2][2], B1[2][2];
    unsigned gC[2][2]; int idN[4];
#pragma unroll
    for (int hf = 0; hf < 2; ++hf)
#pragma unroll
        for (int i = 0; i < 2; ++i) { gC[hf][i] = (unsigned)tok[cur.pm * BM + hf * HALF + PG8_RA(i)] * (unsigned)(K * 2) + PG8_CA2(i); idN[hf * 2 + i] = (int)gC[hf][i]; }
    const char* cA = (const char*)g.A; const char* cB = (const char*)g.Bt + (size_t)cur.pn * tstep;
    PG8_STAGE(PG8_SB(0, 0), cB, voffB); PG8_STAGE(PG8_SB(0, 1), cB + hstep, voffB); PG8_STAGE_A(PG8_SA(0, 0), cA, 0, false); PG8_STAGE_A(PG8_SA(0, 1), cA, 1, false);
    if (wr == 1) PG8_BAR;
    PG8_WAIT_V(2); PG8_BAR;
    PG8_STAGE(PG8_SB(1, 0), cB + kstep, voffB); PG8_STAGE_A(PG8_SA(1, 0), cA + kstep, 0, false); PG8_STAGE(PG8_SB(1, 1), cB + hstep + kstep, voffB);
    PG8_WAIT_V(6); PG8_BAR;
    for (;;) {
        const bool has_next = S.next(ui + 1, nxt);
        const char* nB = has_next ? (const char*)g.Bt + (size_t)nxt.pn * tstep : cB;
        if (has_next) {
            const int* p0 = tok + nxt.pm * BM + PG8_RA(0); const int* p1 = tok + nxt.pm * BM + PG8_RA(1); const int* p2 = p0 + HALF; const int* p3 = p1 + HALF;
            asm volatile("global_load_dword %0, %4, off\n\tglobal_load_dword %1, %5, off\n\tglobal_load_dword %2, %6, off\n\tglobal_load_dword %3, %7, off\n\ts_waitcnt vmcnt(0)"
                         : "=&v"(idN[0]), "=&v"(idN[1]), "=&v"(idN[2]), "=&v"(idN[3]) : "v"(p0), "v"(p1), "v"(p2), "v"(p3) : "memory");
        }
        for (int t = 0; t < nt; t += 2) {
            const bool last = (t == nt - 2); const bool nx = last && has_next;
            if (nx) {
#pragma unroll
                for (int j = 0; j < 4; ++j) idN[j] = (int)((unsigned)idN[j] * (unsigned)(K * 2) + PG8_CA2(j & 1));
            }
            const char* a1 = cA + (size_t)(t + 1) * kstep;
            const char* a2 = last ? cA : cA + (size_t)(t + 2) * kstep; const char* b2 = last ? nB : cB + (size_t)(t + 2) * kstep;
            const char* a3 = a2 + kstep; const char* b3 = b2 + kstep;
            PG8_LDB(B0, 0, 0); PG8_LDB(B1, 0, 1); PG8_SCHED; PG8_LDA(At, 0, 0); PG8_STAGE_A(PG8_SA(1, 1), a1, 1, false);
            PG8_WAIT_V(8); PG8_WAIT_L(0); PG8_BAR; PG8_MMA(0, 0, At, B0); PG8_MMA(0, 1, At, B1); PG8_BAR; PG8_SCHED;
            PG8_LDA(At, 0, 1); PG8_STAGE(PG8_SB(0, 0), b2, voffB); PG8_STAGE(PG8_SB(0, 1), b2 + hstep, voffB); PG8_STAGE_A(PG8_SA(0, 0), a2, 0, nx);
            PG8_WAIT_V(8); PG8_WAIT_L(0); PG8_BAR; PG8_MMA(1, 0, At, B0); PG8_MMA(1, 1, At, B1); PG8_BAR; PG8_SCHED;
            PG8_LDB(B0, 1, 0); PG8_LDB(B1, 1, 1); PG8_SCHED; PG8_LDA(At, 1, 0); PG8_STAGE_A(PG8_SA(0, 1), a2, 1, nx);
            PG8_WAIT_V(8); PG8_WAIT_L(0); PG8_BAR; PG8_MMA(0, 0, At, B0); PG8_MMA(0, 1, At, B1); PG8_BAR; PG8_SCHED;
            PG8_LDA(At, 1, 1); PG8_STAGE(PG8_SB(1, 0), b3, voffB); PG8_STAGE(PG8_SB(1, 1), b3 + hstep, voffB); PG8_STAGE_A(PG8_SA(1, 0), a3, 0, nx);
            PG8_WAIT_V(8); PG8_WAIT_L(0); PG8_BAR; PG8_MMA(1, 0, At, B0); PG8_MMA(1, 1, At, B1); PG8_BAR; PG8_SCHED;
        }
        if (wr == 0) PG8_BAR;
        E(acc, cur, wr, wc, fr, fq);
        if (!has_next) break;
#pragma unroll
        for (int a = 0; a < 2; ++a)
#pragma unroll
            for (int b = 0; b < 2; ++b)
#pragma unroll
                for (int m = 0; m < 4; ++m)
#pragma unroll
                    for (int n = 0; n < 2; ++n) acc[a][b][m][n] = (f32x4){0.f, 0.f, 0.f, 0.f};
        cur = nxt; cB = nB; ++ui;
#pragma unroll
        for (int hf = 0; hf < 2; ++hf)
#pragma unroll
            for (int i = 0; i < 2; ++i) gC[hf][i] = (unsigned)idN[hf * 2 + i];
        if (wr == 1) PG8_BAR;
    }
    PG8_WAIT_V(0);
    PG8_BAR;
#undef PG8_SA
#undef PG8_SB
#undef PG8_STAGE
#undef PG8_STAGE_A
#undef PG8_RA
#undef PG8_CA2
#undef PG8_LDA
#undef PG8_LDB
#undef PG8_MMA
#undef PG8_WAIT_V
#undef PG8_WAIT_L
#undef PG8_BAR
#undef PG8_SCHED
}
}
constexpr int DM = 1024, NBATCH = 16, SEQL = 4096, CTXL = 256, SB = CTXL + SEQL  , TT = NBATCH * SB  , NRT = TT / 256  ;
constexpr int INW = 2704, INWP = 2816;
constexpr int C_Z = 0, C_XBC = 512, C_DT = 1280, C_GQ = 1296, C_GK = 1552, C_GV = 1808, C_GR = 2064, C_GLR = 2320, C_CQ = 2352, C_CKV = 2544, C_KPE = 2672;
constexpr float EPS = 1e-6f;
constexpr int NWAVES = 8, NTHREADS = 512;
enum { I_X = 0, I_C, I_CTX, I_CCTX, I_WMOD, I_BMOD, I_NORM1, I_WIN, I_CONVW, I_CONVB, I_ALOG, I_DTB, I_SSDD, I_SSDNW, I_GUPW, I_GUPB, I_GLANW, I_QNW, I_WUQ, I_KVNW, I_WUKV, I_WOUT, I_NORM2,
       I_RW, I_RB, I_W1, I_B1, I_W2, I_B2, I_FINW, N_IN };
constexpr size_t MiB = 1u << 20;
constexpr size_t WS_CTL = 0, CTL_ZERO_BYTES = 1 * MiB;
constexpr size_t WS_MOD = 1 * MiB;
constexpr size_t WS_ROPE = 1 * MiB + 960 * 1024;
constexpr size_t WS_META = 1 * MiB + 980 * 1024;
constexpr size_t WS_WUQT = 2 * MiB;
constexpr size_t WS_WUKVT = 2 * MiB + 512 * 1024;
constexpr size_t WS_WOUTT = 4 * MiB;
constexpr size_t WS_WINT = 8 * MiB;
constexpr size_t WS_W1T = 20 * MiB;
constexpr size_t WS_W2T = 148 * MiB;
constexpr size_t WS_H = 212 * MiB;
constexpr size_t WS_ACT1 = 484 * MiB;
constexpr size_t WS_ARENA = 620 * MiB;
constexpr size_t WS_COLS = WS_ARENA;
constexpr size_t WS_XBC = WS_ARENA + 374 * MiB;
constexpr size_t WS_DT = WS_ARENA + 476 * MiB;
constexpr size_t WS_G = WS_ARENA + 481 * MiB;
constexpr size_t WS_AQ = WS_ARENA + 617 * MiB;
constexpr size_t WS_AKV = WS_ARENA + 651 * MiB;
constexpr size_t WS_QRAW = WS_ARENA + 685 * MiB;
constexpr size_t WS_KV = WS_ARENA + 753 * MiB;
constexpr size_t WS_KVT = WS_ARENA + 821 * MiB;
constexpr size_t WS_QF = WS_ARENA + 889 * MiB;
constexpr size_t WS_KF = WS_ARENA + 940 * MiB;
constexpr size_t WS_YF = WS_ARENA + 991 * MiB;
constexpr size_t WS_YB = WS_ARENA + 1059 * MiB;
constexpr size_t WS_OF = WS_ARENA + 1127 * MiB;
constexpr size_t WS_OB = WS_ARENA + 1161 * MiB;
constexpr size_t WS_MODP = WS_ARENA;
constexpr int MAXSLOT = 1120 * 256;
constexpr size_t WS_XG = WS_ARENA;
constexpr size_t WS_ACTB = WS_ARENA + 560 * MiB;
constexpr size_t WS_TOKE = WS_ARENA + 1120 * MiB;
constexpr size_t WS_TOKP = WS_ARENA + 1122 * MiB;
constexpr size_t WS_TOKW = WS_ARENA + 1124 * MiB;
constexpr size_t WS_WGCNT = WS_ARENA + 1126 * MiB;
constexpr size_t WS_TOKS = WS_ARENA + 1128 * MiB;
constexpr size_t WS_STOK = WS_ARENA + 1130 * MiB;
constexpr size_t WS_END = WS_ARENA + 1428 * MiB;
constexpr int CW_BAR = 4096;
constexpr int CW_AQ = 8192;
constexpr int CW_ASM = 8192 + 1024;
constexpr int CW_CONV = 8192 + 2048;
constexpr int RING_BYTES = 131072, LDSCTL_OFF = RING_BYTES, LDS_BYTES = 147456;
constexpr int MISC_BAR = 8;
constexpr int MISC_Q = 16;
constexpr int MISC_CNT = 32;
constexpr int MISC_SB = 64;

#define GAS __attribute__((address_space(1)))
#define LAS __attribute__((address_space(3)))
typedef unsigned short bf16;
typedef unsigned v4u __attribute__((ext_vector_type(4)));
typedef unsigned v2u __attribute__((ext_vector_type(2)));
typedef float f32x4 __attribute__((ext_vector_type(4)));
typedef short bf16x8 __attribute__((ext_vector_type(8)));
#define LDS_WAIT() asm volatile("s_waitcnt lgkmcnt(0)" ::: "memory")

__device__ __forceinline__ float bf2f(unsigned v) { return __uint_as_float(v << 16); }
__device__ __forceinline__ float bflo(unsigned w) { return __uint_as_float(w << 16); }
__device__ __forceinline__ float bfhi(unsigned w) { return __uint_as_float(w & 0xffff0000u); }
__device__ __forceinline__ unsigned f2bf(float f) { unsigned u = __float_as_uint(f); return (u + 0x7fffu + ((u >> 16) & 1u)) >> 16; }
typedef float f32x2_t __attribute__((ext_vector_type(2))); typedef __bf16 bf16x2_t __attribute__((ext_vector_type(2)));
__device__ __forceinline__ unsigned pk2(float lo, float hi) { const f32x2_t v = {lo, hi}; const bf16x2_t b = __builtin_convertvector(v, bf16x2_t); return __builtin_bit_cast(unsigned, b); }
__device__ __forceinline__ float wave_sum(float v) {
#pragma unroll
    for (int o = 1; o < 64; o <<= 1) v += __shfl_xor(v, o);
    return v;
}
__device__ __forceinline__ float wave_max(float v) {
#pragma unroll
    for (int o = 1; o < 64; o <<= 1) v = fmaxf(v, __shfl_xor(v, o));
    return v;
}
__device__ __forceinline__ float siluf(float x) { return x / (1.0f + expf(-x)); }
__device__ __forceinline__ float fsilu(float x) { return x * __builtin_amdgcn_rcpf(1.0f + __expf(-x)); }
__device__ __forceinline__ float fsoftplus(float x) { const float e = __expf(-fabsf(x)); const float l1p = e < 0.03125f ? e * (1.0f - e * (0.5f - e * (0.33333334f - 0.25f * e))) : __logf(1.0f + e); return fmaxf(x, 0.f) + l1p; }
__device__ __forceinline__ float softplusf(float x) { return fmaxf(x, 0.f) + log1pf(expf(-fabsf(x))); }

struct Args { const float* in[N_IN]; float* out; unsigned char* ws; int ph_lo, ph_hi; };
constexpr int PTR_OFF = LDSCTL_OFF + 1024;

__device__ __forceinline__ void transpose_item(const float* W, int K, int N, bf16* WT, int Kp, int nblk, int item, LAS float* scr, int lane) {
    const int kb = item / nblk, nb = item - kb * nblk, k0 = 64 * kb, n0 = 32 * nb;
    const int n = n0 + (lane & 31);
#pragma unroll 8
    for (int i = 0; i < 32; ++i) { const int kk = 2 * i + (lane >> 5), k = k0 + kk; scr[kk * 33 + (lane & 31)] = (k < K && n < N) ? W[(size_t)k * N + n] : 0.f; }
    LDS_WAIT(); asm volatile("" ::: "memory");
    const int c = lane & 7;
#pragma unroll
    for (int j = 0; j < 4; ++j) { const int nn = (lane >> 3) + 8 * j; const LAS float* s = scr + (8 * c) * 33 + nn;
        v4u o; o.x = pk2(s[0 * 33], s[1 * 33]); o.y = pk2(s[2 * 33], s[3 * 33]); o.z = pk2(s[4 * 33], s[5 * 33]); o.w = pk2(s[6 * 33], s[7 * 33]);
        *(v4u*)(WT + (size_t)(n0 + nn) * Kp + k0 + 8 * c) = o; }
    LDS_WAIT(); asm volatile("" ::: "memory");
}
__device__ __forceinline__ void norm_mod_row(const float* hrow, const float* nw, const float* shift, const float* scale, bf16* orow, int lane) {
    const f32x4* xr = (const f32x4*)hrow + lane; f32x4 v[4]; float ss = 0.f;
#pragma unroll
    for (int q = 0; q < 4; ++q) { v[q] = xr[64 * q]; ss += (v[q].x * v[q].x + v[q].y * v[q].y) + (v[q].z * v[q].z + v[q].w * v[q].w); }
    const float rstd = rsqrtf(wave_sum(ss) * (1.0f / 1024.0f) + EPS);
#pragma unroll
    for (int q = 0; q < 4; ++q) { const int j4 = lane + 64 * q; const f32x4 w = ((const f32x4*)nw)[j4], sh = ((const f32x4*)shift)[j4], sc = ((const f32x4*)scale)[j4];
        const f32x4 o = (v[q] * rstd * w) * (sc + 1.0f) + sh; v2u p; p.x = pk2(o.x, o.y); p.y = pk2(o.z, o.w); ((v2u*)orow)[j4] = p; }
}
__device__ __forceinline__ const float* h0_row(const float* x, const float* ctx, int m) { const int b = m / SB, s = m - b * SB; return s < CTXL ? ctx + ((size_t)b * CTXL + s) * DM : x + ((size_t)b * SEQL + (s - CTXL)) * DM; }
#define XB_TMO      128
#define XB_XCNT(j)  (256  + 64 * (j))
#define XB_XSUB(j)  (1280 + 64 * (j))
#define XB_XGEN(j)  (2304 + 64 * (j))
#define XB_TOP      3328
#define XB_TOPGEN   3392
#define XCD_BAR_WORDS 3456
#define XB_SPIN_CAP (1u << 22)

__device__ __forceinline__ unsigned xb_ld(unsigned* p)              { return __hip_atomic_load(p, __ATOMIC_RELAXED, __HIP_MEMORY_SCOPE_AGENT); }
__device__ __forceinline__ unsigned xb_add(unsigned* p, unsigned v) { return __hip_atomic_fetch_add(p, v, __ATOMIC_RELAXED, __HIP_MEMORY_SCOPE_AGENT); }
__device__ __forceinline__ unsigned xb_xcc_id() { return (unsigned)__builtin_amdgcn_s_getreg((3 << 11) | 20) & 0xFu; }
#define XB_SPIN(cond, bar) do { unsigned _sp = 0; while (cond) { __builtin_amdgcn_s_sleep(1); \
    if ((++_sp & 255u) == 0u) { if (xb_ld(&(bar)[XB_TMO])) break; if (_sp > XB_SPIN_CAP) { atomicAdd(&(bar)[XB_TMO], 1u); break; } } } } while (0)

struct XcdBarrier {
    unsigned* bar; unsigned x;
    volatile LAS unsigned* st;
};

__device__ __forceinline__ XcdBarrier xcd_barrier_post(unsigned* bar, volatile LAS unsigned* st) {
    XcdBarrier b; b.bar = bar; b.x = xb_xcc_id(); b.st = st;
    if (threadIdx.x == 0) (void)xb_add(&bar[XB_XCNT(b.x)], 1u);
    return b;
}
__device__ __forceinline__ void xcd_barrier_complete(unsigned* bar, unsigned x, unsigned& nloc, unsigned& nx) {
    const unsigned G = gridDim.x * gridDim.y * gridDim.z;
    unsigned sum, cnt, mine, sp = 0u;
    for (;;) {
        sum = 0u; cnt = 0u; mine = 0u;
#pragma unroll
        for (unsigned j = 0; j < 16; ++j) { const unsigned c = xb_ld(&bar[XB_XCNT(j)]); sum += c; cnt += (c > 0u) ? 1u : 0u; mine = (j == x) ? c : mine; }
        if (sum == G) break;
        __builtin_amdgcn_s_sleep(1);
        if ((++sp & 255u) == 0u) { if (xb_ld(&bar[XB_TMO])) break; if (sp > XB_SPIN_CAP) { atomicAdd(&bar[XB_TMO], 1u); break; } }
    }
    nloc = mine > 0u ? mine : 1u; nx = cnt > 0u ? cnt : 1u;
}

__device__ __forceinline__ void xcd_barrier(const XcdBarrier& b) {
    asm volatile("s_waitcnt vmcnt(0)" ::: "memory");
    __syncthreads();
    if (threadIdx.x == 0) {
        unsigned* bar = b.bar;
        __builtin_amdgcn_s_waitcnt(0);
        unsigned nloc = b.st[0], nx = b.st[1];
        if (nloc == 0u) { xcd_barrier_complete(bar, b.x, nloc, nx); b.st[0] = nloc; b.st[1] = nx; }
        const unsigned old = xb_add(&bar[XB_XSUB(b.x)], 1u);
        const unsigned gen = old / nloc;
        if (old + 1u == (gen + 1u) * nloc) {
            __builtin_amdgcn_fence(__ATOMIC_RELEASE, "agent");
            asm volatile("s_waitcnt vmcnt(0)" ::: "memory");
            const unsigned og = xb_add(&bar[XB_TOP], 1u);
            const unsigned tg = og / nx;
            if (og + 1u == (tg + 1u) * nx) xb_add(&bar[XB_TOPGEN], 1u);
            else XB_SPIN(xb_ld(&bar[XB_TOPGEN]) == tg, bar);
            __builtin_amdgcn_fence(__ATOMIC_ACQUIRE, "agent");
            xb_add(&bar[XB_XGEN(b.x)], 1u);
            asm volatile("s_waitcnt vmcnt(0)" ::: "memory");
        } else {
            XB_SPIN(xb_ld(&bar[XB_XGEN(b.x)]) == gen, bar);
            __builtin_amdgcn_fence(__ATOMIC_ACQUIRE, "agent");
            asm volatile("s_waitcnt vmcnt(0)" ::: "memory");
        }
    }
    __syncthreads();
}
struct Ctx { LAS unsigned char* lds; volatile LAS unsigned* MISC; GAS unsigned char* ws; int tid, lane, wave, G, bid; };
__device__ __forceinline__ const float* in_ptr(const Ctx& C, int i) {
    const volatile LAS unsigned* P = (const volatile LAS unsigned*)(C.lds + PTR_OFF) + 2 * i;
    const unsigned lo = __builtin_amdgcn_readfirstlane(P[0]), hi = __builtin_amdgcn_readfirstlane(P[1]);
    return (const float*)(const GAS float*)(((unsigned long long)hi << 32) | lo);
}
#define IN_(i) in_ptr(C, (i))

__device__ __forceinline__ void ph_g0(const Args& A, const Ctx& C) { const float* const p_I_C = IN_(I_C); const float* const p_I_CCTX = IN_(I_CCTX); const float* const p_I_WIN = IN_(I_WIN); const float* const p_I_WMOD = IN_(I_WMOD); const float* const p_I_WOUT = IN_(I_WOUT); const float* const p_I_WUKV = IN_(I_WUKV); const float* const p_I_WUQ = IN_(I_WUQ);
    if (C.bid < 192) {
        const int l = C.bid / 96, rem = C.bid % 96, cb = rem >> 3, s = rem & 7, i0 = s * 128;
        LAS float* sc = (LAS float*)C.lds;
        for (int idx = C.tid; idx < 17 * 128; idx += NTHREADS) { const int r = idx >> 7, i = idx & 127; const float cv = r < 16 ? p_I_C[r * 1024 + i0 + i] : p_I_CCTX[i0 + i]; sc[idx] = siluf(cv); }
        __syncthreads();
        const int j = cb * 512 + C.tid; float acc[17];
#pragma unroll
        for (int r = 0; r < 17; ++r) acc[r] = 0.f;
        const float* wm = p_I_WMOD + ((size_t)l * 1024 + i0) * 6144 + j;
        for (int i = 0; i < 128; ++i) { const float w = wm[(size_t)i * 6144];
#pragma unroll
            for (int r = 0; r < 17; ++r) acc[r] += sc[r * 128 + i] * w; }
        float* mp = (float*)(C.ws + WS_MODP) + ((size_t)(s * 2 + l) * 17) * 6144 + j;
#pragma unroll
        for (int r = 0; r < 17; ++r) mp[(size_t)r * 6144] = acc[r];
        __syncthreads();
    }
    if (C.bid == C.G - 1) {
        const int pos = C.tid >> 3, i = C.tid & 7;
        double f = 1.0; if (i >= 2) f *= 0.1; if (i >= 4) f *= 0.1; if (i >= 6) f *= 0.1; if (i & 1) f *= 0.31622776601683794;
        const double ang = (double)pos * f;
        const double n = __builtin_rint(ang * 0.63661977236758134);
        double r = __builtin_fma(-n, 1.5707963267948966, ang); r = __builtin_fma(-n, 6.123233995736766e-17, r);
        const double r2 = r * r;
        double sn = 1.0 / 355687428096000.0;
        sn = sn * r2 - 1.0 / 1307674368000.0; sn = sn * r2 + 1.0 / 6227020800.0; sn = sn * r2 - 1.0 / 39916800.0; sn = sn * r2 + 1.0 / 362880.0; sn = sn * r2 - 1.0 / 5040.0; sn = sn * r2 + 1.0 / 120.0; sn = sn * r2 - 1.0 / 6.0; sn = sn * r2 + 1.0; sn *= r;
        double cs = 1.0 / 20922789888000.0;
        cs = cs * r2 - 1.0 / 87178291200.0; cs = cs * r2 + 1.0 / 479001600.0; cs = cs * r2 - 1.0 / 3628800.0; cs = cs * r2 + 1.0 / 40320.0; cs = cs * r2 - 1.0 / 720.0; cs = cs * r2 + 1.0 / 24.0; cs = cs * r2 - 0.5; cs = cs * r2 + 1.0;
        const int q = ((int)n) & 3;
        const double c_ = q == 0 ? cs : q == 1 ? -sn : q == 2 ? -cs : sn;
        const double s_ = q == 0 ? sn : q == 1 ? cs : q == 2 ? -sn : -cs;
        float* rt = (float*)(C.ws + WS_ROPE); rt[C.tid * 2] = (float)c_; rt[C.tid * 2 + 1] = (float)s_;
    }
    LAS float* scr = (LAS float*)(C.lds + C.wave * 16384);
    const int gw = C.bid * NWAVES + C.wave, NGW = C.G * NWAVES;
    for (int it = gw; it < 4096; it += NGW) {
        const int l = it >> 11; int r = it & 2047;
        if (r < 1408) { transpose_item(p_I_WIN + (size_t)l * 1024 * INW, 1024, INW, (bf16*)(C.ws + WS_WINT) + (size_t)l * INWP * 1024, 1024, 88, r, scr, C.lane); continue; } r -= 1408;
        if (r < 512) { transpose_item(p_I_WOUT + (size_t)l * 1024 * 1024, 1024, 1024, (bf16*)(C.ws + WS_WOUTT) + (size_t)l * 1024 * 1024, 1024, 32, r, scr, C.lane); continue; } r -= 512;
        if (r < 64) { transpose_item(p_I_WUQ + (size_t)l * 192 * 384, 192, 384, (bf16*)(C.ws + WS_WUQT) + (size_t)l * 512 * 256, 256, 16, r, scr, C.lane); continue; } r -= 64;
        transpose_item(p_I_WUKV + (size_t)l * 128 * 512, 128, 512, (bf16*)(C.ws + WS_WUKVT) + (size_t)l * 512 * 256, 256, 16, r, scr, C.lane);
    }
}
__device__ __forceinline__ void convert_experts(const Args& A, const Ctx& C, int l, int max_items) { const float* const p_I_W1 = IN_(I_W1); const float* const p_I_W2 = IN_(I_W2);
    LAS unsigned* T = (LAS unsigned*)C.lds;
    unsigned* head = (unsigned*)C.ws + CW_CONV + 64 * l;
    const int tid = C.tid, n4 = (tid & 63) * 4, kq = tid >> 6;
    __syncthreads();
    if (tid == 0) C.MISC[MISC_Q] = __hip_atomic_fetch_add(head, 1u, __ATOMIC_RELAXED, __HIP_MEMORY_SCOPE_AGENT);
    __syncthreads();
    int it = (int)C.MISC[MISC_Q];
    for (int n = 0; n < max_items && it < 4096 + 2048; ++n) {
        const float* W; bf16* WT; int N, kb, nb;
        if (it < 4096) { const int e = it >> 7, r = it & 127; kb = r >> 3; nb = r & 7; N = 2048; W = p_I_W1 + ((size_t)l * 32 + e) * 1024 * 2048; WT = (bf16*)(C.ws + WS_W1T) + (size_t)e * 2048 * 1024; }
        else { const int i2 = it - 4096, e = i2 >> 6, r = i2 & 63; kb = r >> 2; nb = r & 3; N = 1024; W = p_I_W2 + ((size_t)l * 32 + e) * 1024 * 1024; WT = (bf16*)(C.ws + WS_W2T) + (size_t)e * 1024 * 1024; }
        const float* src = W + (size_t)(kb * 64) * N + nb * 256 + n4;
        f32x4 a[4], b[4];
#pragma unroll
        for (int i = 0; i < 4; ++i) { const int kp = kq + 8 * i; a[i] = *(const f32x4*)(src + (size_t)(2 * kp) * N); b[i] = *(const f32x4*)(src + (size_t)(2 * kp + 1) * N); }
        if (tid == 0) C.MISC[MISC_Q + ((n + 1) & 1)] = n + 1 < max_items ? __hip_atomic_fetch_add(head, 1u, __ATOMIC_RELAXED, __HIP_MEMORY_SCOPE_AGENT) : 0x7fffffffu;
        __syncthreads();
#pragma unroll
        for (int i = 0; i < 4; ++i) { const int kp = kq + 8 * i; T[(n4 + 0) * 33 + kp] = pk2(a[i].x, b[i].x); T[(n4 + 1) * 33 + kp] = pk2(a[i].y, b[i].y); T[(n4 + 2) * 33 + kp] = pk2(a[i].z, b[i].z); T[(n4 + 3) * 33 + kp] = pk2(a[i].w, b[i].w); }
        __syncthreads();
        it = (int)C.MISC[MISC_Q + ((n + 1) & 1)];
        const int c = tid & 7, r0 = tid >> 3;
#pragma unroll
        for (int ps = 0; ps < 4; ++ps) { const int nn = r0 + 64 * ps; const LAS unsigned* t = T + nn * 33 + 4 * c; v4u o; o.x = t[0]; o.y = t[1]; o.z = t[2]; o.w = t[3];
            *(v4u*)(WT + (size_t)(nb * 256 + nn) * 1024 + kb * 64 + 8 * c) = o; }
    }
    __syncthreads();
}
__device__ __forceinline__ void ph_g1(const Args& A, const Ctx& C) { const float* const p_I_BMOD = IN_(I_BMOD);
    const float* mp = (const float*)(C.ws + WS_MODP); float* mod = (float*)(C.ws + WS_MOD);
    for (int idx = C.bid * NTHREADS + C.tid; idx < 2 * 17 * 6144; idx += C.G * NTHREADS) {
        const int l = idx / (17 * 6144), j = idx % 6144; float s = p_I_BMOD[l * 6144 + j];
#pragma unroll
        for (int p = 0; p < 8; ++p) s += mp[(size_t)p * (2 * 17 * 6144) + idx];
        mod[idx] = s;
    }
}
__device__ __forceinline__ void ph_g2(const Args& A, const Ctx& C) { const float* const p_I_CTX = IN_(I_CTX); const float* const p_I_NORM1 = IN_(I_NORM1); const float* const p_I_X = IN_(I_X);
    const int gw = C.bid * NWAVES + C.wave, NGW = C.G * NWAVES, lane = C.lane; const float* mod = (const float*)(C.ws + WS_MOD); bf16* uo = (bf16*)(C.ws + WS_ACT1);
    f32x4 nw[4];
#pragma unroll
    for (int q = 0; q < 4; ++q) nw[q] = ((const f32x4*)p_I_NORM1)[lane + 64 * q];
    f32x4 cv[2][4], nv[2][4];
#define G2_LOAD(m_, v_) do { _Pragma("unroll") for (int r = 0; r < 2; ++r) { const int mm = (m_) + r * NGW; if (mm < TT) { const f32x4* xr = (const f32x4*)h0_row(p_I_X, p_I_CTX, mm) + lane; \
        _Pragma("unroll") for (int q = 0; q < 4; ++q) v_[r][q] = xr[64 * q]; } } } while (0)
    G2_LOAD(gw, cv);
    for (int m = gw; m < TT; m += 2 * NGW) {
        if (m + 2 * NGW < TT) G2_LOAD(m + 2 * NGW, nv);
        float ss[2];
#pragma unroll
        for (int r = 0; r < 2; ++r) { ss[r] = 0.f;
#pragma unroll
            for (int q = 0; q < 4; ++q) ss[r] += (cv[r][q].x * cv[r][q].x + cv[r][q].y * cv[r][q].y) + (cv[r][q].z * cv[r][q].z + cv[r][q].w * cv[r][q].w); }
#pragma unroll
        for (int o = 1; o < 64; o <<= 1) { ss[0] += __shfl_xor(ss[0], o); ss[1] += __shfl_xor(ss[1], o); }
#pragma unroll
        for (int r = 0; r < 2; ++r) { const int mm = m + r * NGW; if (mm < TT) { const int b = mm / SB, s = mm - b * SB; const float* mr = mod + (size_t)(s < CTXL ? 16 : b) * 6144; const float rstd = rsqrtf(ss[r] * (1.0f / 1024.0f) + EPS);
#pragma unroll
            for (int q = 0; q < 4; ++q) { const int j4 = lane + 64 * q; const f32x4 sh = ((const f32x4*)mr)[j4], sc = ((const f32x4*)(mr + 1024))[j4];
                const f32x4 o = (cv[r][q] * rstd * nw[q]) * (sc + 1.0f) + sh; v2u p; p.x = pk2(o.x, o.y); p.y = pk2(o.z, o.w); ((v2u*)(uo + (size_t)mm * DM))[j4] = p; } } }
#pragma unroll
        for (int r = 0; r < 2; ++r)
#pragma unroll
            for (int q = 0; q < 4; ++q) cv[r][q] = nv[r][q];
    }
#undef G2_LOAD
}
__device__ __forceinline__ void ph_prep(const Args& A, const Ctx& C, int l, int rep) { const float* const p_I_CONVB = IN_(I_CONVB); const float* const p_I_CONVW = IN_(I_CONVW); const float* const p_I_DTB = IN_(I_DTB); const float* const p_I_GUPB = IN_(I_GUPB); const float* const p_I_GUPW = IN_(I_GUPW); const float* const p_I_KVNW = IN_(I_KVNW); const float* const p_I_QNW = IN_(I_QNW);
    LAS float* gws = (LAS float*)C.lds;
    LAS float* cws = (LAS float*)(C.lds + 32768);
    for (int idx = C.tid; idx < 8192; idx += NTHREADS) gws[idx] = p_I_GUPW[l * 8192 + idx];
    for (int idx = C.tid; idx < 2304; idx += NTHREADS) cws[idx] = p_I_CONVW[l * 2304 + idx];
    for (int idx = C.tid; idx < 768; idx += NTHREADS) cws[2304 + idx] = p_I_CONVB[l * 768 + idx];
    __syncthreads();
    const bf16* cols = (const bf16*)(C.ws + WS_COLS);
    bf16* xbc = (bf16*)(C.ws + WS_XBC); float* dt = (float*)(C.ws + WS_DT); bf16* gg = (bf16*)(C.ws + WS_G); bf16* aq = (bf16*)(C.ws + WS_AQ); bf16* akv = (bf16*)(C.ws + WS_AKV);
    const int gw = C.bid * NWAVES + C.wave, NGW = C.G * NWAVES, lane = C.lane;
    const float dtb = lane < 16 ? p_I_DTB[l * 16 + lane] : 0.f;
    const f32x4 gb0 = *(const f32x4*)(p_I_GUPB + l * 512 + lane * 4), gb1 = *(const f32x4*)(p_I_GUPB + l * 512 + 256 + lane * 4);
    const f32x4 qnw = lane < 48 ? *(const f32x4*)(p_I_QNW + l * 192 + lane * 4) : (f32x4){0.f, 0.f, 0.f, 0.f}, kvnw = lane < 32 ? *(const f32x4*)(p_I_KVNW + l * 128 + lane * 4) : (f32x4){0.f, 0.f, 0.f, 0.f};
    v2u cx0[3], cxm[3], cxp[3], ccq, cckv; v4u cgl[4]; unsigned cdt;
    v2u nx0[3], nxm[3], nxp[3], ncq, nckv; v4u ngl[4]; unsigned ndt;
#define PREP_LOAD(m_, x0_, xm_, xp_, cq_, ckv_, gl_, dt_) do { const int b_ = (m_) / SB, s_ = (m_) - b_ * SB; const bool hp_ = (s_ != 0 && s_ != CTXL), hn_ = (s_ != CTXL - 1 && s_ != SB - 1); \
        const bf16* r_ = cols + (size_t)(m_) * INWP; \
        _Pragma("unroll") for (int ch = 0; ch < 3; ++ch) { const int c_ = ch * 256 + lane * 4; x0_[ch] = *(const v2u*)(r_ + C_XBC + c_); xm_[ch] = (v2u){0u, 0u}; xp_[ch] = (v2u){0u, 0u}; \
            if (hp_) xm_[ch] = *(const v2u*)(r_ - INWP + C_XBC + c_); if (hn_) xp_[ch] = *(const v2u*)(r_ + INWP + C_XBC + c_); } \
        dt_ = r_[C_DT + (lane & 15)]; { const v4u* g_ = (const v4u*)(r_ + C_GLR); gl_[0] = g_[0]; gl_[1] = g_[1]; gl_[2] = g_[2]; gl_[3] = g_[3]; } \
        cq_ = *(const v2u*)(r_ + C_CQ + (lane < 48 ? lane : 0) * 4); ckv_ = *(const v2u*)(r_ + C_CKV + (lane & 31) * 4); } while (0)
    if (gw < TT) PREP_LOAD(gw, cx0, cxm, cxp, ccq, cckv, cgl, cdt);
    for (int m = gw; m < TT; m += NGW) {
        const int mn = m + NGW;
        if (mn < TT) PREP_LOAD(mn, nx0, nxm, nxp, ncq, nckv, ngl, ndt);
#pragma unroll
        for (int ch = 0; ch < 3; ++ch) { const int c = ch * 256 + lane * 4; const v2u x0 = cx0[ch], xm = cxm[ch], xp = cxp[ch];
            const f32x4 w0 = *(const LAS f32x4*)(cws + c), w1 = *(const LAS f32x4*)(cws + 768 + c), w2 = *(const LAS f32x4*)(cws + 1536 + c), bb = *(const LAS f32x4*)(cws + 2304 + c);
            f32x4 v; v.x = w0.x * bflo(xm.x) + w1.x * bflo(x0.x) + w2.x * bflo(xp.x) + bb.x; v.y = w0.y * bfhi(xm.x) + w1.y * bfhi(x0.x) + w2.y * bfhi(xp.x) + bb.y;
            v.z = w0.z * bflo(xm.y) + w1.z * bflo(x0.y) + w2.z * bflo(xp.y) + bb.z; v.w = w0.w * bfhi(xm.y) + w1.w * bfhi(x0.y) + w2.w * bfhi(xp.y) + bb.w;
            v2u o; o.x = pk2(fsilu(v.x), fsilu(v.y)); o.y = pk2(fsilu(v.z), fsilu(v.w)); *(v2u*)(xbc + (size_t)m * 768 + c) = o; __builtin_amdgcn_sched_barrier(0); }
        if (lane < 16) dt[(size_t)m * 16 + lane] = fsoftplus(bf2f(cdt) + dtb);
#pragma unroll
        for (int dir = 0; dir < 2; ++dir) { const v4u q0 = cgl[2 * dir], q1 = cgl[2 * dir + 1];
            const unsigned gw32[8] = {q0.x, q0.y, q0.z, q0.w, q1.x, q1.y, q1.z, q1.w};
            f32x4 acc = dir ? gb1 : gb0;
#pragma unroll
            for (int r = 0; r < 16; ++r) { const unsigned w = gw32[r >> 1]; const float gv = (r & 1) ? bfhi(w) : bflo(w); acc += gv * *(const LAS f32x4*)(gws + (dir * 16 + r) * 256 + lane * 4); }
            f32x4 o; o.x = -fsoftplus(-acc.x) * 0.0625f; o.y = -fsoftplus(-acc.y) * 0.0625f; o.z = -fsoftplus(-acc.z) * 0.0625f; o.w = -fsoftplus(-acc.w) * 0.0625f;
            v2u ob; ob.x = pk2(o.x, o.y); ob.y = pk2(o.z, o.w); *(v2u*)(gg + (size_t)m * 512 + dir * 256 + lane * 4) = ob; __builtin_amdgcn_sched_barrier(0); }
        { float v0 = 0.f, v1 = 0.f, v2 = 0.f, v3 = 0.f, u0 = 0.f, u1 = 0.f, u2 = 0.f, u3 = 0.f;
          if (lane < 48) { v0 = bflo(ccq.x); v1 = bfhi(ccq.x); v2 = bflo(ccq.y); v3 = bfhi(ccq.y); }
          if (lane < 32) { u0 = bflo(cckv.x); u1 = bfhi(cckv.x); u2 = bflo(cckv.y); u3 = bfhi(cckv.y); }
          float sa = (v0 * v0 + v1 * v1) + (v2 * v2 + v3 * v3), sb = (u0 * u0 + u1 * u1) + (u2 * u2 + u3 * u3);
#pragma unroll
          for (int o = 1; o < 64; o <<= 1) { sa += __shfl_xor(sa, o); sb += __shfl_xor(sb, o); }
          const float ra = rsqrtf(sa * (1.0f / 192.0f) + EPS), rb = rsqrtf(sb * (1.0f / 128.0f) + EPS);
          v2u oa; oa.x = pk2(v0 * ra * qnw.x, v1 * ra * qnw.y); oa.y = pk2(v2 * ra * qnw.z, v3 * ra * qnw.w); *(v2u*)(aq + (size_t)m * 256 + lane * 4) = oa;
          v2u ob; ob.x = pk2(u0 * rb * kvnw.x, u1 * rb * kvnw.y); ob.y = pk2(u2 * rb * kvnw.z, u3 * rb * kvnw.w); *(v2u*)(akv + (size_t)m * 256 + lane * 4) = ob; }
#pragma unroll
        for (int ch = 0; ch < 3; ++ch) { cx0[ch] = nx0[ch]; cxm[ch] = nxm[ch]; cxp[ch] = nxp[ch]; }
        ccq = ncq; cckv = nckv; cdt = ndt;
#pragma unroll
        for (int q = 0; q < 4; ++q) cgl[q] = ngl[q];
    }
#undef PREP_LOAD
    __syncthreads();
    if (rep == 0) convert_experts(A, C, l, 1 << 30);
}
struct AsmRow { v2u x, kk; float cs, sn; unsigned t1, t2, u1, u2; };
__device__ __forceinline__ void assemble_rows8(const Ctx& C, int m0) {
    const bf16* qraw = (const bf16*)(C.ws + WS_QRAW); const bf16* kv = (const bf16*)(C.ws + WS_KV); const bf16* cols = (const bf16*)(C.ws + WS_COLS);
    bf16* qf = (bf16*)(C.ws + WS_QF); bf16* kf = (bf16*)(C.ws + WS_KF); const float* rope = (const float*)(C.ws + WS_ROPE);
    const float QS = 0.10206207261596575f * 1.4426950408889634f;
    const int lane = C.lane, h = lane >> 4, d = (lane & 15) * 4, a = (lane >> 3) & 1, i = lane & 7;
    auto ld = [&](int m, AsmRow& r) {
        const int b = m / SB, s = m - b * SB; const bool lat = s >= CTXL; const int sp = s - CTXL, pos = a == 0 ? sp >> 6 : sp & 63;
        const bf16* q = qraw + (size_t)m * 512; const bf16* k = kv + (size_t)m * 512; const bf16* kpe = cols + (size_t)m * INWP + C_KPE;
        r.x = *(const v2u*)(q + h * 96 + d); r.kk = *(const v2u*)(k + h * 128 + d);
        r.cs = 1.f; r.sn = 0.f; if (lat) { const float2 t = *(const float2*)(rope + (pos * 8 + i) * 2); r.cs = t.x; r.sn = t.y; }
        r.t1 = q[h * 96 + 64 + a * 16 + i]; r.t2 = q[h * 96 + 64 + a * 16 + 8 + i];
        r.u1 = 0; r.u2 = 0; if (lane < 16) { r.u1 = kpe[a * 16 + i]; r.u2 = kpe[a * 16 + 8 + i]; } };
    auto fin = [&](int m, const AsmRow& r) {
        bf16* qo = qf + (size_t)m * 384; bf16* ko = kf + (size_t)m * 384;
        v2u o; o.x = pk2(bflo(r.x.x) * QS, bfhi(r.x.x) * QS); o.y = pk2(bflo(r.x.y) * QS, bfhi(r.x.y) * QS);
        *(v2u*)(qo + h * 96 + d) = o; *(v2u*)(ko + h * 96 + d) = r.kk;
        const float t1 = bf2f(r.t1), t2 = bf2f(r.t2);
        qo[h * 96 + 64 + a * 16 + i] = (bf16)f2bf((t1 * r.cs - t2 * r.sn) * QS); qo[h * 96 + 64 + a * 16 + 8 + i] = (bf16)f2bf((t2 * r.cs + t1 * r.sn) * QS);
        if (lane < 16) { const float u1 = bf2f(r.u1), u2 = bf2f(r.u2); const bf16 o1 = (bf16)f2bf(u1 * r.cs - u2 * r.sn), o2 = (bf16)f2bf(u2 * r.cs + u1 * r.sn);
#pragma unroll
            for (int hh = 0; hh < 4; ++hh) { ko[hh * 96 + 64 + a * 16 + i] = o1; ko[hh * 96 + 64 + a * 16 + 8 + i] = o2; } } };
#pragma unroll
    for (int g = 0; g < 2; ++g) { AsmRow r0, r1, r2, r3; const int m = m0 + 4 * g;
        ld(m, r0); ld(m + 1, r1); ld(m + 2, r2); ld(m + 3, r3);
        fin(m, r0); fin(m + 1, r1); fin(m + 2, r2); fin(m + 3, r3); }
}
__device__ __forceinline__ void ph_assemble(const Args& A, const Ctx& C, int l, int rep) {
    unsigned* head = (unsigned*)C.ws + CW_ASM + 64 * (2 * l + rep);
    for (;;) {
        unsigned blk = 0; if (C.lane == 0) blk = __hip_atomic_fetch_add(head, 1u, __ATOMIC_RELAXED, __HIP_MEMORY_SCOPE_AGENT);
        blk = __builtin_amdgcn_readfirstlane(blk);
        if (blk >= (unsigned)(TT / 8)) break;
        assemble_rows8(C, (int)blk * 8);
    }
}
constexpr int AT_KP = 224, AT_VP = 160, AT_KB = 64 * AT_KP  , AT_VB = 64 * AT_VP  ;
typedef short at_v4i16 __attribute__((ext_vector_type(4)));
__device__ __forceinline__ bf16x8 at_tr_frag(const LAS unsigned char* tile, int k0a, int k0b, int c0, int lane) {
    const int i = lane & 15, q = i >> 2, p = i & 3;
    const at_v4i16 lo = __builtin_amdgcn_ds_read_tr16_b64_v4i16((LAS at_v4i16*)(tile + (k0a + q) * AT_VP + (c0 + 4 * p) * 2));
    const at_v4i16 hi = __builtin_amdgcn_ds_read_tr16_b64_v4i16((LAS at_v4i16*)(tile + (k0b + q) * AT_VP + (c0 + 4 * p) * 2));
    bf16x8 r; r[0] = lo[0]; r[1] = lo[1]; r[2] = lo[2]; r[3] = lo[3]; r[4] = hi[0]; r[5] = hi[1]; r[6] = hi[2]; r[7] = hi[3]; return r;
}
__device__ __forceinline__ float xmax4(float x) {
    const auto r = __builtin_amdgcn_permlane16_swap(__float_as_uint(x), __float_as_uint(x), false, false); const float m = fmaxf(__uint_as_float(r[0]), __uint_as_float(r[1]));
    const auto q = __builtin_amdgcn_permlane32_swap(__float_as_uint(m), __float_as_uint(m), false, false); return fmaxf(__uint_as_float(q[0]), __uint_as_float(q[1]));
}
constexpr int AT_T = 128, AT_KB2 = AT_T * AT_KP  , AT_VB2 = AT_T * AT_VP  ;
template <int VAR>
__device__ __forceinline__ void attn_unit(const Ctx& C, int b, int h, int qt) {
    const bf16* qfp = (const bf16*)(C.ws + WS_QF); const bf16* kfp = (const bf16*)(C.ws + WS_KF); const bf16* kvp = (const bf16*)(C.ws + WS_KV); bf16* mix = (bf16*)(C.ws + (VAR ? WS_H : WS_ACT1));
    LAS unsigned char* lds = C.lds;
    const int tid = C.tid, lane = C.lane, wave = C.wave, fr = lane & 15, fq = lane >> 4;
    const size_t mb = (size_t)b * SB;
    const int nkt = (qt == 0 ? CTXL : SB) / AT_T;
    const size_t mq = mb + (size_t)qt * 256 + wave * 32;
    bf16x8 qf[2][3];
#pragma unroll
    for (int qb = 0; qb < 2; ++qb)
#pragma unroll
        for (int ks = 0; ks < 3; ++ks) qf[qb][ks] = *(const bf16x8*)(qfp + (mq + qb * 16 + fr) * 384 + h * 96 + ks * 32 + fq * 8);
    f32x4 ot[2][4];
#pragma unroll
    for (int qb = 0; qb < 2; ++qb)
#pragma unroll
        for (int d = 0; d < 4; ++d) ot[qb][d] = (f32x4){0.f, 0.f, 0.f, 0.f};
    float mrun[2] = {0.f, 0.f};
    f32x4 lacc[2]; lacc[0] = (f32x4){0.f, 0.f, 0.f, 0.f}; lacc[1] = lacc[0];
    const bf16x8 ones = __builtin_bit_cast(bf16x8, ((v4u){0x3f803f80u, 0x3f803f80u, 0x3f803f80u, 0x3f803f80u}));
    const bf16* kg[3]; int kl[3];
#pragma unroll
    for (int j = 0; j < 3; ++j) { const int id = tid + 512 * j, r = id / 12, cc = id - r * 12; kg[j] = kfp + (mb + r) * 384 + h * 96 + cc * 8; kl[j] = r * AT_KP + cc * 16; }
    const bf16* vg = kvp + (mb + (tid >> 3)) * 512 + h * 128 + 64 + (tid & 7) * 8; const int vl = (tid >> 3) * AT_VP + (tid & 7) * 16;
    v4u rk[3], rv[2];
#pragma unroll
    for (int j = 0; j < 3; ++j) rk[j] = *(const v4u*)kg[j];
    rv[0] = *(const v4u*)vg; rv[1] = *(const v4u*)(vg + 64 * 512);
    __syncthreads();
    if (wave < 4) __builtin_amdgcn_s_setprio(1);
#pragma unroll
    for (int j = 0; j < 3; ++j) *(LAS v4u*)(lds + kl[j]) = rk[j];
    *(LAS v4u*)(lds + 2 * AT_KB2 + vl) = rv[0]; *(LAS v4u*)(lds + 2 * AT_KB2 + 64 * AT_VP + vl) = rv[1];
    __syncthreads();
    for (int kt = 0; kt < nkt; ++kt) {
        const int cur = kt & 1; const bool more = kt + 1 < nkt;
#ifndef AT_STAGGER
#define AT_STAGGER 0
#endif
        if (AT_STAGGER && wave >= 4) __builtin_amdgcn_s_sleep(AT_STAGGER);
        if (more && VAR != 4) { const size_t ko = (size_t)(kt + 1) * AT_T;
#pragma unroll
            for (int j = 0; j < 3; ++j) rk[j] = *(const v4u*)(kg[j] + ko * 384);
            rv[0] = *(const v4u*)(vg + ko * 512); rv[1] = *(const v4u*)(vg + (ko + 64) * 512); }
#pragma unroll
        for (int hf = 0; hf < 2; ++hf) {
        const LAS unsigned char* kb_ = lds + cur * AT_KB2 + hf * 64 * AT_KP; const LAS unsigned char* vb_ = lds + 2 * AT_KB2 + cur * AT_VB2 + hf * 64 * AT_VP;
        f32x4 sa[2][4];
#pragma unroll
        for (int kb = 0; kb < 4; ++kb) {
            if (VAR == 3) { sa[0][kb] = (f32x4){-mrun[0], -mrun[0], -mrun[0], -mrun[0]}; sa[1][kb] = (f32x4){-mrun[1], -mrun[1], -mrun[1], -mrun[1]}; continue; }
            bf16x8 kfr[3];
#pragma unroll
            for (int ks = 0; ks < 3; ++ks) kfr[ks] = *(const LAS bf16x8*)(kb_ + (kb * 16 + fr) * AT_KP + ks * 64 + fq * 16);
#pragma unroll
            for (int qb = 0; qb < 2; ++qb) { const float nm = -mrun[qb]; f32x4 acc = (f32x4){nm, nm, nm, nm};
#pragma unroll
                for (int ks = 0; ks < 3; ++ks) acc = __builtin_amdgcn_mfma_f32_16x16x32_bf16(kfr[ks], qf[qb][ks], acc, 0, 0, 0);
                sa[qb][kb] = acc; }
        }
        bf16x8 pf[2][2];
#pragma unroll
        for (int qb = 0; qb < 2; ++qb) {
            if (VAR == 1) { pf[qb][0] = __builtin_bit_cast(bf16x8, ((v4u){pk2(sa[qb][0].x, sa[qb][0].y), pk2(sa[qb][0].z, sa[qb][0].w), pk2(sa[qb][1].x, sa[qb][1].y), pk2(sa[qb][1].z, sa[qb][1].w)})); pf[qb][1] = __builtin_bit_cast(bf16x8, ((v4u){pk2(sa[qb][2].x, sa[qb][2].y), pk2(sa[qb][2].z, sa[qb][2].w), pk2(sa[qb][3].x, sa[qb][3].y), pk2(sa[qb][3].z, sa[qb][3].w)})); continue; }
            float mx = fmaxf(fmaxf(sa[qb][0].x, sa[qb][0].y), fmaxf(sa[qb][0].z, sa[qb][0].w));
#pragma unroll
            for (int kb = 1; kb < 4; ++kb) mx = fmaxf(fmaxf(mx, fmaxf(sa[qb][kb].x, sa[qb][kb].y)), fmaxf(sa[qb][kb].z, sa[qb][kb].w));
            if (__any(mx > 0.f)) {
                mx = fmaxf(mx, __shfl_xor(mx, 16)); mx = fmaxf(mx, __shfl_xor(mx, 32));
                const float delta = fmaxf(mx, 0.f), alpha = __builtin_amdgcn_exp2f(-delta); mrun[qb] += delta; lacc[qb] *= alpha;
#pragma unroll
                for (int d = 0; d < 4; ++d) ot[qb][d] *= alpha;
#pragma unroll
                for (int kb = 0; kb < 4; ++kb) sa[qb][kb] -= delta;
            }
            unsigned pw[8];
#pragma unroll
            for (int kb = 0; kb < 4; ++kb) { const float p0 = __builtin_amdgcn_exp2f(sa[qb][kb].x), p1 = __builtin_amdgcn_exp2f(sa[qb][kb].y), p2 = __builtin_amdgcn_exp2f(sa[qb][kb].z), p3 = __builtin_amdgcn_exp2f(sa[qb][kb].w);
                pw[kb * 2] = pk2(p0, p1); pw[kb * 2 + 1] = pk2(p2, p3); }
#pragma unroll
            for (int kk = 0; kk < 2; ++kk) { const v4u w = (v4u){pw[kk * 4], pw[kk * 4 + 1], pw[kk * 4 + 2], pw[kk * 4 + 3]}; pf[qb][kk] = __builtin_bit_cast(bf16x8, w); }
        }
        if (VAR == 2) { ot[0][0] += __builtin_bit_cast(f32x4, pf[0][0]) + __builtin_bit_cast(f32x4, pf[0][1]); ot[1][0] += __builtin_bit_cast(f32x4, pf[1][0]) + __builtin_bit_cast(f32x4, pf[1][1]); lacc[0] += 1.0f; lacc[1] += 1.0f; continue; }
#pragma unroll
        for (int kk = 0; kk < 2; ++kk) { lacc[0] = __builtin_amdgcn_mfma_f32_16x16x32_bf16(ones, pf[0][kk], lacc[0], 0, 0, 0); lacc[1] = __builtin_amdgcn_mfma_f32_16x16x32_bf16(ones, pf[1][kk], lacc[1], 0, 0, 0); }
#pragma unroll
        for (int d = 0; d < 4; ++d)
#pragma unroll
            for (int kk = 0; kk < 2; ++kk) {
                const bf16x8 vf = at_tr_frag(vb_, kk * 32 + 4 * fq, kk * 32 + 16 + 4 * fq, d * 16, lane);
#pragma unroll
                for (int qb = 0; qb < 2; ++qb) ot[qb][d] = __builtin_amdgcn_mfma_f32_16x16x32_bf16(vf, pf[qb][kk], ot[qb][d], 0, 0, 0);
            }
        }
        if (more && VAR != 4) { const int nx = cur ^ 1;
#pragma unroll
            for (int j = 0; j < 3; ++j) *(LAS v4u*)(lds + nx * AT_KB2 + kl[j]) = rk[j];
            *(LAS v4u*)(lds + 2 * AT_KB2 + nx * AT_VB2 + vl) = rv[0]; *(LAS v4u*)(lds + 2 * AT_KB2 + nx * AT_VB2 + 64 * AT_VP + vl) = rv[1]; }
        __syncthreads();
    }
    __builtin_amdgcn_s_setprio(0);
#pragma unroll
    for (int qb = 0; qb < 2; ++qb) {
        const float inv = 1.0f / lacc[qb].x;
        bf16* orow = mix + (mq + qb * 16 + fr) * DM + 768 + h * 64 + 4 * fq;
#pragma unroll
        for (int d = 0; d < 4; ++d) { v2u o; o.x = pk2(ot[qb][d].x * inv, ot[qb][d].y * inv); o.y = pk2(ot[qb][d].z * inv, ot[qb][d].w * inv); *(v2u*)(orow + d * 16) = o; }
    }
}
__device__ __forceinline__ void attn_queue(const Ctx& C, int l, int rep) {
    unsigned* head = (unsigned*)C.ws + CW_AQ + 64 * (8 * l + rep);
    const int nunits = 1024 + (l == 0 ? 64 : 0);
    for (;;) {
        __syncthreads();
        if (C.tid == 0) C.MISC[MISC_Q] = __hip_atomic_fetch_add(head, 1u, __ATOMIC_RELAXED, __HIP_MEMORY_SCOPE_AGENT);
        __syncthreads();
        const int u = (int)C.MISC[MISC_Q];
        if (u >= nunits) break;
        const int ub = u < 1024 ? u >> 6 : (u - 1024) >> 2, uh = u < 1024 ? (u >> 4) & 3 : (u - 1024) & 3, uq = u < 1024 ? 1 + (u & 15) : 0;
#ifdef ATT_VAR
        if (rep == 0) attn_unit<0>(C, ub, uh, uq); else attn_unit<ATT_VAR>(C, ub, uh, uq);
#else
        attn_unit<0>(C, ub, uh, uq);
#endif
    }
}
#ifndef XSTATE
#define XSTATE 1
#endif
#ifndef XINTRA
#define XINTRA 1
#endif
constexpr int CH = 64, NCH = SB / CH  , NCTXCH = CTXL / CH  ;
constexpr int TP = 160;
constexpr int TILE_B = 64 * TP;
typedef short v4i16_t __attribute__((ext_vector_type(4)));
__device__ __forceinline__ bf16x8 tr_frag(const LAS unsigned char* tile, int k0a, int k0b, int c0, int lane) {
#ifdef TR_SLOW
    const int col = c0 + (lane & 15); const LAS unsigned short* t = (const LAS unsigned short*)tile; bf16x8 r;
#pragma unroll
    for (int e = 0; e < 4; ++e) { r[e] = (short)t[(k0a + e) * (TP / 2) + col]; r[4 + e] = (short)t[(k0b + e) * (TP / 2) + col]; }
    return r;
#else
    const int i = lane & 15, q = i >> 2, p = i & 3;
    const v4i16_t lo = __builtin_amdgcn_ds_read_tr16_b64_v4i16((LAS v4i16_t*)(tile + (k0a + q) * TP + (c0 + 4 * p) * 2));
    const v4i16_t hi = __builtin_amdgcn_ds_read_tr16_b64_v4i16((LAS v4i16_t*)(tile + (k0b + q) * TP + (c0 + 4 * p) * 2));
    bf16x8 r; r[0] = lo[0]; r[1] = lo[1]; r[2] = lo[2]; r[3] = lo[3]; r[4] = hi[0]; r[5] = hi[1]; r[6] = hi[2]; r[7] = hi[3]; return r;
#endif
}
__device__ __forceinline__ bf16x8 tr_frag_g4(const LAS unsigned char* tile, int k0a, int k0b, int g, int lane) {
    const int i = lane & 15, q = i >> 2, p = i & 3;
    const v4i16_t lo = __builtin_amdgcn_ds_read_tr16_b64_v4i16((LAS v4i16_t*)(tile + (k0a + q) * TP + (16 * p + 4 * g) * 2));
    const v4i16_t hi = __builtin_amdgcn_ds_read_tr16_b64_v4i16((LAS v4i16_t*)(tile + (k0b + q) * TP + (16 * p + 4 * g) * 2));
    bf16x8 r; r[0] = lo[0]; r[1] = lo[1]; r[2] = lo[2]; r[3] = lo[3]; r[4] = hi[0]; r[5] = hi[1]; r[6] = hi[2]; r[7] = hi[3]; return r;
}
__device__ __forceinline__ bf16x8 row_frag(const LAS unsigned char* tile, int row, int col) { return *(const LAS bf16x8*)(tile + row * TP + col * 2); }
__device__ __forceinline__ v4u scale8(v4u x, float s) { v4u o; o.x = pk2(bflo(x.x) * s, bfhi(x.x) * s); o.y = pk2(bflo(x.y) * s, bfhi(x.y) * s); o.z = pk2(bflo(x.z) * s, bfhi(x.z) * s); o.w = pk2(bflo(x.w) * s, bfhi(x.w) * s); return o; }
__device__ __forceinline__ v4u scale8v(v4u x, f32x4 a, f32x4 b) { v4u o; o.x = pk2(bflo(x.x) * a.x, bfhi(x.x) * a.y); o.y = pk2(bflo(x.y) * a.z, bfhi(x.y) * a.w); o.z = pk2(bflo(x.z) * b.x, bfhi(x.z) * b.y); o.w = pk2(bflo(x.w) * b.z, bfhi(x.w) * b.w); return o; }
__device__ __forceinline__ f32x4 exp4(f32x4 a) { return (f32x4){__expf(a.x), __expf(a.y), __expf(a.z), __expf(a.w)}; }
constexpr size_t WS_SST = WS_ARENA + 1200 * MiB;
constexpr size_t WS_GST = WS_ARENA + 1336 * MiB;
constexpr size_t WS_SEN = WS_ARENA + 991 * MiB;
constexpr size_t WS_GEN = WS_ARENA + 1127 * MiB;
constexpr size_t WS_SDEC = WS_ARENA + 1404 * MiB;
constexpr size_t WS_GDEC = WS_ARENA + 1405 * MiB;
static_assert(WS_GDEC + 5 * MiB <= WS_ARENA + 1428 * MiB, "arena");

template <bool SSD>
__device__ __forceinline__ void chunk_cums(const Ctx& C, int l, size_t m0, int h0, int nh, LAS float* cums, const float* alog) {
    if (SSD) {
        const int w = C.wave; if (w < 2 * nh) { const int hl = w >> 1, d = w & 1, h = h0 + hl, s = d == 0 ? C.lane : 63 - C.lane;
            const float dtv = ((const float*)(C.ws + WS_DT))[(m0 + s) * 16 + d * 8 + h]; float v = dtv * -expf(alog[l * 16 + d * 8 + h]);
#pragma unroll
            for (int o = 1; o < 64; o <<= 1) { const float t = __shfl_up(v, o); if (C.lane >= o) v += t; }
            cums[(d * nh + hl) * 64 + s] = v; cums[((2 + d) * nh + hl) * 64 + s] = dtv; }
    } else {
        if (C.tid < 128) { const int d = C.tid >> 6, k = C.tid & 63; const float* gp = (const float*)(C.ws + WS_G) + m0 * 512 + d * 256 + h0 * 64 + k; float acc = 0.f;
#pragma unroll 16
            for (int i = 0; i < 64; ++i) { const int s = d == 0 ? i : 63 - i; acc += gp[(size_t)s * 512]; cums[d * 4096 + s * 64 + k] = acc; } }
    }
}
template <bool SSD>
__device__ __forceinline__ void chunk_s1(const Ctx& C, int l, int unit, const float* alog) {
    constexpr int NH = SSD ? 8 : 4;
    const int b = unit / (NCH * NH), rem = unit - b * (NCH * NH), c = rem / NH, h = rem - c * NH; const size_t m0 = (size_t)b * SB + c * CH;
    LAS unsigned char* VT = C.lds; LAS unsigned char* KSF = C.lds + TILE_B; LAS unsigned char* KSB = C.lds + 2 * TILE_B; LAS float* cums = (LAS float*)(C.lds + 3 * TILE_B);
    __syncthreads();
    chunk_cums<SSD>(C, l, m0, h, 1, cums, alog);
    __syncthreads();
    { const int s = C.tid >> 3, sub = C.tid & 7; const size_t m = m0 + s;
      v4u vv, kk; v4u kf, kb;
      if (SSD) { const bf16* r = (const bf16*)(C.ws + WS_XBC) + m * 768; vv = *(const v4u*)(r + h * 64 + sub * 8); kk = *(const v4u*)(r + 512 + (h >> 2) * 64 + sub * 8);
          const float wf = cums[128 + s] * __expf(cums[63] - cums[s]), wb = cums[192 + s] * __expf(cums[64] - cums[64 + s]);
          kf = scale8(kk, wf); kb = scale8(kk, wb);
      } else { const bf16* r = (const bf16*)(C.ws + WS_COLS) + m * INWP + h * 64 + sub * 8; vv = *(const v4u*)(r + C_GV); kk = *(const v4u*)(r + C_GK);
          const LAS float* cf = cums + s * 64 + sub * 8; const LAS float* cb = cums + 4096 + s * 64 + sub * 8; const LAS float* cfl = cums + 63 * 64 + sub * 8; const LAS float* cbl = cums + 4096 + sub * 8;
          kf = scale8v(kk, exp4(*(const LAS f32x4*)cfl - *(const LAS f32x4*)cf), exp4(*(const LAS f32x4*)(cfl + 4) - *(const LAS f32x4*)(cf + 4)));
          kb = scale8v(kk, exp4(*(const LAS f32x4*)cbl - *(const LAS f32x4*)cb), exp4(*(const LAS f32x4*)(cbl + 4) - *(const LAS f32x4*)(cb + 4))); }
      *(LAS v4u*)(VT + s * TP + sub * 16) = vv; *(LAS v4u*)(KSF + s * TP + sub * 16) = kf; *(LAS v4u*)(KSB + s * TP + sub * 16) = kb; }
    __syncthreads();
    { const int w = C.wave, d = w >> 2, kb_ = w & 3, lane = C.lane, fr = lane & 15, fq = lane >> 4; const LAS unsigned char* KS = d ? KSB : KSF;
      f32x4 acc[4];
#pragma unroll
      for (int vb = 0; vb < 4; ++vb) acc[vb] = (f32x4){0.f, 0.f, 0.f, 0.f};
#pragma unroll
      for (int ks = 0; ks < 2; ++ks) { const bf16x8 a = tr_frag(KS, ks * 32 + 8 * fq, ks * 32 + 8 * fq + 4, kb_ * 16, lane);
#pragma unroll
          for (int vb = 0; vb < 4; ++vb) { const bf16x8 bo = tr_frag(VT, ks * 32 + 8 * fq, ks * 32 + 8 * fq + 4, vb * 16, lane); acc[vb] = __builtin_amdgcn_mfma_f32_16x16x32_bf16(a, bo, acc[vb], 0, 0, 0); } }
      bf16* st = (bf16*)(C.ws + (SSD ? WS_SST : WS_GST)) + ((((size_t)b * NCH + c) * 2 + d) * NH + h) * 4096;
#pragma unroll
      for (int vb = 0; vb < 4; ++vb) { v2u o; o.x = pk2(acc[vb].x, acc[vb].y); o.y = pk2(acc[vb].z, acc[vb].w); *(v2u*)(st + (vb * 16 + fr) * 64 + kb_ * 16 + 4 * fq) = o; } }
    if (SSD) { if (C.tid < 2) ((float*)(C.ws + WS_SDEC))[(((size_t)b * NCH + c) * 2 + C.tid) * 8 + h] = __expf(C.tid == 0 ? cums[63] : cums[64]); }
    else { if (C.tid < 128) { const int d = C.tid >> 6, k = C.tid & 63; ((float*)(C.ws + WS_GDEC))[((((size_t)b * NCH + c) * 2 + d) * 4 + h) * 64 + k] = __expf(d == 0 ? cums[63 * 64 + k] : cums[4096 + k]); } }
}
template <bool SSD>
__device__ __forceinline__ void chunk_s2(const Ctx& C, int chain) {
    constexpr int NH = SSD ? 8 : 4;
    const int b = chain / (2 * NH), d = (chain / NH) & 1, h = chain % NH;
    const bf16* st = (const bf16*)(C.ws + (SSD ? WS_SST : WS_GST)); bf16* en = (bf16*)(C.ws + (SSD ? WS_SEN : WS_GEN)); const float* dec = (const float*)(C.ws + (SSD ? WS_SDEC : WS_GDEC));
    const int v = C.tid >> 3, k0 = (C.tid & 7) * 8;
    float run[8];
#pragma unroll
    for (int j = 0; j < 8; ++j) run[j] = 0.f;
    auto chunk_at = [&](int i) { return d == 0 ? i : (i < NCTXCH ? NCTXCH - 1 - i : NCH + NCTXCH - 1 - i); };
    v4u nxt = *(const v4u*)(st + ((((size_t)b * NCH + chunk_at(0)) * 2 + d) * NH + h) * 4096 + v * 64 + k0);
    for (int i = 0; i < NCH; ++i) {
        const int c = chunk_at(i); const size_t base = (((size_t)b * NCH + c) * 2 + d) * NH + h; bf16* p = en + base * 4096 + v * 64 + k0;
        const v4u inc = nxt; if (i + 1 < NCH) nxt = *(const v4u*)(st + ((((size_t)b * NCH + chunk_at(i + 1)) * 2 + d) * NH + h) * 4096 + v * 64 + k0);
        f32x4 d0, d1; if (SSD) { const float dd = dec[base]; d0 = (f32x4){dd, dd, dd, dd}; d1 = d0; } else { d0 = *(const f32x4*)(dec + base * 64 + k0); d1 = *(const f32x4*)(dec + base * 64 + k0 + 4); }
        v4u o; o.x = pk2(run[0], run[1]); o.y = pk2(run[2], run[3]); o.z = pk2(run[4], run[5]); o.w = pk2(run[6], run[7]); *(v4u*)p = o;
        run[0] = d0.x * run[0] + bflo(inc.x); run[1] = d0.y * run[1] + bfhi(inc.x); run[2] = d0.z * run[2] + bflo(inc.y); run[3] = d0.w * run[3] + bfhi(inc.y);
        run[4] = d1.x * run[4] + bflo(inc.z); run[5] = d1.y * run[5] + bfhi(inc.z); run[6] = d1.z * run[6] + bflo(inc.w); run[7] = d1.w * run[7] + bfhi(inc.w);
    }
}
template <bool SSD>
__device__ __forceinline__ void chunk_s2_wave(const Ctx& C, int chain) {
    constexpr int NH = SSD ? 8 : 4;
    const int b = chain / (2 * NH), d = (chain / NH) & 1, h = chain % NH, lane = C.lane;
    const bf16* st = (const bf16*)(C.ws + (SSD ? WS_SST : WS_GST)); bf16* en = (bf16*)(C.ws + (SSD ? WS_SEN : WS_GEN)); const float* dec = (const float*)(C.ws + (SSD ? WS_SDEC : WS_GDEC));
    const int k0 = (lane & 7) * 8;
    float run[64];
#pragma unroll
    for (int e = 0; e < 64; ++e) run[e] = 0.f;
    auto chunk_at = [&](int i) { return d == 0 ? i : (i < NCTXCH ? NCTXCH - 1 - i : NCH + NCTXCH - 1 - i); };
    auto base_at = [&](int i) { return (((size_t)b * NCH + chunk_at(i)) * 2 + d) * NH + h; };
    v4u q0[8], q1[8], q2[8]; f32x4 a0, b0, a1, b1, a2, b2;
    auto ld = [&](int i, v4u (&q)[8], f32x4& da, f32x4& db) { const size_t base = base_at(i);
#pragma unroll
        for (int j = 0; j < 8; ++j) q[j] = *(const v4u*)(st + base * 4096 + j * 512 + lane * 8);
        if (SSD) { const float dd = dec[base]; da = (f32x4){dd, dd, dd, dd}; db = da; } else { da = *(const f32x4*)(dec + base * 64 + k0); db = *(const f32x4*)(dec + base * 64 + k0 + 4); } };
    auto step = [&](int i, const v4u (&inc)[8], const f32x4& d0, const f32x4& d1, v4u (&pq)[8], f32x4& pa, f32x4& pb) {
        if (i + 2 < NCH) ld(i + 2, pq, pa, pb);
        bf16* p = en + base_at(i) * 4096 + lane * 8;
#pragma unroll
        for (int j = 0; j < 8; ++j) { float* r = run + j * 8;
            v4u o; o.x = pk2(r[0], r[1]); o.y = pk2(r[2], r[3]); o.z = pk2(r[4], r[5]); o.w = pk2(r[6], r[7]); *(v4u*)(p + j * 512) = o;
            r[0] = d0.x * r[0] + bflo(inc[j].x); r[1] = d0.y * r[1] + bfhi(inc[j].x); r[2] = d0.z * r[2] + bflo(inc[j].y); r[3] = d0.w * r[3] + bfhi(inc[j].y);
            r[4] = d1.x * r[4] + bflo(inc[j].z); r[5] = d1.y * r[5] + bfhi(inc[j].z); r[6] = d1.z * r[6] + bflo(inc[j].w); r[7] = d1.w * r[7] + bfhi(inc[j].w); } };
    ld(0, q0, a0, b0); ld(1, q1, a1, b1);
    for (int i = 0; i < NCH; i += 3) {
        step(i, q0, a0, b0, q2, a2, b2);
        if (i + 1 < NCH) step(i + 1, q1, a1, b1, q0, a0, b0);
        if (i + 2 < NCH) step(i + 2, q2, a2, b2, q1, a1, b1);
    }
}
template <bool SSD>
__device__ __forceinline__ void chunk_s2_slice(const Ctx& C, int chain, int sl) {
    constexpr int NH = SSD ? 8 : 4;
    static_assert(NCH % 4 == 0, "ring of four");
    const int b = chain / (2 * NH), d = (chain / NH) & 1, h = chain % NH, lane = C.lane;
    const bf16* st = (const bf16*)(C.ws + (SSD ? WS_SST : WS_GST)) + sl * 1024 + lane * 8; bf16* en = (bf16*)(C.ws + (SSD ? WS_SEN : WS_GEN)) + sl * 1024 + lane * 8; const float* dec = (const float*)(C.ws + (SSD ? WS_SDEC : WS_GDEC));
    const int k0 = (lane & 7) * 8;
    float run[16];
#pragma unroll
    for (int e = 0; e < 16; ++e) run[e] = 0.f;
    auto chunk_at = [&](int i) { return d == 0 ? i : (i < NCTXCH ? NCTXCH - 1 - i : NCH + NCTXCH - 1 - i); };
    auto base_at = [&](int i) { return (((size_t)b * NCH + chunk_at(i)) * 2 + d) * NH + h; };
    v4u q0[2], q1[2], q2[2], q3[2]; f32x4 a0, b0, a1, b1, a2, b2, a3, b3;
    auto ld = [&](int i, v4u (&q)[2], f32x4& da, f32x4& db) { const size_t base = base_at(i);
        q[0] = *(const v4u*)(st + base * 4096); q[1] = *(const v4u*)(st + base * 4096 + 512);
        if (SSD) { const float dd = dec[base]; da = (f32x4){dd, dd, dd, dd}; db = da; } else { da = *(const f32x4*)(dec + base * 64 + k0); db = *(const f32x4*)(dec + base * 64 + k0 + 4); } };
    auto step = [&](int i, const v4u (&inc)[2], const f32x4& d0, const f32x4& d1, v4u (&pq)[2], f32x4& pa, f32x4& pb) {
        if (i + 3 < NCH) ld(i + 3, pq, pa, pb);
        bf16* p = en + base_at(i) * 4096;
#pragma unroll
        for (int j = 0; j < 2; ++j) { float* r = run + j * 8;
            v4u o; o.x = pk2(r[0], r[1]); o.y = pk2(r[2], r[3]); o.z = pk2(r[4], r[5]); o.w = pk2(r[6], r[7]); *(v4u*)(p + j * 512) = o;
            r[0] = d0.x * r[0] + bflo(inc[j].x); r[1] = d0.y * r[1] + bfhi(inc[j].x); r[2] = d0.z * r[2] + bflo(inc[j].y); r[3] = d0.w * r[3] + bfhi(inc[j].y);
            r[4] = d1.x * r[4] + bflo(inc[j].z); r[5] = d1.y * r[5] + bfhi(inc[j].z); r[6] = d1.z * r[6] + bflo(inc[j].w); r[7] = d1.w * r[7] + bfhi(inc[j].w); } };
    ld(0, q0, a0, b0); ld(1, q1, a1, b1); ld(2, q2, a2, b2);
    for (int i = 0; i < NCH; i += 4) {
        step(i, q0, a0, b0, q3, a3, b3);
        step(i + 1, q1, a1, b1, q0, a0, b0);
        step(i + 2, q2, a2, b2, q1, a1, b1);
        step(i + 3, q3, a3, b3, q2, a2, b2);
    }
}
__device__ __forceinline__ bf16x8 pack_p(f32x4 a, f32x4 b) { const v4u w = (v4u){pk2(a.x, a.y), pk2(a.z, a.w), pk2(b.x, b.y), pk2(b.z, b.w)}; return __builtin_bit_cast(bf16x8, w); }
__device__ __forceinline__ void ssd_s3(const Ctx& C, int l, int unit, const float* alog, const float* dskip, const float* normw) {
    const int b = unit / (NCH * 2), rem = unit - b * (NCH * 2), c = rem >> 1, g = rem & 1; const size_t m0 = (size_t)b * SB + c * CH;
    LAS unsigned char* XT = C.lds;
    LAS unsigned char* KR = C.lds + 4 * TILE_B; LAS unsigned char* QR = C.lds + 5 * TILE_B;
    LAS float* cums = (LAS float*)(C.lds + 6 * TILE_B);
    LAS float* ssx = cums + 1024;
    __syncthreads();
    chunk_cums<true>(C, l, m0, g * 4, 4, cums, alog);
    { const int s = C.tid >> 3, sub = C.tid & 7; const bf16* r = (const bf16*)(C.ws + WS_XBC) + (m0 + s) * 768;
#pragma unroll
      for (int hl = 0; hl < 4; ++hl) *(LAS v4u*)(XT + hl * TILE_B + s * TP + sub * 16) = *(const v4u*)(r + (g * 4 + hl) * 64 + sub * 8);
      *(LAS v4u*)(KR + s * TP + sub * 16) = *(const v4u*)(r + 512 + g * 64 + sub * 8); *(LAS v4u*)(QR + s * TP + sub * 16) = *(const v4u*)(r + 640 + g * 64 + sub * 8); }
    const int w = C.wave, hl = w >> 1, lh = w & 1, h = g * 4 + hl, lane = C.lane, fr = lane & 15, fq = lane >> 4;
    bf16x8 hst[2][4][2];
    { const bf16* stb = (const bf16*)(C.ws + WS_SEN) + (((size_t)b * NCH + c) * 2 * 8 + h) * 4096;
#pragma unroll
      for (int d = 0; d < 2; ++d)
#pragma unroll
          for (int vb = 0; vb < 4; ++vb)
#pragma unroll
              for (int ks = 0; ks < 2; ++ks) hst[d][vb][ks] = *(const bf16x8*)(stb + (size_t)d * 8 * 4096 + (vb * 16 + fr) * 64 + ks * 32 + fq * 8);
 }
    __syncthreads();
    const LAS float* cf = cums + hl * 64; const LAS float* cb = cums + 256 + hl * 64; const LAS float* df = cums + 512 + hl * 64; const LAS float* db = cums + 768 + hl * 64;
    const LAS unsigned char* VT = XT + hl * TILE_B;
    bf16x8 cq[2][2];
#pragma unroll
    for (int lb = 0; lb < 2; ++lb)
#pragma unroll
        for (int ks = 0; ks < 2; ++ks) cq[lb][ks] = row_frag(QR, (2 * lh + lb) * 16 + fr, ks * 32 + fq * 8);
    f32x4 ao[2][4];
#pragma unroll
    for (int lb = 0; lb < 2; ++lb)
#pragma unroll
        for (int vb = 0; vb < 4; ++vb) ao[lb][vb] = (f32x4){0.f, 0.f, 0.f, 0.f};
    if (XINTRA) {
        f32x4 ap[2][4];
#pragma unroll
        for (int sb = 0; sb < 4; ++sb) { const bf16x8 k0f = row_frag(KR, sb * 16 + fr, fq * 8), k1f = row_frag(KR, sb * 16 + fr, 32 + fq * 8);
#pragma unroll
            for (int lb = 0; lb < 2; ++lb) { f32x4 a = (f32x4){0.f, 0.f, 0.f, 0.f}; a = __builtin_amdgcn_mfma_f32_16x16x32_bf16(k0f, cq[lb][0], a, 0, 0, 0); a = __builtin_amdgcn_mfma_f32_16x16x32_bf16(k1f, cq[lb][1], a, 0, 0, 0); ap[lb][sb] = a; } }
#pragma unroll
        for (int lb = 0; lb < 2; ++lb) { const int lrow = (2 * lh + lb) * 16 + fr; const float cfl = cf[lrow], cbl = cb[lrow];
#pragma unroll
            for (int sb = 0; sb < 4; ++sb) { const int s0 = sb * 16 + 4 * fq; const f32x4 cfs = *(const LAS f32x4*)(cf + s0), cbs = *(const LAS f32x4*)(cb + s0), dfs = *(const LAS f32x4*)(df + s0), dbs = *(const LAS f32x4*)(db + s0);
                f32x4 m;
                m.x = (s0 + 0 <= lrow ? dfs.x * __expf(fminf(cfl - cfs.x, 0.f)) : 0.f) + (s0 + 0 >= lrow ? dbs.x * __expf(fminf(cbl - cbs.x, 0.f)) : 0.f);
                m.y = (s0 + 1 <= lrow ? dfs.y * __expf(fminf(cfl - cfs.y, 0.f)) : 0.f) + (s0 + 1 >= lrow ? dbs.y * __expf(fminf(cbl - cbs.y, 0.f)) : 0.f);
                m.z = (s0 + 2 <= lrow ? dfs.z * __expf(fminf(cfl - cfs.z, 0.f)) : 0.f) + (s0 + 2 >= lrow ? dbs.z * __expf(fminf(cbl - cbs.z, 0.f)) : 0.f);
                m.w = (s0 + 3 <= lrow ? dfs.w * __expf(fminf(cfl - cfs.w, 0.f)) : 0.f) + (s0 + 3 >= lrow ? dbs.w * __expf(fminf(cbl - cbs.w, 0.f)) : 0.f);
                ap[lb][sb] *= m; } }
#pragma unroll
        for (int kk = 0; kk < 2; ++kk) { bf16x8 pf[2]; pf[0] = pack_p(ap[0][2 * kk], ap[0][2 * kk + 1]); pf[1] = pack_p(ap[1][2 * kk], ap[1][2 * kk + 1]);
#pragma unroll
            for (int vb = 0; vb < 4; ++vb) { const bf16x8 xa = tr_frag(VT, kk * 32 + 4 * fq, kk * 32 + 16 + 4 * fq, vb * 16, lane);
                ao[0][vb] = __builtin_amdgcn_mfma_f32_16x16x32_bf16(xa, pf[0], ao[0][vb], 0, 0, 0); ao[1][vb] = __builtin_amdgcn_mfma_f32_16x16x32_bf16(xa, pf[1], ao[1][vb], 0, 0, 0); } }
    }
    v2u zz_[2][4];
    { const bf16* colz = (const bf16*)(C.ws + WS_COLS);
#pragma unroll
      for (int lb = 0; lb < 2; ++lb)
#pragma unroll
          for (int vb = 0; vb < 4; ++vb) zz_[lb][vb] = *(const v2u*)(colz + (m0 + (2 * lh + lb) * 16 + fr) * INWP + C_Z + h * 64 + vb * 16 + 4 * fq); }
    if (XSTATE) {
#pragma unroll
        for (int d = 0; d < 2; ++d) { bf16x8 cs[2][2];
#pragma unroll
            for (int lb = 0; lb < 2; ++lb) { const int lrow = (2 * lh + lb) * 16 + fr; const float e = __expf(d == 0 ? cf[lrow] : cb[lrow]);
#pragma unroll
                for (int ks = 0; ks < 2; ++ks) cs[lb][ks] = __builtin_bit_cast(bf16x8, scale8(__builtin_bit_cast(v4u, cq[lb][ks]), e)); }
#pragma unroll
            for (int vb = 0; vb < 4; ++vb)
#pragma unroll
                for (int ks = 0; ks < 2; ++ks) { const bf16x8 ha = hst[d][vb][ks];
                    ao[0][vb] = __builtin_amdgcn_mfma_f32_16x16x32_bf16(ha, cs[0][ks], ao[0][vb], 0, 0, 0); ao[1][vb] = __builtin_amdgcn_mfma_f32_16x16x32_bf16(ha, cs[1][ks], ao[1][vb], 0, 0, 0); } }
    }
    const float dsk = dskip[l * 8 + h]; const bf16* cols = (const bf16*)(C.ws + WS_COLS);
    float ssl[2];
#pragma unroll
    for (int lb = 0; lb < 2; ++lb) { const int lrow = (2 * lh + lb) * 16 + fr; float ss = 0.f;
#pragma unroll
        for (int vb = 0; vb < 4; ++vb) { const int p0 = vb * 16 + 4 * fq; const v2u xx = *(const LAS v2u*)(VT + lrow * TP + p0 * 2); const v2u zz = zz_[lb][vb];
            f32x4 y = ao[lb][vb]; y.x = (y.x + dsk * bflo(xx.x)) * fsilu(bflo(zz.x)); y.y = (y.y + dsk * bfhi(xx.x)) * fsilu(bfhi(zz.x)); y.z = (y.z + dsk * bflo(xx.y)) * fsilu(bflo(zz.y)); y.w = (y.w + dsk * bfhi(xx.y)) * fsilu(bfhi(zz.y));
            ao[lb][vb] = y; ss += (y.x * y.x + y.y * y.y) + (y.z * y.z + y.w * y.w); }
        ss += __shfl_xor(ss, 16); ss += __shfl_xor(ss, 32); ssl[lb] = ss; if (fq == 0) ssx[hl * 64 + lrow] = ss; }
    __syncthreads();
    bf16* mix = (bf16*)(C.ws + WS_ACT1);
#pragma unroll
    for (int lb = 0; lb < 2; ++lb) { const int lrow = (2 * lh + lb) * 16 + fr; const float tot = (ssx[lrow] + ssx[64 + lrow]) + (ssx[128 + lrow] + ssx[192 + lrow]); const float rstd = rsqrtf(tot * (1.0f / 256.0f) + EPS);
#pragma unroll
        for (int vb = 0; vb < 4; ++vb) { const int p0 = vb * 16 + 4 * fq; const f32x4 nw = *(const f32x4*)(normw + l * 512 + h * 64 + p0); const f32x4 y = ao[lb][vb];
            v2u o; o.x = pk2(y.x * rstd * nw.x, y.y * rstd * nw.y); o.y = pk2(y.z * rstd * nw.z, y.w * rstd * nw.w); *(v2u*)(mix + (m0 + lrow) * DM + h * 64 + p0) = o; } }
}
__device__ __forceinline__ void gla_s3(const Ctx& C, int l, int unit, const float* normw) {
    const int b = unit / (NCH * 4), rem = unit - b * (NCH * 4), c = rem >> 2, h = rem & 3; const size_t m0 = (size_t)b * SB + c * CH;
    LAS unsigned char* VT = C.lds; LAS unsigned char* KIF = C.lds + TILE_B; LAS unsigned char* KIB = C.lds + 2 * TILE_B; LAS unsigned char* QSF = C.lds + 3 * TILE_B; LAS unsigned char* QSB = C.lds + 4 * TILE_B;
    LAS float* cums = (LAS float*)(C.lds + 5 * TILE_B);
    LAS float* ssx = cums + 8192;
    __syncthreads();
    chunk_cums<false>(C, l, m0, h, 1, cums, nullptr);
    __syncthreads();
    { const int s = C.tid >> 3, sub = C.tid & 7; const bf16* r = (const bf16*)(C.ws + WS_COLS) + (m0 + s) * INWP + h * 64 + sub * 8;
      const v4u vv = *(const v4u*)(r + C_GV), kk = *(const v4u*)(r + C_GK), qq = scale8(*(const v4u*)(r + C_GQ), 0.125f);
      const LAS float* cf = cums + s * 64 + sub * 8; const LAS float* cb = cums + 4096 + s * 64 + sub * 8;
      const f32x4 f0 = *(const LAS f32x4*)cf, f1 = *(const LAS f32x4*)(cf + 4), b0 = *(const LAS f32x4*)cb, b1 = *(const LAS f32x4*)(cb + 4);
      *(LAS v4u*)(VT + s * TP + sub * 16) = vv;
      *(LAS v4u*)(KIF + s * TP + sub * 16) = scale8v(kk, exp4(-f0), exp4(-f1)); *(LAS v4u*)(KIB + s * TP + sub * 16) = scale8v(kk, exp4(-b0), exp4(-b1));
      *(LAS v4u*)(QSF + s * TP + sub * 16) = scale8v(qq, exp4(f0), exp4(f1)); *(LAS v4u*)(QSB + s * TP + sub * 16) = scale8v(qq, exp4(b0), exp4(b1)); }
    __syncthreads();
    const int w = C.wave, lb = w & 3, vh = w >> 2, lane = C.lane, fr = lane & 15, fq = lane >> 4; const int lrow = lb * 16 + fr;
    bf16x8 qf[2][2];
#pragma unroll
    for (int ks = 0; ks < 2; ++ks) { qf[0][ks] = row_frag(QSF, lrow, ks * 32 + fq * 8); qf[1][ks] = row_frag(QSB, lrow, ks * 32 + fq * 8); }
    f32x4 ao[2];
    ao[0] = (f32x4){0.f, 0.f, 0.f, 0.f}; ao[1] = ao[0];
    {   f32x4 ap[4];
#pragma unroll
        for (int sb = 0; sb < 4; ++sb) { f32x4 af = (f32x4){0.f, 0.f, 0.f, 0.f}, ab = af;
#pragma unroll
            for (int ks = 0; ks < 2; ++ks) { af = __builtin_amdgcn_mfma_f32_16x16x32_bf16(row_frag(KIF, sb * 16 + fr, ks * 32 + fq * 8), qf[0][ks], af, 0, 0, 0); ab = __builtin_amdgcn_mfma_f32_16x16x32_bf16(row_frag(KIB, sb * 16 + fr, ks * 32 + fq * 8), qf[1][ks], ab, 0, 0, 0); }
            const int s0 = sb * 16 + 4 * fq; f32x4 m;
            m.x = (s0 + 0 <= lrow ? af.x : 0.f) + (s0 + 0 >= lrow ? ab.x : 0.f); m.y = (s0 + 1 <= lrow ? af.y : 0.f) + (s0 + 1 >= lrow ? ab.y : 0.f);
            m.z = (s0 + 2 <= lrow ? af.z : 0.f) + (s0 + 2 >= lrow ? ab.z : 0.f); m.w = (s0 + 3 <= lrow ? af.w : 0.f) + (s0 + 3 >= lrow ? ab.w : 0.f);
            ap[sb] = m; }
#pragma unroll
        for (int kk = 0; kk < 2; ++kk) { const bf16x8 pf = pack_p(ap[2 * kk], ap[2 * kk + 1]);
#pragma unroll
            for (int vi = 0; vi < 2; ++vi) ao[vi] = __builtin_amdgcn_mfma_f32_16x16x32_bf16(tr_frag(VT, kk * 32 + 4 * fq, kk * 32 + 16 + 4 * fq, (2 * vh + vi) * 16, lane), pf, ao[vi], 0, 0, 0); }
    }
    {   const bf16* stb = (const bf16*)(C.ws + WS_GEN) + (((size_t)b * NCH + c) * 2 * 4 + h) * 4096;
#pragma unroll
        for (int d = 0; d < 2; ++d) { const bf16* sp = stb + (size_t)d * 4 * 4096;
#pragma unroll
            for (int vi = 0; vi < 2; ++vi)
#pragma unroll
                for (int ks = 0; ks < 2; ++ks) ao[vi] = __builtin_amdgcn_mfma_f32_16x16x32_bf16(*(const bf16x8*)(sp + ((2 * vh + vi) * 16 + fr) * 64 + ks * 32 + fq * 8), qf[d][ks], ao[vi], 0, 0, 0); } }
    float ss = 0.f;
#pragma unroll
    for (int vi = 0; vi < 2; ++vi) ss += (ao[vi].x * ao[vi].x + ao[vi].y * ao[vi].y) + (ao[vi].z * ao[vi].z + ao[vi].w * ao[vi].w);
    ss += __shfl_xor(ss, 16); ss += __shfl_xor(ss, 32); if (fq == 0) ssx[vh * 64 + lrow] = ss;
    __syncthreads();
    const float rstd = rsqrtf((ssx[lrow] + ssx[64 + lrow]) * (1.0f / 64.0f) + EPS);
    const bf16* cols = (const bf16*)(C.ws + WS_COLS); bf16* mix = (bf16*)(C.ws + WS_ACT1);
#pragma unroll
    for (int vi = 0; vi < 2; ++vi) { const int v0 = (2 * vh + vi) * 16 + 4 * fq; const f32x4 nw = *(const f32x4*)(normw + l * 64 + v0); const v2u rr = *(const v2u*)(cols + (m0 + lrow) * INWP + C_GR + h * 64 + v0);
        v2u o; o.x = pk2(ao[vi].x * rstd * nw.x * fsilu(bflo(rr.x)), ao[vi].y * rstd * nw.y * fsilu(bfhi(rr.x))); o.y = pk2(ao[vi].z * rstd * nw.z * fsilu(bflo(rr.y)), ao[vi].w * rstd * nw.w * fsilu(bfhi(rr.y)));
        *(v2u*)(mix + (m0 + lrow) * DM + 512 + h * 64 + v0) = o; }
}


__device__ __forceinline__ void ssd_s1_bc(const Ctx& C, int l, int unit, const float* alog) {
    const int b = unit / NCH, c = unit - b * NCH; const size_t m0 = (size_t)b * SB + c * CH;
    LAS unsigned char* XT = C.lds; LAS unsigned char* BT = C.lds + 8 * TILE_B; LAS float* wtab = (LAS float*)(C.lds + 10 * TILE_B);
    const int w = C.wave, lane = C.lane, fr = lane & 15, fq = lane >> 4;
    __syncthreads();
#pragma unroll
    for (int d = 0; d < 2; ++d) { const int s = d == 0 ? lane : 63 - lane;
        const float dtv = ((const float*)(C.ws + WS_DT))[(m0 + s) * 16 + d * 8 + w]; float v = dtv * -expf(alog[l * 16 + d * 8 + w]);
#pragma unroll
        for (int o = 1; o < 64; o <<= 1) { const float t = __shfl_up(v, o); if (lane >= o) v += t; }
        const float tot = __shfl(v, 63);
        wtab[(d * 8 + w) * 64 + s] = dtv * __expf(tot - v);
        if (lane == 63) ((float*)(C.ws + WS_SDEC))[(((size_t)b * NCH + c) * 2 + d) * 8 + w] = __expf(tot); }
    { const int s = C.tid >> 3, sub = C.tid & 7; const bf16* r = (const bf16*)(C.ws + WS_XBC) + (m0 + s) * 768;
#pragma unroll
      for (int hl = 0; hl < 8; ++hl) *(LAS v4u*)(XT + hl * TILE_B + s * TP + sub * 16) = *(const v4u*)(r + hl * 64 + sub * 8);
      *(LAS v4u*)(BT + s * TP + sub * 16) = *(const v4u*)(r + 512 + sub * 8); *(LAS v4u*)(BT + TILE_B + s * TP + sub * 16) = *(const v4u*)(r + 576 + sub * 8); }
    __syncthreads();
    const LAS unsigned char* XH = XT + w * TILE_B; const LAS unsigned char* BG = BT + (w >> 2) * TILE_B;
    bf16x8 bo[4][2];
#pragma unroll
    for (int pb = 0; pb < 4; ++pb)
#pragma unroll
        for (int ks = 0; ks < 2; ++ks) bo[pb][ks] = tr_frag(XH, ks * 32 + 8 * fq, ks * 32 + 8 * fq + 4, pb * 16, lane);
#pragma unroll 1
    for (int d = 0; d < 2; ++d) {
        f32x4 acc[4][4];
#pragma unroll
        for (int nb = 0; nb < 4; ++nb)
#pragma unroll
            for (int pb = 0; pb < 4; ++pb) acc[nb][pb] = (f32x4){0.f, 0.f, 0.f, 0.f};
#pragma unroll
        for (int ks = 0; ks < 2; ++ks) { const LAS float* wp = wtab + (d * 8 + w) * 64 + ks * 32 + 8 * fq; const f32x4 w0 = *(const LAS f32x4*)wp, w1 = *(const LAS f32x4*)(wp + 4);
#pragma unroll
            for (int nb = 0; nb < 4; ++nb) { const bf16x8 a = __builtin_bit_cast(bf16x8, scale8v(__builtin_bit_cast(v4u, tr_frag_g4(BG, ks * 32 + 8 * fq, ks * 32 + 8 * fq + 4, nb, lane)), w0, w1));
#pragma unroll
                for (int pb = 0; pb < 4; ++pb) acc[nb][pb] = __builtin_amdgcn_mfma_f32_16x16x32_bf16(a, bo[pb][ks], acc[nb][pb], 0, 0, 0); } }
        bf16* st = (bf16*)(C.ws + WS_SST) + ((((size_t)b * NCH + c) * 2 + d) * 8 + w) * 4096;
#pragma unroll
        for (int pb = 0; pb < 4; ++pb) { v4u o0, o1; o0.x = pk2(acc[0][pb].x, acc[0][pb].y); o0.y = pk2(acc[0][pb].z, acc[0][pb].w); o0.z = pk2(acc[1][pb].x, acc[1][pb].y); o0.w = pk2(acc[1][pb].z, acc[1][pb].w);
            o1.x = pk2(acc[2][pb].x, acc[2][pb].y); o1.y = pk2(acc[2][pb].z, acc[2][pb].w); o1.z = pk2(acc[3][pb].x, acc[3][pb].y); o1.w = pk2(acc[3][pb].z, acc[3][pb].w);
            bf16* rp = st + (pb * 16 + fr) * 64 + 16 * fq; *(v4u*)rp = o0; *(v4u*)(rp + 8) = o1; }
    }
}
constexpr size_t WS_GC0 = WS_H + ((size_t)136 << 20), WS_GC1 = WS_H + ((size_t)170 << 20);
__device__ __forceinline__ void gla_s1_pair(const Ctx& C, int l, int unit) {
    const int b = unit / (NCH * 2), rem = unit - b * (NCH * 2), c = rem >> 1, hp = rem & 1; const size_t m0 = (size_t)b * SB + c * CH;
    LAS unsigned char* VT = C.lds; LAS unsigned char* KS = C.lds + 2 * TILE_B; LAS float* GS = (LAS float*)(C.lds + 6 * TILE_B);
    const int w = C.wave, lane = C.lane, fr = lane & 15, fq = lane >> 4;
    const int s = C.tid >> 3, sub = C.tid & 7; const size_t m = m0 + s;
    __syncthreads();
    v4u kk[2];
    { const bf16* gr = (const bf16*)(C.ws + WS_G) + m * 512 + hp * 128 + sub * 8; const bf16* cr = (const bf16*)(C.ws + WS_COLS) + m * INWP + hp * 128 + sub * 8;
#pragma unroll
      for (int hd = 0; hd < 4; ++hd) { const int hl = hd >> 1, d = hd & 1; const v4u g = *(const v4u*)(gr + d * 256 + hl * 64); *(LAS f32x4*)(GS + hd * 4096 + s * 64 + sub * 8) = (f32x4){bflo(g.x), bfhi(g.x), bflo(g.y), bfhi(g.y)}; *(LAS f32x4*)(GS + hd * 4096 + s * 64 + sub * 8 + 4) = (f32x4){bflo(g.z), bfhi(g.z), bflo(g.w), bfhi(g.w)}; }
#pragma unroll
      for (int hl = 0; hl < 2; ++hl) { kk[hl] = *(const v4u*)(cr + C_GK + hl * 64); *(LAS v4u*)(VT + hl * TILE_B + s * TP + sub * 16) = *(const v4u*)(cr + C_GV + hl * 64); } }
    __syncthreads();
    if (C.tid < 256) { const int hd = C.tid >> 6, hl = hd >> 1, d = hd & 1, k = C.tid & 63, h = hp * 2 + hl; LAS float* col = GS + hd * 4096 + k; bf16* gc = (bf16*)(C.ws + (d ? WS_GC1 : WS_GC0)) + m0 * 256 + h * 64 + k; float r = 0.f;
#pragma unroll 8
        for (int i = 0; i < 64; ++i) { const int ss = d == 0 ? i : 63 - i; r += col[ss * 64]; col[ss * 64] = r; gc[(size_t)ss * 256] = (bf16)f2bf(r); }
        ((float*)(C.ws + WS_GDEC))[((((size_t)b * NCH + c) * 2 + d) * 4 + h) * 64 + k] = __expf(r); }
    __syncthreads();
#pragma unroll
    for (int hd = 0; hd < 4; ++hd) { const int hl = hd >> 1, d = hd & 1; const LAS float* cs = GS + hd * 4096 + s * 64 + sub * 8; const LAS float* cl = GS + hd * 4096 + (d == 0 ? 63 : 0) * 64 + sub * 8;
        *(LAS v4u*)(KS + hd * TILE_B + s * TP + sub * 16) = scale8v(kk[hl], exp4(*(const LAS f32x4*)cl - *(const LAS f32x4*)cs), exp4(*(const LAS f32x4*)(cl + 4) - *(const LAS f32x4*)(cs + 4))); }
    __syncthreads();
    const int hd = w >> 1, half = w & 1, hl = hd >> 1, d = hd & 1, h = hp * 2 + hl; const LAS unsigned char* KH = KS + hd * TILE_B; const LAS unsigned char* VH = VT + hl * TILE_B;
    f32x4 acc[2][4];
#pragma unroll
    for (int kb = 0; kb < 2; ++kb)
#pragma unroll
        for (int vb = 0; vb < 4; ++vb) acc[kb][vb] = (f32x4){0.f, 0.f, 0.f, 0.f};
#pragma unroll
    for (int ks = 0; ks < 2; ++ks) { bf16x8 bo[4];
#pragma unroll
        for (int vb = 0; vb < 4; ++vb) bo[vb] = tr_frag(VH, ks * 32 + 8 * fq, ks * 32 + 8 * fq + 4, vb * 16, lane);
#pragma unroll
        for (int kb = 0; kb < 2; ++kb) { const bf16x8 a = tr_frag(KH, ks * 32 + 8 * fq, ks * 32 + 8 * fq + 4, (2 * half + kb) * 16, lane);
#pragma unroll
            for (int vb = 0; vb < 4; ++vb) acc[kb][vb] = __builtin_amdgcn_mfma_f32_16x16x32_bf16(a, bo[vb], acc[kb][vb], 0, 0, 0); } }
    bf16* st = (bf16*)(C.ws + WS_GST) + ((((size_t)b * NCH + c) * 2 + d) * 4 + h) * 4096;
#pragma unroll
    for (int kb = 0; kb < 2; ++kb)
#pragma unroll
        for (int vb = 0; vb < 4; ++vb) { v2u o; o.x = pk2(acc[kb][vb].x, acc[kb][vb].y); o.y = pk2(acc[kb][vb].z, acc[kb][vb].w); *(v2u*)(st + (vb * 16 + fr) * 64 + (2 * half + kb) * 16 + 4 * fq) = o; }
}
__device__ __forceinline__ void gla_s3_pair(const Ctx& C, int l, int unit, const float* normw) {
    const int b = unit / (NCH * 2), rem = unit - b * (NCH * 2), c = rem >> 1, hp = rem & 1; const size_t m0 = (size_t)b * SB + c * CH;
    LAS unsigned char* VT = C.lds; LAS unsigned char* QS = C.lds + 2 * TILE_B; LAS unsigned char* KI = C.lds + 6 * TILE_B;
    const int w = C.wave, lane = C.lane, fr = lane & 15, fq = lane >> 4;
    __syncthreads();
    { const int s = C.tid >> 3, sub = C.tid & 7; const size_t m = m0 + s; const bf16* cr = (const bf16*)(C.ws + WS_COLS) + m * INWP + hp * 128 + sub * 8; const bf16* gc0 = (const bf16*)(C.ws + WS_GC0) + m * 256 + hp * 128 + sub * 8; const bf16* gc1 = (const bf16*)(C.ws + WS_GC1) + m * 256 + hp * 128 + sub * 8;
#pragma unroll
      for (int hl = 0; hl < 2; ++hl) { const v4u q8 = scale8(*(const v4u*)(cr + C_GQ + hl * 64), 0.125f), k8 = *(const v4u*)(cr + C_GK + hl * 64);
          *(LAS v4u*)(VT + hl * TILE_B + s * TP + sub * 16) = *(const v4u*)(cr + C_GV + hl * 64);
#pragma unroll
          for (int d = 0; d < 2; ++d) { const v4u cw = *(const v4u*)((d ? gc1 : gc0) + hl * 64); const f32x4 c0 = (f32x4){bflo(cw.x), bfhi(cw.x), bflo(cw.y), bfhi(cw.y)}, c1 = (f32x4){bflo(cw.z), bfhi(cw.z), bflo(cw.w), bfhi(cw.w)};
              *(LAS v4u*)(QS + (hl * 2 + d) * TILE_B + s * TP + sub * 16) = scale8v(q8, exp4(c0), exp4(c1)); *(LAS v4u*)(KI + (hl * 2 + d) * TILE_B + s * TP + sub * 16) = scale8v(k8, exp4(-c0), exp4(-c1)); } } }
    const int hl = w >> 2, lb = w & 3, h = hp * 2 + hl, lrow = lb * 16 + fr;
    bf16x8 hst[2][4][2]; v2u rr_[4];
    { const bf16* stb = (const bf16*)(C.ws + WS_GEN) + (((size_t)b * NCH + c) * 2 * 4 + h) * 4096;
#pragma unroll
      for (int d = 0; d < 2; ++d)
#pragma unroll
          for (int vb = 0; vb < 4; ++vb)
#pragma unroll
              for (int ks = 0; ks < 2; ++ks) hst[d][vb][ks] = *(const bf16x8*)(stb + (size_t)d * 4 * 4096 + (vb * 16 + fr) * 64 + ks * 32 + fq * 8);
      const bf16* colr = (const bf16*)(C.ws + WS_COLS);
#pragma unroll
      for (int vb = 0; vb < 4; ++vb) rr_[vb] = *(const v2u*)(colr + (m0 + lrow) * INWP + C_GR + h * 64 + vb * 16 + 4 * fq); }
    __syncthreads();
    const LAS unsigned char* QF_ = QS + (hl * 2) * TILE_B; const LAS unsigned char* QB_ = QF_ + TILE_B; const LAS unsigned char* KF_ = KI + (hl * 2) * TILE_B; const LAS unsigned char* KB_ = KF_ + TILE_B; const LAS unsigned char* VH = VT + hl * TILE_B;
    bf16x8 qf[2][2];
#pragma unroll
    for (int ks = 0; ks < 2; ++ks) { qf[0][ks] = row_frag(QF_, lrow, ks * 32 + fq * 8); qf[1][ks] = row_frag(QB_, lrow, ks * 32 + fq * 8); }
    f32x4 ao[4];
#pragma unroll
    for (int vb = 0; vb < 4; ++vb) ao[vb] = (f32x4){0.f, 0.f, 0.f, 0.f};
    {   f32x4 ap[4];
#pragma unroll
        for (int sb = 0; sb < 4; ++sb) { f32x4 af = (f32x4){0.f, 0.f, 0.f, 0.f}, ab = af;
#pragma unroll
            for (int ks = 0; ks < 2; ++ks) { af = __builtin_amdgcn_mfma_f32_16x16x32_bf16(row_frag(KF_, sb * 16 + fr, ks * 32 + fq * 8), qf[0][ks], af, 0, 0, 0); ab = __builtin_amdgcn_mfma_f32_16x16x32_bf16(row_frag(KB_, sb * 16 + fr, ks * 32 + fq * 8), qf[1][ks], ab, 0, 0, 0); }
            const int s0 = sb * 16 + 4 * fq; f32x4 m;
            m.x = (s0 + 0 <= lrow ? af.x : 0.f) + (s0 + 0 >= lrow ? ab.x : 0.f); m.y = (s0 + 1 <= lrow ? af.y : 0.f) + (s0 + 1 >= lrow ? ab.y : 0.f);
            m.z = (s0 + 2 <= lrow ? af.z : 0.f) + (s0 + 2 >= lrow ? ab.z : 0.f); m.w = (s0 + 3 <= lrow ? af.w : 0.f) + (s0 + 3 >= lrow ? ab.w : 0.f);
            ap[sb] = m; }
#pragma unroll
        for (int kk = 0; kk < 2; ++kk) { const bf16x8 pf = pack_p(ap[2 * kk], ap[2 * kk + 1]);
#pragma unroll
            for (int vb = 0; vb < 4; ++vb) ao[vb] = __builtin_amdgcn_mfma_f32_16x16x32_bf16(tr_frag(VH, kk * 32 + 4 * fq, kk * 32 + 16 + 4 * fq, vb * 16, lane), pf, ao[vb], 0, 0, 0); }
    }
    {
#pragma unroll
        for (int d = 0; d < 2; ++d)
#pragma unroll
            for (int vb = 0; vb < 4; ++vb)
#pragma unroll
                for (int ks = 0; ks < 2; ++ks) ao[vb] = __builtin_amdgcn_mfma_f32_16x16x32_bf16(hst[d][vb][ks], qf[d][ks], ao[vb], 0, 0, 0); }
    float ss = 0.f;
#pragma unroll
    for (int vb = 0; vb < 4; ++vb) ss += (ao[vb].x * ao[vb].x + ao[vb].y * ao[vb].y) + (ao[vb].z * ao[vb].z + ao[vb].w * ao[vb].w);
    ss += __shfl_xor(ss, 16); ss += __shfl_xor(ss, 32);
    const float rstd = rsqrtf(ss * (1.0f / 64.0f) + EPS);
    bf16* mix = (bf16*)(C.ws + WS_ACT1);
#pragma unroll
    for (int vb = 0; vb < 4; ++vb) { const int v0 = vb * 16 + 4 * fq; const f32x4 nw = *(const f32x4*)(normw + l * 64 + v0); const v2u rr = rr_[vb];
        v2u o; o.x = pk2(ao[vb].x * rstd * nw.x * fsilu(bflo(rr.x)), ao[vb].y * rstd * nw.y * fsilu(bfhi(rr.x))); o.y = pk2(ao[vb].z * rstd * nw.z * fsilu(bflo(rr.y)), ao[vb].w * rstd * nw.w * fsilu(bfhi(rr.y)));
        *(v2u*)(mix + (m0 + lrow) * DM + 512 + h * 64 + v0) = o; }
}
__device__ __forceinline__ void zero_mix(const Ctx& C, int unit, int ssd) {
    bf16* mix = (bf16*)(C.ws + WS_ACT1); const int s = C.tid >> 3, sub = C.tid & 7;
    if (ssd) { const int b = unit / (NCH * 2), rem = unit - b * (NCH * 2), c = rem >> 1, g = rem & 1; const size_t m = (size_t)b * SB + c * CH + s;
        for (int q = 0; q < 4; ++q) *(v4u*)(mix + m * DM + g * 256 + q * 64 + sub * 8) = (v4u){0u, 0u, 0u, 0u}; }
    else { const int b = unit / (NCH * 4), rem = unit - b * (NCH * 4), c = rem >> 2, h = rem & 3; const size_t m = (size_t)b * SB + c * CH + s; *(v4u*)(mix + m * DM + 512 + h * 64 + sub * 8) = (v4u){0u, 0u, 0u, 0u}; }
}
constexpr int NU_S1 = NBATCH * NCH, NU_S3S = NBATCH * NCH * 2, NU_S3G = NBATCH * NCH * 2;
__device__ __forceinline__ void ph_chunk_s1(const Ctx& C, int l) { const float* alog = IN_(I_ALOG);
    for (int u = C.bid; u < 3 * NU_S1; u += C.G) { if (u < NU_S1) ssd_s1_bc(C, l, u, alog); else gla_s1_pair(C, l, u - NU_S1); }
}
__device__ __forceinline__ void ph_s2_assemble(const Args& A, const Ctx& C, int l, int rep) {
    if (C.wave < 6) { const int id = C.bid * 6 + C.wave, chain = id >> 2, sl = id & 3;
        if (chain < NBATCH * 2 * 8) chunk_s2_slice<true>(C, chain, sl); else if (chain < NBATCH * 2 * 12) chunk_s2_slice<false>(C, chain - NBATCH * 2 * 8, sl); }
    ph_assemble(A, C, l, rep);
}
__device__ __forceinline__ void ph_chunk_s3(const Ctx& C, int l, int rep) { const float* alog = IN_(I_ALOG); const float* dskip = IN_(I_SSDD); const float* nws = IN_(I_SSDNW); const float* nwg = IN_(I_GLANW);
    for (int u = C.bid; u < NU_S3S + NU_S3G; u += C.G) {
        const int uu = u < NU_S3S ? u : u - NU_S3S, c = (uu % (NCH * 2)) >> 1; if (l == 1 && c < NCTXCH) continue;
        if (u < NU_S3S) ssd_s3(C, l, uu, alog, dskip, nws); else gla_s3_pair(C, l, uu, nwg);
    }
}
constexpr int RT_VP = 2064;
__device__ __forceinline__ void ph_route(const Args& A, const Ctx& C, int l) { const float* const p_I_NORM2 = IN_(I_NORM2); const float* const p_I_RB = IN_(I_RB); const float* const p_I_RW = IN_(I_RW);
    LAS unsigned char* VH = C.lds; LAS unsigned char* VL = C.lds + 16 * RT_VP; LAS float* PART = (LAS float*)(C.lds + 32 * RT_VP);
    if (C.tid < 32) C.MISC[MISC_CNT + C.tid] = 0u;
    const bf16* Hp = (const bf16*)(C.ws + WS_H); const float* mod = (const float*)(C.ws + WS_MOD) + (size_t)l * 17 * 6144; bf16* vout = (bf16*)(C.ws + WS_ACT1);
    int* toke = (int*)(C.ws + WS_TOKE); int* tokp = (int*)(C.ws + WS_TOKP); float* tokw = (float*)(C.ws + WS_TOKW);
    const int lane = C.lane, w = C.wave, fr = lane & 15, fq = lane >> 4; const int RPW = TT / 256;
    bf16x8 wh[4][2], wl[4][2];
#pragma unroll
    for (int ks = 0; ks < 4; ++ks)
#pragma unroll
        for (int cb = 0; cb < 2; ++cb) { float x[8];
#pragma unroll
            for (int j = 0; j < 8; ++j) x[j] = p_I_RW[(size_t)l * 32768 + (size_t)(128 * w + 32 * ks + 8 * fq + j) * 32 + cb * 16 + fr];
            unsigned hh[4], ll[4];
#pragma unroll
            for (int j = 0; j < 4; ++j) { hh[j] = pk2(x[2 * j], x[2 * j + 1]); ll[j] = pk2(x[2 * j] - bflo(hh[j]), x[2 * j + 1] - bfhi(hh[j])); }
            wh[ks][cb] = __builtin_bit_cast(bf16x8, ((v4u){hh[0], hh[1], hh[2], hh[3]})); wl[ks][cb] = __builtin_bit_cast(bf16x8, ((v4u){ll[0], ll[1], ll[2], ll[3]})); }
    const f32x4* nwp = (const f32x4*)(p_I_NORM2 + l * 1024) + lane; f32x4 nw[4];
#pragma unroll
    for (int q = 0; q < 4; ++q) nw[q] = nwp[64 * q];
    const float rbias = p_I_RB[l * 32 + (lane & 31)];
    const int bb = (C.bid * RPW) / SB;
    for (int t = 0; t < RPW / 16; ++t) {
        const int mt = C.bid * RPW + t * 16, st = mt - bb * SB;
        if (l == 1 && st < CTXL) continue;
        const float* mr = mod + (size_t)(st < CTXL ? 16 : bb) * 6144;
        __syncthreads();
        {
            f32x4 v[2][4]; float ss[2];
#pragma unroll
            for (int r = 0; r < 2; ++r) { const v2u* xr = (const v2u*)(Hp + (size_t)(mt + 2 * w + r) * DM) + lane; ss[r] = 0.f;
#pragma unroll
                for (int q = 0; q < 4; ++q) { const v2u hw = xr[64 * q]; v[r][q] = (f32x4){bflo(hw.x), bfhi(hw.x), bflo(hw.y), bfhi(hw.y)}; ss[r] += (v[r][q].x * v[r][q].x + v[r][q].y * v[r][q].y) + (v[r][q].z * v[r][q].z + v[r][q].w * v[r][q].w); } }
#pragma unroll
            for (int o = 1; o < 64; o <<= 1) { ss[0] += __shfl_xor(ss[0], o); ss[1] += __shfl_xor(ss[1], o); }
#pragma unroll
            for (int r = 0; r < 2; ++r) { const float rstd = rsqrtf(ss[r] * (1.0f / 1024.0f) + EPS); const int row = 2 * w + r;
#pragma unroll
                for (int q = 0; q < 4; ++q) { const int j4 = lane + 64 * q; const f32x4 sh = ((const f32x4*)(mr + 3 * 1024))[j4], sc = ((const f32x4*)(mr + 4 * 1024))[j4];
                    const f32x4 o = (v[r][q] * rstd * nw[q]) * (sc + 1.0f) + sh; v2u hi; hi.x = pk2(o.x, o.y); hi.y = pk2(o.z, o.w);
                    v2u lo; lo.x = pk2(o.x - bflo(hi.x), o.y - bfhi(hi.x)); lo.y = pk2(o.z - bflo(hi.y), o.w - bfhi(hi.y));
                    ((v2u*)(vout + (size_t)(mt + row) * DM))[j4] = hi; *(LAS v2u*)(VH + row * RT_VP + j4 * 8) = hi; *(LAS v2u*)(VL + row * RT_VP + j4 * 8) = lo; } }
        }
        __syncthreads();
        {
            f32x4 acc[2]; acc[0] = (f32x4){0.f, 0.f, 0.f, 0.f}; acc[1] = acc[0];
#pragma unroll
            for (int ks = 0; ks < 4; ++ks) { const bf16x8 ah = *(const LAS bf16x8*)(VH + fr * RT_VP + (128 * w + 32 * ks + 8 * fq) * 2), al = *(const LAS bf16x8*)(VL + fr * RT_VP + (128 * w + 32 * ks + 8 * fq) * 2);
#pragma unroll
                for (int cb = 0; cb < 2; ++cb) { acc[cb] = __builtin_amdgcn_mfma_f32_16x16x32_bf16(ah, wh[ks][cb], acc[cb], 0, 0, 0); acc[cb] = __builtin_amdgcn_mfma_f32_16x16x32_bf16(al, wh[ks][cb], acc[cb], 0, 0, 0); acc[cb] = __builtin_amdgcn_mfma_f32_16x16x32_bf16(ah, wl[ks][cb], acc[cb], 0, 0, 0); } }
#pragma unroll
            for (int cb = 0; cb < 2; ++cb) { PART[w * 512 + (4 * fq + 0) * 32 + cb * 16 + fr] = acc[cb].x; PART[w * 512 + (4 * fq + 1) * 32 + cb * 16 + fr] = acc[cb].y; PART[w * 512 + (4 * fq + 2) * 32 + cb * 16 + fr] = acc[cb].z; PART[w * 512 + (4 * fq + 3) * 32 + cb * 16 + fr] = acc[cb].w; }
        }
        __syncthreads();
        {
            const int row = C.tid >> 5, e = lane & 31, half = lane >> 5; float lg = rbias;
#pragma unroll
            for (int ww = 0; ww < 8; ++ww) lg += PART[ww * 512 + row * 32 + e];
            int es[4]; float vs[4];
#pragma unroll
            for (int k = 0; k < 4; ++k) { float mx = lg;
#pragma unroll
                for (int o = 1; o < 32; o <<= 1) mx = fmaxf(mx, __shfl_xor(mx, o));
                const unsigned long long bal = __ballot(lg == mx); const unsigned bits = (unsigned)(bal >> (32 * half)); const int first = __ffs((int)bits) - 1;
                es[k] = first; vs[k] = mx; if (e == first) lg = -3.0e38f; }
            const float p1 = expf(vs[1] - vs[0]), p2 = expf(vs[2] - vs[0]), p3 = expf(vs[3] - vs[0]); const float inv = 1.0f / (1.0f + p1 + p2 + p3);
            if (e < 4) { const int ek = e == 0 ? es[0] : e == 1 ? es[1] : e == 2 ? es[2] : es[3]; const float wk = (e == 0 ? 1.0f : e == 1 ? p1 : e == 2 ? p2 : p3) * inv; const size_t m = (size_t)(mt + row);
                const unsigned pos = atomicAdd((unsigned*)&C.MISC[MISC_CNT + ek], 1u);
                toke[m * 4 + e] = ek; tokp[m * 4 + e] = (int)pos; tokw[m * 4 + e] = wk; }
        }
    }
    __syncthreads();
    if (C.tid < 32) ((int*)(C.ws + WS_WGCNT))[C.bid * 32 + C.tid] = (int)C.MISC[MISC_CNT + C.tid];
}
__device__ __forceinline__ void ph_slots(const Args& A, const Ctx& C, int l) {
    LAS int* wc = (LAS int*)C.lds;
    LAS int* ps = wc + 256 * 32;
    const int* wgcnt = (const int*)(C.ws + WS_WGCNT);
    for (int idx = C.tid; idx < C.G * 32; idx += NTHREADS) wc[idx] = wgcnt[idx];
    __syncthreads();
    { const int e = C.tid & 31, part = C.tid >> 5; int tot = 0, base = 0;
#pragma unroll
      for (int k = 0; k < 16; ++k) { const int g = part * 16 + k; const int c = wc[g * 32 + e]; tot += c; base += g < C.bid ? c : 0; }
      ps[part * 32 + e] = tot; ps[512 + part * 32 + e] = base; }
    __syncthreads();
    if (C.tid < 64) {
        const int e = C.tid & 31; int tot = 0, base = 0;
#pragma unroll
        for (int k = 0; k < 16; ++k) { tot += ps[k * 32 + e]; base += ps[512 + k * 32 + e]; }
        const int padded = (tot + 255) & ~255; int incl = padded;
#pragma unroll
        for (int o = 1; o < 32; o <<= 1) { const int t = __shfl_up(incl, o); if (e >= o) incl += t; }
        const int off = incl - padded;
        if (C.tid < 32) { C.MISC[MISC_SB + e] = (unsigned)(off + base); ps[1024 + e] = tot; ps[1056 + e] = off;
            if (C.bid == 0) { int* meta = (int*)(C.ws + WS_META); meta[e] = off >> 8; if (e == 31) meta[32] = incl >> 8; } }
    }
    __syncthreads();
    const int* toke = (const int*)(C.ws + WS_TOKE); const int* tokp = (const int*)(C.ws + WS_TOKP); int* toks = (int*)(C.ws + WS_TOKS); int* stok = (int*)(C.ws + WS_STOK);
    if (C.bid < 32) { const int tot = ps[1024 + C.bid], off = ps[1056 + C.bid], p2 = tot + C.tid; if (p2 < ((tot + 255) & ~255)) stok[off + p2] = 0; }
    const int RPW = TT / 256;
    int ee[3], pp[3];
#pragma unroll
    for (int k = 0; k < 3; ++k) { const int idx = C.tid + k * NTHREADS; ee[k] = 0; pp[k] = 0; if (idx < RPW * 4) { const size_t m = (size_t)C.bid * RPW + (idx >> 2); ee[k] = toke[m * 4 + (idx & 3)]; pp[k] = tokp[m * 4 + (idx & 3)]; } }
    static_assert(RPW * 4 <= 3 * NTHREADS, "three items per thread");
#pragma unroll
    for (int k = 0; k < 3; ++k) { const int idx = C.tid + k * NTHREADS; if (idx < RPW * 4) { const int m = C.bid * RPW + (idx >> 2); const int b = m / SB, s = m - b * SB;
        if (!(l == 1 && s < CTXL)) { const int slot = (int)C.MISC[MISC_SB + ee[k]] + pp[k]; toks[(size_t)m * 4 + (idx & 3)] = slot; stok[slot] = m; } } }
}
__device__ __forceinline__ void ph_combine(const Args& A, const Ctx& C, int l) { const float* const p_I_FINW = IN_(I_FINW); const float* const p_I_NORM1 = IN_(I_NORM1); float* const p_OUT = (float*)IN_(N_IN);
    const bf16* Y = (const bf16*)(C.ws + WS_XG); bf16* Hp = (bf16*)(C.ws + WS_H); const float* modl = (const float*)(C.ws + WS_MOD) + (size_t)l * 17 * 6144;
    const int* tokp = (const int*)(C.ws + WS_TOKS); const float* tokw = (const float*)(C.ws + WS_TOKW);
    const int gw = C.bid * NWAVES + C.wave, NGW = C.G * NWAVES, lane = C.lane;
    const int NR = l == 0 ? TT : NBATCH * SEQL;
#define ROW_OF(i_) (l == 0 ? (i_) : ((i_) >> 12) * SB + CTXL + ((i_) & 4095))
    const f32x4* nwp = (const f32x4*)(l == 0 ? p_I_NORM1 + 1024 : p_I_FINW); f32x4 nw[4];
#pragma unroll
    for (int q = 0; q < 2; ++q) { nw[2 * q] = nwp[(lane + 64 * q) * 2]; nw[2 * q + 1] = nwp[(lane + 64 * q) * 2 + 1]; }
    int s0[4], s1[4], s2[4]; float w0[4], w1[4], w2[4];
    v4u y0[4][2], y1[4][2]; f32x4 h0[4], h1[4];
#define CMB_SLOTS(i_, s_, w_) do { const size_t m_ = (size_t)ROW_OF(i_); _Pragma("unroll") for (int k = 0; k < 4; ++k) { s_[k] = tokp[m_ * 4 + k]; w_[k] = tokw[m_ * 4 + k]; } } while (0)
#define CMB_DATA(i_, s_, y_, h_) do { const size_t m_ = (size_t)ROW_OF(i_); _Pragma("unroll") for (int q = 0; q < 2; ++q) { const int j8 = lane + 64 * q; \
        _Pragma("unroll") for (int k = 0; k < 4; ++k) y_[k][q] = ((const v4u*)(Y + (size_t)s_[k] * DM))[j8]; \
        { const v4u hw_ = ((const v4u*)(Hp + m_ * DM))[j8]; h_[2 * q] = (f32x4){bflo(hw_.x), bfhi(hw_.x), bflo(hw_.y), bfhi(hw_.y)}; h_[2 * q + 1] = (f32x4){bflo(hw_.z), bfhi(hw_.z), bflo(hw_.w), bfhi(hw_.w)}; } } } while (0)
    if (gw < NR) { CMB_SLOTS(gw, s0, w0); if (gw + NGW < NR) CMB_SLOTS(gw + NGW, s1, w1); CMB_DATA(gw, s0, y0, h0); }
    for (int i = gw; i < NR; i += NGW) {
        if (i + NGW < NR) CMB_DATA(i + NGW, s1, y1, h1);
        if (i + 2 * NGW < NR) CMB_SLOTS(i + 2 * NGW, s2, w2);
        const int m = ROW_OF(i); const int b = m / SB, s = m - b * SB; const int rr = s < CTXL ? 16 : b; const float* g5 = modl + (size_t)rr * 6144 + 5 * 1024;
        float hn[16]; float ss = 0.f;
#pragma unroll
        for (int q = 0; q < 2; ++q) { const int j8 = lane + 64 * q; float f[8];
#pragma unroll
            for (int k = 0; k < 8; ++k) f[k] = 0.f;
#pragma unroll
            for (int k = 0; k < 4; ++k) { const v4u y = y0[k][q]; const float wk = w0[k];
                f[0] += wk * bflo(y.x); f[1] += wk * bfhi(y.x); f[2] += wk * bflo(y.y); f[3] += wk * bfhi(y.y); f[4] += wk * bflo(y.z); f[5] += wk * bfhi(y.z); f[6] += wk * bflo(y.w); f[7] += wk * bfhi(y.w); }
            const f32x4 ha = h0[2 * q], hb = h0[2 * q + 1];
            const f32x4 ga = ((const f32x4*)g5)[j8 * 2], gb = ((const f32x4*)g5)[j8 * 2 + 1];
            hn[q * 8 + 0] = ha.x + ga.x * f[0]; hn[q * 8 + 1] = ha.y + ga.y * f[1]; hn[q * 8 + 2] = ha.z + ga.z * f[2]; hn[q * 8 + 3] = ha.w + ga.w * f[3];
            hn[q * 8 + 4] = hb.x + gb.x * f[4]; hn[q * 8 + 5] = hb.y + gb.y * f[5]; hn[q * 8 + 6] = hb.z + gb.z * f[6]; hn[q * 8 + 7] = hb.w + gb.w * f[7];
#pragma unroll
            for (int k = 0; k < 8; ++k) ss += hn[q * 8 + k] * hn[q * 8 + k]; }
        const float rstd = rsqrtf(wave_sum(ss) * (1.0f / 1024.0f) + EPS);
        if (l == 0) {
            const float* mn = (const float*)(C.ws + WS_MOD) + (size_t)17 * 6144 + (size_t)rr * 6144; bf16* uo = (bf16*)(C.ws + WS_ACT1) + (size_t)m * DM;
#pragma unroll
            for (int q = 0; q < 2; ++q) { const int j8 = lane + 64 * q;
                { v4u hw; hw.x = pk2(hn[q * 8], hn[q * 8 + 1]); hw.y = pk2(hn[q * 8 + 2], hn[q * 8 + 3]); hw.z = pk2(hn[q * 8 + 4], hn[q * 8 + 5]); hw.w = pk2(hn[q * 8 + 6], hn[q * 8 + 7]); ((v4u*)(Hp + (size_t)m * DM))[j8] = hw; }
                float o[8];
#pragma unroll
                for (int hh = 0; hh < 2; ++hh) { const f32x4 w = nw[2 * q + hh], sh = ((const f32x4*)mn)[j8 * 2 + hh], sc = ((const f32x4*)(mn + 1024))[j8 * 2 + hh];
                    o[hh * 4 + 0] = (hn[q * 8 + hh * 4 + 0] * rstd * w.x) * (sc.x + 1.0f) + sh.x; o[hh * 4 + 1] = (hn[q * 8 + hh * 4 + 1] * rstd * w.y) * (sc.y + 1.0f) + sh.y;
                    o[hh * 4 + 2] = (hn[q * 8 + hh * 4 + 2] * rstd * w.z) * (sc.z + 1.0f) + sh.z; o[hh * 4 + 3] = (hn[q * 8 + hh * 4 + 3] * rstd * w.w) * (sc.w + 1.0f) + sh.w; }
                v4u p; p.x = pk2(o[0], o[1]); p.y = pk2(o[2], o[3]); p.z = pk2(o[4], o[5]); p.w = pk2(o[6], o[7]); ((v4u*)uo)[j8] = p; }
        } else {
            float* orow = p_OUT + ((size_t)b * SEQL + (s - CTXL)) * DM;
#pragma unroll
            for (int q = 0; q < 2; ++q) { const int j8 = lane + 64 * q;
#pragma unroll
                for (int hh = 0; hh < 2; ++hh) { const f32x4 w = nw[2 * q + hh];
                    ((f32x4*)orow)[j8 * 2 + hh] = (f32x4){hn[q * 8 + hh * 4] * rstd * w.x, hn[q * 8 + hh * 4 + 1] * rstd * w.y, hn[q * 8 + hh * 4 + 2] * rstd * w.z, hn[q * 8 + hh * 4 + 3] * rstd * w.w}; } }
        }
#pragma unroll
        for (int k = 0; k < 4; ++k) { s0[k] = s1[k]; w0[k] = w1[k]; s1[k] = s2[k]; w1[k] = w2[k]; y0[k][0] = y1[k][0]; y0[k][1] = y1[k][1]; h0[k] = h1[k]; }
    }
#undef ROW_OF
#undef CMB_SLOTS
#undef CMB_DATA
}
constexpr int NLP = 12;
constexpr int N_PHASES = 3 + 2 * NLP;
constexpr int NWG_ = 256;
#ifndef TAIL_CONV
#define TAIL_CONV 6
#endif
#ifndef GA_
#define GA_ true
#endif
#ifndef GS_
#define GS_ true
#endif
#ifndef PHMASK
#define PHMASK 0xffff
#endif
#define PH_ON(id) (lo <= (id) && (id) < hi && ((PHMASK >> ((id) < 3 ? (id) : 3 + ((id) - 3) % NLP)) & 1))
#define FRESH() do { int t_ = C.tid; unsigned wl_ = __builtin_amdgcn_readfirstlane((unsigned)(unsigned long long)C.ws), wh_ = __builtin_amdgcn_readfirstlane((unsigned)((unsigned long long)C.ws >> 32)); \
        int g_ = __builtin_amdgcn_readfirstlane(C.G), b_ = __builtin_amdgcn_readfirstlane(C.bid); \
        asm volatile("" : "+s"(wl_), "+s"(wh_), "+s"(g_), "+s"(b_), "+v"(t_)); \
        C.tid = t_; C.G = g_; C.bid = b_; C.ws = (GAS unsigned char*)(((unsigned long long)wh_ << 32) | wl_); C.lane = C.tid & 63; C.wave = __builtin_amdgcn_readfirstlane(C.tid >> 6); ws = C.ws; } while (0)
#ifdef DBLBAR
#define PH_SEAM(id) do { if ((id) + 1 < hi) { xcd_barrier(bar); xcd_barrier(bar); } } while (0)
#else
#define PH_SEAM(id) do { if ((id) + 1 < hi) xcd_barrier(bar); } while (0)
#endif
#ifndef PHREP
#define PHREP 0ull
#endif
#if PHREP
#ifndef PHREPN
#define PHREPN 1
#endif
#define REPS_(id) (((id) < 3 || (((PHREP >> (3 + ((id) - 3) % NLP)) | (PHREP >> (3 + NLP + ((id) - 3) % NLP))) & 1ull)) ? (int)((PHREP >> (id)) & 1ull) * PHREPN : 0)
#define PH_BEGIN(id) if (PH_ON(id)) { for (int rep_ = 0; rep_ <= REPS_(id); ++rep_) { FRESH();
#define PH_END(id) if (rep_ < REPS_(id)) xcd_barrier(bar); } PH_SEAM(id); }
#else
#define PH_BEGIN(id) if (PH_ON(id)) { const int rep_ = 0; (void)rep_; FRESH();
#define PH_END(id) PH_SEAM(id); }
#endif
template <int L> __device__ __forceinline__ void layer_phases(const Args& args, Ctx& C, const XcdBarrier& bar, const int lo, const int hi) {
    GAS unsigned char* ws = C.ws; constexpr int l = L; constexpr int pb = 3 + NLP * L;
        PH_BEGIN(pb + 0)
            pg8::Gemm g{(const bf16*)(ws + WS_ACT1), (const bf16*)(ws + WS_WINT) + (size_t)l * INWP * 1024, TT, INWP, 1024}; pg8::StaticOrder S; S.init(TT, INWP, C.G, C.bid);
            pg8::EpiBf16 E{(bf16*)(ws + WS_COLS), INWP, nullptr, 0, 0};
            pg8::gemm_phase<pg8::EpiBf16, pg8::StaticOrder, GA_, GS_>(C.lds, g, S, E, C.tid);
            if (rep_ == 0 && C.bid >= ((TT / 256) * (INWP / 256)) % NWG_) convert_experts(args, C, l, TAIL_CONV);
            PH_END(pb + 0)
        PH_BEGIN(pb + 1) ph_prep(args, C, l, rep_); PH_END(pb + 1)
        PH_BEGIN(pb + 2)
            { pg8::Gemm g{(const bf16*)(ws + WS_AQ), (const bf16*)(ws + WS_WUQT) + (size_t)l * 512 * 256, TT, 512, 256}; pg8::StaticOrder S; S.init(TT, 512, C.G, C.bid);
              pg8::EpiBf16 E{(bf16*)(ws + WS_QRAW), 512, nullptr, 0, 0}; pg8::gemm_phase<pg8::EpiBf16, pg8::StaticOrder, GA_, GS_>(C.lds, g, S, E, C.tid); }
            { pg8::Gemm g{(const bf16*)(ws + WS_AKV), (const bf16*)(ws + WS_WUKVT) + (size_t)l * 512 * 256, TT, 512, 256}; pg8::StaticOrder S; S.init(TT, 512, C.G, C.bid);
              pg8::EpiBf16 E{(bf16*)(ws + WS_KV), 512, nullptr, 0, 0}; pg8::gemm_phase<pg8::EpiBf16, pg8::StaticOrder, GA_, GS_>(C.lds, g, S, E, C.tid); }
            ph_chunk_s1(C, l);
            PH_END(pb + 2)
        PH_BEGIN(pb + 3) ph_s2_assemble(args, C, l, rep_); PH_END(pb + 3)
        PH_BEGIN(pb + 4) attn_queue(C, l, rep_); PH_END(pb + 4)
        PH_BEGIN(pb + 5) ph_chunk_s3(C, l, rep_); PH_END(pb + 5)
        PH_BEGIN(pb + 6)
            pg8::Gemm g{(const bf16*)(ws + WS_ACT1), (const bf16*)(ws + WS_WOUTT) + (size_t)l * 1024 * 1024, TT, 1024, 1024};
            pg8::MapOrder S; S.init(l == 0 ? TT : NBATCH * SEQL, 1024, C.G, C.bid); S.skipctx = l;
            pg8::EpiResid E{IN_(I_X), IN_(I_CTX), (const bf16*)(ws + WS_H), (bf16*)(ws + WS_H), (const float*)(ws + WS_MOD) + (size_t)l * 17 * 6144, l};
            pg8::gemm_phase<pg8::EpiResid, pg8::MapOrder, GA_, GS_>(C.lds, g, S, E, C.tid);
            if (l == 0 && rep_ == 0 && C.bid >= ((TT / 256) * 4) % NWG_) convert_experts(args, C, l, TAIL_CONV);
            PH_END(pb + 6)
        PH_BEGIN(pb + 7) ph_route(args, C, l); PH_END(pb + 7)
        PH_BEGIN(pb + 8) ph_slots(args, C, l); PH_END(pb + 8)
        PH_BEGIN(pb + 9)
            pg8::Gemm g{(const bf16*)(ws + WS_ACT1), (const bf16*)(ws + WS_W1T), MAXSLOT, 32 * 2048, 1024};
            pg8::MoeOrder S{(const int*)(ws + WS_META), 8, C.G, C.bid};
            pg8::EpiSwiglu E{(bf16*)(ws + WS_ACTB), IN_(I_B1) + (size_t)l * 32 * 2048};
            pg8::gemm_phase_gather<pg8::EpiSwiglu, pg8::MoeOrder>(C.lds, g, S, E, C.tid, (const int*)(ws + WS_STOK));
            PH_END(pb + 9)
        PH_BEGIN(pb + 10)
            pg8::Gemm g{(const bf16*)(ws + WS_ACTB), (const bf16*)(ws + WS_W2T), MAXSLOT, 32 * 1024, 1024};
            pg8::MoeOrder S{(const int*)(ws + WS_META), 4, C.G, C.bid};
            pg8::EpiBf16 E{(bf16*)(ws + WS_XG), 1024, IN_(I_B2) + (size_t)l * 32 * 1024, 1024, 0};
            pg8::gemm_phase<pg8::EpiBf16, pg8::MoeOrder, GA_, GS_>(C.lds, g, S, E, C.tid);
            PH_END(pb + 10)
        PH_BEGIN(pb + 11) ph_combine(args, C, l); PH_END(pb + 11)
}
__global__ void __launch_bounds__(NTHREADS, 2) fwd_kernel(Args args) {
    extern __shared__ __attribute__((aligned(16))) unsigned char lds_raw[];
    Ctx C;
    C.lds = (LAS unsigned char*)lds_raw; C.MISC = (volatile LAS unsigned*)(C.lds + LDSCTL_OFF); C.ws = (GAS unsigned char*)args.ws;
    C.tid = threadIdx.x; C.lane = C.tid & 63; C.wave = __builtin_amdgcn_readfirstlane(C.tid >> 6); C.G = gridDim.x; C.bid = blockIdx.x;
    for (int u = C.tid; u < (LDS_BYTES - LDSCTL_OFF) / 4; u += NTHREADS) ((LAS unsigned*)(C.lds + LDSCTL_OFF))[u] = 0u;
    __syncthreads();
    if (C.tid <= N_IN) {
        const unsigned long long* ka = (const unsigned long long*)__builtin_amdgcn_kernarg_segment_ptr();
        ((volatile LAS unsigned long long*)(C.lds + PTR_OFF))[C.tid] = ka[C.tid]; }
    __syncthreads();
    XcdBarrier bar = xcd_barrier_post((unsigned*)args.ws + CW_BAR, C.MISC + MISC_BAR);
    const int lo = args.ph_lo, hi = args.ph_hi;
    GAS unsigned char* ws = (GAS unsigned char*)args.ws;
    PH_BEGIN(0) ph_g0(args, C); PH_END(0)
    PH_BEGIN(1) ph_g1(args, C); PH_END(1)
    PH_BEGIN(2) ph_g2(args, C); PH_END(2)
    layer_phases<0>(args, C, bar, lo, hi);
    layer_phases<1>(args, C, bar, lo, hi);
}
#undef PH_ON
#undef PH_SEAM


#ifndef MK_CUTS
#define MK_CUTS 0
#endif
extern "C" void kernel_launch(void* const* d_in, const int* in_sizes, int n_in, void* d_out, int out_size, void* d_ws, size_t ws_size, hipStream_t stream) {
    static int grid = 0;
    if (grid == 0) {
        if (n_in != N_IN || ws_size < WS_END || out_size != NBATCH * SEQL * DM) { fprintf(stderr, "kernel_launch: unexpected shapes (n_in %d, ws %zu, out %d); nothing launched\n", n_in, ws_size, out_size); grid = -1; return; }
        int dev = 0, cus = 0, per_cu = 0;
        if (hipGetDevice(&dev) != hipSuccess || hipDeviceGetAttribute(&cus, hipDeviceAttributeMultiprocessorCount, dev) != hipSuccess) { grid = -1; return; }
        if (hipFuncSetAttribute((const void*)fwd_kernel, hipFuncAttributeMaxDynamicSharedMemorySize, LDS_BYTES) != hipSuccess) { fprintf(stderr, "kernel_launch: hipFuncSetAttribute failed\n"); grid = -1; return; }
        if (hipOccupancyMaxActiveBlocksPerMultiprocessor(&per_cu, (const void*)fwd_kernel, NTHREADS, LDS_BYTES) != hipSuccess || per_cu < 1)
            fprintf(stderr, "kernel_launch: note: occupancy query reports %d workgroups per CU\n", per_cu);
        (void)hipGetLastError();
        if (cus < 256) { fprintf(stderr, "kernel_launch: this kernel is laid out for 256 CUs (found %d); nothing launched\n", cus); grid = -1; return; }
        grid = 256;
    }
    if (grid < 0) return;
    if (hipMemsetAsync((char*)d_ws + WS_CTL, 0, CTL_ZERO_BYTES, stream) != hipSuccess) return;
    Args a{};
    for (int i = 0; i < N_IN; ++i) a.in[i] = (const float*)d_in[i];
    a.out = (float*)d_out; a.ws = (unsigned char*)d_ws;
#if MK_CUTS
    for (int p = 0; p < N_PHASES; ++p) { a.ph_lo = p; a.ph_hi = p + 1; hipLaunchKernelGGL(fwd_kernel, dim3(grid), dim3(NTHREADS), LDS_BYTES, stream, a); }
#else
    a.ph_lo = 0; a.ph_hi = N_PHASES;
    hipLaunchKernelGGL(fwd_kernel, dim3(grid), dim3(NTHREADS), LDS_BYTES, stream, a);
#endif
    const hipError_t le = hipPeekAtLastError();
    if (le != hipSuccess) fprintf(stderr, "kernel_launch: launch failed: %s\n", hipGetErrorName(le));
}
```

```cpp
#include <hip/hip_runtime.h>
#include <cstdio>
#include <cstdint>
namespace pg8 {
#define PG8_LAS __attribute__((address_space(3)))
typedef unsigned short bf16_t;
typedef short bf16x8 __attribute__((ext_vector_type(8)));
typedef float f32x4 __attribute__((ext_vector_type(4)));
typedef unsigned u32x4 __attribute__((ext_vector_type(4)));
constexpr int BM = 256, BK = 64, HALF = 128, HTB = HALF * BK * 2  , STAGE_BYTES = 8 * HTB, NXCD = 8,
#ifndef PG8_WGM
#define PG8_WGM 8
#endif
    WGM = PG8_WGM;

__host__ __device__ __forceinline__ int lds_byte(int r, int c) { const int st = (r >> 4) * 2 + (c >> 5), rr = r & 15, cc = c & 31, ob = rr * 64 + cc * 2; return st * 1024 + (ob ^ (((ob >> 9) & 1) << 5)); }
__host__ __device__ __forceinline__ void stage_rc(int b, int& R, int& C) { const int st = b / 1024, sb = b % 1024, swz = sb ^ (((sb >> 9) & 1) << 5); R = (st >> 1) * 16 + swz / 64; C = (st & 1) * 32 + (swz % 64) / 2; }
__host__ __device__ __forceinline__ int perm32(int rho) { const int n = rho >> 4, i = rho & 15; return 8 * (i >> 2) + 4 * n + (i & 3); }

struct Unit { int pm, pn; };
struct Gemm { const bf16_t* A; const bf16_t* Bt; int M, N, K; };

struct StaticOrder {
    int nM, nN, nwg, G, c;
    __host__ __device__ void init(int M, int N, int G_, int c_) { nM = M / BM; nN = N / BM; nwg = nM * nN; G = G_; c = c_; }
    __host__ __device__ bool next(int i, Unit& u) const {
        const long L = (long)i * G + c; if (L >= nwg) return false;
        int wgid = (int)L; { const int q = nwg / NXCD, r = nwg % NXCD, xcd = wgid % NXCD, off = wgid / NXCD; wgid = (xcd < r ? xcd * (q + 1) : r * (q + 1) + (xcd - r) * q) + off; }
        const int nig = WGM * nN, gid = wgid / nig, fm = gid * WGM, gsz = (nM - fm) < WGM ? (nM - fm) : WGM;
        u.pm = fm + ((wgid % nig) % gsz); u.pn = (wgid % nig) / gsz; return true;
    }
    __device__ __forceinline__ void a_ready(const Unit&) const {}
    __device__ __forceinline__ void done(const Unit&) const {}
};

__device__ __forceinline__ unsigned cvt_pk_bf16(float lo, float hi) { unsigned r; asm volatile("v_cvt_pk_bf16_f32 %0, %1, %2" : "=v"(r) : "v"(lo), "v"(hi)); return r; }
typedef float f32x2 __attribute__((ext_vector_type(2)));
struct EpiBf16 {
    static constexpr bool PERM = true, AFTER_DRAIN = false;
    bf16_t* O; int ldc; const float* bias; int split_cols; size_t split_stride;
    __device__ __forceinline__ void operator()(const f32x4 (&acc)[2][2][4][2], const Unit& u, int wr, int wc, int fr, int fq) const {
        const int row0 = u.pm * BM + wr * 64 + fr; int colt = u.pn * BM; bf16_t* base = O;
        if (split_cols) { const int t = colt / split_cols; base += (size_t)t * split_stride; colt -= t * split_cols; }
        const int col0 = colt + wc * 32 + 8 * fq, bcol0 = u.pn * BM + wc * 32 + 8 * fq;
        f32x4 bv[2][2];
#pragma unroll
        for (int bj = 0; bj < 2; ++bj)
#pragma unroll
            for (int n = 0; n < 2; ++n) bv[bj][n] = bias ? *(const f32x4*)(bias + bcol0 + bj * HALF + 4 * n) : (f32x4){0.f, 0.f, 0.f, 0.f};
#pragma unroll
        for (int ai = 0; ai < 2; ++ai)
#pragma unroll
            for (int m = 0; m < 4; ++m) { bf16_t* rowp = base + (size_t)(row0 + ai * HALF + m * 16) * ldc + col0;
#pragma unroll
                for (int bj = 0; bj < 2; ++bj) { const f32x4 v0 = acc[ai][bj][m][0] + bv[bj][0], v1 = acc[ai][bj][m][1] + bv[bj][1];
                    u32x4 w; w.x = cvt_pk_bf16(v0[0], v0[1]); w.y = cvt_pk_bf16(v0[2], v0[3]); w.z = cvt_pk_bf16(v1[0], v1[1]); w.w = cvt_pk_bf16(v1[2], v1[3]);
                    *(u32x4*)(rowp + bj * HALF) = w; } }
    }
};
struct EpiSwiglu {
    static constexpr bool PERM = true, AFTER_DRAIN = false;
    bf16_t* O; const float* bias;
    __device__ __forceinline__ void operator()(const f32x4 (&acc)[2][2][4][2], const Unit& u, int wr, int wc, int fr, int fq) const {
        const int row0 = u.pm * BM + wr * 64 + fr;
        const int hc0 = (u.pn & 7) * BM + wc * 32 + 8 * fq, bcol0 = u.pn * BM + wc * 32 + 8 * fq;
        f32x4 bv[2][2];
#pragma unroll
        for (int bj = 0; bj < 2; ++bj)
#pragma unroll
            for (int n = 0; n < 2; ++n) bv[bj][n] = *(const f32x4*)(bias + bcol0 + bj * HALF + 4 * n);
#pragma unroll
        for (int ai = 0; ai < 2; ++ai)
#pragma unroll
            for (int m = 0; m < 4; ++m) { bf16_t* rowp = O + (size_t)(row0 + ai * HALF + m * 16) * 1024 + (hc0 >> 1);
#pragma unroll
                for (int bj = 0; bj < 2; ++bj) { const f32x4 v0 = acc[ai][bj][m][0] + bv[bj][0], v1 = acc[ai][bj][m][1] + bv[bj][1];
                    float a[4];
#pragma unroll
                    for (int q = 0; q < 4; ++q) { const float gl = fminf(q < 2 ? v0[2 * q] : v1[2 * q - 4], 7.0f); float li = q < 2 ? v0[2 * q + 1] : v1[2 * q - 3]; li = fminf(fmaxf(li, -7.0f), 7.0f);
                        a[q] = gl * __builtin_amdgcn_rcpf(1.0f + __builtin_amdgcn_exp2f(-2.4554669595930156f * gl)) * (li + 1.0f); }
                    typedef unsigned u32x2 __attribute__((ext_vector_type(2)));
                    u32x2 w; w.x = cvt_pk_bf16(a[0], a[1]); w.y = cvt_pk_bf16(a[2], a[3]);
                    *(u32x2*)(rowp + bj * (HALF / 2)) = w; } }
    }
};
struct EpiResid {
    static constexpr bool PERM = false, AFTER_DRAIN = false;
    const float* x; const float* ctx; const bf16_t* H; bf16_t* Hout; const float* mod; int layer;
    __device__ __forceinline__ void operator()(const f32x4 (&acc)[2][2][4][2], const Unit& u, int wr, int wc, int fr, int fq) const {
        typedef unsigned u32x2 __attribute__((ext_vector_type(2)));
        const int b = u.pm / 17, tin = u.pm - b * 17; const float* gate = mod + (size_t)(tin == 0 ? 16 : b) * 6144 + 2048;
        const float* base = tin == 0 ? ctx + (size_t)b * 256 * 1024 : x + ((size_t)b * 4096 + (size_t)(tin - 1) * 256) * 1024;
        const bf16_t* hb = H + (size_t)u.pm * 256 * 1024; bf16_t* outp = Hout + (size_t)u.pm * 256 * 1024;
        const int rl0 = wr * 64 + fr, col0 = u.pn * BM + wc * 32 + 4 * fq;
        f32x4 gv[2][2];
#pragma unroll
        for (int bj = 0; bj < 2; ++bj)
#pragma unroll
            for (int n = 0; n < 2; ++n) gv[bj][n] = *(const f32x4*)(gate + col0 + bj * HALF + n * 16);
#pragma unroll
        for (int ai = 0; ai < 2; ++ai)
#pragma unroll
            for (int m = 0; m < 4; ++m) { const size_t off = (size_t)(rl0 + ai * HALF + m * 16) * 1024 + col0;
#pragma unroll
                for (int bj = 0; bj < 2; ++bj)
#pragma unroll
                    for (int n = 0; n < 2; ++n) { f32x4 bs;
                        if (layer == 0) bs = *(const f32x4*)(base + off + bj * HALF + n * 16);
                        else { const u32x2 hw = *(const u32x2*)(hb + off + bj * HALF + n * 16); bs = (f32x4){__uint_as_float(hw.x << 16), __uint_as_float(hw.x & 0xffff0000u), __uint_as_float(hw.y << 16), __uint_as_float(hw.y & 0xffff0000u)}; }
                        const f32x4 o = bs + gv[bj][n] * acc[ai][bj][m][n]; u32x2 w; w.x = cvt_pk_bf16(o[0], o[1]); w.y = cvt_pk_bf16(o[2], o[3]); *(u32x2*)(outp + off + bj * HALF + n * 16) = w; } }
    }
};
struct MapOrder : StaticOrder {
    int skipctx;
    __device__ __forceinline__ bool next(int i, Unit& u) const { if (!StaticOrder::next(i, u)) return false; if (skipctx) u.pm = (u.pm >> 4) * 17 + 1 + (u.pm & 15); return true; }
};
struct MoeOrder {
    const int* toff; int npn, G, c;
    __device__ __forceinline__ bool next(int i, Unit& u) const {
        const int nt = toff[32], nwg = nt * npn; const long L = (long)i * G + c; if (L >= (long)nwg) return false;
        int wgid = (int)L; { const int q = nwg / NXCD, r = nwg % NXCD, xcd = wgid % NXCD, off = wgid / NXCD; wgid = (xcd < r ? xcd * (q + 1) : r * (q + 1) + (xcd - r) * q) + off; }
#ifndef MOE_WGM
#define MOE_WGM 8
#endif
        const int nig = MOE_WGM * npn, gid = wgid / nig, fm = gid * MOE_WGM, gsz = (nt - fm) < MOE_WGM ? (nt - fm) : MOE_WGM;
        const int pm = fm + ((wgid % nig) % gsz), pnl = (wgid % nig) / gsz; int e = 0;
        for (int q = 1; q < 32; ++q) e += (toff[q] <= pm) ? 1 : 0;
        u.pm = pm; u.pn = e * npn + pnl; return true;
    }
    __device__ __forceinline__ void a_ready(const Unit&) const {}
    __device__ __forceinline__ void done(const Unit&) const {}
};
template <class Epi, class Sched, bool ALIGN_EPI = false, bool SP2 = false>
__device__ __forceinline__ void gemm_phase(PG8_LAS unsigned char* lds, const Gemm g, const Sched& S, const Epi& E, const int tid) {
    const int  wid = __builtin_amdgcn_readfirstlane(tid >> 6), lane = tid & 63, wr = wid >> 2, wc = wid & 3, fr = lane & 15, fq = lane >> 4;
    const int K = g.K, nt = K / BK;
    unsigned voffA[2], voffB[2];
#pragma unroll
    for (int i = 0; i < 2; ++i) { int R, C; stage_rc(tid * 16 + i * 8192, R, C); const int Rb = Epi::PERM ? ((R & ~31) + perm32(R & 31)) : R;
        voffA[i] = (unsigned)(R * K + C) * 2u; voffB[i] = (unsigned)(Rb * K + C) * 2u; }
    const size_t kstep = (size_t)(BK * 2);
    const size_t hstep = (size_t)HALF * K * 2;
    const size_t tstep = 2 * hstep;
    const unsigned ldsw = (unsigned)wid * 1024u;
    const int aoff = lds_byte(wr * 64 + fr, fq * 8), boff = lds_byte(wc * 32 + fr, fq * 8);
#define PG8_SA(b, h) (((b) * 2 + (h)) * HTB)
#define PG8_SB(b, h) ((4 + (b) * 2 + (h)) * HTB)
#define PG8_STAGE(bufoff, gbase, voff) do { _Pragma("unroll") for (int _i = 0; _i < 2; ++_i) \
        __builtin_amdgcn_global_load_lds((const unsigned*)((const char*)(gbase) + (voff)[_i]), (PG8_LAS unsigned*)(lds + (bufoff) + ldsw + _i * 8192), 16, 0, 0); } while (0)
#define PG8_LDA(dst, b, h) do { _Pragma("unroll") for (int m = 0; m < 4; ++m) _Pragma("unroll") for (int k = 0; k < 2; ++k) dst[m][k] = *(const PG8_LAS bf16x8*)(lds + PG8_SA(b, h) + aoff + m * 2048 + k * 1024); } while (0)
#define PG8_LDB(dst, b, h) do { _Pragma("unroll") for (int n = 0; n < 2; ++n) _Pragma("unroll") for (int k = 0; k < 2; ++k) dst[n][k] = *(const PG8_LAS bf16x8*)(lds + PG8_SB(b, h) + boff + n * 2048 + k * 1024); } while (0)
#define PG8_MMA(ai, bj, At, Bt) do { __builtin_amdgcn_s_setprio(1); _Pragma("unroll") for (int m = 0; m < 4; ++m) _Pragma("unroll") for (int n = 0; n < 2; ++n) _Pragma("unroll") for (int k = 0; k < 2; ++k) \
        acc[ai][bj][m][n] = __builtin_amdgcn_mfma_f32_16x16x32_bf16(Bt[n][k], At[m][k], acc[ai][bj][m][n], 0, 0, 0); __builtin_amdgcn_s_setprio(0); } while (0)
#define PG8_WAIT_V(n) asm volatile("s_waitcnt vmcnt(" #n ")" ::: "memory")
#define PG8_WAIT_L(n) asm volatile("s_waitcnt lgkmcnt(" #n ")" ::: "memory")
#define PG8_BAR __builtin_amdgcn_s_barrier()
#define PG8_SCHED __builtin_amdgcn_sched_barrier(0)
    Unit cur, nxt; int ui = 0;
    if (!S.next(0, cur)) return;
    f32x4 acc[2][2][4][2];
#pragma unroll
    for (int a = 0; a < 2; ++a)
#pragma unroll
        for (int b = 0; b < 2; ++b)
#pragma unroll
            for (int m = 0; m < 4; ++m)
#pragma unroll
                for (int n = 0; n < 2; ++n) acc[a][b][m][n] = (f32x4){0.f, 0.f, 0.f, 0.f};
    bf16x8 At[4][2], B0[2][2], B1[2][2];
    const char* cA = (const char*)g.A + (size_t)cur.pm * tstep; const char* cB = (const char*)g.Bt + (size_t)cur.pn * tstep;
    S.a_ready(cur);
    if constexpr (SP2) {
        PG8_STAGE(PG8_SB(0, 0), cB, voffB); PG8_STAGE(PG8_SB(0, 1), cB + hstep, voffB); PG8_STAGE(PG8_SA(0, 0), cA, voffA); PG8_STAGE(PG8_SA(0, 1), cA + hstep, voffA);
        if (wr == 1) PG8_BAR;
        PG8_WAIT_V(2); PG8_BAR;
        PG8_STAGE(PG8_SB(1, 0), cB + kstep, voffB); PG8_STAGE(PG8_SA(1, 0), cA + kstep, voffA); PG8_STAGE(PG8_SB(1, 1), cB + hstep + kstep, voffB);
        PG8_WAIT_V(6); PG8_BAR;
    } else {
        PG8_STAGE(PG8_SB(0, 0), cB, voffB); PG8_STAGE(PG8_SA(0, 0), cA, voffA); PG8_STAGE(PG8_SB(0, 1), cB + hstep, voffB); PG8_STAGE(PG8_SA(0, 1), cA + hstep, voffA);
        if (wr == 1) PG8_BAR;
        PG8_WAIT_V(4); PG8_BAR;
        PG8_STAGE(PG8_SB(1, 0), cB + kstep, voffB); PG8_STAGE(PG8_SA(1, 0), cA + kstep, voffA); PG8_STAGE(PG8_SB(1, 1), cB + hstep + kstep, voffB);
        PG8_WAIT_V(6); PG8_BAR;
    }
    for (;;) {
        const bool has_next = S.next(ui + 1, nxt);
        const char* nA = has_next ? (const char*)g.A + (size_t)nxt.pm * tstep : cA; const char* nB = has_next ? (const char*)g.Bt + (size_t)nxt.pn * tstep : cB;
        for (int t = 0; t < nt; t += 2) {
            const bool last = (t == nt - 2);
            const char* a1 = cA + (size_t)(t + 1) * kstep;
            const char* a2 = last ? nA : cA + (size_t)(t + 2) * kstep; const char* b2 = last ? nB : cB + (size_t)(t + 2) * kstep;
            const char* a3 = a2 + kstep; const char* b3 = b2 + kstep;
            if (last && has_next) S.a_ready(nxt);
            if constexpr (SP2) {
            PG8_LDB(B0, 0, 0); PG8_LDB(B1, 0, 1); PG8_SCHED; PG8_LDA(At, 0, 0); PG8_STAGE(PG8_SA(1, 1), a1 + hstep, voffA);
            PG8_WAIT_V(8); PG8_WAIT_L(0); PG8_BAR; PG8_MMA(0, 0, At, B0); PG8_MMA(0, 1, At, B1); PG8_BAR; PG8_SCHED;
            PG8_LDA(At, 0, 1); PG8_STAGE(PG8_SB(0, 0), b2, voffB); PG8_STAGE(PG8_SB(0, 1), b2 + hstep, voffB); PG8_STAGE(PG8_SA(0, 0), a2, voffA);
            PG8_WAIT_V(8); PG8_WAIT_L(0); PG8_BAR; PG8_MMA(1, 0, At, B0); PG8_MMA(1, 1, At, B1); PG8_BAR; PG8_SCHED;
            PG8_LDB(B0, 1, 0); PG8_LDB(B1, 1, 1); PG8_SCHED; PG8_LDA(At, 1, 0); PG8_STAGE(PG8_SA(0, 1), a2 + hstep, voffA);
            PG8_WAIT_V(8); PG8_WAIT_L(0); PG8_BAR; PG8_MMA(0, 0, At, B0); PG8_MMA(0, 1, At, B1); PG8_BAR; PG8_SCHED;
            PG8_LDA(At, 1, 1); PG8_STAGE(PG8_SB(1, 0), b3, voffB); PG8_STAGE(PG8_SB(1, 1), b3 + hstep, voffB); PG8_STAGE(PG8_SA(1, 0), a3, voffA);
            PG8_WAIT_V(8); PG8_WAIT_L(0); PG8_BAR; PG8_MMA(1, 0, At, B0); PG8_MMA(1, 1, At, B1); PG8_BAR; PG8_SCHED;
            } else {
            PG8_LDB(B0, 0, 0); PG8_SCHED; PG8_LDA(At, 0, 0); PG8_STAGE(PG8_SA(1, 1), a1 + hstep, voffA);
            PG8_WAIT_L(8); PG8_BAR; PG8_WAIT_L(0); PG8_MMA(0, 0, At, B0); PG8_BAR; PG8_SCHED;
            PG8_LDB(B1, 0, 1); PG8_STAGE(PG8_SB(0, 0), b2, voffB);
            PG8_BAR; PG8_WAIT_L(0); PG8_MMA(0, 1, At, B1); PG8_BAR;
            PG8_LDA(At, 0, 1); PG8_STAGE(PG8_SA(0, 0), a2, voffA);
            PG8_BAR; PG8_WAIT_L(0); PG8_MMA(1, 0, At, B0); PG8_BAR; PG8_SCHED;
            PG8_STAGE(PG8_SB(0, 1), b2 + hstep, voffB);
            PG8_WAIT_V(6); PG8_BAR; PG8_MMA(1, 1, At, B1); PG8_BAR;
            PG8_LDB(B0, 1, 0); PG8_SCHED; PG8_LDA(At, 1, 0); PG8_STAGE(PG8_SA(0, 1), a2 + hstep, voffA);
            PG8_WAIT_L(8); PG8_BAR; PG8_WAIT_L(0); PG8_MMA(0, 0, At, B0); PG8_BAR; PG8_SCHED;
            PG8_LDB(B1, 1, 1); PG8_STAGE(PG8_SB(1, 0), b3, voffB);
            PG8_BAR; PG8_WAIT_L(0); PG8_MMA(0, 1, At, B1); PG8_BAR;
            PG8_LDA(At, 1, 1); PG8_STAGE(PG8_SA(1, 0), a3, voffA);
            PG8_BAR; PG8_WAIT_L(0); PG8_MMA(1, 0, At, B0); PG8_BAR; PG8_SCHED;
            PG8_STAGE(PG8_SB(1, 1), b3 + hstep, voffB);
            PG8_WAIT_V(6); PG8_BAR; PG8_MMA(1, 1, At, B1); PG8_BAR;
            }
        }
        if constexpr (ALIGN_EPI) { if (wr == 0) PG8_BAR; }
        if constexpr (!Epi::AFTER_DRAIN) { E(acc, cur, wr, wc, fr, fq); S.done(cur); }
        if (!has_next) break;
#pragma unroll
        for (int a = 0; a < 2; ++a)
#pragma unroll
            for (int b = 0; b < 2; ++b)
#pragma unroll
                for (int m = 0; m < 4; ++m)
#pragma unroll
                    for (int n = 0; n < 2; ++n) acc[a][b][m][n] = (f32x4){0.f, 0.f, 0.f, 0.f};
        cur = nxt; cA = nA; cB = nB; ++ui;
        if constexpr (ALIGN_EPI) { if (wr == 1) PG8_BAR; }
    }
    PG8_WAIT_V(0);
    if constexpr (!ALIGN_EPI) { if (wr == 0) PG8_BAR; }
    PG8_BAR;
    if constexpr (Epi::AFTER_DRAIN) { E.fused(acc, cur, wr, wc, fr, fq, lds, wid, lane); S.done(cur); }
#undef PG8_SA
#undef PG8_SB
#undef PG8_STAGE
#undef PG8_LDA
#undef PG8_LDB
#undef PG8_MMA
#undef PG8_WAIT_V
#undef PG8_WAIT_L
#undef PG8_BAR
#undef PG8_SCHED
}
template <class Epi, class Sched>
__device__ __forceinline__ void gemm_phase_gather(PG8_LAS unsigned char* lds, const Gemm g, const Sched& S, const Epi& E, const int tid, const int* tok) {
    const int wid = __builtin_amdgcn_readfirstlane(tid >> 6), lane = tid & 63, wr = wid >> 2, wc = wid & 3, fr = lane & 15, fq = lane >> 4;
    const int K = g.K, nt = K / BK;
    unsigned voffB[2];
#pragma unroll
    for (int i = 0; i < 2; ++i) { int R, C; stage_rc(tid * 16 + i * 8192, R, C); const int Rb = Epi::PERM ? ((R & ~31) + perm32(R & 31)) : R; voffB[i] = (unsigned)(Rb * K + C) * 2u; }
#define PG8_RA(i) ({ int R_, C_; stage_rc(tid * 16 + (i) * 8192, R_, C_); R_; })
#define PG8_CA2(i) ({ int R_, C_; stage_rc(tid * 16 + (i) * 8192, R_, C_); (unsigned)C_ * 2u; })
    const size_t kstep = (size_t)(BK * 2);
    const size_t hstep = (size_t)HALF * K * 2;
    const size_t tstep = 2 * hstep;
    const unsigned ldsw = (unsigned)wid * 1024u;
    const int aoff = lds_byte(wr * 64 + fr, fq * 8), boff = lds_byte(wc * 32 + fr, fq * 8);
#define PG8_SA(b, h) (((b) * 2 + (h)) * HTB)
#define PG8_SB(b, h) ((4 + (b) * 2 + (h)) * HTB)
#define PG8_STAGE(bufoff, gbase, voff) do { _Pragma("unroll") for (int _i = 0; _i < 2; ++_i) \
        __builtin_amdgcn_global_load_lds((const unsigned*)((const char*)(gbase) + (voff)[_i]), (PG8_LAS unsigned*)(lds + (bufoff) + ldsw + _i * 8192), 16, 0, 0); } while (0)
#define PG8_STAGE_A(bufoff, kptr, hf, nx) do { _Pragma("unroll") for (int _i = 0; _i < 2; ++_i) { const unsigned _o = (nx) ? (unsigned)idN[(hf) * 2 + _i] : gC[hf][_i]; \
        __builtin_amdgcn_global_load_lds((const unsigned*)((const char*)(kptr) + _o), (PG8_LAS unsigned*)(lds + (bufoff) + ldsw + _i * 8192), 16, 0, 0); } } while (0)
#define PG8_LDA(dst, b, h) do { _Pragma("unroll") for (int m = 0; m < 4; ++m) _Pragma("unroll") for (int k = 0; k < 2; ++k) dst[m][k] = *(const PG8_LAS bf16x8*)(lds + PG8_SA(b, h) + aoff + m * 2048 + k * 1024); } while (0)
#define PG8_LDB(dst, b, h) do { _Pragma("unroll") for (int n = 0; n < 2; ++n) _Pragma("unroll") for (int k = 0; k < 2; ++k) dst[n][k] = *(const PG8_LAS bf16x8*)(lds + PG8_SB(b, h) + boff + n * 2048 + k * 1024); } while (0)
#define PG8_MMA(ai, bj, At, Bt) do { __builtin_amdgcn_s_setprio(1); _Pragma("unroll") for (int m = 0; m < 4; ++m) _Pragma("unroll") for (int n = 0; n < 2; ++n) _Pragma("unroll") for (int k = 0; k < 2; ++k) \
        acc[ai][bj][m][n] = __builtin_amdgcn_mfma_f32_16x16x32_bf16(Bt[n][k], At[m][k], acc[ai][bj][m][n], 0, 0, 0); __builtin_amdgcn_s_setprio(0); } while (0)
#define PG8_WAIT_V(n) asm volatile("s_waitcnt vmcnt(" #n ")" ::: "memory")
#define PG8_WAIT_L(n) asm volatile("s_waitcnt lgkmcnt(" #n ")" ::: "memory")
#define PG8_BAR __builtin_amdgcn_s_barrier()
#define PG8_SCHED __builtin_amdgcn_sched_barrier(0)
    Unit cur, nxt; int ui = 0;
    if (!S.next(0, cur)) return;
    f32x4 acc[2][2][4][2];
#pragma unroll
    for (int a = 0; a < 2; ++a)
#pragma unroll
        for (int b = 0; b < 2; ++b)
#pragma unroll
            for (int m = 0; m < 4; ++m)
#pragma unroll
                for (int n = 0; n < 2; ++n) acc[a][b][m][n] = (f32x4){0.f, 0.f, 0.f, 0.f};
    bf16x8 At[4][2], B0[2][2], B1[2][2];
    unsigned gC[2][2]; int idN[4];
#pragma unroll
    for (int hf = 0; hf < 2; ++hf)
#pragma unroll
        for (int i = 0; i < 2; ++i) { gC[hf][i] = (unsigned)tok[cur.pm * BM + hf * HALF + PG8_RA(i)] * (unsigned)(K * 2) + PG8_CA2(i); idN[hf * 2 + i] = (int)gC[hf][i]; }
    const char* cA = (const char*)g.A; const char* cB = (const char*)g.Bt + (size_t)cur.pn * tstep;
    PG8_STAGE(PG8_SB(0, 0), cB, voffB); PG8_STAGE(PG8_SB(0, 1), cB + hstep, voffB); PG8_STAGE_A(PG8_SA(0, 0), cA, 0, false); PG8_STAGE_A(PG8_SA(0, 1), cA, 1, false);
    if (wr == 1) PG8_BAR;
    PG8_WAIT_V(2); PG8_BAR;
    PG8_STAGE(PG8_SB(1, 0), cB + kstep, voffB); PG8_STAGE_A(PG8_SA(1, 0), cA + kstep, 0, false); PG8_STAGE(PG8_SB(1, 1), cB + hstep + kstep, voffB);
    PG8_WAIT_V(6); PG8_BAR;
    for (;;) {
        const bool has_next = S.next(ui + 1, nxt);
        const char* nB = has_next ? (const char*)g.Bt + (size_t)nxt.pn * tstep : cB;
        if (has_next) {
            const int* p0 = tok + nxt.pm * BM + PG8_RA(0); const int* p1 = tok + nxt.pm * BM + PG8_RA(1); const int* p2 = p0 + HALF; const int* p3 = p1 + HALF;
            asm volatile("global_load_dword %0, %4, off\n\tglobal_load_dword %1, %5, off\n\tglobal_load_dword %2, %6, off\n\tglobal_load_dword %3, %7, off\n\ts_waitcnt vmcnt(0)"
                         : "=&v"(idN[0]), "=&v"(idN[1]), "=&v"(idN[2]), "=&v"(idN[3]) : "v"(p0), "v"(p1), "v"(p2), "v"(p3) : "memory");
        }
        for (int t = 0; t < nt; t += 2) {
            const bool last = (t == nt - 2); const bool nx = last && has_next;
            if (nx) {
#pragma unroll
                for (int j = 0; j < 4; ++j) idN[j] = (int)((unsigned)idN[j] * (unsigned)(K * 2) + PG8_CA2(j & 1));
            }
            const char* a1 = cA + (size_t)(t + 1) * kstep;
            const char* a2 = last ? cA : cA + (size_t)(t + 2) * kstep; const char* b2 = last ? nB : cB + (size_t)(t + 2) * kstep;
            const char* a3 = a2 + kstep; const char* b3 = b2 + kstep;
            PG8_LDB(B0, 0, 0); PG8_LDB(B1, 0, 1); PG8_SCHED; PG8_LDA(At, 0, 0); PG8_STAGE_A(PG8_SA(1, 1), a1, 1, false);
            PG8_WAIT_V(8); PG8_WAIT_L(0); PG8_BAR; PG8_MMA(0, 0, At, B0); PG8_MMA(0, 1, At, B1); PG8_BAR; PG8_SCHED;
            PG8_LDA(At, 0, 1); PG8_STAGE(PG8_SB(0, 0), b2, voffB); PG8_STAGE(PG8_SB(0, 1), b2 + hstep, voffB); PG8_STAGE_A(PG8_SA(0, 0), a2, 0, nx);
            PG8_WAIT_V(8); PG8_WAIT_L(0); PG8_BAR; PG8_MMA(1, 0, At, B0); PG8_MMA(1, 1, At, B1); PG8_BAR; PG8_SCHED;
            PG8_LDB(B0, 1, 0); PG8_LDB(B1, 1, 1); PG8_SCHED; PG8_LDA(At, 1, 0); PG8_STAGE_A(PG8_SA(0, 1), a2, 1, nx);
            PG8_WAIT_V(8); PG8_WAIT_L(0); PG8_BAR; PG8_MMA(0, 0, At, B0); PG8_MMA(0, 1, At, B1); PG8_BAR; PG8_SCHED;
            PG8_LDA(At, 1, 1); PG8_STAGE(PG8_SB(1, 0), b3, voffB); PG8_STAGE(PG8_SB(1, 1), b3 + hstep, voffB); PG8_STAGE_A(PG8_SA(1, 0), a3, 0, nx);
            PG8_WAIT_V(8); PG8_WAIT_L(0); PG8_BAR; PG8_MMA(1, 0, At, B0); PG8_MMA(1, 1, At, B1); PG8_BAR; PG8_SCHED;
        }
        if (wr == 0) PG8_BAR;
        E(acc, cur, wr, wc, fr, fq);
        if (!has_next) break;
#pragma unroll
        for (int a = 0; a < 2; ++a)
#pragma unroll
            for (int b = 0; b < 2; ++b)
#pragma unroll
                for (int m = 0; m < 4; ++m)
#pragma unroll
                    for (int n = 0; n < 2; ++n) acc[a][b][m][n] = (f32x4){0.f, 0.f, 0.f, 0.f};
        cur = nxt; cB = nB; ++ui;
#pragma unroll
        for (int hf = 0; hf < 2; ++hf)
#pragma unroll
            for (int i = 0; i < 2; ++i) gC[hf][i] = (unsigned)idN[hf * 2 + i];
        if (wr == 1) PG8_BAR;
    }
    PG8_WAIT_V(0);
    PG8_BAR;
#undef PG8_SA
#undef PG8_SB
#undef PG8_STAGE
#undef PG8_STAGE_A
#undef PG8_RA
#undef PG8_CA2
#undef PG8_LDA
#undef PG8_LDB
#undef PG8_MMA
#undef PG8_WAIT_V
#undef PG8_WAIT_L
#undef PG8_BAR
#undef PG8_SCHED
}
}
constexpr int DM = 1024, NBATCH = 16, SEQL = 4096, CTXL = 256, SB = CTXL + SEQL  , TT = NBATCH * SB  , NRT = TT / 256  ;
constexpr int INW = 2704, INWP = 2816;
constexpr int C_Z = 0, C_XBC = 512, C_DT = 1280, C_GQ = 1296, C_GK = 1552, C_GV = 1808, C_GR = 2064, C_GLR = 2320, C_CQ = 2352, C_CKV = 2544, C_KPE = 2672;
constexpr float EPS = 1e-6f;
constexpr int NWAVES = 8, NTHREADS = 512;
enum { I_X = 0, I_C, I_CTX, I_CCTX, I_WMOD, I_BMOD, I_NORM1, I_WIN, I_CONVW, I_CONVB, I_ALOG, I_DTB, I_SSDD, I_SSDNW, I_GUPW, I_GUPB, I_GLANW, I_QNW, I_WUQ, I_KVNW, I_WUKV, I_WOUT, I_NORM2,
       I_RW, I_RB, I_W1, I_B1, I_W2, I_B2, I_FINW, N_IN };
constexpr size_t MiB = 1u << 20;
constexpr size_t WS_CTL = 0, CTL_ZERO_BYTES = 1 * MiB;
constexpr size_t WS_MOD = 1 * MiB;
constexpr size_t WS_ROPE = 1 * MiB + 960 * 1024;
constexpr size_t WS_META = 1 * MiB + 980 * 1024;
constexpr size_t WS_WUQT = 2 * MiB;
constexpr size_t WS_WUKVT = 2 * MiB + 512 * 1024;
constexpr size_t WS_WOUTT = 4 * MiB;
constexpr size_t WS_WINT = 8 * MiB;
constexpr size_t WS_W1T = 20 * MiB;
constexpr size_t WS_W2T = 148 * MiB;
constexpr size_t WS_H = 212 * MiB;
constexpr size_t WS_ACT1 = 484 * MiB;
constexpr size_t WS_ARENA = 620 * MiB;
constexpr size_t WS_COLS = WS_ARENA;
constexpr size_t WS_XBC = WS_ARENA + 374 * MiB;
constexpr size_t WS_DT = WS_ARENA + 476 * MiB;
constexpr size_t WS_G = WS_ARENA + 481 * MiB;
constexpr size_t WS_AQ = WS_ARENA + 617 * MiB;
constexpr size_t WS_AKV = WS_ARENA + 651 * MiB;
constexpr size_t WS_QRAW = WS_ARENA + 685 * MiB;
constexpr size_t WS_KV = WS_ARENA + 753 * MiB;
constexpr size_t WS_KVT = WS_ARENA + 821 * MiB;
constexpr size_t WS_QF = WS_ARENA + 889 * MiB;
constexpr size_t WS_KF = WS_ARENA + 940 * MiB;
constexpr size_t WS_YF = WS_ARENA + 991 * MiB;
constexpr size_t WS_YB = WS_ARENA + 1059 * MiB;
constexpr size_t WS_OF = WS_ARENA + 1127 * MiB;
constexpr size_t WS_OB = WS_ARENA + 1161 * MiB;
constexpr size_t WS_MODP = WS_ARENA;
constexpr int MAXSLOT = 1120 * 256;
constexpr size_t WS_XG = WS_ARENA;
constexpr size_t WS_ACTB = WS_ARENA + 560 * MiB;
constexpr size_t WS_TOKE = WS_ARENA + 1120 * MiB;
constexpr size_t WS_TOKP = WS_ARENA + 1122 * MiB;
constexpr size_t WS_TOKW = WS_ARENA + 1124 * MiB;
constexpr size_t WS_WGCNT = WS_ARENA + 1126 * MiB;
constexpr size_t WS_TOKS = WS_ARENA + 1128 * MiB;
constexpr size_t WS_STOK = WS_ARENA + 1130 * MiB;
constexpr size_t WS_END = WS_ARENA + 1428 * MiB;
constexpr int CW_BAR = 4096;
constexpr int CW_AQ = 8192;
constexpr int CW_ASM = 8192 + 1024;
constexpr int RING_BYTES = 131072, LDSCTL_OFF = RING_BYTES, LDS_BYTES = 147456;
constexpr int MISC_BAR = 8;
constexpr int MISC_Q = 16;
constexpr int MISC_CNT = 32;
constexpr int MISC_SB = 64;

#define GAS __attribute__((address_space(1)))
#define LAS __attribute__((address_space(3)))
typedef unsigned short bf16;
typedef unsigned v4u __attribute__((ext_vector_type(4)));
typedef unsigned v2u __attribute__((ext_vector_type(2)));
typedef float f32x4 __attribute__((ext_vector_type(4)));
typedef short bf16x8 __attribute__((ext_vector_type(8)));
#define LDS_WAIT() asm volatile("s_waitcnt lgkmcnt(0)" ::: "memory")

__device__ __forceinline__ float bf2f(unsigned v) { return __uint_as_float(v << 16); }
__device__ __forceinline__ float bflo(unsigned w) { return __uint_as_float(w << 16); }
__device__ __forceinline__ float bfhi(unsigned w) { return __uint_as_float(w & 0xffff0000u); }
__device__ __forceinline__ unsigned f2bf(float f) { unsigned u = __float_as_uint(f); return (u + 0x7fffu + ((u >> 16) & 1u)) >> 16; }
typedef float f32x2_t __attribute__((ext_vector_type(2))); typedef __bf16 bf16x2_t __attribute__((ext_vector_type(2)));
__device__ __forceinline__ unsigned pk2(float lo, float hi) { const f32x2_t v = {lo, hi}; const bf16x2_t b = __builtin_convertvector(v, bf16x2_t); return __builtin_bit_cast(unsigned, b); }
__device__ __forceinline__ float wave_sum(float v) {
#pragma unroll
    for (int o = 1; o < 64; o <<= 1) v += __shfl_xor(v, o);
    return v;
}
__device__ __forceinline__ float wave_max(float v) {
#pragma unroll
    for (int o = 1; o < 64; o <<= 1) v = fmaxf(v, __shfl_xor(v, o));
    return v;
}
__device__ __forceinline__ float siluf(float x) { return x / (1.0f + expf(-x)); }
__device__ __forceinline__ float fsilu(float x) { return x * __builtin_amdgcn_rcpf(1.0f + __expf(-x)); }
__device__ __forceinline__ float fsoftplus(float x) { const float e = __expf(-fabsf(x)); const float l1p = e < 0.03125f ? e * (1.0f - e * (0.5f - e * (0.33333334f - 0.25f * e))) : __logf(1.0f + e); return fmaxf(x, 0.f) + l1p; }
__device__ __forceinline__ float softplusf(float x) { return fmaxf(x, 0.f) + log1pf(expf(-fabsf(x))); }

struct Args { const float* in[N_IN]; float* out; unsigned char* ws; int ph_lo, ph_hi; };
constexpr int PTR_OFF = LDSCTL_OFF + 1024;

__device__ __forceinline__ void transpose_item(const float* W, int K, int N, bf16* WT, int Kp, int nblk, int item, LAS float* scr, int lane) {
    const int kb = item / nblk, nb = item - kb * nblk, k0 = 64 * kb, n0 = 32 * nb;
    const int n = n0 + (lane & 31);
#pragma unroll 8
    for (int i = 0; i < 32; ++i) { const int kk = 2 * i + (lane >> 5), k = k0 + kk; scr[kk * 33 + (lane & 31)] = (k < K && n < N) ? W[(size_t)k * N + n] : 0.f; }
    LDS_WAIT(); asm volatile("" ::: "memory");
    const int c = lane & 7;
#pragma unroll
    for (int j = 0; j < 4; ++j) { const int nn = (lane >> 3) + 8 * j; const LAS float* s = scr + (8 * c) * 33 + nn;
        v4u o; o.x = pk2(s[0 * 33], s[1 * 33]); o.y = pk2(s[2 * 33], s[3 * 33]); o.z = pk2(s[4 * 33], s[5 * 33]); o.w = pk2(s[6 * 33], s[7 * 33]);
        *(v4u*)(WT + (size_t)(n0 + nn) * Kp + k0 + 8 * c) = o; }
    LDS_WAIT(); asm volatile("" ::: "memory");
}
__device__ __forceinline__ void norm_mod_row(const float* hrow, const float* nw, const float* shift, const float* scale, bf16* orow, int lane) {
    const f32x4* xr = (const f32x4*)hrow + lane; f32x4 v[4]; float ss = 0.f;
#pragma unroll
    for (int q = 0; q < 4; ++q) { v[q] = xr[64 * q]; ss += (v[q].x * v[q].x + v[q].y * v[q].y) + (v[q].z * v[q].z + v[q].w * v[q].w); }
    const float rstd = rsqrtf(wave_sum(ss) * (1.0f / 1024.0f) + EPS);
#pragma unroll
    for (int q = 0; q < 4; ++q) { const int j4 = lane + 64 * q; const f32x4 w = ((const f32x4*)nw)[j4], sh = ((const f32x4*)shift)[j4], sc = ((const f32x4*)scale)[j4];
        const f32x4 o = (v[q] * rstd * w) * (sc + 1.0f) + sh; v2u p; p.x = pk2(o.x, o.y); p.y = pk2(o.z, o.w); ((v2u*)orow)[j4] = p; }
}
__device__ __forceinline__ const float* h0_row(const float* x, const float* ctx, int m) { const int b = m / SB, s = m - b * SB; return s < CTXL ? ctx + ((size_t)b * CTXL + s) * DM : x + ((size_t)b * SEQL + (s - CTXL)) * DM; }
#define XB_TMO      128
#define XB_XCNT(j)  (256  + 64 * (j))
#define XB_XSUB(j)  (1280 + 64 * (j))
#define XB_XGEN(j)  (2304 + 64 * (j))
#define XB_TOP      3328
#define XB_TOPGEN   3392
#define XCD_BAR_WORDS 3456
#define XB_SPIN_CAP (1u << 22)

__device__ __forceinline__ unsigned xb_ld(unsigned* p)              { return __hip_atomic_load(p, __ATOMIC_RELAXED, __HIP_MEMORY_SCOPE_AGENT); }
__device__ __forceinline__ unsigned xb_add(unsigned* p, unsigned v) { return __hip_atomic_fetch_add(p, v, __ATOMIC_RELAXED, __HIP_MEMORY_SCOPE_AGENT); }
__device__ __forceinline__ unsigned xb_xcc_id() { return (unsigned)__builtin_amdgcn_s_getreg((3 << 11) | 20) & 0xFu; }
#define XB_SPIN(cond, bar) do { unsigned _sp = 0; while (cond) { __builtin_amdgcn_s_sleep(1); \
    if ((++_sp & 255u) == 0u) { if (xb_ld(&(bar)[XB_TMO])) break; if (_sp > XB_SPIN_CAP) { atomicAdd(&(bar)[XB_TMO], 1u); break; } } } } while (0)

struct XcdBarrier {
    unsigned* bar; unsigned x;
    volatile LAS unsigned* st;
};

__device__ __forceinline__ XcdBarrier xcd_barrier_post(unsigned* bar, volatile LAS unsigned* st) {
    XcdBarrier b; b.bar = bar; b.x = xb_xcc_id(); b.st = st;
    if (threadIdx.x == 0) (void)xb_add(&bar[XB_XCNT(b.x)], 1u);
    return b;
}
__device__ __forceinline__ void xcd_barrier_complete(unsigned* bar, unsigned x, unsigned& nloc, unsigned& nx) {
    const unsigned G = gridDim.x * gridDim.y * gridDim.z;
    unsigned sum, cnt, mine, sp = 0u;
    for (;;) {
        sum = 0u; cnt = 0u; mine = 0u;
#pragma unroll
        for (unsigned j = 0; j < 16; ++j) { const unsigned c = xb_ld(&bar[XB_XCNT(j)]); sum += c; cnt += (c > 0u) ? 1u : 0u; mine = (j == x) ? c : mine; }
        if (sum == G) break;
        __builtin_amdgcn_s_sleep(1);
        if ((++sp & 255u) == 0u) { if (xb_ld(&bar[XB_TMO])) break; if (sp > XB_SPIN_CAP) { atomicAdd(&bar[XB_TMO], 1u); break; } }
    }
    nloc = mine > 0u ? mine : 1u; nx = cnt > 0u ? cnt : 1u;
}

__device__ __forceinline__ void xcd_barrier(const XcdBarrier& b) {
    asm volatile("s_waitcnt vmcnt(0)" ::: "memory");
    __syncthreads();
    if (threadIdx.x == 0) {
        unsigned* bar = b.bar;
        __builtin_amdgcn_s_waitcnt(0);
        unsigned nloc = b.st[0], nx = b.st[1];
        if (nloc == 0u) { xcd_barrier_complete(bar, b.x, nloc, nx); b.st[0] = nloc; b.st[1] = nx; }
        const unsigned old = xb_add(&bar[XB_XSUB(b.x)], 1u);
        const unsigned gen = old / nloc;
        if (old + 1u == (gen + 1u) * nloc) {
            __builtin_amdgcn_fence(__ATOMIC_RELEASE, "agent");
            asm volatile("s_waitcnt vmcnt(0)" ::: "memory");
            const unsigned og = xb_add(&bar[XB_TOP], 1u);
            const unsigned tg = og / nx;
            if (og + 1u == (tg + 1u) * nx) xb_add(&bar[XB_TOPGEN], 1u);
            else XB_SPIN(xb_ld(&bar[XB_TOPGEN]) == tg, bar);
            __builtin_amdgcn_fence(__ATOMIC_ACQUIRE, "agent");
            xb_add(&bar[XB_XGEN(b.x)], 1u);
            asm volatile("s_waitcnt vmcnt(0)" ::: "memory");
        } else {
            XB_SPIN(xb_ld(&bar[XB_XGEN(b.x)]) == gen, bar);
            __builtin_amdgcn_fence(__ATOMIC_ACQUIRE, "agent");
            asm volatile("s_waitcnt vmcnt(0)" ::: "memory");
        }
    }
    __syncthreads();
}
struct Ctx { LAS unsigned char* lds; volatile LAS unsigned* MISC; GAS unsigned char* ws; int tid, lane, wave, G, bid; };
__device__ __forceinline__ const float* in_ptr(const Ctx& C, int i) {
    const volatile LAS unsigned* P = (const volatile LAS unsigned*)(C.lds + PTR_OFF) + 2 * i;
    const unsigned lo = __builtin_amdgcn_readfirstlane(P[0]), hi = __builtin_amdgcn_readfirstlane(P[1]);
    return (const float*)(const GAS float*)(((unsigned long long)hi << 32) | lo);
}
#define IN_(i) in_ptr(C, (i))

__device__ __forceinline__ void ph_g0(const Args& A, const Ctx& C) { const float* const p_I_C = IN_(I_C); const float* const p_I_CCTX = IN_(I_CCTX); const float* const p_I_WIN = IN_(I_WIN); const float* const p_I_WMOD = IN_(I_WMOD); const float* const p_I_WOUT = IN_(I_WOUT); const float* const p_I_WUKV = IN_(I_WUKV); const float* const p_I_WUQ = IN_(I_WUQ);
    if (C.bid < 192) {
        const int l = C.bid / 96, rem = C.bid % 96, cb = rem >> 3, s = rem & 7, i0 = s * 128;
        LAS float* sc = (LAS float*)C.lds;
        for (int idx = C.tid; idx < 17 * 128; idx += NTHREADS) { const int r = idx >> 7, i = idx & 127; const float cv = r < 16 ? p_I_C[r * 1024 + i0 + i] : p_I_CCTX[i0 + i]; sc[idx] = siluf(cv); }
        __syncthreads();
        const int j = cb * 512 + C.tid; float acc[17];
#pragma unroll
        for (int r = 0; r < 17; ++r) acc[r] = 0.f;
        const float* wm = p_I_WMOD + ((size_t)l * 1024 + i0) * 6144 + j;
        for (int i = 0; i < 128; ++i) { const float w = wm[(size_t)i * 6144];
#pragma unroll
            for (int r = 0; r < 17; ++r) acc[r] += sc[r * 128 + i] * w; }
        float* mp = (float*)(C.ws + WS_MODP) + ((size_t)(s * 2 + l) * 17) * 6144 + j;
#pragma unroll
        for (int r = 0; r < 17; ++r) mp[(size_t)r * 6144] = acc[r];
        __syncthreads();
    }
    if (C.bid == C.G - 1) {
        const int pos = C.tid >> 3, i = C.tid & 7;
        double f = 1.0; if (i >= 2) f *= 0.1; if (i >= 4) f *= 0.1; if (i >= 6) f *= 0.1; if (i & 1) f *= 0.31622776601683794;
        const double ang = (double)pos * f;
        const double n = __builtin_rint(ang * 0.63661977236758134);
        double r = __builtin_fma(-n, 1.5707963267948966, ang); r = __builtin_fma(-n, 6.123233995736766e-17, r);
        const double r2 = r * r;
        double sn = 1.0 / 355687428096000.0;
        sn = sn * r2 - 1.0 / 1307674368000.0; sn = sn * r2 + 1.0 / 6227020800.0; sn = sn * r2 - 1.0 / 39916800.0; sn = sn * r2 + 1.0 / 362880.0; sn = sn * r2 - 1.0 / 5040.0; sn = sn * r2 + 1.0 / 120.0; sn = sn * r2 - 1.0 / 6.0; sn = sn * r2 + 1.0; sn *= r;
        double cs = 1.0 / 20922789888000.0;
        cs = cs * r2 - 1.0 / 87178291200.0; cs = cs * r2 + 1.0 / 479001600.0; cs = cs * r2 - 1.0 / 3628800.0; cs = cs * r2 + 1.0 / 40320.0; cs = cs * r2 - 1.0 / 720.0; cs = cs * r2 + 1.0 / 24.0; cs = cs * r2 - 0.5; cs = cs * r2 + 1.0;
        const int q = ((int)n) & 3;
        const double c_ = q == 0 ? cs : q == 1 ? -sn : q == 2 ? -cs : sn;
        const double s_ = q == 0 ? sn : q == 1 ? cs : q == 2 ? -sn : -cs;
        float* rt = (float*)(C.ws + WS_ROPE); rt[C.tid * 2] = (float)c_; rt[C.tid * 2 + 1] = (float)s_;
    }
    LAS float* scr = (LAS float*)(C.lds + C.wave * 16384);
    const int gw = C.bid * NWAVES + C.wave, NGW = C.G * NWAVES;
    for (int it = gw; it < 4096; it += NGW) {
        const int l = it >> 11; int r = it & 2047;
        if (r < 1408) { transpose_item(p_I_WIN + (size_t)l * 1024 * INW, 1024, INW, (bf16*)(C.ws + WS_WINT) + (size_t)l * INWP * 1024, 1024, 88, r, scr, C.lane); continue; } r -= 1408;
        if (r < 512) { transpose_item(p_I_WOUT + (size_t)l * 1024 * 1024, 1024, 1024, (bf16*)(C.ws + WS_WOUTT) + (size_t)l * 1024 * 1024, 1024, 32, r, scr, C.lane); continue; } r -= 512;
        if (r < 64) { transpose_item(p_I_WUQ + (size_t)l * 192 * 384, 192, 384, (bf16*)(C.ws + WS_WUQT) + (size_t)l * 512 * 256, 256, 16, r, scr, C.lane); continue; } r -= 64;
        transpose_item(p_I_WUKV + (size_t)l * 128 * 512, 128, 512, (bf16*)(C.ws + WS_WUKVT) + (size_t)l * 512 * 256, 256, 16, r, scr, C.lane);
    }
}
__device__ __forceinline__ void convert_experts(const Args& A, const Ctx& C, int l) { const float* const p_I_W1 = IN_(I_W1); const float* const p_I_W2 = IN_(I_W2);
    LAS unsigned* T = (LAS unsigned*)C.lds;
    const int tid = C.tid, n4 = (tid & 63) * 4, kq = tid >> 6;
    for (int it = C.bid; it < 4096 + 2048; it += C.G) {
        const float* W; bf16* WT; int N, kb, nb;
        if (it < 4096) { const int e = it >> 7, r = it & 127; kb = r >> 3; nb = r & 7; N = 2048; W = p_I_W1 + ((size_t)l * 32 + e) * 1024 * 2048; WT = (bf16*)(C.ws + WS_W1T) + (size_t)e * 2048 * 1024; }
        else { const int i2 = it - 4096, e = i2 >> 6, r = i2 & 63; kb = r >> 2; nb = r & 3; N = 1024; W = p_I_W2 + ((size_t)l * 32 + e) * 1024 * 1024; WT = (bf16*)(C.ws + WS_W2T) + (size_t)e * 1024 * 1024; }
        const float* src = W + (size_t)(kb * 64) * N + nb * 256 + n4;
        f32x4 a[4], b[4];
#pragma unroll
        for (int i = 0; i < 4; ++i) { const int kp = kq + 8 * i; a[i] = *(const f32x4*)(src + (size_t)(2 * kp) * N); b[i] = *(const f32x4*)(src + (size_t)(2 * kp + 1) * N); }
        __syncthreads();
#pragma unroll
        for (int i = 0; i < 4; ++i) { const int kp = kq + 8 * i; T[(n4 + 0) * 33 + kp] = pk2(a[i].x, b[i].x); T[(n4 + 1) * 33 + kp] = pk2(a[i].y, b[i].y); T[(n4 + 2) * 33 + kp] = pk2(a[i].z, b[i].z); T[(n4 + 3) * 33 + kp] = pk2(a[i].w, b[i].w); }
        __syncthreads();
        const int c = tid & 7, r0 = tid >> 3;
#pragma unroll
        for (int ps = 0; ps < 4; ++ps) { const int n = r0 + 64 * ps; const LAS unsigned* t = T + n * 33 + 4 * c; v4u o; o.x = t[0]; o.y = t[1]; o.z = t[2]; o.w = t[3];
            *(v4u*)(WT + (size_t)(nb * 256 + n) * 1024 + kb * 64 + 8 * c) = o; }
    }
    __syncthreads();
}
__device__ __forceinline__ void ph_g1(const Args& A, const Ctx& C) { const float* const p_I_BMOD = IN_(I_BMOD);
    const float* mp = (const float*)(C.ws + WS_MODP); float* mod = (float*)(C.ws + WS_MOD);
    for (int idx = C.bid * NTHREADS + C.tid; idx < 2 * 17 * 6144; idx += C.G * NTHREADS) {
        const int l = idx / (17 * 6144), j = idx % 6144; float s = p_I_BMOD[l * 6144 + j];
#pragma unroll
        for (int p = 0; p < 8; ++p) s += mp[(size_t)p * (2 * 17 * 6144) + idx];
        mod[idx] = s;
    }
}
__device__ __forceinline__ void ph_g2(const Args& A, const Ctx& C) { const float* const p_I_CTX = IN_(I_CTX); const float* const p_I_NORM1 = IN_(I_NORM1); const float* const p_I_X = IN_(I_X);
    const int gw = C.bid * NWAVES + C.wave, NGW = C.G * NWAVES, lane = C.lane; const float* mod = (const float*)(C.ws + WS_MOD); bf16* uo = (bf16*)(C.ws + WS_ACT1);
    f32x4 nw[4];
#pragma unroll
    for (int q = 0; q < 4; ++q) nw[q] = ((const f32x4*)p_I_NORM1)[lane + 64 * q];
    f32x4 cv[2][4], nv[2][4];
#define G2_LOAD(m_, v_) do { _Pragma("unroll") for (int r = 0; r < 2; ++r) { const int mm = (m_) + r * NGW; if (mm < TT) { const f32x4* xr = (const f32x4*)h0_row(p_I_X, p_I_CTX, mm) + lane; \
        _Pragma("unroll") for (int q = 0; q < 4; ++q) v_[r][q] = xr[64 * q]; } } } while (0)
    G2_LOAD(gw, cv);
    for (int m = gw; m < TT; m += 2 * NGW) {
        if (m + 2 * NGW < TT) G2_LOAD(m + 2 * NGW, nv);
        float ss[2];
#pragma unroll
        for (int r = 0; r < 2; ++r) { ss[r] = 0.f;
#pragma unroll
            for (int q = 0; q < 4; ++q) ss[r] += (cv[r][q].x * cv[r][q].x + cv[r][q].y * cv[r][q].y) + (cv[r][q].z * cv[r][q].z + cv[r][q].w * cv[r][q].w); }
#pragma unroll
        for (int o = 1; o < 64; o <<= 1) { ss[0] += __shfl_xor(ss[0], o); ss[1] += __shfl_xor(ss[1], o); }
#pragma unroll
        for (int r = 0; r < 2; ++r) { const int mm = m + r * NGW; if (mm < TT) { const int b = mm / SB, s = mm - b * SB; const float* mr = mod + (size_t)(s < CTXL ? 16 : b) * 6144; const float rstd = rsqrtf(ss[r] * (1.0f / 1024.0f) + EPS);
#pragma unroll
            for (int q = 0; q < 4; ++q) { const int j4 = lane + 64 * q; const f32x4 sh = ((const f32x4*)mr)[j4], sc = ((const f32x4*)(mr + 1024))[j4];
                const f32x4 o = (cv[r][q] * rstd * nw[q]) * (sc + 1.0f) + sh; v2u p; p.x = pk2(o.x, o.y); p.y = pk2(o.z, o.w); ((v2u*)(uo + (size_t)mm * DM))[j4] = p; } } }
#pragma unroll
        for (int r = 0; r < 2; ++r)
#pragma unroll
            for (int q = 0; q < 4; ++q) cv[r][q] = nv[r][q];
    }
#undef G2_LOAD
}
__device__ __forceinline__ void ph_prep(const Args& A, const Ctx& C, int l, int rep) { const float* const p_I_CONVB = IN_(I_CONVB); const float* const p_I_CONVW = IN_(I_CONVW); const float* const p_I_DTB = IN_(I_DTB); const float* const p_I_GUPB = IN_(I_GUPB); const float* const p_I_GUPW = IN_(I_GUPW); const float* const p_I_KVNW = IN_(I_KVNW); const float* const p_I_QNW = IN_(I_QNW);
    LAS float* gws = (LAS float*)C.lds;
    LAS float* cws = (LAS float*)(C.lds + 32768);
    for (int idx = C.tid; idx < 8192; idx += NTHREADS) gws[idx] = p_I_GUPW[l * 8192 + idx];
    for (int idx = C.tid; idx < 2304; idx += NTHREADS) cws[idx] = p_I_CONVW[l * 2304 + idx];
    for (int idx = C.tid; idx < 768; idx += NTHREADS) cws[2304 + idx] = p_I_CONVB[l * 768 + idx];
    __syncthreads();
    const bf16* cols = (const bf16*)(C.ws + WS_COLS);
    bf16* xbc = (bf16*)(C.ws + WS_XBC); float* dt = (float*)(C.ws + WS_DT); bf16* gg = (bf16*)(C.ws + WS_G); bf16* aq = (bf16*)(C.ws + WS_AQ); bf16* akv = (bf16*)(C.ws + WS_AKV);
    const int gw = C.bid * NWAVES + C.wave, NGW = C.G * NWAVES, lane = C.lane;
    const float dtb = lane < 16 ? p_I_DTB[l * 16 + lane] : 0.f;
    const f32x4 gb0 = *(const f32x4*)(p_I_GUPB + l * 512 + lane * 4), gb1 = *(const f32x4*)(p_I_GUPB + l * 512 + 256 + lane * 4);
    const f32x4 qnw = lane < 48 ? *(const f32x4*)(p_I_QNW + l * 192 + lane * 4) : (f32x4){0.f, 0.f, 0.f, 0.f}, kvnw = lane < 32 ? *(const f32x4*)(p_I_KVNW + l * 128 + lane * 4) : (f32x4){0.f, 0.f, 0.f, 0.f};
    v2u cx0[3], cxm[3], cxp[3], ccq, cckv; v4u cgl[4]; unsigned cdt;
    v2u nx0[3], nxm[3], nxp[3], ncq, nckv; v4u ngl[4]; unsigned ndt;
#define PREP_LOAD(m_, x0_, xm_, xp_, cq_, ckv_, gl_, dt_) do { const int b_ = (m_) / SB, s_ = (m_) - b_ * SB; const bool hp_ = (s_ != 0 && s_ != CTXL), hn_ = (s_ != CTXL - 1 && s_ != SB - 1); \
        const bf16* r_ = cols + (size_t)(m_) * INWP; \
        _Pragma("unroll") for (int ch = 0; ch < 3; ++ch) { const int c_ = ch * 256 + lane * 4; x0_[ch] = *(const v2u*)(r_ + C_XBC + c_); xm_[ch] = (v2u){0u, 0u}; xp_[ch] = (v2u){0u, 0u}; \
            if (hp_) xm_[ch] = *(const v2u*)(r_ - INWP + C_XBC + c_); if (hn_) xp_[ch] = *(const v2u*)(r_ + INWP + C_XBC + c_); } \
        dt_ = r_[C_DT + (lane & 15)]; { const v4u* g_ = (const v4u*)(r_ + C_GLR); gl_[0] = g_[0]; gl_[1] = g_[1]; gl_[2] = g_[2]; gl_[3] = g_[3]; } \
        cq_ = *(const v2u*)(r_ + C_CQ + (lane < 48 ? lane : 0) * 4); ckv_ = *(const v2u*)(r_ + C_CKV + (lane & 31) * 4); } while (0)
    if (gw < TT) PREP_LOAD(gw, cx0, cxm, cxp, ccq, cckv, cgl, cdt);
    for (int m = gw; m < TT; m += NGW) {
        const int mn = m + NGW;
        if (mn < TT) PREP_LOAD(mn, nx0, nxm, nxp, ncq, nckv, ngl, ndt);
#pragma unroll
        for (int ch = 0; ch < 3; ++ch) { const int c = ch * 256 + lane * 4; const v2u x0 = cx0[ch], xm = cxm[ch], xp = cxp[ch];
            const f32x4 w0 = *(const LAS f32x4*)(cws + c), w1 = *(const LAS f32x4*)(cws + 768 + c), w2 = *(const LAS f32x4*)(cws + 1536 + c), bb = *(const LAS f32x4*)(cws + 2304 + c);
            f32x4 v; v.x = w0.x * bflo(xm.x) + w1.x * bflo(x0.x) + w2.x * bflo(xp.x) + bb.x; v.y = w0.y * bfhi(xm.x) + w1.y * bfhi(x0.x) + w2.y * bfhi(xp.x) + bb.y;
            v.z = w0.z * bflo(xm.y) + w1.z * bflo(x0.y) + w2.z * bflo(xp.y) + bb.z; v.w = w0.w * bfhi(xm.y) + w1.w * bfhi(x0.y) + w2.w * bfhi(xp.y) + bb.w;
            v2u o; o.x = pk2(fsilu(v.x), fsilu(v.y)); o.y = pk2(fsilu(v.z), fsilu(v.w)); *(v2u*)(xbc + (size_t)m * 768 + c) = o; __builtin_amdgcn_sched_barrier(0); }
        if (lane < 16) dt[(size_t)m * 16 + lane] = fsoftplus(bf2f(cdt) + dtb);
#pragma unroll
        for (int dir = 0; dir < 2; ++dir) { const v4u q0 = cgl[2 * dir], q1 = cgl[2 * dir + 1];
            const unsigned gw32[8] = {q0.x, q0.y, q0.z, q0.w, q1.x, q1.y, q1.z, q1.w};
            f32x4 acc = dir ? gb1 : gb0;
#pragma unroll
            for (int r = 0; r < 16; ++r) { const unsigned w = gw32[r >> 1]; const float gv = (r & 1) ? bfhi(w) : bflo(w); acc += gv * *(const LAS f32x4*)(gws + (dir * 16 + r) * 256 + lane * 4); }
            f32x4 o; o.x = -fsoftplus(-acc.x) * 0.0625f; o.y = -fsoftplus(-acc.y) * 0.0625f; o.z = -fsoftplus(-acc.z) * 0.0625f; o.w = -fsoftplus(-acc.w) * 0.0625f;
            v2u ob; ob.x = pk2(o.x, o.y); ob.y = pk2(o.z, o.w); *(v2u*)(gg + (size_t)m * 512 + dir * 256 + lane * 4) = ob; __builtin_amdgcn_sched_barrier(0); }
        { float v0 = 0.f, v1 = 0.f, v2 = 0.f, v3 = 0.f, u0 = 0.f, u1 = 0.f, u2 = 0.f, u3 = 0.f;
          if (lane < 48) { v0 = bflo(ccq.x); v1 = bfhi(ccq.x); v2 = bflo(ccq.y); v3 = bfhi(ccq.y); }
          if (lane < 32) { u0 = bflo(cckv.x); u1 = bfhi(cckv.x); u2 = bflo(cckv.y); u3 = bfhi(cckv.y); }
          float sa = (v0 * v0 + v1 * v1) + (v2 * v2 + v3 * v3), sb = (u0 * u0 + u1 * u1) + (u2 * u2 + u3 * u3);
#pragma unroll
          for (int o = 1; o < 64; o <<= 1) { sa += __shfl_xor(sa, o); sb += __shfl_xor(sb, o); }
          const float ra = rsqrtf(sa * (1.0f / 192.0f) + EPS), rb = rsqrtf(sb * (1.0f / 128.0f) + EPS);
          v2u oa; oa.x = pk2(v0 * ra * qnw.x, v1 * ra * qnw.y); oa.y = pk2(v2 * ra * qnw.z, v3 * ra * qnw.w); *(v2u*)(aq + (size_t)m * 256 + lane * 4) = oa;
          v2u ob; ob.x = pk2(u0 * rb * kvnw.x, u1 * rb * kvnw.y); ob.y = pk2(u2 * rb * kvnw.z, u3 * rb * kvnw.w); *(v2u*)(akv + (size_t)m * 256 + lane * 4) = ob; }
#pragma unroll
        for (int ch = 0; ch < 3; ++ch) { cx0[ch] = nx0[ch]; cxm[ch] = nxm[ch]; cxp[ch] = nxp[ch]; }
        ccq = ncq; cckv = nckv; cdt = ndt;
#pragma unroll
        for (int q = 0; q < 4; ++q) cgl[q] = ngl[q];
    }
#undef PREP_LOAD
    __syncthreads();
    if (rep == 0) convert_experts(A, C, l);
}
struct AsmRow { v2u x, kk; float cs, sn; unsigned t1, t2, u1, u2; };
__device__ __forceinline__ void assemble_rows8(const Ctx& C, int m0) {
    const bf16* qraw = (const bf16*)(C.ws + WS_QRAW); const bf16* kv = (const bf16*)(C.ws + WS_KV); const bf16* cols = (const bf16*)(C.ws + WS_COLS);
    bf16* qf = (bf16*)(C.ws + WS_QF); bf16* kf = (bf16*)(C.ws + WS_KF); const float* rope = (const float*)(C.ws + WS_ROPE);
    const float QS = 0.10206207261596575f * 1.4426950408889634f;
    const int lane = C.lane, h = lane >> 4, d = (lane & 15) * 4, a = (lane >> 3) & 1, i = lane & 7;
    auto ld = [&](int m, AsmRow& r) {
        const int b = m / SB, s = m - b * SB; const bool lat = s >= CTXL; const int sp = s - CTXL, pos = a == 0 ? sp >> 6 : sp & 63;
        const bf16* q = qraw + (size_t)m * 512; const bf16* k = kv + (size_t)m * 512; const bf16* kpe = cols + (size_t)m * INWP + C_KPE;
        r.x = *(const v2u*)(q + h * 96 + d); r.kk = *(const v2u*)(k + h * 128 + d);
        r.cs = 1.f; r.sn = 0.f; if (lat) { const float2 t = *(const float2*)(rope + (pos * 8 + i) * 2); r.cs = t.x; r.sn = t.y; }
        r.t1 = q[h * 96 + 64 + a * 16 + i]; r.t2 = q[h * 96 + 64 + a * 16 + 8 + i];
        r.u1 = 0; r.u2 = 0; if (lane < 16) { r.u1 = kpe[a * 16 + i]; r.u2 = kpe[a * 16 + 8 + i]; } };
    auto fin = [&](int m, const AsmRow& r) {
        bf16* qo = qf + (size_t)m * 384; bf16* ko = kf + (size_t)m * 384;
        v2u o; o.x = pk2(bflo(r.x.x) * QS, bfhi(r.x.x) * QS); o.y = pk2(bflo(r.x.y) * QS, bfhi(r.x.y) * QS);
        *(v2u*)(qo + h * 96 + d) = o; *(v2u*)(ko + h * 96 + d) = r.kk;
        const float t1 = bf2f(r.t1), t2 = bf2f(r.t2);
        qo[h * 96 + 64 + a * 16 + i] = (bf16)f2bf((t1 * r.cs - t2 * r.sn) * QS); qo[h * 96 + 64 + a * 16 + 8 + i] = (bf16)f2bf((t2 * r.cs + t1 * r.sn) * QS);
        if (lane < 16) { const float u1 = bf2f(r.u1), u2 = bf2f(r.u2); const bf16 o1 = (bf16)f2bf(u1 * r.cs - u2 * r.sn), o2 = (bf16)f2bf(u2 * r.cs + u1 * r.sn);
#pragma unroll
            for (int hh = 0; hh < 4; ++hh) { ko[hh * 96 + 64 + a * 16 + i] = o1; ko[hh * 96 + 64 + a * 16 + 8 + i] = o2; } } };
#pragma unroll
    for (int g = 0; g < 2; ++g) { AsmRow r0, r1, r2, r3; const int m = m0 + 4 * g;
        ld(m, r0); ld(m + 1, r1); ld(m + 2, r2); ld(m + 3, r3);
        fin(m, r0); fin(m + 1, r1); fin(m + 2, r2); fin(m + 3, r3); }
}
__device__ __forceinline__ void ph_assemble(const Args& A, const Ctx& C, int l, int rep) {
    unsigned* head = (unsigned*)C.ws + CW_ASM + 64 * (2 * l + rep);
    for (;;) {
        unsigned blk = 0; if (C.lane == 0) blk = __hip_atomic_fetch_add(head, 1u, __ATOMIC_RELAXED, __HIP_MEMORY_SCOPE_AGENT);
        blk = __builtin_amdgcn_readfirstlane(blk);
        if (blk >= (unsigned)(TT / 8)) break;
        assemble_rows8(C, (int)blk * 8);
    }
}
constexpr int AT_KP = 224, AT_VP = 160, AT_KB = 64 * AT_KP  , AT_VB = 64 * AT_VP  ;
typedef short at_v4i16 __attribute__((ext_vector_type(4)));
__device__ __forceinline__ bf16x8 at_tr_frag(const LAS unsigned char* tile, int k0a, int k0b, int c0, int lane) {
    const int i = lane & 15, q = i >> 2, p = i & 3;
    const at_v4i16 lo = __builtin_amdgcn_ds_read_tr16_b64_v4i16((LAS at_v4i16*)(tile + (k0a + q) * AT_VP + (c0 + 4 * p) * 2));
    const at_v4i16 hi = __builtin_amdgcn_ds_read_tr16_b64_v4i16((LAS at_v4i16*)(tile + (k0b + q) * AT_VP + (c0 + 4 * p) * 2));
    bf16x8 r; r[0] = lo[0]; r[1] = lo[1]; r[2] = lo[2]; r[3] = lo[3]; r[4] = hi[0]; r[5] = hi[1]; r[6] = hi[2]; r[7] = hi[3]; return r;
}
__device__ __forceinline__ float xmax4(float x) {
    const auto r = __builtin_amdgcn_permlane16_swap(__float_as_uint(x), __float_as_uint(x), false, false); const float m = fmaxf(__uint_as_float(r[0]), __uint_as_float(r[1]));
    const auto q = __builtin_amdgcn_permlane32_swap(__float_as_uint(m), __float_as_uint(m), false, false); return fmaxf(__uint_as_float(q[0]), __uint_as_float(q[1]));
}
constexpr int AT_T = 128, AT_KB2 = AT_T * AT_KP  , AT_VB2 = AT_T * AT_VP  ;
template <int VAR>
__device__ __forceinline__ void attn_unit(const Ctx& C, int b, int h, int qt) {
    const bf16* qfp = (const bf16*)(C.ws + WS_QF); const bf16* kfp = (const bf16*)(C.ws + WS_KF); const bf16* kvp = (const bf16*)(C.ws + WS_KV); bf16* mix = (bf16*)(C.ws + (VAR ? WS_H : WS_ACT1));
    LAS unsigned char* lds = C.lds;
    const int tid = C.tid, lane = C.lane, wave = C.wave, fr = lane & 15, fq = lane >> 4;
    const size_t mb = (size_t)b * SB;
    const int nkt = (qt == 0 ? CTXL : SB) / AT_T;
    const size_t mq = mb + (size_t)qt * 256 + wave * 32;
    bf16x8 qf[2][3];
#pragma unroll
    for (int qb = 0; qb < 2; ++qb)
#pragma unroll
        for (int ks = 0; ks < 3; ++ks) qf[qb][ks] = *(const bf16x8*)(qfp + (mq + qb * 16 + fr) * 384 + h * 96 + ks * 32 + fq * 8);
    f32x4 ot[2][4];
#pragma unroll
    for (int qb = 0; qb < 2; ++qb)
#pragma unroll
        for (int d = 0; d < 4; ++d) ot[qb][d] = (f32x4){0.f, 0.f, 0.f, 0.f};
    float mrun[2] = {0.f, 0.f};
    f32x4 lacc[2]; lacc[0] = (f32x4){0.f, 0.f, 0.f, 0.f}; lacc[1] = lacc[0];
    const bf16x8 ones = __builtin_bit_cast(bf16x8, ((v4u){0x3f803f80u, 0x3f803f80u, 0x3f803f80u, 0x3f803f80u}));
    const bf16* kg[3]; int kl[3];
#pragma unroll
    for (int j = 0; j < 3; ++j) { const int id = tid + 512 * j, r = id / 12, cc = id - r * 12; kg[j] = kfp + (mb + r) * 384 + h * 96 + cc * 8; kl[j] = r * AT_KP + cc * 16; }
    const bf16* vg = kvp + (mb + (tid >> 3)) * 512 + h * 128 + 64 + (tid & 7) * 8; const int vl = (tid >> 3) * AT_VP + (tid & 7) * 16;
    v4u rk[3], rv[2];
#pragma unroll
    for (int j = 0; j < 3; ++j) rk[j] = *(const v4u*)kg[j];
    rv[0] = *(const v4u*)vg; rv[1] = *(const v4u*)(vg + 64 * 512);
    __syncthreads();
    if (wave < 4) __builtin_amdgcn_s_setprio(1);
#pragma unroll
    for (int j = 0; j < 3; ++j) *(LAS v4u*)(lds + kl[j]) = rk[j];
    *(LAS v4u*)(lds + 2 * AT_KB2 + vl) = rv[0]; *(LAS v4u*)(lds + 2 * AT_KB2 + 64 * AT_VP + vl) = rv[1];
    __syncthreads();
    f32x4 saA[2][4], saB[2][4]; bf16x8 pfA[2][2], pfB[2][2];
    auto qk = [&](const LAS unsigned char* kb_, f32x4 (&sa)[2][4]) {
#pragma unroll
        for (int kb = 0; kb < 4; ++kb) {
            bf16x8 kfr[3];
#pragma unroll
            for (int ks = 0; ks < 3; ++ks) kfr[ks] = *(const LAS bf16x8*)(kb_ + (kb * 16 + fr) * AT_KP + ks * 64 + fq * 16);
#pragma unroll
            for (int qb = 0; qb < 2; ++qb) { const float nm = -mrun[qb]; f32x4 acc = (f32x4){nm, nm, nm, nm};
#pragma unroll
                for (int ks = 0; ks < 3; ++ks) acc = __builtin_amdgcn_mfma_f32_16x16x32_bf16(kfr[ks], qf[qb][ks], acc, 0, 0, 0);
                sa[qb][kb] = acc; }
        } };
    auto sm_max = [&](f32x4 (&sa)[2][4]) {
#pragma unroll
        for (int qb = 0; qb < 2; ++qb) {
            float mx = fmaxf(fmaxf(sa[qb][0].x, sa[qb][0].y), fmaxf(sa[qb][0].z, sa[qb][0].w));
#pragma unroll
            for (int kb = 1; kb < 4; ++kb) mx = fmaxf(fmaxf(mx, fmaxf(sa[qb][kb].x, sa[qb][kb].y)), fmaxf(sa[qb][kb].z, sa[qb][kb].w));
            mx = fmaxf(mx, __shfl_xor(mx, 16)); mx = fmaxf(mx, __shfl_xor(mx, 32));
            if (__any(mx > 0.f)) {
                const float delta = fmaxf(mx, 0.f), alpha = __builtin_amdgcn_exp2f(-delta); mrun[qb] += delta; lacc[qb] *= alpha;
#pragma unroll
                for (int d = 0; d < 4; ++d) ot[qb][d] *= alpha;
#pragma unroll
                for (int kb = 0; kb < 4; ++kb) sa[qb][kb] -= delta;
            }
        } };
    auto sm_exp = [&](const f32x4 (&sa)[2][4], bf16x8 (&pf)[2][2]) {
#pragma unroll
        for (int qb = 0; qb < 2; ++qb) { unsigned pw[8];
#pragma unroll
            for (int kb = 0; kb < 4; ++kb) { const float p0 = __builtin_amdgcn_exp2f(sa[qb][kb].x), p1 = __builtin_amdgcn_exp2f(sa[qb][kb].y), p2 = __builtin_amdgcn_exp2f(sa[qb][kb].z), p3 = __builtin_amdgcn_exp2f(sa[qb][kb].w);
                pw[kb * 2] = pk2(p0, p1); pw[kb * 2 + 1] = pk2(p2, p3); }
#pragma unroll
            for (int kk = 0; kk < 2; ++kk) { const v4u w = (v4u){pw[kk * 4], pw[kk * 4 + 1], pw[kk * 4 + 2], pw[kk * 4 + 3]}; pf[qb][kk] = __builtin_bit_cast(bf16x8, w); } } };
    auto pv = [&](const LAS unsigned char* vb_, const bf16x8 (&pf)[2][2]) {
#pragma unroll
        for (int kk = 0; kk < 2; ++kk) { lacc[0] = __builtin_amdgcn_mfma_f32_16x16x32_bf16(ones, pf[0][kk], lacc[0], 0, 0, 0); lacc[1] = __builtin_amdgcn_mfma_f32_16x16x32_bf16(ones, pf[1][kk], lacc[1], 0, 0, 0); }
#pragma unroll
        for (int d = 0; d < 4; ++d)
#pragma unroll
            for (int kk = 0; kk < 2; ++kk) {
                const bf16x8 vf = at_tr_frag(vb_, kk * 32 + 4 * fq, kk * 32 + 16 + 4 * fq, d * 16, lane);
#pragma unroll
                for (int qb = 0; qb < 2; ++qb) ot[qb][d] = __builtin_amdgcn_mfma_f32_16x16x32_bf16(vf, pf[qb][kk], ot[qb][d], 0, 0, 0);
            } };
    int vcur = 2 * AT_KB2, vnext = vcur + AT_VB2, vfree = vnext + AT_VB2;
    qk(lds, saA);
    for (int kt = 0; kt < nkt; ++kt) {
        const int cur = kt & 1; const bool more = kt + 1 < nkt;
        if (more) { const size_t ko = (size_t)(kt + 1) * AT_T;
#pragma unroll
            for (int j = 0; j < 3; ++j) rk[j] = *(const v4u*)(kg[j] + ko * 384);
            rv[0] = *(const v4u*)(vg + ko * 512); rv[1] = *(const v4u*)(vg + (ko + 64) * 512); }
        const LAS unsigned char* kb_ = lds + cur * AT_KB2;
        sm_max(saA);
        qk(kb_ + 64 * AT_KP, saB); sm_exp(saA, pfA);
        pv(lds + vcur, pfA);
        sm_max(saB);
        if (more) { const int nx = cur ^ 1;
#pragma unroll
            for (int j = 0; j < 3; ++j) *(LAS v4u*)(lds + nx * AT_KB2 + kl[j]) = rk[j];
            *(LAS v4u*)(lds + vnext + vl) = rv[0]; *(LAS v4u*)(lds + vnext + 64 * AT_VP + vl) = rv[1]; }
        __syncthreads();
        if (more) { qk(lds + (cur ^ 1) * AT_KB2, saA); sm_exp(saB, pfB); } else sm_exp(saB, pfB);
        pv(lds + vcur + 64 * AT_VP, pfB);
        { const int t = vfree; vfree = vcur; vcur = vnext; vnext = t; }
    }
    __builtin_amdgcn_s_setprio(0);
#pragma unroll
    for (int qb = 0; qb < 2; ++qb) {
        const float inv = 1.0f / lacc[qb].x;
        bf16* orow = mix + (mq + qb * 16 + fr) * DM + 768 + h * 64 + 4 * fq;
#pragma unroll
        for (int d = 0; d < 4; ++d) { v2u o; o.x = pk2(ot[qb][d].x * inv, ot[qb][d].y * inv); o.y = pk2(ot[qb][d].z * inv, ot[qb][d].w * inv); *(v2u*)(orow + d * 16) = o; }
    }
}
__device__ __forceinline__ void attn_queue(const Ctx& C, int l, int rep) {
    unsigned* head = (unsigned*)C.ws + CW_AQ + 64 * (8 * l + rep);
    const int nunits = 1024 + (l == 0 ? 64 : 0);
    for (;;) {
        __syncthreads();
        if (C.tid == 0) C.MISC[MISC_Q] = __hip_atomic_fetch_add(head, 1u, __ATOMIC_RELAXED, __HIP_MEMORY_SCOPE_AGENT);
        __syncthreads();
        const int u = (int)C.MISC[MISC_Q];
        if (u >= nunits) break;
        const int ub = u < 1024 ? u >> 6 : (u - 1024) >> 2, uh = u < 1024 ? (u >> 4) & 3 : (u - 1024) & 3, uq = u < 1024 ? 1 + (u & 15) : 0;
#ifdef ATT_VAR
        if (rep == 0) attn_unit<0>(C, ub, uh, uq); else attn_unit<ATT_VAR>(C, ub, uh, uq);
#else
        attn_unit<0>(C, ub, uh, uq);
#endif
    }
}
#ifndef XSTATE
#define XSTATE 1
#endif
#ifndef XINTRA
#define XINTRA 1
#endif
constexpr int CH = 64, NCH = SB / CH  , NCTXCH = CTXL / CH  ;
constexpr int TP = 160;
constexpr int TILE_B = 64 * TP;
typedef short v4i16_t __attribute__((ext_vector_type(4)));
__device__ __forceinline__ bf16x8 tr_frag(const LAS unsigned char* tile, int k0a, int k0b, int c0, int lane) {
#ifdef TR_SLOW
    const int col = c0 + (lane & 15); const LAS unsigned short* t = (const LAS unsigned short*)tile; bf16x8 r;
#pragma unroll
    for (int e = 0; e < 4; ++e) { r[e] = (short)t[(k0a + e) * (TP / 2) + col]; r[4 + e] = (short)t[(k0b + e) * (TP / 2) + col]; }
    return r;
#else
    const int i = lane & 15, q = i >> 2, p = i & 3;
    const v4i16_t lo = __builtin_amdgcn_ds_read_tr16_b64_v4i16((LAS v4i16_t*)(tile + (k0a + q) * TP + (c0 + 4 * p) * 2));
    const v4i16_t hi = __builtin_amdgcn_ds_read_tr16_b64_v4i16((LAS v4i16_t*)(tile + (k0b + q) * TP + (c0 + 4 * p) * 2));
    bf16x8 r; r[0] = lo[0]; r[1] = lo[1]; r[2] = lo[2]; r[3] = lo[3]; r[4] = hi[0]; r[5] = hi[1]; r[6] = hi[2]; r[7] = hi[3]; return r;
#endif
}
__device__ __forceinline__ bf16x8 tr_frag_g4(const LAS unsigned char* tile, int k0a, int k0b, int g, int lane) {
    const int i = lane & 15, q = i >> 2, p = i & 3;
    const v4i16_t lo = __builtin_amdgcn_ds_read_tr16_b64_v4i16((LAS v4i16_t*)(tile + (k0a + q) * TP + (16 * p + 4 * g) * 2));
    const v4i16_t hi = __builtin_amdgcn_ds_read_tr16_b64_v4i16((LAS v4i16_t*)(tile + (k0b + q) * TP + (16 * p + 4 * g) * 2));
    bf16x8 r; r[0] = lo[0]; r[1] = lo[1]; r[2] = lo[2]; r[3] = lo[3]; r[4] = hi[0]; r[5] = hi[1]; r[6] = hi[2]; r[7] = hi[3]; return r;
}
__device__ __forceinline__ bf16x8 row_frag(const LAS unsigned char* tile, int row, int col) { return *(const LAS bf16x8*)(tile + row * TP + col * 2); }
__device__ __forceinline__ v4u scale8(v4u x, float s) { v4u o; o.x = pk2(bflo(x.x) * s, bfhi(x.x) * s); o.y = pk2(bflo(x.y) * s, bfhi(x.y) * s); o.z = pk2(bflo(x.z) * s, bfhi(x.z) * s); o.w = pk2(bflo(x.w) * s, bfhi(x.w) * s); return o; }
__device__ __forceinline__ v4u scale8v(v4u x, f32x4 a, f32x4 b) { v4u o; o.x = pk2(bflo(x.x) * a.x, bfhi(x.x) * a.y); o.y = pk2(bflo(x.y) * a.z, bfhi(x.y) * a.w); o.z = pk2(bflo(x.z) * b.x, bfhi(x.z) * b.y); o.w = pk2(bflo(x.w) * b.z, bfhi(x.w) * b.w); return o; }
__device__ __forceinline__ f32x4 exp4(f32x4 a) { return (f32x4){__expf(a.x), __expf(a.y), __expf(a.z), __expf(a.w)}; }
constexpr size_t WS_SST = WS_ARENA + 1200 * MiB;
constexpr size_t WS_GST = WS_ARENA + 1336 * MiB;
constexpr size_t WS_SEN = WS_ARENA + 991 * MiB;
constexpr size_t WS_GEN = WS_ARENA + 1127 * MiB;
constexpr size_t WS_SDEC = WS_ARENA + 1404 * MiB;
constexpr size_t WS_GDEC = WS_ARENA + 1405 * MiB;
static_assert(WS_GDEC + 5 * MiB <= WS_ARENA + 1428 * MiB, "arena");

template <bool SSD>
__device__ __forceinline__ void chunk_cums(const Ctx& C, int l, size_t m0, int h0, int nh, LAS float* cums, const float* alog) {
    if (SSD) {
        const int w = C.wave; if (w < 2 * nh) { const int hl = w >> 1, d = w & 1, h = h0 + hl, s = d == 0 ? C.lane : 63 - C.lane;
            const float dtv = ((const float*)(C.ws + WS_DT))[(m0 + s) * 16 + d * 8 + h]; float v = dtv * -expf(alog[l * 16 + d * 8 + h]);
#pragma unroll
            for (int o = 1; o < 64; o <<= 1) { const float t = __shfl_up(v, o); if (C.lane >= o) v += t; }
            cums[(d * nh + hl) * 64 + s] = v; cums[((2 + d) * nh + hl) * 64 + s] = dtv; }
    } else {
        if (C.tid < 128) { const int d = C.tid >> 6, k = C.tid & 63; const float* gp = (const float*)(C.ws + WS_G) + m0 * 512 + d * 256 + h0 * 64 + k; float acc = 0.f;
#pragma unroll 16
            for (int i = 0; i < 64; ++i) { const int s = d == 0 ? i : 63 - i; acc += gp[(size_t)s * 512]; cums[d * 4096 + s * 64 + k] = acc; } }
    }
}
template <bool SSD>
__device__ __forceinline__ void chunk_s1(const Ctx& C, int l, int unit, const float* alog) {
    constexpr int NH = SSD ? 8 : 4;
    const int b = unit / (NCH * NH), rem = unit - b * (NCH * NH), c = rem / NH, h = rem - c * NH; const size_t m0 = (size_t)b * SB + c * CH;
    LAS unsigned char* VT = C.lds; LAS unsigned char* KSF = C.lds + TILE_B; LAS unsigned char* KSB = C.lds + 2 * TILE_B; LAS float* cums = (LAS float*)(C.lds + 3 * TILE_B);
    __syncthreads();
    chunk_cums<SSD>(C, l, m0, h, 1, cums, alog);
    __syncthreads();
    { const int s = C.tid >> 3, sub = C.tid & 7; const size_t m = m0 + s;
      v4u vv, kk; v4u kf, kb;
      if (SSD) { const bf16* r = (const bf16*)(C.ws + WS_XBC) + m * 768; vv = *(const v4u*)(r + h * 64 + sub * 8); kk = *(const v4u*)(r + 512 + (h >> 2) * 64 + sub * 8);
          const float wf = cums[128 + s] * __expf(cums[63] - cums[s]), wb = cums[192 + s] * __expf(cums[64] - cums[64 + s]);
          kf = scale8(kk, wf); kb = scale8(kk, wb);
      } else { const bf16* r = (const bf16*)(C.ws + WS_COLS) + m * INWP + h * 64 + sub * 8; vv = *(const v4u*)(r + C_GV); kk = *(const v4u*)(r + C_GK);
          const LAS float* cf = cums + s * 64 + sub * 8; const LAS float* cb = cums + 4096 + s * 64 + sub * 8; const LAS float* cfl = cums + 63 * 64 + sub * 8; const LAS float* cbl = cums + 4096 + sub * 8;
          kf = scale8v(kk, exp4(*(const LAS f32x4*)cfl - *(const LAS f32x4*)cf), exp4(*(const LAS f32x4*)(cfl + 4) - *(const LAS f32x4*)(cf + 4)));
          kb = scale8v(kk, exp4(*(const LAS f32x4*)cbl - *(const LAS f32x4*)cb), exp4(*(const LAS f32x4*)(cbl + 4) - *(const LAS f32x4*)(cb + 4))); }
      *(LAS v4u*)(VT + s * TP + sub * 16) = vv; *(LAS v4u*)(KSF + s * TP + sub * 16) = kf; *(LAS v4u*)(KSB + s * TP + sub * 16) = kb; }
    __syncthreads();
    { const int w = C.wave, d = w >> 2, kb_ = w & 3, lane = C.lane, fr = lane & 15, fq = lane >> 4; const LAS unsigned char* KS = d ? KSB : KSF;
      f32x4 acc[4];
#pragma unroll
      for (int vb = 0; vb < 4; ++vb) acc[vb] = (f32x4){0.f, 0.f, 0.f, 0.f};
#pragma unroll
      for (int ks = 0; ks < 2; ++ks) { const bf16x8 a = tr_frag(KS, ks * 32 + 8 * fq, ks * 32 + 8 * fq + 4, kb_ * 16, lane);
#pragma unroll
          for (int vb = 0; vb < 4; ++vb) { const bf16x8 bo = tr_frag(VT, ks * 32 + 8 * fq, ks * 32 + 8 * fq + 4, vb * 16, lane); acc[vb] = __builtin_amdgcn_mfma_f32_16x16x32_bf16(a, bo, acc[vb], 0, 0, 0); } }
      bf16* st = (bf16*)(C.ws + (SSD ? WS_SST : WS_GST)) + ((((size_t)b * NCH + c) * 2 + d) * NH + h) * 4096;
#pragma unroll
      for (int vb = 0; vb < 4; ++vb) { v2u o; o.x = pk2(acc[vb].x, acc[vb].y); o.y = pk2(acc[vb].z, acc[vb].w); *(v2u*)(st + (vb * 16 + fr) * 64 + kb_ * 16 + 4 * fq) = o; } }
    if (SSD) { if (C.tid < 2) ((float*)(C.ws + WS_SDEC))[(((size_t)b * NCH + c) * 2 + C.tid) * 8 + h] = __expf(C.tid == 0 ? cums[63] : cums[64]); }
    else { if (C.tid < 128) { const int d = C.tid >> 6, k = C.tid & 63; ((float*)(C.ws + WS_GDEC))[((((size_t)b * NCH + c) * 2 + d) * 4 + h) * 64 + k] = __expf(d == 0 ? cums[63 * 64 + k] : cums[4096 + k]); } }
}
template <bool SSD>
__device__ __forceinline__ void chunk_s2(const Ctx& C, int chain) {
    constexpr int NH = SSD ? 8 : 4;
    const int b = chain / (2 * NH), d = (chain / NH) & 1, h = chain % NH;
    const bf16* st = (const bf16*)(C.ws + (SSD ? WS_SST : WS_GST)); bf16* en = (bf16*)(C.ws + (SSD ? WS_SEN : WS_GEN)); const float* dec = (const float*)(C.ws + (SSD ? WS_SDEC : WS_GDEC));
    const int v = C.tid >> 3, k0 = (C.tid & 7) * 8;
    float run[8];
#pragma unroll
    for (int j = 0; j < 8; ++j) run[j] = 0.f;
    auto chunk_at = [&](int i) { return d == 0 ? i : (i < NCTXCH ? NCTXCH - 1 - i : NCH + NCTXCH - 1 - i); };
    v4u nxt = *(const v4u*)(st + ((((size_t)b * NCH + chunk_at(0)) * 2 + d) * NH + h) * 4096 + v * 64 + k0);
    for (int i = 0; i < NCH; ++i) {
        const int c = chunk_at(i); const size_t base = (((size_t)b * NCH + c) * 2 + d) * NH + h; bf16* p = en + base * 4096 + v * 64 + k0;
        const v4u inc = nxt; if (i + 1 < NCH) nxt = *(const v4u*)(st + ((((size_t)b * NCH + chunk_at(i + 1)) * 2 + d) * NH + h) * 4096 + v * 64 + k0);
        f32x4 d0, d1; if (SSD) { const float dd = dec[base]; d0 = (f32x4){dd, dd, dd, dd}; d1 = d0; } else { d0 = *(const f32x4*)(dec + base * 64 + k0); d1 = *(const f32x4*)(dec + base * 64 + k0 + 4); }
        v4u o; o.x = pk2(run[0], run[1]); o.y = pk2(run[2], run[3]); o.z = pk2(run[4], run[5]); o.w = pk2(run[6], run[7]); *(v4u*)p = o;
        run[0] = d0.x * run[0] + bflo(inc.x); run[1] = d0.y * run[1] + bfhi(inc.x); run[2] = d0.z * run[2] + bflo(inc.y); run[3] = d0.w * run[3] + bfhi(inc.y);
        run[4] = d1.x * run[4] + bflo(inc.z); run[5] = d1.y * run[5] + bfhi(inc.z); run[6] = d1.z * run[6] + bflo(inc.w); run[7] = d1.w * run[7] + bfhi(inc.w);
    }
}
template <bool SSD>
__device__ __forceinline__ void chunk_s2_wave(const Ctx& C, int chain) {
    constexpr int NH = SSD ? 8 : 4;
    const int b = chain / (2 * NH), d = (chain / NH) & 1, h = chain % NH, lane = C.lane;
    const bf16* st = (const bf16*)(C.ws + (SSD ? WS_SST : WS_GST)); bf16* en = (bf16*)(C.ws + (SSD ? WS_SEN : WS_GEN)); const float* dec = (const float*)(C.ws + (SSD ? WS_SDEC : WS_GDEC));
    const int k0 = (lane & 7) * 8;
    float run[64];
#pragma unroll
    for (int e = 0; e < 64; ++e) run[e] = 0.f;
    auto chunk_at = [&](int i) { return d == 0 ? i : (i < NCTXCH ? NCTXCH - 1 - i : NCH + NCTXCH - 1 - i); };
    auto base_at = [&](int i) { return (((size_t)b * NCH + chunk_at(i)) * 2 + d) * NH + h; };
    v4u q0[8], q1[8], q2[8]; f32x4 a0, b0, a1, b1, a2, b2;
    auto ld = [&](int i, v4u (&q)[8], f32x4& da, f32x4& db) { const size_t base = base_at(i);
#pragma unroll
        for (int j = 0; j < 8; ++j) q[j] = *(const v4u*)(st + base * 4096 + j * 512 + lane * 8);
        if (SSD) { const float dd = dec[base]; da = (f32x4){dd, dd, dd, dd}; db = da; } else { da = *(const f32x4*)(dec + base * 64 + k0); db = *(const f32x4*)(dec + base * 64 + k0 + 4); } };
    auto step = [&](int i, const v4u (&inc)[8], const f32x4& d0, const f32x4& d1, v4u (&pq)[8], f32x4& pa, f32x4& pb) {
        if (i + 2 < NCH) ld(i + 2, pq, pa, pb);
        bf16* p = en + base_at(i) * 4096 + lane * 8;
#pragma unroll
        for (int j = 0; j < 8; ++j) { float* r = run + j * 8;
            v4u o; o.x = pk2(r[0], r[1]); o.y = pk2(r[2], r[3]); o.z = pk2(r[4], r[5]); o.w = pk2(r[6], r[7]); *(v4u*)(p + j * 512) = o;
            r[0] = d0.x * r[0] + bflo(inc[j].x); r[1] = d0.y * r[1] + bfhi(inc[j].x); r[2] = d0.z * r[2] + bflo(inc[j].y); r[3] = d0.w * r[3] + bfhi(inc[j].y);
            r[4] = d1.x * r[4] + bflo(inc[j].z); r[5] = d1.y * r[5] + bfhi(inc[j].z); r[6] = d1.z * r[6] + bflo(inc[j].w); r[7] = d1.w * r[7] + bfhi(inc[j].w); } };
    ld(0, q0, a0, b0); ld(1, q1, a1, b1);
    for (int i = 0; i < NCH; i += 3) {
        step(i, q0, a0, b0, q2, a2, b2);
        if (i + 1 < NCH) step(i + 1, q1, a1, b1, q0, a0, b0);
        if (i + 2 < NCH) step(i + 2, q2, a2, b2, q1, a1, b1);
    }
}
template <bool SSD>
__device__ __forceinline__ void chunk_s2_slice(const Ctx& C, int chain, int sl) {
    constexpr int NH = SSD ? 8 : 4;
    static_assert(NCH % 4 == 0, "ring of four");
    const int b = chain / (2 * NH), d = (chain / NH) & 1, h = chain % NH, lane = C.lane;
    const bf16* st = (const bf16*)(C.ws + (SSD ? WS_SST : WS_GST)) + sl * 1024 + lane * 8; bf16* en = (bf16*)(C.ws + (SSD ? WS_SEN : WS_GEN)) + sl * 1024 + lane * 8; const float* dec = (const float*)(C.ws + (SSD ? WS_SDEC : WS_GDEC));
    const int k0 = (lane & 7) * 8;
    float run[16];
#pragma unroll
    for (int e = 0; e < 16; ++e) run[e] = 0.f;
    auto chunk_at = [&](int i) { return d == 0 ? i : (i < NCTXCH ? NCTXCH - 1 - i : NCH + NCTXCH - 1 - i); };
    auto base_at = [&](int i) { return (((size_t)b * NCH + chunk_at(i)) * 2 + d) * NH + h; };
    v4u q0[2], q1[2], q2[2], q3[2]; f32x4 a0, b0, a1, b1, a2, b2, a3, b3;
    auto ld = [&](int i, v4u (&q)[2], f32x4& da, f32x4& db) { const size_t base = base_at(i);
        q[0] = *(const v4u*)(st + base * 4096); q[1] = *(const v4u*)(st + base * 4096 + 512);
        if (SSD) { const float dd = dec[base]; da = (f32x4){dd, dd, dd, dd}; db = da; } else { da = *(const f32x4*)(dec + base * 64 + k0); db = *(const f32x4*)(dec + base * 64 + k0 + 4); } };
    auto step = [&](int i, const v4u (&inc)[2], const f32x4& d0, const f32x4& d1, v4u (&pq)[2], f32x4& pa, f32x4& pb) {
        if (i + 3 < NCH) ld(i + 3, pq, pa, pb);
        bf16* p = en + base_at(i) * 4096;
#pragma unroll
        for (int j = 0; j < 2; ++j) { float* r = run + j * 8;
            v4u o; o.x = pk2(r[0], r[1]); o.y = pk2(r[2], r[3]); o.z = pk2(r[4], r[5]); o.w = pk2(r[6], r[7]); *(v4u*)(p + j * 512) = o;
            r[0] = d0.x * r[0] + bflo(inc[j].x); r[1] = d0.y * r[1] + bfhi(inc[j].x); r[2] = d0.z * r[2] + bflo(inc[j].y); r[3] = d0.w * r[3] + bfhi(inc[j].y);
            r[4] = d1.x * r[4] + bflo(inc[j].z); r[5] = d1.y * r[5] + bfhi(inc[j].z); r[6] = d1.z * r[6] + bflo(inc[j].w); r[7] = d1.w * r[7] + bfhi(inc[j].w); } };
    ld(0, q0, a0, b0); ld(1, q1, a1, b1); ld(2, q2, a2, b2);
    for (int i = 0; i < NCH; i += 4) {
        step(i, q0, a0, b0, q3, a3, b3);
        step(i + 1, q1, a1, b1, q0, a0, b0);
        step(i + 2, q2, a2, b2, q1, a1, b1);
        step(i + 3, q3, a3, b3, q2, a2, b2);
    }
}
__device__ __forceinline__ bf16x8 pack_p(f32x4 a, f32x4 b) { const v4u w = (v4u){pk2(a.x, a.y), pk2(a.z, a.w), pk2(b.x, b.y), pk2(b.z, b.w)}; return __builtin_bit_cast(bf16x8, w); }
__device__ __forceinline__ void ssd_s3(const Ctx& C, int l, int unit, const float* alog, const float* dskip, const float* normw) {
    const int b = unit / (NCH * 2), rem = unit - b * (NCH * 2), c = rem >> 1, g = rem & 1; const size_t m0 = (size_t)b * SB + c * CH;
    LAS unsigned char* XT = C.lds;
    LAS unsigned char* KR = C.lds + 4 * TILE_B; LAS unsigned char* QR = C.lds + 5 * TILE_B;
    LAS float* cums = (LAS float*)(C.lds + 6 * TILE_B);
    LAS float* ssx = cums + 1024;
    __syncthreads();
    chunk_cums<true>(C, l, m0, g * 4, 4, cums, alog);
    { const int s = C.tid >> 3, sub = C.tid & 7; const bf16* r = (const bf16*)(C.ws + WS_XBC) + (m0 + s) * 768;
#pragma unroll
      for (int hl = 0; hl < 4; ++hl) *(LAS v4u*)(XT + hl * TILE_B + s * TP + sub * 16) = *(const v4u*)(r + (g * 4 + hl) * 64 + sub * 8);
      *(LAS v4u*)(KR + s * TP + sub * 16) = *(const v4u*)(r + 512 + g * 64 + sub * 8); *(LAS v4u*)(QR + s * TP + sub * 16) = *(const v4u*)(r + 640 + g * 64 + sub * 8); }
    const int w = C.wave, hl = w >> 1, lh = w & 1, h = g * 4 + hl, lane = C.lane, fr = lane & 15, fq = lane >> 4;
    bf16x8 hst[2][4][2];
    { const bf16* stb = (const bf16*)(C.ws + WS_SEN) + (((size_t)b * NCH + c) * 2 * 8 + h) * 4096;
#pragma unroll
      for (int d = 0; d < 2; ++d)
#pragma unroll
          for (int vb = 0; vb < 4; ++vb)
#pragma unroll
              for (int ks = 0; ks < 2; ++ks) hst[d][vb][ks] = *(const bf16x8*)(stb + (size_t)d * 8 * 4096 + (vb * 16 + fr) * 64 + ks * 32 + fq * 8);
 }
    __syncthreads();
    const LAS float* cf = cums + hl * 64; const LAS float* cb = cums + 256 + hl * 64; const LAS float* df = cums + 512 + hl * 64; const LAS float* db = cums + 768 + hl * 64;
    const LAS unsigned char* VT = XT + hl * TILE_B;
    bf16x8 cq[2][2];
#pragma unroll
    for (int lb = 0; lb < 2; ++lb)
#pragma unroll
        for (int ks = 0; ks < 2; ++ks) cq[lb][ks] = row_frag(QR, (2 * lh + lb) * 16 + fr, ks * 32 + fq * 8);
    f32x4 ao[2][4];
#pragma unroll
    for (int lb = 0; lb < 2; ++lb)
#pragma unroll
        for (int vb = 0; vb < 4; ++vb) ao[lb][vb] = (f32x4){0.f, 0.f, 0.f, 0.f};
    if (XINTRA) {
        f32x4 ap[2][4];
#pragma unroll
        for (int sb = 0; sb < 4; ++sb) { const bf16x8 k0f = row_frag(KR, sb * 16 + fr, fq * 8), k1f = row_frag(KR, sb * 16 + fr, 32 + fq * 8);
#pragma unroll
            for (int lb = 0; lb < 2; ++lb) { f32x4 a = (f32x4){0.f, 0.f, 0.f, 0.f}; a = __builtin_amdgcn_mfma_f32_16x16x32_bf16(k0f, cq[lb][0], a, 0, 0, 0); a = __builtin_amdgcn_mfma_f32_16x16x32_bf16(k1f, cq[lb][1], a, 0, 0, 0); ap[lb][sb] = a; } }
#pragma unroll
        for (int lb = 0; lb < 2; ++lb) { const int lrow = (2 * lh + lb) * 16 + fr; const float cfl = cf[lrow], cbl = cb[lrow];
#pragma unroll
            for (int sb = 0; sb < 4; ++sb) { const int s0 = sb * 16 + 4 * fq; const f32x4 cfs = *(const LAS f32x4*)(cf + s0), cbs = *(const LAS f32x4*)(cb + s0), dfs = *(const LAS f32x4*)(df + s0), dbs = *(const LAS f32x4*)(db + s0);
                f32x4 m;
                m.x = (s0 + 0 <= lrow ? dfs.x * __expf(fminf(cfl - cfs.x, 0.f)) : 0.f) + (s0 + 0 >= lrow ? dbs.x * __expf(fminf(cbl - cbs.x, 0.f)) : 0.f);
                m.y = (s0 + 1 <= lrow ? dfs.y * __expf(fminf(cfl - cfs.y, 0.f)) : 0.f) + (s0 + 1 >= lrow ? dbs.y * __expf(fminf(cbl - cbs.y, 0.f)) : 0.f);
                m.z = (s0 + 2 <= lrow ? dfs.z * __expf(fminf(cfl - cfs.z, 0.f)) : 0.f) + (s0 + 2 >= lrow ? dbs.z * __expf(fminf(cbl - cbs.z, 0.f)) : 0.f);
                m.w = (s0 + 3 <= lrow ? dfs.w * __expf(fminf(cfl - cfs.w, 0.f)) : 0.f) + (s0 + 3 >= lrow ? dbs.w * __expf(fminf(cbl - cbs.w, 0.f)) : 0.f);
                ap[lb][sb] *= m; } }
#pragma unroll
        for (int kk = 0; kk < 2; ++kk) { bf16x8 pf[2]; pf[0] = pack_p(ap[0][2 * kk], ap[0][2 * kk + 1]); pf[1] = pack_p(ap[1][2 * kk], ap[1][2 * kk + 1]);
#pragma unroll
            for (int vb = 0; vb < 4; ++vb) { const bf16x8 xa = tr_frag(VT, kk * 32 + 4 * fq, kk * 32 + 16 + 4 * fq, vb * 16, lane);
                ao[0][vb] = __builtin_amdgcn_mfma_f32_16x16x32_bf16(xa, pf[0], ao[0][vb], 0, 0, 0); ao[1][vb] = __builtin_amdgcn_mfma_f32_16x16x32_bf16(xa, pf[1], ao[1][vb], 0, 0, 0); } }
    }
    v2u zz_[2][4];
    { const bf16* colz = (const bf16*)(C.ws + WS_COLS);
#pragma unroll
      for (int lb = 0; lb < 2; ++lb)
#pragma unroll
          for (int vb = 0; vb < 4; ++vb) zz_[lb][vb] = *(const v2u*)(colz + (m0 + (2 * lh + lb) * 16 + fr) * INWP + C_Z + h * 64 + vb * 16 + 4 * fq); }
    if (XSTATE) {
#pragma unroll
        for (int d = 0; d < 2; ++d) { bf16x8 cs[2][2];
#pragma unroll
            for (int lb = 0; lb < 2; ++lb) { const int lrow = (2 * lh + lb) * 16 + fr; const float e = __expf(d == 0 ? cf[lrow] : cb[lrow]);
#pragma unroll
                for (int ks = 0; ks < 2; ++ks) cs[lb][ks] = __builtin_bit_cast(bf16x8, scale8(__builtin_bit_cast(v4u, cq[lb][ks]), e)); }
#pragma unroll
            for (int vb = 0; vb < 4; ++vb)
#pragma unroll
                for (int ks = 0; ks < 2; ++ks) { const bf16x8 ha = hst[d][vb][ks];
                    ao[0][vb] = __builtin_amdgcn_mfma_f32_16x16x32_bf16(ha, cs[0][ks], ao[0][vb], 0, 0, 0); ao[1][vb] = __builtin_amdgcn_mfma_f32_16x16x32_bf16(ha, cs[1][ks], ao[1][vb], 0, 0, 0); } }
    }
    const float dsk = dskip[l * 8 + h]; const bf16* cols = (const bf16*)(C.ws + WS_COLS);
    float ssl[2];
#pragma unroll
    for (int lb = 0; lb < 2; ++lb) { const int lrow = (2 * lh + lb) * 16 + fr; float ss = 0.f;
#pragma unroll
        for (int vb = 0; vb < 4; ++vb) { const int p0 = vb * 16 + 4 * fq; const v2u xx = *(const LAS v2u*)(VT + lrow * TP + p0 * 2); const v2u zz = zz_[lb][vb];
            f32x4 y = ao[lb][vb]; y.x = (y.x + dsk * bflo(xx.x)) * fsilu(bflo(zz.x)); y.y = (y.y + dsk * bfhi(xx.x)) * fsilu(bfhi(zz.x)); y.z = (y.z + dsk * bflo(xx.y)) * fsilu(bflo(zz.y)); y.w = (y.w + dsk * bfhi(xx.y)) * fsilu(bfhi(zz.y));
            ao[lb][vb] = y; ss += (y.x * y.x + y.y * y.y) + (y.z * y.z + y.w * y.w); }
        ss += __shfl_xor(ss, 16); ss += __shfl_xor(ss, 32); ssl[lb] = ss; if (fq == 0) ssx[hl * 64 + lrow] = ss; }
    __syncthreads();
    bf16* mix = (bf16*)(C.ws + WS_ACT1);
#pragma unroll
    for (int lb = 0; lb < 2; ++lb) { const int lrow = (2 * lh + lb) * 16 + fr; const float tot = (ssx[lrow] + ssx[64 + lrow]) + (ssx[128 + lrow] + ssx[192 + lrow]); const float rstd = rsqrtf(tot * (1.0f / 256.0f) + EPS);
#pragma unroll
        for (int vb = 0; vb < 4; ++vb) { const int p0 = vb * 16 + 4 * fq; const f32x4 nw = *(const f32x4*)(normw + l * 512 + h * 64 + p0); const f32x4 y = ao[lb][vb];
            v2u o; o.x = pk2(y.x * rstd * nw.x, y.y * rstd * nw.y); o.y = pk2(y.z * rstd * nw.z, y.w * rstd * nw.w); *(v2u*)(mix + (m0 + lrow) * DM + h * 64 + p0) = o; } }
}
__device__ __forceinline__ void gla_s3(const Ctx& C, int l, int unit, const float* normw) {
    const int b = unit / (NCH * 4), rem = unit - b * (NCH * 4), c = rem >> 2, h = rem & 3; const size_t m0 = (size_t)b * SB + c * CH;
    LAS unsigned char* VT = C.lds; LAS unsigned char* KIF = C.lds + TILE_B; LAS unsigned char* KIB = C.lds + 2 * TILE_B; LAS unsigned char* QSF = C.lds + 3 * TILE_B; LAS unsigned char* QSB = C.lds + 4 * TILE_B;
    LAS float* cums = (LAS float*)(C.lds + 5 * TILE_B);
    LAS float* ssx = cums + 8192;
    __syncthreads();
    chunk_cums<false>(C, l, m0, h, 1, cums, nullptr);
    __syncthreads();
    { const int s = C.tid >> 3, sub = C.tid & 7; const bf16* r = (const bf16*)(C.ws + WS_COLS) + (m0 + s) * INWP + h * 64 + sub * 8;
      const v4u vv = *(const v4u*)(r + C_GV), kk = *(const v4u*)(r + C_GK), qq = scale8(*(const v4u*)(r + C_GQ), 0.125f);
      const LAS float* cf = cums + s * 64 + sub * 8; const LAS float* cb = cums + 4096 + s * 64 + sub * 8;
      const f32x4 f0 = *(const LAS f32x4*)cf, f1 = *(const LAS f32x4*)(cf + 4), b0 = *(const LAS f32x4*)cb, b1 = *(const LAS f32x4*)(cb + 4);
      *(LAS v4u*)(VT + s * TP + sub * 16) = vv;
      *(LAS v4u*)(KIF + s * TP + sub * 16) = scale8v(kk, exp4(-f0), exp4(-f1)); *(LAS v4u*)(KIB + s * TP + sub * 16) = scale8v(kk, exp4(-b0), exp4(-b1));
      *(LAS v4u*)(QSF + s * TP + sub * 16) = scale8v(qq, exp4(f0), exp4(f1)); *(LAS v4u*)(QSB + s * TP + sub * 16) = scale8v(qq, exp4(b0), exp4(b1)); }
    __syncthreads();
    const int w = C.wave, lb = w & 3, vh = w >> 2, lane = C.lane, fr = lane & 15, fq = lane >> 4; const int lrow = lb * 16 + fr;
    bf16x8 qf[2][2];
#pragma unroll
    for (int ks = 0; ks < 2; ++ks) { qf[0][ks] = row_frag(QSF, lrow, ks * 32 + fq * 8); qf[1][ks] = row_frag(QSB, lrow, ks * 32 + fq * 8); }
    f32x4 ao[2];
    ao[0] = (f32x4){0.f, 0.f, 0.f, 0.f}; ao[1] = ao[0];
    {   f32x4 ap[4];
#pragma unroll
        for (int sb = 0; sb < 4; ++sb) { f32x4 af = (f32x4){0.f, 0.f, 0.f, 0.f}, ab = af;
#pragma unroll
            for (int ks = 0; ks < 2; ++ks) { af = __builtin_amdgcn_mfma_f32_16x16x32_bf16(row_frag(KIF, sb * 16 + fr, ks * 32 + fq * 8), qf[0][ks], af, 0, 0, 0); ab = __builtin_amdgcn_mfma_f32_16x16x32_bf16(row_frag(KIB, sb * 16 + fr, ks * 32 + fq * 8), qf[1][ks], ab, 0, 0, 0); }
            const int s0 = sb * 16 + 4 * fq; f32x4 m;
            m.x = (s0 + 0 <= lrow ? af.x : 0.f) + (s0 + 0 >= lrow ? ab.x : 0.f); m.y = (s0 + 1 <= lrow ? af.y : 0.f) + (s0 + 1 >= lrow ? ab.y : 0.f);
            m.z = (s0 + 2 <= lrow ? af.z : 0.f) + (s0 + 2 >= lrow ? ab.z : 0.f); m.w = (s0 + 3 <= lrow ? af.w : 0.f) + (s0 + 3 >= lrow ? ab.w : 0.f);
            ap[sb] = m; }
#pragma unroll
        for (int kk = 0; kk < 2; ++kk) { const bf16x8 pf = pack_p(ap[2 * kk], ap[2 * kk + 1]);
#pragma unroll
            for (int vi = 0; vi < 2; ++vi) ao[vi] = __builtin_amdgcn_mfma_f32_16x16x32_bf16(tr_frag(VT, kk * 32 + 4 * fq, kk * 32 + 16 + 4 * fq, (2 * vh + vi) * 16, lane), pf, ao[vi], 0, 0, 0); }
    }
    {   const bf16* stb = (const bf16*)(C.ws + WS_GEN) + (((size_t)b * NCH + c) * 2 * 4 + h) * 4096;
#pragma unroll
        for (int d = 0; d < 2; ++d) { const bf16* sp = stb + (size_t)d * 4 * 4096;
#pragma unroll
            for (int vi = 0; vi < 2; ++vi)
#pragma unroll
                for (int ks = 0; ks < 2; ++ks) ao[vi] = __builtin_amdgcn_mfma_f32_16x16x32_bf16(*(const bf16x8*)(sp + ((2 * vh + vi) * 16 + fr) * 64 + ks * 32 + fq * 8), qf[d][ks], ao[vi], 0, 0, 0); } }
    float ss = 0.f;
#pragma unroll
    for (int vi = 0; vi < 2; ++vi) ss += (ao[vi].x * ao[vi].x + ao[vi].y * ao[vi].y) + (ao[vi].z * ao[vi].z + ao[vi].w * ao[vi].w);
    ss += __shfl_xor(ss, 16); ss += __shfl_xor(ss, 32); if (fq == 0) ssx[vh * 64 + lrow] = ss;
    __syncthreads();
    const float rstd = rsqrtf((ssx[lrow] + ssx[64 + lrow]) * (1.0f / 64.0f) + EPS);
    const bf16* cols = (const bf16*)(C.ws + WS_COLS); bf16* mix = (bf16*)(C.ws + WS_ACT1);
#pragma unroll
    for (int vi = 0; vi < 2; ++vi) { const int v0 = (2 * vh + vi) * 16 + 4 * fq; const f32x4 nw = *(const f32x4*)(normw + l * 64 + v0); const v2u rr = *(const v2u*)(cols + (m0 + lrow) * INWP + C_GR + h * 64 + v0);
        v2u o; o.x = pk2(ao[vi].x * rstd * nw.x * fsilu(bflo(rr.x)), ao[vi].y * rstd * nw.y * fsilu(bfhi(rr.x))); o.y = pk2(ao[vi].z * rstd * nw.z * fsilu(bflo(rr.y)), ao[vi].w * rstd * nw.w * fsilu(bfhi(rr.y)));
        *(v2u*)(mix + (m0 + lrow) * DM + 512 + h * 64 + v0) = o; }
}


__device__ __forceinline__ void ssd_s1_bc(const Ctx& C, int l, int unit, const float* alog) {
    const int b = unit / NCH, c = unit - b * NCH; const size_t m0 = (size_t)b * SB + c * CH;
    LAS unsigned char* XT = C.lds; LAS unsigned char* BT = C.lds + 8 * TILE_B; LAS float* wtab = (LAS float*)(C.lds + 10 * TILE_B);
    const int w = C.wave, lane = C.lane, fr = lane & 15, fq = lane >> 4;
    __syncthreads();
#pragma unroll
    for (int d = 0; d < 2; ++d) { const int s = d == 0 ? lane : 63 - lane;
        const float dtv = ((const float*)(C.ws + WS_DT))[(m0 + s) * 16 + d * 8 + w]; float v = dtv * -expf(alog[l * 16 + d * 8 + w]);
#pragma unroll
        for (int o = 1; o < 64; o <<= 1) { const float t = __shfl_up(v, o); if (lane >= o) v += t; }
        const float tot = __shfl(v, 63);
        wtab[(d * 8 + w) * 64 + s] = dtv * __expf(tot - v);
        if (lane == 63) ((float*)(C.ws + WS_SDEC))[(((size_t)b * NCH + c) * 2 + d) * 8 + w] = __expf(tot); }
    { const int s = C.tid >> 3, sub = C.tid & 7; const bf16* r = (const bf16*)(C.ws + WS_XBC) + (m0 + s) * 768;
#pragma unroll
      for (int hl = 0; hl < 8; ++hl) *(LAS v4u*)(XT + hl * TILE_B + s * TP + sub * 16) = *(const v4u*)(r + hl * 64 + sub * 8);
      *(LAS v4u*)(BT + s * TP + sub * 16) = *(const v4u*)(r + 512 + sub * 8); *(LAS v4u*)(BT + TILE_B + s * TP + sub * 16) = *(const v4u*)(r + 576 + sub * 8); }
    __syncthreads();
    const LAS unsigned char* XH = XT + w * TILE_B; const LAS unsigned char* BG = BT + (w >> 2) * TILE_B;
    bf16x8 bo[4][2];
#pragma unroll
    for (int pb = 0; pb < 4; ++pb)
#pragma unroll
        for (int ks = 0; ks < 2; ++ks) bo[pb][ks] = tr_frag(XH, ks * 32 + 8 * fq, ks * 32 + 8 * fq + 4, pb * 16, lane);
#pragma unroll 1
    for (int d = 0; d < 2; ++d) {
        f32x4 acc[4][4];
#pragma unroll
        for (int nb = 0; nb < 4; ++nb)
#pragma unroll
            for (int pb = 0; pb < 4; ++pb) acc[nb][pb] = (f32x4){0.f, 0.f, 0.f, 0.f};
#pragma unroll
        for (int ks = 0; ks < 2; ++ks) { const LAS float* wp = wtab + (d * 8 + w) * 64 + ks * 32 + 8 * fq; const f32x4 w0 = *(const LAS f32x4*)wp, w1 = *(const LAS f32x4*)(wp + 4);
#pragma unroll
            for (int nb = 0; nb < 4; ++nb) { const bf16x8 a = __builtin_bit_cast(bf16x8, scale8v(__builtin_bit_cast(v4u, tr_frag_g4(BG, ks * 32 + 8 * fq, ks * 32 + 8 * fq + 4, nb, lane)), w0, w1));
#pragma unroll
                for (int pb = 0; pb < 4; ++pb) acc[nb][pb] = __builtin_amdgcn_mfma_f32_16x16x32_bf16(a, bo[pb][ks], acc[nb][pb], 0, 0, 0); } }
        bf16* st = (bf16*)(C.ws + WS_SST) + ((((size_t)b * NCH + c) * 2 + d) * 8 + w) * 4096;
#pragma unroll
        for (int pb = 0; pb < 4; ++pb) { v4u o0, o1; o0.x = pk2(acc[0][pb].x, acc[0][pb].y); o0.y = pk2(acc[0][pb].z, acc[0][pb].w); o0.z = pk2(acc[1][pb].x, acc[1][pb].y); o0.w = pk2(acc[1][pb].z, acc[1][pb].w);
            o1.x = pk2(acc[2][pb].x, acc[2][pb].y); o1.y = pk2(acc[2][pb].z, acc[2][pb].w); o1.z = pk2(acc[3][pb].x, acc[3][pb].y); o1.w = pk2(acc[3][pb].z, acc[3][pb].w);
            bf16* rp = st + (pb * 16 + fr) * 64 + 16 * fq; *(v4u*)rp = o0; *(v4u*)(rp + 8) = o1; }
    }
}
constexpr size_t WS_GC0 = WS_H + ((size_t)136 << 20), WS_GC1 = WS_H + ((size_t)170 << 20);
__device__ __forceinline__ void gla_s1_pair(const Ctx& C, int l, int unit) {
    const int b = unit / (NCH * 2), rem = unit - b * (NCH * 2), c = rem >> 1, hp = rem & 1; const size_t m0 = (size_t)b * SB + c * CH;
    LAS unsigned char* VT = C.lds; LAS unsigned char* KS = C.lds + 2 * TILE_B; LAS float* GS = (LAS float*)(C.lds + 6 * TILE_B);
    const int w = C.wave, lane = C.lane, fr = lane & 15, fq = lane >> 4;
    const int s = C.tid >> 3, sub = C.tid & 7; const size_t m = m0 + s;
    __syncthreads();
    v4u kk[2];
    { const bf16* gr = (const bf16*)(C.ws + WS_G) + m * 512 + hp * 128 + sub * 8; const bf16* cr = (const bf16*)(C.ws + WS_COLS) + m * INWP + hp * 128 + sub * 8;
#pragma unroll
      for (int hd = 0; hd < 4; ++hd) { const int hl = hd >> 1, d = hd & 1; const v4u g = *(const v4u*)(gr + d * 256 + hl * 64); *(LAS f32x4*)(GS + hd * 4096 + s * 64 + sub * 8) = (f32x4){bflo(g.x), bfhi(g.x), bflo(g.y), bfhi(g.y)}; *(LAS f32x4*)(GS + hd * 4096 + s * 64 + sub * 8 + 4) = (f32x4){bflo(g.z), bfhi(g.z), bflo(g.w), bfhi(g.w)}; }
#pragma unroll
      for (int hl = 0; hl < 2; ++hl) { kk[hl] = *(const v4u*)(cr + C_GK + hl * 64); *(LAS v4u*)(VT + hl * TILE_B + s * TP + sub * 16) = *(const v4u*)(cr + C_GV + hl * 64); } }
    __syncthreads();
    if (C.tid < 256) { const int hd = C.tid >> 6, hl = hd >> 1, d = hd & 1, k = C.tid & 63, h = hp * 2 + hl; LAS float* col = GS + hd * 4096 + k; bf16* gc = (bf16*)(C.ws + (d ? WS_GC1 : WS_GC0)) + m0 * 256 + h * 64 + k; float r = 0.f;
#pragma unroll 8
        for (int i = 0; i < 64; ++i) { const int ss = d == 0 ? i : 63 - i; r += col[ss * 64]; col[ss * 64] = r; gc[(size_t)ss * 256] = (bf16)f2bf(r); }
        ((float*)(C.ws + WS_GDEC))[((((size_t)b * NCH + c) * 2 + d) * 4 + h) * 64 + k] = __expf(r); }
    __syncthreads();
#pragma unroll
    for (int hd = 0; hd < 4; ++hd) { const int hl = hd >> 1, d = hd & 1; const LAS float* cs = GS + hd * 4096 + s * 64 + sub * 8; const LAS float* cl = GS + hd * 4096 + (d == 0 ? 63 : 0) * 64 + sub * 8;
        *(LAS v4u*)(KS + hd * TILE_B + s * TP + sub * 16) = scale8v(kk[hl], exp4(*(const LAS f32x4*)cl - *(const LAS f32x4*)cs), exp4(*(const LAS f32x4*)(cl + 4) - *(const LAS f32x4*)(cs + 4))); }
    __syncthreads();
    const int hd = w >> 1, half = w & 1, hl = hd >> 1, d = hd & 1, h = hp * 2 + hl; const LAS unsigned char* KH = KS + hd * TILE_B; const LAS unsigned char* VH = VT + hl * TILE_B;
    f32x4 acc[2][4];
#pragma unroll
    for (int kb = 0; kb < 2; ++kb)
#pragma unroll
        for (int vb = 0; vb < 4; ++vb) acc[kb][vb] = (f32x4){0.f, 0.f, 0.f, 0.f};
#pragma unroll
    for (int ks = 0; ks < 2; ++ks) { bf16x8 bo[4];
#pragma unroll
        for (int vb = 0; vb < 4; ++vb) bo[vb] = tr_frag(VH, ks * 32 + 8 * fq, ks * 32 + 8 * fq + 4, vb * 16, lane);
#pragma unroll
        for (int kb = 0; kb < 2; ++kb) { const bf16x8 a = tr_frag(KH, ks * 32 + 8 * fq, ks * 32 + 8 * fq + 4, (2 * half + kb) * 16, lane);
#pragma unroll
            for (int vb = 0; vb < 4; ++vb) acc[kb][vb] = __builtin_amdgcn_mfma_f32_16x16x32_bf16(a, bo[vb], acc[kb][vb], 0, 0, 0); } }
    bf16* st = (bf16*)(C.ws + WS_GST) + ((((size_t)b * NCH + c) * 2 + d) * 4 + h) * 4096;
#pragma unroll
    for (int kb = 0; kb < 2; ++kb)
#pragma unroll
        for (int vb = 0; vb < 4; ++vb) { v2u o; o.x = pk2(acc[kb][vb].x, acc[kb][vb].y); o.y = pk2(acc[kb][vb].z, acc[kb][vb].w); *(v2u*)(st + (vb * 16 + fr) * 64 + (2 * half + kb) * 16 + 4 * fq) = o; }
}
__device__ __forceinline__ void gla_s3_pair(const Ctx& C, int l, int unit, const float* normw) {
    const int b = unit / (NCH * 2), rem = unit - b * (NCH * 2), c = rem >> 1, hp = rem & 1; const size_t m0 = (size_t)b * SB + c * CH;
    LAS unsigned char* VT = C.lds; LAS unsigned char* QS = C.lds + 2 * TILE_B; LAS unsigned char* KI = C.lds + 6 * TILE_B;
    const int w = C.wave, lane = C.lane, fr = lane & 15, fq = lane >> 4;
    __syncthreads();
    { const int s = C.tid >> 3, sub = C.tid & 7; const size_t m = m0 + s; const bf16* cr = (const bf16*)(C.ws + WS_COLS) + m * INWP + hp * 128 + sub * 8; const bf16* gc0 = (const bf16*)(C.ws + WS_GC0) + m * 256 + hp * 128 + sub * 8; const bf16* gc1 = (const bf16*)(C.ws + WS_GC1) + m * 256 + hp * 128 + sub * 8;
#pragma unroll
      for (int hl = 0; hl < 2; ++hl) { const v4u q8 = scale8(*(const v4u*)(cr + C_GQ + hl * 64), 0.125f), k8 = *(const v4u*)(cr + C_GK + hl * 64);
          *(LAS v4u*)(VT + hl * TILE_B + s * TP + sub * 16) = *(const v4u*)(cr + C_GV + hl * 64);
#pragma unroll
          for (int d = 0; d < 2; ++d) { const v4u cw = *(const v4u*)((d ? gc1 : gc0) + hl * 64); const f32x4 c0 = (f32x4){bflo(cw.x), bfhi(cw.x), bflo(cw.y), bfhi(cw.y)}, c1 = (f32x4){bflo(cw.z), bfhi(cw.z), bflo(cw.w), bfhi(cw.w)};
              *(LAS v4u*)(QS + (hl * 2 + d) * TILE_B + s * TP + sub * 16) = scale8v(q8, exp4(c0), exp4(c1)); *(LAS v4u*)(KI + (hl * 2 + d) * TILE_B + s * TP + sub * 16) = scale8v(k8, exp4(-c0), exp4(-c1)); } } }
    const int hl = w >> 2, lb = w & 3, h = hp * 2 + hl, lrow = lb * 16 + fr;
    bf16x8 hst[2][4][2]; v2u rr_[4];
    { const bf16* stb = (const bf16*)(C.ws + WS_GEN) + (((size_t)b * NCH + c) * 2 * 4 + h) * 4096;
#pragma unroll
      for (int d = 0; d < 2; ++d)
#pragma unroll
          for (int vb = 0; vb < 4; ++vb)
#pragma unroll
              for (int ks = 0; ks < 2; ++ks) hst[d][vb][ks] = *(const bf16x8*)(stb + (size_t)d * 4 * 4096 + (vb * 16 + fr) * 64 + ks * 32 + fq * 8);
      const bf16* colr = (const bf16*)(C.ws + WS_COLS);
#pragma unroll
      for (int vb = 0; vb < 4; ++vb) rr_[vb] = *(const v2u*)(colr + (m0 + lrow) * INWP + C_GR + h * 64 + vb * 16 + 4 * fq); }
    __syncthreads();
    const LAS unsigned char* QF_ = QS + (hl * 2) * TILE_B; const LAS unsigned char* QB_ = QF_ + TILE_B; const LAS unsigned char* KF_ = KI + (hl * 2) * TILE_B; const LAS unsigned char* KB_ = KF_ + TILE_B; const LAS unsigned char* VH = VT + hl * TILE_B;
    bf16x8 qf[2][2];
#pragma unroll
    for (int ks = 0; ks < 2; ++ks) { qf[0][ks] = row_frag(QF_, lrow, ks * 32 + fq * 8); qf[1][ks] = row_frag(QB_, lrow, ks * 32 + fq * 8); }
    f32x4 ao[4];
#pragma unroll
    for (int vb = 0; vb < 4; ++vb) ao[vb] = (f32x4){0.f, 0.f, 0.f, 0.f};
    {   f32x4 ap[4];
#pragma unroll
        for (int sb = 0; sb < 4; ++sb) { f32x4 af = (f32x4){0.f, 0.f, 0.f, 0.f}, ab = af;
#pragma unroll
            for (int ks = 0; ks < 2; ++ks) { af = __builtin_amdgcn_mfma_f32_16x16x32_bf16(row_frag(KF_, sb * 16 + fr, ks * 32 + fq * 8), qf[0][ks], af, 0, 0, 0); ab = __builtin_amdgcn_mfma_f32_16x16x32_bf16(row_frag(KB_, sb * 16 + fr, ks * 32 + fq * 8), qf[1][ks], ab, 0, 0, 0); }
            const int s0 = sb * 16 + 4 * fq; f32x4 m;
            m.x = (s0 + 0 <= lrow ? af.x : 0.f) + (s0 + 0 >= lrow ? ab.x : 0.f); m.y = (s0 + 1 <= lrow ? af.y : 0.f) + (s0 + 1 >= lrow ? ab.y : 0.f);
            m.z = (s0 + 2 <= lrow ? af.z : 0.f) + (s0 + 2 >= lrow ? ab.z : 0.f); m.w = (s0 + 3 <= lrow ? af.w : 0.f) + (s0 + 3 >= lrow ? ab.w : 0.f);
            ap[sb] = m; }
#pragma unroll
        for (int kk = 0; kk < 2; ++kk) { const bf16x8 pf = pack_p(ap[2 * kk], ap[2 * kk + 1]);
#pragma unroll
            for (int vb = 0; vb < 4; ++vb) ao[vb] = __builtin_amdgcn_mfma_f32_16x16x32_bf16(tr_frag(VH, kk * 32 + 4 * fq, kk * 32 + 16 + 4 * fq, vb * 16, lane), pf, ao[vb], 0, 0, 0); }
    }
    {
#pragma unroll
        for (int d = 0; d < 2; ++d)
#pragma unroll
            for (int vb = 0; vb < 4; ++vb)
#pragma unroll
                for (int ks = 0; ks < 2; ++ks) ao[vb] = __builtin_amdgcn_mfma_f32_16x16x32_bf16(hst[d][vb][ks], qf[d][ks], ao[vb], 0, 0, 0); }
    float ss = 0.f;
#pragma unroll
    for (int vb = 0; vb < 4; ++vb) ss += (ao[vb].x * ao[vb].x + ao[vb].y * ao[vb].y) + (ao[vb].z * ao[vb].z + ao[vb].w * ao[vb].w);
    ss += __shfl_xor(ss, 16); ss += __shfl_xor(ss, 32);
    const float rstd = rsqrtf(ss * (1.0f / 64.0f) + EPS);
    bf16* mix = (bf16*)(C.ws + WS_ACT1);
#pragma unroll
    for (int vb = 0; vb < 4; ++vb) { const int v0 = vb * 16 + 4 * fq; const f32x4 nw = *(const f32x4*)(normw + l * 64 + v0); const v2u rr = rr_[vb];
        v2u o; o.x = pk2(ao[vb].x * rstd * nw.x * fsilu(bflo(rr.x)), ao[vb].y * rstd * nw.y * fsilu(bfhi(rr.x))); o.y = pk2(ao[vb].z * rstd * nw.z * fsilu(bflo(rr.y)), ao[vb].w * rstd * nw.w * fsilu(bfhi(rr.y)));
        *(v2u*)(mix + (m0 + lrow) * DM + 512 + h * 64 + v0) = o; }
}
__device__ __forceinline__ void zero_mix(const Ctx& C, int unit, int ssd) {
    bf16* mix = (bf16*)(C.ws + WS_ACT1); const int s = C.tid >> 3, sub = C.tid & 7;
    if (ssd) { const int b = unit / (NCH * 2), rem = unit - b * (NCH * 2), c = rem >> 1, g = rem & 1; const size_t m = (size_t)b * SB + c * CH + s;
        for (int q = 0; q < 4; ++q) *(v4u*)(mix + m * DM + g * 256 + q * 64 + sub * 8) = (v4u){0u, 0u, 0u, 0u}; }
    else { const int b = unit / (NCH * 4), rem = unit - b * (NCH * 4), c = rem >> 2, h = rem & 3; const size_t m = (size_t)b * SB + c * CH + s; *(v4u*)(mix + m * DM + 512 + h * 64 + sub * 8) = (v4u){0u, 0u, 0u, 0u}; }
}
constexpr int NU_S1 = NBATCH * NCH, NU_S3S = NBATCH * NCH * 2, NU_S3G = NBATCH * NCH * 2;
__device__ __forceinline__ void ph_chunk_s1(const Ctx& C, int l) { const float* alog = IN_(I_ALOG);
    for (int u = C.bid; u < 3 * NU_S1; u += C.G) { if (u < NU_S1) ssd_s1_bc(C, l, u, alog); else gla_s1_pair(C, l, u - NU_S1); }
}
__device__ __forceinline__ void ph_s2_assemble(const Args& A, const Ctx& C, int l, int rep) {
    if (C.wave < 6) { const int id = C.bid * 6 + C.wave, chain = id >> 2, sl = id & 3;
        if (chain < NBATCH * 2 * 8) chunk_s2_slice<true>(C, chain, sl); else if (chain < NBATCH * 2 * 12) chunk_s2_slice<false>(C, chain - NBATCH * 2 * 8, sl); }
    ph_assemble(A, C, l, rep);
}
__device__ __forceinline__ void ph_chunk_s3(const Ctx& C, int l, int rep) { const float* alog = IN_(I_ALOG); const float* dskip = IN_(I_SSDD); const float* nws = IN_(I_SSDNW); const float* nwg = IN_(I_GLANW);
    for (int u = C.bid; u < NU_S3S + NU_S3G; u += C.G) {
        const int uu = u < NU_S3S ? u : u - NU_S3S, c = (uu % (NCH * 2)) >> 1; if (l == 1 && c < NCTXCH) continue;
        if (u < NU_S3S) ssd_s3(C, l, uu, alog, dskip, nws); else gla_s3_pair(C, l, uu, nwg);
    }
}
constexpr int RT_VP = 2064;
__device__ __forceinline__ void ph_route(const Args& A, const Ctx& C, int l) { const float* const p_I_NORM2 = IN_(I_NORM2); const float* const p_I_RB = IN_(I_RB); const float* const p_I_RW = IN_(I_RW);
    LAS unsigned char* VH = C.lds; LAS unsigned char* VL = C.lds + 16 * RT_VP; LAS float* PART = (LAS float*)(C.lds + 32 * RT_VP);
    if (C.tid < 32) C.MISC[MISC_CNT + C.tid] = 0u;
    const bf16* Hp = (const bf16*)(C.ws + WS_H); const float* mod = (const float*)(C.ws + WS_MOD) + (size_t)l * 17 * 6144; bf16* vout = (bf16*)(C.ws + WS_ACT1);
    int* toke = (int*)(C.ws + WS_TOKE); int* tokp = (int*)(C.ws + WS_TOKP); float* tokw = (float*)(C.ws + WS_TOKW);
    const int lane = C.lane, w = C.wave, fr = lane & 15, fq = lane >> 4; const int RPW = TT / 256;
    bf16x8 wh[4][2], wl[4][2];
#pragma unroll
    for (int ks = 0; ks < 4; ++ks)
#pragma unroll
        for (int cb = 0; cb < 2; ++cb) { float x[8];
#pragma unroll
            for (int j = 0; j < 8; ++j) x[j] = p_I_RW[(size_t)l * 32768 + (size_t)(128 * w + 32 * ks + 8 * fq + j) * 32 + cb * 16 + fr];
            unsigned hh[4], ll[4];
#pragma unroll
            for (int j = 0; j < 4; ++j) { hh[j] = pk2(x[2 * j], x[2 * j + 1]); ll[j] = pk2(x[2 * j] - bflo(hh[j]), x[2 * j + 1] - bfhi(hh[j])); }
            wh[ks][cb] = __builtin_bit_cast(bf16x8, ((v4u){hh[0], hh[1], hh[2], hh[3]})); wl[ks][cb] = __builtin_bit_cast(bf16x8, ((v4u){ll[0], ll[1], ll[2], ll[3]})); }
    const f32x4* nwp = (const f32x4*)(p_I_NORM2 + l * 1024) + lane; f32x4 nw[4];
#pragma unroll
    for (int q = 0; q < 4; ++q) nw[q] = nwp[64 * q];
    const float rbias = p_I_RB[l * 32 + (lane & 31)];
    const int bb = (C.bid * RPW) / SB;
    for (int t = 0; t < RPW / 16; ++t) {
        const int mt = C.bid * RPW + t * 16, st = mt - bb * SB;
        if (l == 1 && st < CTXL) continue;
        const float* mr = mod + (size_t)(st < CTXL ? 16 : bb) * 6144;
        __syncthreads();
        {
            f32x4 v[2][4]; float ss[2];
#pragma unroll
            for (int r = 0; r < 2; ++r) { const v2u* xr = (const v2u*)(Hp + (size_t)(mt + 2 * w + r) * DM) + lane; ss[r] = 0.f;
#pragma unroll
                for (int q = 0; q < 4; ++q) { const v2u hw = xr[64 * q]; v[r][q] = (f32x4){bflo(hw.x), bfhi(hw.x), bflo(hw.y), bfhi(hw.y)}; ss[r] += (v[r][q].x * v[r][q].x + v[r][q].y * v[r][q].y) + (v[r][q].z * v[r][q].z + v[r][q].w * v[r][q].w); } }
#pragma unroll
            for (int o = 1; o < 64; o <<= 1) { ss[0] += __shfl_xor(ss[0], o); ss[1] += __shfl_xor(ss[1], o); }
#pragma unroll
            for (int r = 0; r < 2; ++r) { const float rstd = rsqrtf(ss[r] * (1.0f / 1024.0f) + EPS); const int row = 2 * w + r;
#pragma unroll
                for (int q = 0; q < 4; ++q) { const int j4 = lane + 64 * q; const f32x4 sh = ((const f32x4*)(mr + 3 * 1024))[j4], sc = ((const f32x4*)(mr + 4 * 1024))[j4];
                    const f32x4 o = (v[r][q] * rstd * nw[q]) * (sc + 1.0f) + sh; v2u hi; hi.x = pk2(o.x, o.y); hi.y = pk2(o.z, o.w);
                    v2u lo; lo.x = pk2(o.x - bflo(hi.x), o.y - bfhi(hi.x)); lo.y = pk2(o.z - bflo(hi.y), o.w - bfhi(hi.y));
                    ((v2u*)(vout + (size_t)(mt + row) * DM))[j4] = hi; *(LAS v2u*)(VH + row * RT_VP + j4 * 8) = hi; *(LAS v2u*)(VL + row * RT_VP + j4 * 8) = lo; } }
        }
        __syncthreads();
        {
            f32x4 acc[2]; acc[0] = (f32x4){0.f, 0.f, 0.f, 0.f}; acc[1] = acc[0];
#pragma unroll
            for (int ks = 0; ks < 4; ++ks) { const bf16x8 ah = *(const LAS bf16x8*)(VH + fr * RT_VP + (128 * w + 32 * ks + 8 * fq) * 2), al = *(const LAS bf16x8*)(VL + fr * RT_VP + (128 * w + 32 * ks + 8 * fq) * 2);
#pragma unroll
                for (int cb = 0; cb < 2; ++cb) { acc[cb] = __builtin_amdgcn_mfma_f32_16x16x32_bf16(ah, wh[ks][cb], acc[cb], 0, 0, 0); acc[cb] = __builtin_amdgcn_mfma_f32_16x16x32_bf16(al, wh[ks][cb], acc[cb], 0, 0, 0); acc[cb] = __builtin_amdgcn_mfma_f32_16x16x32_bf16(ah, wl[ks][cb], acc[cb], 0, 0, 0); } }
#pragma unroll
            for (int cb = 0; cb < 2; ++cb) { PART[w * 512 + (4 * fq + 0) * 32 + cb * 16 + fr] = acc[cb].x; PART[w * 512 + (4 * fq + 1) * 32 + cb * 16 + fr] = acc[cb].y; PART[w * 512 + (4 * fq + 2) * 32 + cb * 16 + fr] = acc[cb].z; PART[w * 512 + (4 * fq + 3) * 32 + cb * 16 + fr] = acc[cb].w; }
        }
        __syncthreads();
        {
            const int row = C.tid >> 5, e = lane & 31, half = lane >> 5; float lg = rbias;
#pragma unroll
            for (int ww = 0; ww < 8; ++ww) lg += PART[ww * 512 + row * 32 + e];
            int es[4]; float vs[4];
#pragma unroll
            for (int k = 0; k < 4; ++k) { float mx = lg;
#pragma unroll
                for (int o = 1; o < 32; o <<= 1) mx = fmaxf(mx, __shfl_xor(mx, o));
                const unsigned long long bal = __ballot(lg == mx); const unsigned bits = (unsigned)(bal >> (32 * half)); const int first = __ffs((int)bits) - 1;
                es[k] = first; vs[k] = mx; if (e == first) lg = -3.0e38f; }
            const float p1 = expf(vs[1] - vs[0]), p2 = expf(vs[2] - vs[0]), p3 = expf(vs[3] - vs[0]); const float inv = 1.0f / (1.0f + p1 + p2 + p3);
            if (e < 4) { const int ek = e == 0 ? es[0] : e == 1 ? es[1] : e == 2 ? es[2] : es[3]; const float wk = (e == 0 ? 1.0f : e == 1 ? p1 : e == 2 ? p2 : p3) * inv; const size_t m = (size_t)(mt + row);
                const unsigned pos = atomicAdd((unsigned*)&C.MISC[MISC_CNT + ek], 1u);
                toke[m * 4 + e] = ek; tokp[m * 4 + e] = (int)pos; tokw[m * 4 + e] = wk; }
        }
    }
    __syncthreads();
    if (C.tid < 32) ((int*)(C.ws + WS_WGCNT))[C.bid * 32 + C.tid] = (int)C.MISC[MISC_CNT + C.tid];
}
__device__ __forceinline__ void ph_slots(const Args& A, const Ctx& C, int l) {
    LAS int* wc = (LAS int*)C.lds;
    LAS int* ps = wc + 256 * 32;
    const int* wgcnt = (const int*)(C.ws + WS_WGCNT);
    for (int idx = C.tid; idx < C.G * 32; idx += NTHREADS) wc[idx] = wgcnt[idx];
    __syncthreads();
    { const int e = C.tid & 31, part = C.tid >> 5; int tot = 0, base = 0;
#pragma unroll
      for (int k = 0; k < 16; ++k) { const int g = part * 16 + k; const int c = wc[g * 32 + e]; tot += c; base += g < C.bid ? c : 0; }
      ps[part * 32 + e] = tot; ps[512 + part * 32 + e] = base; }
    __syncthreads();
    if (C.tid < 64) {
        const int e = C.tid & 31; int tot = 0, base = 0;
#pragma unroll
        for (int k = 0; k < 16; ++k) { tot += ps[k * 32 + e]; base += ps[512 + k * 32 + e]; }
        const int padded = (tot + 255) & ~255; int incl = padded;
#pragma unroll
        for (int o = 1; o < 32; o <<= 1) { const int t = __shfl_up(incl, o); if (e >= o) incl += t; }
        const int off = incl - padded;
        if (C.tid < 32) { C.MISC[MISC_SB + e] = (unsigned)(off + base); ps[1024 + e] = tot; ps[1056 + e] = off;
            if (C.bid == 0) { int* meta = (int*)(C.ws + WS_META); meta[e] = off >> 8; if (e == 31) meta[32] = incl >> 8; } }
    }
    __syncthreads();
    const int* toke = (const int*)(C.ws + WS_TOKE); const int* tokp = (const int*)(C.ws + WS_TOKP); int* toks = (int*)(C.ws + WS_TOKS); int* stok = (int*)(C.ws + WS_STOK);
    if (C.bid < 32) { const int tot = ps[1024 + C.bid], off = ps[1056 + C.bid], p2 = tot + C.tid; if (p2 < ((tot + 255) & ~255)) stok[off + p2] = 0; }
    const int RPW = TT / 256;
    int ee[3], pp[3];
#pragma unroll
    for (int k = 0; k < 3; ++k) { const int idx = C.tid + k * NTHREADS; ee[k] = 0; pp[k] = 0; if (idx < RPW * 4) { const size_t m = (size_t)C.bid * RPW + (idx >> 2); ee[k] = toke[m * 4 + (idx & 3)]; pp[k] = tokp[m * 4 + (idx & 3)]; } }
    static_assert(RPW * 4 <= 3 * NTHREADS, "three items per thread");
#pragma unroll
    for (int k = 0; k < 3; ++k) { const int idx = C.tid + k * NTHREADS; if (idx < RPW * 4) { const int m = C.bid * RPW + (idx >> 2); const int b = m / SB, s = m - b * SB;
        if (!(l == 1 && s < CTXL)) { const int slot = (int)C.MISC[MISC_SB + ee[k]] + pp[k]; toks[(size_t)m * 4 + (idx & 3)] = slot; stok[slot] = m; } } }
}
__device__ __forceinline__ void ph_combine(const Args& A, const Ctx& C, int l) { const float* const p_I_FINW = IN_(I_FINW); const float* const p_I_NORM1 = IN_(I_NORM1); float* const p_OUT = (float*)IN_(N_IN);
    const bf16* Y = (const bf16*)(C.ws + WS_XG); bf16* Hp = (bf16*)(C.ws + WS_H); const float* modl = (const float*)(C.ws + WS_MOD) + (size_t)l * 17 * 6144;
    const int* tokp = (const int*)(C.ws + WS_TOKS); const float* tokw = (const float*)(C.ws + WS_TOKW);
    const int gw = C.bid * NWAVES + C.wave, NGW = C.G * NWAVES, lane = C.lane;
    const int NR = l == 0 ? TT : NBATCH * SEQL;
#define ROW_OF(i_) (l == 0 ? (i_) : ((i_) >> 12) * SB + CTXL + ((i_) & 4095))
    const f32x4* nwp = (const f32x4*)(l == 0 ? p_I_NORM1 + 1024 : p_I_FINW); f32x4 nw[4];
#pragma unroll
    for (int q = 0; q < 2; ++q) { nw[2 * q] = nwp[(lane + 64 * q) * 2]; nw[2 * q + 1] = nwp[(lane + 64 * q) * 2 + 1]; }
    int s0[4], s1[4], s2[4]; float w0[4], w1[4], w2[4];
    v4u y0[4][2], y1[4][2]; f32x4 h0[4], h1[4];
#define CMB_SLOTS(i_, s_, w_) do { const size_t m_ = (size_t)ROW_OF(i_); _Pragma("unroll") for (int k = 0; k < 4; ++k) { s_[k] = tokp[m_ * 4 + k]; w_[k] = tokw[m_ * 4 + k]; } } while (0)
#define CMB_DATA(i_, s_, y_, h_) do { const size_t m_ = (size_t)ROW_OF(i_); _Pragma("unroll") for (int q = 0; q < 2; ++q) { const int j8 = lane + 64 * q; \
        _Pragma("unroll") for (int k = 0; k < 4; ++k) y_[k][q] = ((const v4u*)(Y + (size_t)s_[k] * DM))[j8]; \
        { const v4u hw_ = ((const v4u*)(Hp + m_ * DM))[j8]; h_[2 * q] = (f32x4){bflo(hw_.x), bfhi(hw_.x), bflo(hw_.y), bfhi(hw_.y)}; h_[2 * q + 1] = (f32x4){bflo(hw_.z), bfhi(hw_.z), bflo(hw_.w), bfhi(hw_.w)}; } } } while (0)
    if (gw < NR) { CMB_SLOTS(gw, s0, w0); if (gw + NGW < NR) CMB_SLOTS(gw + NGW, s1, w1); CMB_DATA(gw, s0, y0, h0); }
    for (int i = gw; i < NR; i += NGW) {
        if (i + NGW < NR) CMB_DATA(i + NGW, s1, y1, h1);
        if (i + 2 * NGW < NR) CMB_SLOTS(i + 2 * NGW, s2, w2);
        const int m = ROW_OF(i); const int b = m / SB, s = m - b * SB; const int rr = s < CTXL ? 16 : b; const float* g5 = modl + (size_t)rr * 6144 + 5 * 1024;
        float hn[16]; float ss = 0.f;
#pragma unroll
        for (int q = 0; q < 2; ++q) { const int j8 = lane + 64 * q; float f[8];
#pragma unroll
            for (int k = 0; k < 8; ++k) f[k] = 0.f;
#pragma unroll
            for (int k = 0; k < 4; ++k) { const v4u y = y0[k][q]; const float wk = w0[k];
                f[0] += wk * bflo(y.x); f[1] += wk * bfhi(y.x); f[2] += wk * bflo(y.y); f[3] += wk * bfhi(y.y); f[4] += wk * bflo(y.z); f[5] += wk * bfhi(y.z); f[6] += wk * bflo(y.w); f[7] += wk * bfhi(y.w); }
            const f32x4 ha = h0[2 * q], hb = h0[2 * q + 1];
            const f32x4 ga = ((const f32x4*)g5)[j8 * 2], gb = ((const f32x4*)g5)[j8 * 2 + 1];
            hn[q * 8 + 0] = ha.x + ga.x * f[0]; hn[q * 8 + 1] = ha.y + ga.y * f[1]; hn[q * 8 + 2] = ha.z + ga.z * f[2]; hn[q * 8 + 3] = ha.w + ga.w * f[3];
            hn[q * 8 + 4] = hb.x + gb.x * f[4]; hn[q * 8 + 5] = hb.y + gb.y * f[5]; hn[q * 8 + 6] = hb.z + gb.z * f[6]; hn[q * 8 + 7] = hb.w + gb.w * f[7];
#pragma unroll
            for (int k = 0; k < 8; ++k) ss += hn[q * 8 + k] * hn[q * 8 + k]; }
        const float rstd = rsqrtf(wave_sum(ss) * (1.0f / 1024.0f) + EPS);
        if (l == 0) {
            const float* mn = (const float*)(C.ws + WS_MOD) + (size_t)17 * 6144 + (size_t)rr * 6144; bf16* uo = (bf16*)(C.ws + WS_ACT1) + (size_t)m * DM;
#pragma unroll
            for (int q = 0; q < 2; ++q) { const int j8 = lane + 64 * q;
                { v4u hw; hw.x = pk2(hn[q * 8], hn[q * 8 + 1]); hw.y = pk2(hn[q * 8 + 2], hn[q * 8 + 3]); hw.z = pk2(hn[q * 8 + 4], hn[q * 8 + 5]); hw.w = pk2(hn[q * 8 + 6], hn[q * 8 + 7]); ((v4u*)(Hp + (size_t)m * DM))[j8] = hw; }
                float o[8];
#pragma unroll
                for (int hh = 0; hh < 2; ++hh) { const f32x4 w = nw[2 * q + hh], sh = ((const f32x4*)mn)[j8 * 2 + hh], sc = ((const f32x4*)(mn + 1024))[j8 * 2 + hh];
                    o[hh * 4 + 0] = (hn[q * 8 + hh * 4 + 0] * rstd * w.x) * (sc.x + 1.0f) + sh.x; o[hh * 4 + 1] = (hn[q * 8 + hh * 4 + 1] * rstd * w.y) * (sc.y + 1.0f) + sh.y;
                    o[hh * 4 + 2] = (hn[q * 8 + hh * 4 + 2] * rstd * w.z) * (sc.z + 1.0f) + sh.z; o[hh * 4 + 3] = (hn[q * 8 + hh * 4 + 3] * rstd * w.w) * (sc.w + 1.0f) + sh.w; }
                v4u p; p.x = pk2(o[0], o[1]); p.y = pk2(o[2], o[3]); p.z = pk2(o[4], o[5]); p.w = pk2(o[6], o[7]); ((v4u*)uo)[j8] = p; }
        } else {
            float* orow = p_OUT + ((size_t)b * SEQL + (s - CTXL)) * DM;
#pragma unroll
            for (int q = 0; q < 2; ++q) { const int j8 = lane + 64 * q;
#pragma unroll
                for (int hh = 0; hh < 2; ++hh) { const f32x4 w = nw[2 * q + hh];
                    ((f32x4*)orow)[j8 * 2 + hh] = (f32x4){hn[q * 8 + hh * 4] * rstd * w.x, hn[q * 8 + hh * 4 + 1] * rstd * w.y, hn[q * 8 + hh * 4 + 2] * rstd * w.z, hn[q * 8 + hh * 4 + 3] * rstd * w.w}; } }
        }
#pragma unroll
        for (int k = 0; k < 4; ++k) { s0[k] = s1[k]; w0[k] = w1[k]; s1[k] = s2[k]; w1[k] = w2[k]; y0[k][0] = y1[k][0]; y0[k][1] = y1[k][1]; h0[k] = h1[k]; }
    }
#undef ROW_OF
#undef CMB_SLOTS
#undef CMB_DATA
}
constexpr int NLP = 12;
constexpr int N_PHASES = 3 + 2 * NLP;
#ifndef GA_
#define GA_ true
#endif
#ifndef GS_
#define GS_ true
#endif
#ifndef PHMASK
#define PHMASK 0xffff
#endif
#define PH_ON(id) (lo <= (id) && (id) < hi && ((PHMASK >> ((id) < 3 ? (id) : 3 + ((id) - 3) % NLP)) & 1))
#define FRESH() do { int t_ = C.tid; unsigned wl_ = __builtin_amdgcn_readfirstlane((unsigned)(unsigned long long)C.ws), wh_ = __builtin_amdgcn_readfirstlane((unsigned)((unsigned long long)C.ws >> 32)); \
        int g_ = __builtin_amdgcn_readfirstlane(C.G), b_ = __builtin_amdgcn_readfirstlane(C.bid); \
        asm volatile("" : "+s"(wl_), "+s"(wh_), "+s"(g_), "+s"(b_), "+v"(t_)); \
        C.tid = t_; C.G = g_; C.bid = b_; C.ws = (GAS unsigned char*)(((unsigned long long)wh_ << 32) | wl_); C.lane = C.tid & 63; C.wave = __builtin_amdgcn_readfirstlane(C.tid >> 6); ws = C.ws; } while (0)
#ifdef DBLBAR
#define PH_SEAM(id) do { if ((id) + 1 < hi) { xcd_barrier(bar); xcd_barrier(bar); } } while (0)
#else
#define PH_SEAM(id) do { if ((id) + 1 < hi) xcd_barrier(bar); } while (0)
#endif
#ifndef PHREP
#define PHREP 0ull
#endif
#if PHREP
#ifndef PHREPN
#define PHREPN 1
#endif
#define REPS_(id) (((id) < 3 || (((PHREP >> (3 + ((id) - 3) % NLP)) | (PHREP >> (3 + NLP + ((id) - 3) % NLP))) & 1ull)) ? (int)((PHREP >> (id)) & 1ull) * PHREPN : 0)
#define PH_BEGIN(id) if (PH_ON(id)) { for (int rep_ = 0; rep_ <= REPS_(id); ++rep_) { FRESH();
#define PH_END(id) if (rep_ < REPS_(id)) xcd_barrier(bar); } PH_SEAM(id); }
#else
#define PH_BEGIN(id) if (PH_ON(id)) { const int rep_ = 0; (void)rep_; FRESH();
#define PH_END(id) PH_SEAM(id); }
#endif
template <int L> __device__ __forceinline__ void layer_phases(const Args& args, Ctx& C, const XcdBarrier& bar, const int lo, const int hi) {
    GAS unsigned char* ws = C.ws; constexpr int l = L; constexpr int pb = 3 + NLP * L;
        PH_BEGIN(pb + 0)
            pg8::Gemm g{(const bf16*)(ws + WS_ACT1), (const bf16*)(ws + WS_WINT) + (size_t)l * INWP * 1024, TT, INWP, 1024}; pg8::StaticOrder S; S.init(TT, INWP, C.G, C.bid);
            pg8::EpiBf16 E{(bf16*)(ws + WS_COLS), INWP, nullptr, 0, 0};
            pg8::gemm_phase<pg8::EpiBf16, pg8::StaticOrder, GA_, GS_>(C.lds, g, S, E, C.tid);
            PH_END(pb + 0)
        PH_BEGIN(pb + 1) ph_prep(args, C, l, rep_); PH_END(pb + 1)
        PH_BEGIN(pb + 2)
            { pg8::Gemm g{(const bf16*)(ws + WS_AQ), (const bf16*)(ws + WS_WUQT) + (size_t)l * 512 * 256, TT, 512, 256}; pg8::StaticOrder S; S.init(TT, 512, C.G, C.bid);
              pg8::EpiBf16 E{(bf16*)(ws + WS_QRAW), 512, nullptr, 0, 0}; pg8::gemm_phase<pg8::EpiBf16, pg8::StaticOrder, GA_, GS_>(C.lds, g, S, E, C.tid); }
            { pg8::Gemm g{(const bf16*)(ws + WS_AKV), (const bf16*)(ws + WS_WUKVT) + (size_t)l * 512 * 256, TT, 512, 256}; pg8::StaticOrder S; S.init(TT, 512, C.G, C.bid);
              pg8::EpiBf16 E{(bf16*)(ws + WS_KV), 512, nullptr, 0, 0}; pg8::gemm_phase<pg8::EpiBf16, pg8::StaticOrder, GA_, GS_>(C.lds, g, S, E, C.tid); }
            ph_chunk_s1(C, l);
            PH_END(pb + 2)
        PH_BEGIN(pb + 3) ph_s2_assemble(args, C, l, rep_); PH_END(pb + 3)
        PH_BEGIN(pb + 4) attn_queue(C, l, rep_); PH_END(pb + 4)
        PH_BEGIN(pb + 5) ph_chunk_s3(C, l, rep_); PH_END(pb + 5)
        PH_BEGIN(pb + 6)
            pg8::Gemm g{(const bf16*)(ws + WS_ACT1), (const bf16*)(ws + WS_WOUTT) + (size_t)l * 1024 * 1024, TT, 1024, 1024};
            pg8::MapOrder S; S.init(l == 0 ? TT : NBATCH * SEQL, 1024, C.G, C.bid); S.skipctx = l;
            pg8::EpiResid E{IN_(I_X), IN_(I_CTX), (const bf16*)(ws + WS_H), (bf16*)(ws + WS_H), (const float*)(ws + WS_MOD) + (size_t)l * 17 * 6144, l};
            pg8::gemm_phase<pg8::EpiResid, pg8::MapOrder, GA_, GS_>(C.lds, g, S, E, C.tid);
            PH_END(pb + 6)
        PH_BEGIN(pb + 7) ph_route(args, C, l); PH_END(pb + 7)
        PH_BEGIN(pb + 8) ph_slots(args, C, l); PH_END(pb + 8)
        PH_BEGIN(pb + 9)
            pg8::Gemm g{(const bf16*)(ws + WS_ACT1), (const bf16*)(ws + WS_W1T), MAXSLOT, 32 * 2048, 1024};
            pg8::MoeOrder S{(const int*)(ws + WS_META), 8, C.G, C.bid};
            pg8::EpiSwiglu E{(bf16*)(ws + WS_ACTB), IN_(I_B1) + (size_t)l * 32 * 2048};
            pg8::gemm_phase_gather<pg8::EpiSwiglu, pg8::MoeOrder>(C.lds, g, S, E, C.tid, (const int*)(ws + WS_STOK));
            PH_END(pb + 9)
        PH_BEGIN(pb + 10)
            pg8::Gemm g{(const bf16*)(ws + WS_ACTB), (const bf16*)(ws + WS_W2T), MAXSLOT, 32 * 1024, 1024};
            pg8::MoeOrder S{(const int*)(ws + WS_META), 4, C.G, C.bid};
            pg8::EpiBf16 E{(bf16*)(ws + WS_XG), 1024, IN_(I_B2) + (size_t)l * 32 * 1024, 1024, 0};
            pg8::gemm_phase<pg8::EpiBf16, pg8::MoeOrder, GA_, GS_>(C.lds, g, S, E, C.tid);
            PH_END(pb + 10)
        PH_BEGIN(pb + 11) ph_combine(args, C, l); PH_END(pb + 11)
}
__global__ void __launch_bounds__(NTHREADS, 2) fwd_kernel(Args args) {
    extern __shared__ __attribute__((aligned(16))) unsigned char lds_raw[];
    Ctx C;
    C.lds = (LAS unsigned char*)lds_raw; C.MISC = (volatile LAS unsigned*)(C.lds + LDSCTL_OFF); C.ws = (GAS unsigned char*)args.ws;
    C.tid = threadIdx.x; C.lane = C.tid & 63; C.wave = __builtin_amdgcn_readfirstlane(C.tid >> 6); C.G = gridDim.x; C.bid = blockIdx.x;
    for (int u = C.tid; u < (LDS_BYTES - LDSCTL_OFF) / 4; u += NTHREADS) ((LAS unsigned*)(C.lds + LDSCTL_OFF))[u] = 0u;
    __syncthreads();
    if (C.tid <= N_IN) {
        const unsigned long long* ka = (const unsigned long long*)__builtin_amdgcn_kernarg_segment_ptr();
        ((volatile LAS unsigned long long*)(C.lds + PTR_OFF))[C.tid] = ka[C.tid]; }
    __syncthreads();
    XcdBarrier bar = xcd_barrier_post((unsigned*)args.ws + CW_BAR, C.MISC + MISC_BAR);
    const int lo = args.ph_lo, hi = args.ph_hi;
    GAS unsigned char* ws = (GAS unsigned char*)args.ws;
    PH_BEGIN(0) ph_g0(args, C); PH_END(0)
    PH_BEGIN(1) ph_g1(args, C); PH_END(1)
    PH_BEGIN(2) ph_g2(args, C); PH_END(2)
    layer_phases<0>(args, C, bar, lo, hi);
    layer_phases<1>(args, C, bar, lo, hi);
}
#undef PH_ON
#undef PH_SEAM


#ifndef MK_CUTS
#define MK_CUTS 0
#endif
extern "C" void kernel_launch(void* const* d_in, const int* in_sizes, int n_in, void* d_out, int out_size, void* d_ws, size_t ws_size, hipStream_t stream) {
    static int grid = 0;
    if (grid == 0) {
        if (n_in != N_IN || ws_size < WS_END || out_size != NBATCH * SEQL * DM) { fprintf(stderr, "kernel_launch: unexpected shapes (n_in %d, ws %zu, out %d); nothing launched\n", n_in, ws_size, out_size); grid = -1; return; }
        int dev = 0, cus = 0, per_cu = 0;
        if (hipGetDevice(&dev) != hipSuccess || hipDeviceGetAttribute(&cus, hipDeviceAttributeMultiprocessorCount, dev) != hipSuccess) { grid = -1; return; }
        if (hipFuncSetAttribute((const void*)fwd_kernel, hipFuncAttributeMaxDynamicSharedMemorySize, LDS_BYTES) != hipSuccess) { fprintf(stderr, "kernel_launch: hipFuncSetAttribute failed\n"); grid = -1; return; }
        if (hipOccupancyMaxActiveBlocksPerMultiprocessor(&per_cu, (const void*)fwd_kernel, NTHREADS, LDS_BYTES) != hipSuccess || per_cu < 1)
            fprintf(stderr, "kernel_launch: note: occupancy query reports %d workgroups per CU\n", per_cu);
        (void)hipGetLastError();
        if (cus < 256) { fprintf(stderr, "kernel_launch: this kernel is laid out for 256 CUs (found %d); nothing launched\n", cus); grid = -1; return; }
        grid = 256;
    }
    if (grid < 0) return;
    if (hipMemsetAsync((char*)d_ws + WS_CTL, 0, CTL_ZERO_BYTES, stream) != hipSuccess) return;
    Args a{};
    for (int i = 0; i < N_IN; ++i) a.in[i] = (const float*)d_in[i];
    a.out = (float*)d_out; a.ws = (unsigned char*)d_ws;
#if MK_CUTS
    for (int p = 0; p < N_PHASES; ++p) { a.ph_lo = p; a.ph_hi = p + 1; hipLaunchKernelGGL(fwd_kernel, dim3(grid), dim3(NTHREADS), LDS_BYTES, stream, a); }
#else
    a.ph_lo = 0; a.ph_hi = N_PHASES;
    hipLaunchKernelGGL(fwd_kernel, dim3(grid), dim3(NTHREADS), LDS_BYTES, stream, a);
#endif
    const hipError_t le = hipPeekAtLastError();
    if (le != hipSuccess) fprintf(stderr, "kernel_launch: launch failed: %s\n", hipGetErrorName(le));
}
```

```cpp
#include <hip/hip_runtime.h>
#include <cstdio>
#include <cstdint>
namespace pg8 {
#define PG8_LAS __attribute__((address_space(3)))
typedef unsigned short bf16_t;
typedef short bf16x8 __attribute__((ext_vector_type(8)));
typedef float f32x4 __attribute__((ext_vector_type(4)));
typedef unsigned u32x4 __attribute__((ext_vector_type(4)));
constexpr int BM = 256, BK = 64, HALF = 128, HTB = HALF * BK * 2  , STAGE_BYTES = 8 * HTB, NXCD = 8,
#ifndef PG8_WGM
#define PG8_WGM 4
#endif
    WGM = PG8_WGM;

__host__ __device__ __forceinline__ int lds_byte(int r, int c) { const int st = (r >> 4) * 2 + (c >> 5), rr = r & 15, cc = c & 31, ob = rr * 64 + cc * 2; return st * 1024 + (ob ^ (((ob >> 9) & 1) << 5)); }
__host__ __device__ __forceinline__ void stage_rc(int b, int& R, int& C) { const int st = b / 1024, sb = b % 1024, swz = sb ^ (((sb >> 9) & 1) << 5); R = (st >> 1) * 16 + swz / 64; C = (st & 1) * 32 + (swz % 64) / 2; }
__host__ __device__ __forceinline__ int perm32(int rho) { const int n = rho >> 4, i = rho & 15; return 8 * (i >> 2) + 4 * n + (i & 3); }

struct Unit { int pm, pn; };
struct Gemm { const bf16_t* A; const bf16_t* Bt; int M, N, K; };

struct StaticOrder {
    int nM, nN, nwg, G, c;
    __host__ __device__ void init(int M, int N, int G_, int c_) { nM = M / BM; nN = N / BM; nwg = nM * nN; G = G_; c = c_; }
    __host__ __device__ bool next(int i, Unit& u) const {
        const long L = (long)i * G + c; if (L >= nwg) return false;
        int wgid = (int)L; { const int q = nwg / NXCD, r = nwg % NXCD, xcd = wgid % NXCD, off = wgid / NXCD; wgid = (xcd < r ? xcd * (q + 1) : r * (q + 1) + (xcd - r) * q) + off; }
        const int nig = WGM * nN, gid = wgid / nig, fm = gid * WGM, gsz = (nM - fm) < WGM ? (nM - fm) : WGM;
        u.pm = fm + ((wgid % nig) % gsz); u.pn = (wgid % nig) / gsz; return true;
    }
    __device__ __forceinline__ void a_ready(const Unit&) const {}
    __device__ __forceinline__ void done(const Unit&) const {}
};

__device__ __forceinline__ unsigned cvt_pk_bf16(float lo, float hi) { unsigned r; asm volatile("v_cvt_pk_bf16_f32 %0, %1, %2" : "=v"(r) : "v"(lo), "v"(hi)); return r; }
typedef float f32x2 __attribute__((ext_vector_type(2)));
struct EpiBf16 {
    static constexpr bool PERM = true, AFTER_DRAIN = false;
    bf16_t* O; int ldc; const float* bias; int split_cols; size_t split_stride;
    __device__ __forceinline__ void operator()(const f32x4 (&acc)[2][2][4][2], const Unit& u, int wr, int wc, int fr, int fq) const {
        const int row0 = u.pm * BM + wr * 64 + fr; int colt = u.pn * BM; bf16_t* base = O;
        if (split_cols) { const int t = colt / split_cols; base += (size_t)t * split_stride; colt -= t * split_cols; }
        const int col0 = colt + wc * 32 + 8 * fq, bcol0 = u.pn * BM + wc * 32 + 8 * fq;
        f32x4 bv[2][2];
#pragma unroll
        for (int bj = 0; bj < 2; ++bj)
#pragma unroll
            for (int n = 0; n < 2; ++n) bv[bj][n] = bias ? *(const f32x4*)(bias + bcol0 + bj * HALF + 4 * n) : (f32x4){0.f, 0.f, 0.f, 0.f};
#pragma unroll
        for (int ai = 0; ai < 2; ++ai)
#pragma unroll
            for (int m = 0; m < 4; ++m) { bf16_t* rowp = base + (size_t)(row0 + ai * HALF + m * 16) * ldc + col0;
#pragma unroll
                for (int bj = 0; bj < 2; ++bj) { const f32x4 v0 = acc[ai][bj][m][0] + bv[bj][0], v1 = acc[ai][bj][m][1] + bv[bj][1];
                    u32x4 w; w.x = cvt_pk_bf16(v0[0], v0[1]); w.y = cvt_pk_bf16(v0[2], v0[3]); w.z = cvt_pk_bf16(v1[0], v1[1]); w.w = cvt_pk_bf16(v1[2], v1[3]);
                    *(u32x4*)(rowp + bj * HALF) = w; } }
    }
};
struct EpiSwiglu {
    static constexpr bool PERM = true, AFTER_DRAIN = false;
    bf16_t* O; const float* bias;
    __device__ __forceinline__ void operator()(const f32x4 (&acc)[2][2][4][2], const Unit& u, int wr, int wc, int fr, int fq) const {
        typedef unsigned u32x2 __attribute__((ext_vector_type(2)));
        const int row0 = u.pm * BM + wr * 64 + fr;
        const int hc0 = (u.pn & 7) * BM + wc * 32 + 8 * fq, bcol0 = u.pn * BM + wc * 32 + 8 * fq;
        f32x4 bv[2][2];
#pragma unroll
        for (int bj = 0; bj < 2; ++bj)
#pragma unroll
            for (int n = 0; n < 2; ++n) bv[bj][n] = *(const f32x4*)(bias + bcol0 + bj * HALF + 4 * n);
        const int odd = fq & 1, cst = ((hc0 >> 1) & ~7);
        auto act4 = [&](int ai, int bj, int m) { const f32x4 v0 = acc[ai][bj][m][0] + bv[bj][0], v1 = acc[ai][bj][m][1] + bv[bj][1]; float a[4];
#pragma unroll
            for (int q = 0; q < 4; ++q) { const float gl = fminf(q < 2 ? v0[2 * q] : v1[2 * q - 4], 7.0f); float li = q < 2 ? v0[2 * q + 1] : v1[2 * q - 3]; li = fminf(fmaxf(li, -7.0f), 7.0f);
                a[q] = gl * __builtin_amdgcn_rcpf(1.0f + __builtin_amdgcn_exp2f(-2.4554669595930156f * gl)) * (li + 1.0f); }
            u32x2 w; w.x = cvt_pk_bf16(a[0], a[1]); w.y = cvt_pk_bf16(a[2], a[3]); return w; };
#pragma unroll
        for (int ai = 0; ai < 2; ++ai)
#pragma unroll
            for (int mp = 0; mp < 2; ++mp) { bf16_t* rowp = O + (size_t)(row0 + ai * HALF + (2 * mp + odd) * 16) * 1024 + cst;
#pragma unroll
                for (int bj = 0; bj < 2; ++bj) { u32x2 wa = act4(ai, bj, 2 * mp), wb = act4(ai, bj, 2 * mp + 1);
                    { const auto r = __builtin_amdgcn_permlane16_swap(wa.x, wb.x, false, false); wa.x = r[0]; wb.x = r[1]; }
                    { const auto r = __builtin_amdgcn_permlane16_swap(wa.y, wb.y, false, false); wa.y = r[0]; wb.y = r[1]; }
                    u32x4 w; w.x = wa.x; w.y = wa.y; w.z = wb.x; w.w = wb.y;
                    *(u32x4*)(rowp + bj * (HALF / 2)) = w; } }
    }
};
struct EpiResid {
    static constexpr bool PERM = false, AFTER_DRAIN = false;
    const float* x; const float* ctx; const bf16_t* H; bf16_t* Hout; const float* mod; int layer;
    __device__ __forceinline__ void operator()(const f32x4 (&acc)[2][2][4][2], const Unit& u, int wr, int wc, int fr, int fq) const {
        typedef unsigned u32x2 __attribute__((ext_vector_type(2)));
        const int b = u.pm / 17, tin = u.pm - b * 17; const float* gate = mod + (size_t)(tin == 0 ? 16 : b) * 6144 + 2048;
        const float* base = tin == 0 ? ctx + (size_t)b * 256 * 1024 : x + ((size_t)b * 4096 + (size_t)(tin - 1) * 256) * 1024;
        const bf16_t* hb = H + (size_t)u.pm * 256 * 1024; bf16_t* outp = Hout + (size_t)u.pm * 256 * 1024;
        const int rl0 = wr * 64 + fr, col0 = u.pn * BM + wc * 32 + 4 * fq, odd = fq & 1, cst = col0 & ~7;
        f32x4 gv[2][2];
#pragma unroll
        for (int bj = 0; bj < 2; ++bj)
#pragma unroll
            for (int n = 0; n < 2; ++n) gv[bj][n] = *(const f32x4*)(gate + col0 + bj * HALF + n * 16);
        auto item = [&](int ai, int m, int bj, int n) { const size_t off = (size_t)(rl0 + ai * HALF + m * 16) * 1024 + col0 + bj * HALF + n * 16; f32x4 bs;
            if (layer == 0) bs = *(const f32x4*)(base + off);
            else { const u32x2 hw = *(const u32x2*)(hb + off); bs = (f32x4){__uint_as_float(hw.x << 16), __uint_as_float(hw.x & 0xffff0000u), __uint_as_float(hw.y << 16), __uint_as_float(hw.y & 0xffff0000u)}; }
            const f32x4 o = bs + gv[bj][n] * acc[ai][bj][m][n]; u32x2 w; w.x = cvt_pk_bf16(o[0], o[1]); w.y = cvt_pk_bf16(o[2], o[3]); return w; };
#pragma unroll
        for (int ai = 0; ai < 2; ++ai)
#pragma unroll
            for (int mp = 0; mp < 2; ++mp) { bf16_t* rowp = outp + (size_t)(rl0 + ai * HALF + (2 * mp + odd) * 16) * 1024 + cst;
#pragma unroll
                for (int bj = 0; bj < 2; ++bj)
#pragma unroll
                    for (int n = 0; n < 2; ++n) { u32x2 wa = item(ai, 2 * mp, bj, n), wb = item(ai, 2 * mp + 1, bj, n);
                        { const auto r = __builtin_amdgcn_permlane16_swap(wa.x, wb.x, false, false); wa.x = r[0]; wb.x = r[1]; }
                        { const auto r = __builtin_amdgcn_permlane16_swap(wa.y, wb.y, false, false); wa.y = r[0]; wb.y = r[1]; }
                        u32x4 w; w.x = wa.x; w.y = wa.y; w.z = wb.x; w.w = wb.y;
                        *(u32x4*)(rowp + bj * HALF + n * 16) = w; } }
    }
};
struct MapOrder : StaticOrder {
    int skipctx;
    __device__ __forceinline__ bool next(int i, Unit& u) const { if (!StaticOrder::next(i, u)) return false; if (skipctx) u.pm = (u.pm >> 4) * 17 + 1 + (u.pm & 15); return true; }
};
struct MoeOrder {
    const int* toff; int npn, G, c;
    __device__ __forceinline__ bool next(int i, Unit& u) const {
        const int nt = toff[32], nwg = nt * npn; const long L = (long)i * G + c; if (L >= (long)nwg) return false;
        int wgid = (int)L; { const int q = nwg / NXCD, r = nwg % NXCD, xcd = wgid % NXCD, off = wgid / NXCD; wgid = (xcd < r ? xcd * (q + 1) : r * (q + 1) + (xcd - r) * q) + off; }
#ifndef MOE_WGM
#define MOE_WGM 8
#endif
        const int nig = MOE_WGM * npn, gid = wgid / nig, fm = gid * MOE_WGM, gsz = (nt - fm) < MOE_WGM ? (nt - fm) : MOE_WGM;
        const int pm = fm + ((wgid % nig) % gsz), pnl = (wgid % nig) / gsz; int e = 0;
        for (int q = 1; q < 32; ++q) e += (toff[q] <= pm) ? 1 : 0;
        u.pm = pm; u.pn = e * npn + pnl; return true;
    }
    __device__ __forceinline__ void a_ready(const Unit&) const {}
    __device__ __forceinline__ void done(const Unit&) const {}
};
template <class Epi, class Sched, bool ALIGN_EPI = false, bool SP2 = false>
__device__ __forceinline__ void gemm_phase(PG8_LAS unsigned char* lds, const Gemm g, const Sched& S, const Epi& E, const int tid) {
    const int  wid = __builtin_amdgcn_readfirstlane(tid >> 6), lane = tid & 63, wr = wid >> 2, wc = wid & 3, fr = lane & 15, fq = lane >> 4;
    const int K = g.K, nt = K / BK;
    unsigned voffA[2], voffB[2];
#pragma unroll
    for (int i = 0; i < 2; ++i) { int R, C; stage_rc(tid * 16 + i * 8192, R, C); const int Rb = Epi::PERM ? ((R & ~31) + perm32(R & 31)) : R;
        voffA[i] = (unsigned)(R * K + C) * 2u; voffB[i] = (unsigned)(Rb * K + C) * 2u; }
    const size_t kstep = (size_t)(BK * 2);
    const size_t hstep = (size_t)HALF * K * 2;
    const size_t tstep = 2 * hstep;
    const unsigned ldsw = (unsigned)wid * 1024u;
    const int aoff = lds_byte(wr * 64 + fr, fq * 8), boff = lds_byte(wc * 32 + fr, fq * 8);
#define PG8_SA(b, h) (((b) * 2 + (h)) * HTB)
#define PG8_SB(b, h) ((4 + (b) * 2 + (h)) * HTB)
#define PG8_STAGE(bufoff, gbase, voff) do { _Pragma("unroll") for (int _i = 0; _i < 2; ++_i) \
        __builtin_amdgcn_global_load_lds((const unsigned*)((const char*)(gbase) + (voff)[_i]), (PG8_LAS unsigned*)(lds + (bufoff) + ldsw + _i * 8192), 16, 0, 0); } while (0)
#define PG8_LDA(dst, b, h) do { _Pragma("unroll") for (int m = 0; m < 4; ++m) _Pragma("unroll") for (int k = 0; k < 2; ++k) dst[m][k] = *(const PG8_LAS bf16x8*)(lds + PG8_SA(b, h) + aoff + m * 2048 + k * 1024); } while (0)
#define PG8_LDB(dst, b, h) do { _Pragma("unroll") for (int n = 0; n < 2; ++n) _Pragma("unroll") for (int k = 0; k < 2; ++k) dst[n][k] = *(const PG8_LAS bf16x8*)(lds + PG8_SB(b, h) + boff + n * 2048 + k * 1024); } while (0)
#define PG8_MMA(ai, bj, At, Bt) do { __builtin_amdgcn_s_setprio(1); _Pragma("unroll") for (int m = 0; m < 4; ++m) _Pragma("unroll") for (int n = 0; n < 2; ++n) _Pragma("unroll") for (int k = 0; k < 2; ++k) \
        acc[ai][bj][m][n] = __builtin_amdgcn_mfma_f32_16x16x32_bf16(Bt[n][k], At[m][k], acc[ai][bj][m][n], 0, 0, 0); __builtin_amdgcn_s_setprio(0); } while (0)
#define PG8_WAIT_V(n) asm volatile("s_waitcnt vmcnt(" #n ")" ::: "memory")
#define PG8_WAIT_L(n) asm volatile("s_waitcnt lgkmcnt(" #n ")" ::: "memory")
#define PG8_BAR __builtin_amdgcn_s_barrier()
#define PG8_SCHED __builtin_amdgcn_sched_barrier(0)
    Unit cur, nxt; int ui = 0;
    if (!S.next(0, cur)) return;
    f32x4 acc[2][2][4][2];
#pragma unroll
    for (int a = 0; a < 2; ++a)
#pragma unroll
        for (int b = 0; b < 2; ++b)
#pragma unroll
            for (int m = 0; m < 4; ++m)
#pragma unroll
                for (int n = 0; n < 2; ++n) acc[a][b][m][n] = (f32x4){0.f, 0.f, 0.f, 0.f};
    bf16x8 At[4][2], B0[2][2], B1[2][2];
    const char* cA = (const char*)g.A + (size_t)cur.pm * tstep; const char* cB = (const char*)g.Bt + (size_t)cur.pn * tstep;
    S.a_ready(cur);
    if constexpr (SP2) {
        PG8_STAGE(PG8_SB(0, 0), cB, voffB); PG8_STAGE(PG8_SB(0, 1), cB + hstep, voffB); PG8_STAGE(PG8_SA(0, 0), cA, voffA); PG8_STAGE(PG8_SA(0, 1), cA + hstep, voffA);
        if (wr == 1) PG8_BAR;
        PG8_WAIT_V(2); PG8_BAR;
        PG8_STAGE(PG8_SB(1, 0), cB + kstep, voffB); PG8_STAGE(PG8_SA(1, 0), cA + kstep, voffA); PG8_STAGE(PG8_SB(1, 1), cB + hstep + kstep, voffB);
        PG8_WAIT_V(6); PG8_BAR;
    } else {
        PG8_STAGE(PG8_SB(0, 0), cB, voffB); PG8_STAGE(PG8_SA(0, 0), cA, voffA); PG8_STAGE(PG8_SB(0, 1), cB + hstep, voffB); PG8_STAGE(PG8_SA(0, 1), cA + hstep, voffA);
        if (wr == 1) PG8_BAR;
        PG8_WAIT_V(4); PG8_BAR;
        PG8_STAGE(PG8_SB(1, 0), cB + kstep, voffB); PG8_STAGE(PG8_SA(1, 0), cA + kstep, voffA); PG8_STAGE(PG8_SB(1, 1), cB + hstep + kstep, voffB);
        PG8_WAIT_V(6); PG8_BAR;
    }
    for (;;) {
        const bool has_next = S.next(ui + 1, nxt);
        const char* nA = has_next ? (const char*)g.A + (size_t)nxt.pm * tstep : cA; const char* nB = has_next ? (const char*)g.Bt + (size_t)nxt.pn * tstep : cB;
        for (int t = 0; t < nt; t += 2) {
            const bool last = (t == nt - 2);
            const char* a1 = cA + (size_t)(t + 1) * kstep;
            const char* a2 = last ? nA : cA + (size_t)(t + 2) * kstep; const char* b2 = last ? nB : cB + (size_t)(t + 2) * kstep;
            const char* a3 = a2 + kstep; const char* b3 = b2 + kstep;
            if (last && has_next) S.a_ready(nxt);
            if constexpr (SP2) {
            PG8_LDB(B0, 0, 0); PG8_LDB(B1, 0, 1); PG8_SCHED; PG8_LDA(At, 0, 0); PG8_STAGE(PG8_SA(1, 1), a1 + hstep, voffA);
            PG8_WAIT_V(8); PG8_WAIT_L(0); PG8_BAR; PG8_MMA(0, 0, At, B0); PG8_MMA(0, 1, At, B1); PG8_BAR; PG8_SCHED;
            PG8_LDA(At, 0, 1); PG8_STAGE(PG8_SB(0, 0), b2, voffB); PG8_STAGE(PG8_SB(0, 1), b2 + hstep, voffB); PG8_STAGE(PG8_SA(0, 0), a2, voffA);
            PG8_WAIT_V(8); PG8_WAIT_L(0); PG8_BAR; PG8_MMA(1, 0, At, B0); PG8_MMA(1, 1, At, B1); PG8_BAR; PG8_SCHED;
            PG8_LDB(B0, 1, 0); PG8_LDB(B1, 1, 1); PG8_SCHED; PG8_LDA(At, 1, 0); PG8_STAGE(PG8_SA(0, 1), a2 + hstep, voffA);
            PG8_WAIT_V(8); PG8_WAIT_L(0); PG8_BAR; PG8_MMA(0, 0, At, B0); PG8_MMA(0, 1, At, B1); PG8_BAR; PG8_SCHED;
            PG8_LDA(At, 1, 1); PG8_STAGE(PG8_SB(1, 0), b3, voffB); PG8_STAGE(PG8_SB(1, 1), b3 + hstep, voffB); PG8_STAGE(PG8_SA(1, 0), a3, voffA);
            PG8_WAIT_V(8); PG8_WAIT_L(0); PG8_BAR; PG8_MMA(1, 0, At, B0); PG8_MMA(1, 1, At, B1); PG8_BAR; PG8_SCHED;
            } else {
            PG8_LDB(B0, 0, 0); PG8_SCHED; PG8_LDA(At, 0, 0); PG8_STAGE(PG8_SA(1, 1), a1 + hstep, voffA);
            PG8_WAIT_L(8); PG8_BAR; PG8_WAIT_L(0); PG8_MMA(0, 0, At, B0); PG8_BAR; PG8_SCHED;
            PG8_LDB(B1, 0, 1); PG8_STAGE(PG8_SB(0, 0), b2, voffB);
            PG8_BAR; PG8_WAIT_L(0); PG8_MMA(0, 1, At, B1); PG8_BAR;
            PG8_LDA(At, 0, 1); PG8_STAGE(PG8_SA(0, 0), a2, voffA);
            PG8_BAR; PG8_WAIT_L(0); PG8_MMA(1, 0, At, B0); PG8_BAR; PG8_SCHED;
            PG8_STAGE(PG8_SB(0, 1), b2 + hstep, voffB);
            PG8_WAIT_V(6); PG8_BAR; PG8_MMA(1, 1, At, B1); PG8_BAR;
            PG8_LDB(B0, 1, 0); PG8_SCHED; PG8_LDA(At, 1, 0); PG8_STAGE(PG8_SA(0, 1), a2 + hstep, voffA);
            PG8_WAIT_L(8); PG8_BAR; PG8_WAIT_L(0); PG8_MMA(0, 0, At, B0); PG8_BAR; PG8_SCHED;
            PG8_LDB(B1, 1, 1); PG8_STAGE(PG8_SB(1, 0), b3, voffB);
            PG8_BAR; PG8_WAIT_L(0); PG8_MMA(0, 1, At, B1); PG8_BAR;
            PG8_LDA(At, 1, 1); PG8_STAGE(PG8_SA(1, 0), a3, voffA);
            PG8_BAR; PG8_WAIT_L(0); PG8_MMA(1, 0, At, B0); PG8_BAR; PG8_SCHED;
            PG8_STAGE(PG8_SB(1, 1), b3 + hstep, voffB);
            PG8_WAIT_V(6); PG8_BAR; PG8_MMA(1, 1, At, B1); PG8_BAR;
            }
        }
        if constexpr (ALIGN_EPI) { if (wr == 0) PG8_BAR; }
        if constexpr (!Epi::AFTER_DRAIN) { E(acc, cur, wr, wc, fr, fq); S.done(cur); }
        if (!has_next) break;
#pragma unroll
        for (int a = 0; a < 2; ++a)
#pragma unroll
            for (int b = 0; b < 2; ++b)
#pragma unroll
                for (int m = 0; m < 4; ++m)
#pragma unroll
                    for (int n = 0; n < 2; ++n) acc[a][b][m][n] = (f32x4){0.f, 0.f, 0.f, 0.f};
        cur = nxt; cA = nA; cB = nB; ++ui;
        if constexpr (ALIGN_EPI) { if (wr == 1) PG8_BAR; }
    }
    PG8_WAIT_V(0);
    if constexpr (!ALIGN_EPI) { if (wr == 0) PG8_BAR; }
    PG8_BAR;
    if constexpr (Epi::AFTER_DRAIN) { E.fused(acc, cur, wr, wc, fr, fq, lds, wid, lane); S.done(cur); }
#undef PG8_SA
#undef PG8_SB
#undef PG8_STAGE
#undef PG8_LDA
#undef PG8_LDB
#undef PG8_MMA
#undef PG8_WAIT_V
#undef PG8_WAIT_L
#undef PG8_BAR
#undef PG8_SCHED
}
template <class Epi, class Sched>
__device__ __forceinline__ void gemm_phase_gather(PG8_LAS unsigned char* lds, const Gemm g, const Sched& S, const Epi& E, const int tid, const int* tok) {
    const int wid = __builtin_amdgcn_readfirstlane(tid >> 6), lane = tid & 63, wr = wid >> 2, wc = wid & 3, fr = lane & 15, fq = lane >> 4;
    const int K = g.K, nt = K / BK;
    unsigned voffB[2];
#pragma unroll
    for (int i = 0; i < 2; ++i) { int R, C; stage_rc(tid * 16 + i * 8192, R, C); const int Rb = Epi::PERM ? ((R & ~31) + perm32(R & 31)) : R; voffB[i] = (unsigned)(Rb * K + C) * 2u; }
#define PG8_RA(i) ({ int R_, C_; stage_rc(tid * 16 + (i) * 8192, R_, C_); R_; })
#define PG8_CA2(i) ({ int R_, C_; stage_rc(tid * 16 + (i) * 8192, R_, C_); (unsigned)C_ * 2u; })
    const size_t kstep = (size_t)(BK * 2);
    const size_t hstep = (size_t)HALF * K * 2;
    const size_t tstep = 2 * hstep;
    const unsigned ldsw = (unsigned)wid * 1024u;
    const int aoff = lds_byte(wr * 64 + fr, fq * 8), boff = lds_byte(wc * 32 + fr, fq * 8);
#define PG8_SA(b, h) (((b) * 2 + (h)) * HTB)
#define PG8_SB(b, h) ((4 + (b) * 2 + (h)) * HTB)
#define PG8_STAGE(bufoff, gbase, voff) do { _Pragma("unroll") for (int _i = 0; _i < 2; ++_i) \
        __builtin_amdgcn_global_load_lds((const unsigned*)((const char*)(gbase) + (voff)[_i]), (PG8_LAS unsigned*)(lds + (bufoff) + ldsw + _i * 8192), 16, 0, 0); } while (0)
#define PG8_STAGE_A(bufoff, kptr, hf, nx) do { _Pragma("unroll") for (int _i = 0; _i < 2; ++_i) { const unsigned _o = (nx) ? (unsigned)idN[(hf) * 2 + _i] : gC[hf][_i]; \
        __builtin_amdgcn_global_load_lds((const unsigned*)((const char*)(kptr) + _o), (PG8_LAS unsigned*)(lds + (bufoff) + ldsw + _i * 8192), 16, 0, 0); } } while (0)
#define PG8_LDA(dst, b, h) do { _Pragma("unroll") for (int m = 0; m < 4; ++m) _Pragma("unroll") for (int k = 0; k < 2; ++k) dst[m][k] = *(const PG8_LAS bf16x8*)(lds + PG8_SA(b, h) + aoff + m * 2048 + k * 1024); } while (0)
#define PG8_LDB(dst, b, h) do { _Pragma("unroll") for (int n = 0; n < 2; ++n) _Pragma("unroll") for (int k = 0; k < 2; ++k) dst[n][k] = *(const PG8_LAS bf16x8*)(lds + PG8_SB(b, h) + boff + n * 2048 + k * 1024); } while (0)
#define PG8_MMA(ai, bj, At, Bt) do { __builtin_amdgcn_s_setprio(1); _Pragma("unroll") for (int m = 0; m < 4; ++m) _Pragma("unroll") for (int n = 0; n < 2; ++n) _Pragma("unroll") for (int k = 0; k < 2; ++k) \
        acc[ai][bj][m][n] = __builtin_amdgcn_mfma_f32_16x16x32_bf16(Bt[n][k], At[m][k], acc[ai][bj][m][n], 0, 0, 0); __builtin_amdgcn_s_setprio(0); } while (0)
#define PG8_WAIT_V(n) asm volatile("s_waitcnt vmcnt(" #n ")" ::: "memory")
#define PG8_WAIT_L(n) asm volatile("s_waitcnt lgkmcnt(" #n ")" ::: "memory")
#define PG8_BAR __builtin_amdgcn_s_barrier()
#define PG8_SCHED __builtin_amdgcn_sched_barrier(0)
    Unit cur, nxt; int ui = 0;
    if (!S.next(0, cur)) return;
    f32x4 acc[2][2][4][2];
#pragma unroll
    for (int a = 0; a < 2; ++a)
#pragma unroll
        for (int b = 0; b < 2; ++b)
#pragma unroll
            for (int m = 0; m < 4; ++m)
#pragma unroll
                for (int n = 0; n < 2; ++n) acc[a][b][m][n] = (f32x4){0.f, 0.f, 0.f, 0.f};
    bf16x8 At[4][2], B0[2][2], B1[2][2];
    unsigned gC[2][2]; int idN[4];
#pragma unroll
    for (int hf = 0; hf < 2; ++hf)
#pragma unroll
        for (int i = 0; i < 2; ++i) { gC[hf][i] = (unsigned)tok[cur.pm * BM + hf * HALF + PG8_RA(i)] * (unsigned)(K * 2) + PG8_CA2(i); idN[hf * 2 + i] = (int)gC[hf][i]; }
    const char* cA = (const char*)g.A; const char* cB = (const char*)g.Bt + (size_t)cur.pn * tstep;
    PG8_STAGE(PG8_SB(0, 0), cB, voffB); PG8_STAGE(PG8_SB(0, 1), cB + hstep, voffB); PG8_STAGE_A(PG8_SA(0, 0), cA, 0, false); PG8_STAGE_A(PG8_SA(0, 1), cA, 1, false);
    if (wr == 1) PG8_BAR;
    PG8_WAIT_V(2); PG8_BAR;
    PG8_STAGE(PG8_SB(1, 0), cB + kstep, voffB); PG8_STAGE_A(PG8_SA(1, 0), cA + kstep, 0, false); PG8_STAGE(PG8_SB(1, 1), cB + hstep + kstep, voffB);
    PG8_WAIT_V(6); PG8_BAR;
#define PG8_LOAD_IDS(pm_) do { const int* p0 = tok + (pm_) * BM + PG8_RA(0); const int* p1 = tok + (pm_) * BM + PG8_RA(1); const int* p2 = p0 + HALF; const int* p3 = p1 + HALF; \
        asm volatile("global_load_dword %0, %4, off\n\tglobal_load_dword %1, %5, off\n\tglobal_load_dword %2, %6, off\n\tglobal_load_dword %3, %7, off\n\ts_waitcnt vmcnt(0)" \
                     : "=&v"(idN[0]), "=&v"(idN[1]), "=&v"(idN[2]), "=&v"(idN[3]) : "v"(p0), "v"(p1), "v"(p2), "v"(p3) : "memory"); } while (0)
    { Unit u1; if (S.next(1, u1)) PG8_LOAD_IDS(u1.pm); }
    for (;;) {
        const bool has_next = S.next(ui + 1, nxt);
        const char* nB = has_next ? (const char*)g.Bt + (size_t)nxt.pn * tstep : cB;
        for (int t = 0; t < nt; t += 2) {
            const bool last = (t == nt - 2); const bool nx = last && has_next;
            if (nx) {
#pragma unroll
                for (int j = 0; j < 4; ++j) idN[j] = (int)((unsigned)idN[j] * (unsigned)(K * 2) + PG8_CA2(j & 1));
            }
            const char* a1 = cA + (size_t)(t + 1) * kstep;
            const char* a2 = last ? cA : cA + (size_t)(t + 2) * kstep; const char* b2 = last ? nB : cB + (size_t)(t + 2) * kstep;
            const char* a3 = a2 + kstep; const char* b3 = b2 + kstep;
            PG8_LDB(B0, 0, 0); PG8_LDB(B1, 0, 1); PG8_SCHED; PG8_LDA(At, 0, 0); PG8_STAGE_A(PG8_SA(1, 1), a1, 1, false);
            PG8_WAIT_V(8); PG8_WAIT_L(0); PG8_BAR; PG8_MMA(0, 0, At, B0); PG8_MMA(0, 1, At, B1); PG8_BAR; PG8_SCHED;
            PG8_LDA(At, 0, 1); PG8_STAGE(PG8_SB(0, 0), b2, voffB); PG8_STAGE(PG8_SB(0, 1), b2 + hstep, voffB); PG8_STAGE_A(PG8_SA(0, 0), a2, 0, nx);
            PG8_WAIT_V(8); PG8_WAIT_L(0); PG8_BAR; PG8_MMA(1, 0, At, B0); PG8_MMA(1, 1, At, B1); PG8_BAR; PG8_SCHED;
            PG8_LDB(B0, 1, 0); PG8_LDB(B1, 1, 1); PG8_SCHED; PG8_LDA(At, 1, 0); PG8_STAGE_A(PG8_SA(0, 1), a2, 1, nx);
            PG8_WAIT_V(8); PG8_WAIT_L(0); PG8_BAR; PG8_MMA(0, 0, At, B0); PG8_MMA(0, 1, At, B1); PG8_BAR; PG8_SCHED;
            PG8_LDA(At, 1, 1); PG8_STAGE(PG8_SB(1, 0), b3, voffB); PG8_STAGE(PG8_SB(1, 1), b3 + hstep, voffB); PG8_STAGE_A(PG8_SA(1, 0), a3, 0, nx);
            PG8_WAIT_V(8); PG8_WAIT_L(0); PG8_BAR; PG8_MMA(1, 0, At, B0); PG8_MMA(1, 1, At, B1); PG8_BAR; PG8_SCHED;
        }
        if (has_next) {
#pragma unroll
            for (int hf = 0; hf < 2; ++hf)
#pragma unroll
                for (int i = 0; i < 2; ++i) gC[hf][i] = (unsigned)idN[hf * 2 + i];
            Unit u2; if (S.next(ui + 2, u2)) PG8_LOAD_IDS(u2.pm);
        }
        if (wr == 0) PG8_BAR;
        E(acc, cur, wr, wc, fr, fq);
        if (!has_next) break;
#pragma unroll
        for (int a = 0; a < 2; ++a)
#pragma unroll
            for (int b = 0; b < 2; ++b)
#pragma unroll
                for (int m = 0; m < 4; ++m)
#pragma unroll
                    for (int n = 0; n < 2; ++n) acc[a][b][m][n] = (f32x4){0.f, 0.f, 0.f, 0.f};
        cur = nxt; cB = nB; ++ui;
        if (wr == 1) PG8_BAR;
    }
    PG8_WAIT_V(0);
    PG8_BAR;
#undef PG8_SA
#undef PG8_SB
#undef PG8_STAGE
#undef PG8_STAGE_A
#undef PG8_LOAD_IDS
#undef PG8_RA
#undef PG8_CA2
#undef PG8_LDA
#undef PG8_LDB
#undef PG8_MMA
#undef PG8_WAIT_V
#undef PG8_WAIT_L
#undef PG8_BAR
#undef PG8_SCHED
}
}
constexpr int DM = 1024, NBATCH = 16, SEQL = 4096, CTXL = 256, SB = CTXL + SEQL  , TT = NBATCH * SB  , NRT = TT / 256  ;
constexpr int INW = 2704, INWP = 2816;
constexpr int C_Z = 0, C_XBC = 512, C_DT = 1280, C_GQ = 1296, C_GK = 1552, C_GV = 1808, C_GR = 2064, C_GLR = 2320, C_CQ = 2352, C_CKV = 2544, C_KPE = 2672;
constexpr float EPS = 1e-6f;
constexpr int NWAVES = 8, NTHREADS = 512;
enum { I_X = 0, I_C, I_CTX, I_CCTX, I_WMOD, I_BMOD, I_NORM1, I_WIN, I_CONVW, I_CONVB, I_ALOG, I_DTB, I_SSDD, I_SSDNW, I_GUPW, I_GUPB, I_GLANW, I_QNW, I_WUQ, I_KVNW, I_WUKV, I_WOUT, I_NORM2,
       I_RW, I_RB, I_W1, I_B1, I_W2, I_B2, I_FINW, N_IN };
constexpr size_t MiB = 1u << 20;
constexpr size_t WS_CTL = 0, CTL_ZERO_BYTES = 1 * MiB;
constexpr size_t WS_MOD = 1 * MiB;
constexpr size_t WS_ROPE = 1 * MiB + 960 * 1024;
constexpr size_t WS_META = 1 * MiB + 980 * 1024;
constexpr size_t WS_WUQT = 2 * MiB;
constexpr size_t WS_WUKVT = 2 * MiB + 512 * 1024;
constexpr size_t WS_WOUTT = 4 * MiB;
constexpr size_t WS_WINT = 8 * MiB;
constexpr size_t WS_W1T = 20 * MiB;
constexpr size_t WS_W2T = 148 * MiB;
constexpr size_t WS_H = 212 * MiB;
constexpr size_t WS_ACT1 = 484 * MiB;
constexpr size_t WS_ARENA = 620 * MiB;
constexpr size_t WS_COLS = WS_ARENA;
constexpr size_t WS_XBC = WS_ARENA + 374 * MiB;
constexpr size_t WS_DT = WS_ARENA + 476 * MiB;
constexpr size_t WS_G = WS_ARENA + 481 * MiB;
constexpr size_t WS_AQ = WS_ARENA + 617 * MiB;
constexpr size_t WS_AKV = WS_ARENA + 651 * MiB;
constexpr size_t WS_QRAW = WS_ARENA + 685 * MiB;
constexpr size_t WS_KV = WS_ARENA + 753 * MiB;
constexpr size_t WS_KVT = WS_ARENA + 821 * MiB;
constexpr size_t WS_QF = WS_ARENA + 889 * MiB;
constexpr size_t WS_KF = WS_ARENA + 940 * MiB;
constexpr size_t WS_YF = WS_ARENA + 991 * MiB;
constexpr size_t WS_YB = WS_ARENA + 1059 * MiB;
constexpr size_t WS_OF = WS_ARENA + 1127 * MiB;
constexpr size_t WS_OB = WS_ARENA + 1161 * MiB;
constexpr size_t WS_MODP = WS_ARENA;
constexpr int MAXSLOT = 1120 * 256;
constexpr size_t WS_XG = WS_ARENA;
constexpr size_t WS_ACTB = WS_ARENA + 560 * MiB;
constexpr size_t WS_TOKE = WS_ARENA + 1120 * MiB;
constexpr size_t WS_TOKP = WS_ARENA + 1122 * MiB;
constexpr size_t WS_TOKW = WS_ARENA + 1124 * MiB;
constexpr size_t WS_WGCNT = WS_ARENA + 1126 * MiB;
constexpr size_t WS_TOKS = WS_ARENA + 1128 * MiB;
constexpr size_t WS_STOK = WS_ARENA + 1130 * MiB;
constexpr size_t WS_END = WS_ARENA + 1428 * MiB;
constexpr int CW_BAR = 4096;
constexpr int CW_AQ = 8192;
constexpr int CW_ASM = 8192 + 1024;
constexpr int RING_BYTES = 131072, LDSCTL_OFF = RING_BYTES, LDS_BYTES = 147456;
constexpr int MISC_BAR = 8;
constexpr int MISC_Q = 16;
constexpr int MISC_CNT = 32;
constexpr int MISC_SB = 64;

#define GAS __attribute__((address_space(1)))
#define LAS __attribute__((address_space(3)))
typedef unsigned short bf16;
typedef unsigned v4u __attribute__((ext_vector_type(4)));
typedef unsigned v2u __attribute__((ext_vector_type(2)));
typedef float f32x4 __attribute__((ext_vector_type(4)));
typedef short bf16x8 __attribute__((ext_vector_type(8)));
#define LDS_WAIT() asm volatile("s_waitcnt lgkmcnt(0)" ::: "memory")

__device__ __forceinline__ float bf2f(unsigned v) { return __uint_as_float(v << 16); }
__device__ __forceinline__ float bflo(unsigned w) { return __uint_as_float(w << 16); }
__device__ __forceinline__ float bfhi(unsigned w) { return __uint_as_float(w & 0xffff0000u); }
__device__ __forceinline__ unsigned f2bf(float f) { unsigned u = __float_as_uint(f); return (u + 0x7fffu + ((u >> 16) & 1u)) >> 16; }
typedef float f32x2_t __attribute__((ext_vector_type(2))); typedef __bf16 bf16x2_t __attribute__((ext_vector_type(2)));
__device__ __forceinline__ unsigned pk2(float lo, float hi) { const f32x2_t v = {lo, hi}; const bf16x2_t b = __builtin_convertvector(v, bf16x2_t); return __builtin_bit_cast(unsigned, b); }
template <int CTRL> __device__ __forceinline__ float dppf(float x) { return __int_as_float(__builtin_amdgcn_update_dpp(0, __float_as_int(x), CTRL, 0xf, 0xf, true)); }
#define XROW16(x, OP) do { const auto r_ = __builtin_amdgcn_permlane16_swap(__float_as_uint(x), __float_as_uint(x), false, false); x = OP(__uint_as_float(r_[0]), __uint_as_float(r_[1])); } while (0)
#define XROW32(x, OP) do { const auto r_ = __builtin_amdgcn_permlane32_swap(__float_as_uint(x), __float_as_uint(x), false, false); x = OP(__uint_as_float(r_[0]), __uint_as_float(r_[1])); } while (0)
__device__ __forceinline__ float op_add(float a, float b) { return a + b; }
__device__ __forceinline__ float op_max(float a, float b) { return fmaxf(a, b); }
__device__ __forceinline__ float row_sum16(float v) { v += dppf<0xB1>(v); v += dppf<0x4E>(v); v += dppf<0x141>(v); v += dppf<0x140>(v); return v; }
__device__ __forceinline__ float row_max16(float v) { v = fmaxf(v, dppf<0xB1>(v)); v = fmaxf(v, dppf<0x4E>(v)); v = fmaxf(v, dppf<0x141>(v)); v = fmaxf(v, dppf<0x140>(v)); return v; }
template <int CTRL, int ROWS> __device__ __forceinline__ float dppz(float x) { return __int_as_float(__builtin_amdgcn_update_dpp(0, __float_as_int(x), CTRL, ROWS, 0xf, false)); }
__device__ __forceinline__ float wave_scan_incl(float v) {
    v += dppz<0x111, 0xf>(v); v += dppz<0x112, 0xf>(v); v += dppz<0x114, 0xf>(v); v += dppz<0x118, 0xf>(v);
    v += dppz<0x142, 0xa>(v); v += dppz<0x143, 0xc>(v); return v;
}
__device__ __forceinline__ float wave_sum(float v) { v = row_sum16(v); XROW16(v, op_add); XROW32(v, op_add); return v; }
__device__ __forceinline__ float wave_max(float v) { v = row_max16(v); XROW16(v, op_max); XROW32(v, op_max); return v; }
__device__ __forceinline__ float half_max32(float v) { v = row_max16(v); XROW16(v, op_max); return v; }
__device__ __forceinline__ float sum_x16_x32(float v) { XROW16(v, op_add); XROW32(v, op_add); return v; }
__device__ __forceinline__ v4u pair16(v2u a, v2u b) {
    const auto r0 = __builtin_amdgcn_permlane16_swap(a.x, b.x, false, false); const auto r1 = __builtin_amdgcn_permlane16_swap(a.y, b.y, false, false);
    return (v4u){r0[0], r1[0], r0[1], r1[1]};
}
__device__ __forceinline__ float siluf(float x) { return x / (1.0f + expf(-x)); }
__device__ __forceinline__ float fsilu(float x) { return x * __builtin_amdgcn_rcpf(1.0f + __expf(-x)); }
__device__ __forceinline__ float fsoftplus(float x) { const float e = __expf(-fabsf(x)); const float l1p = e < 0.03125f ? e * (1.0f - e * (0.5f - e * (0.33333334f - 0.25f * e))) : __logf(1.0f + e); return fmaxf(x, 0.f) + l1p; }
__device__ __forceinline__ float softplusf(float x) { return fmaxf(x, 0.f) + log1pf(expf(-fabsf(x))); }

struct Args { const float* in[N_IN]; float* out; unsigned char* ws; int ph_lo, ph_hi; };
constexpr int PTR_OFF = LDSCTL_OFF + 1024;

__device__ __forceinline__ void transpose_item(const float* W, int K, int N, bf16* WT, int Kp, int nblk, int item, LAS float* scr, int lane) {
    const int kb = item / nblk, nb = item - kb * nblk, k0 = 64 * kb, n0 = 32 * nb;
    const int n = n0 + (lane & 31);
#pragma unroll 8
    for (int i = 0; i < 32; ++i) { const int kk = 2 * i + (lane >> 5), k = k0 + kk; scr[kk * 33 + (lane & 31)] = (k < K && n < N) ? W[(size_t)k * N + n] : 0.f; }
    LDS_WAIT(); asm volatile("" ::: "memory");
    const int c = lane & 7;
#pragma unroll
    for (int j = 0; j < 4; ++j) { const int nn = (lane >> 3) + 8 * j; const LAS float* s = scr + (8 * c) * 33 + nn;
        v4u o; o.x = pk2(s[0 * 33], s[1 * 33]); o.y = pk2(s[2 * 33], s[3 * 33]); o.z = pk2(s[4 * 33], s[5 * 33]); o.w = pk2(s[6 * 33], s[7 * 33]);
        *(v4u*)(WT + (size_t)(n0 + nn) * Kp + k0 + 8 * c) = o; }
    LDS_WAIT(); asm volatile("" ::: "memory");
}
__device__ __forceinline__ void norm_mod_row(const float* hrow, const float* nw, const float* shift, const float* scale, bf16* orow, int lane) {
    const f32x4* xr = (const f32x4*)hrow + lane; f32x4 v[4]; float ss = 0.f;
#pragma unroll
    for (int q = 0; q < 4; ++q) { v[q] = xr[64 * q]; ss += (v[q].x * v[q].x + v[q].y * v[q].y) + (v[q].z * v[q].z + v[q].w * v[q].w); }
    const float rstd = rsqrtf(wave_sum(ss) * (1.0f / 1024.0f) + EPS);
#pragma unroll
    for (int q = 0; q < 4; ++q) { const int j4 = lane + 64 * q; const f32x4 w = ((const f32x4*)nw)[j4], sh = ((const f32x4*)shift)[j4], sc = ((const f32x4*)scale)[j4];
        const f32x4 o = (v[q] * rstd * w) * (sc + 1.0f) + sh; v2u p; p.x = pk2(o.x, o.y); p.y = pk2(o.z, o.w); ((v2u*)orow)[j4] = p; }
}
__device__ __forceinline__ const float* h0_row(const float* x, const float* ctx, int m) { const int b = m / SB, s = m - b * SB; return s < CTXL ? ctx + ((size_t)b * CTXL + s) * DM : x + ((size_t)b * SEQL + (s - CTXL)) * DM; }
#define XB_TMO      128
#define XB_XCNT(j)  (256  + 64 * (j))
#define XB_XSUB(j)  (1280 + 64 * (j))
#define XB_XGEN(j)  (2304 + 64 * (j))
#define XB_TOP      3328
#define XB_TOPGEN   3392
#define XCD_BAR_WORDS 3456
#define XB_SPIN_CAP (1u << 22)

__device__ __forceinline__ unsigned xb_ld(unsigned* p)              { return __hip_atomic_load(p, __ATOMIC_RELAXED, __HIP_MEMORY_SCOPE_AGENT); }
__device__ __forceinline__ unsigned xb_add(unsigned* p, unsigned v) { return __hip_atomic_fetch_add(p, v, __ATOMIC_RELAXED, __HIP_MEMORY_SCOPE_AGENT); }
__device__ __forceinline__ unsigned xb_xcc_id() { return (unsigned)__builtin_amdgcn_s_getreg((3 << 11) | 20) & 0xFu; }
#define XB_SPIN(cond, bar) do { unsigned _sp = 0; while (cond) { __builtin_amdgcn_s_sleep(1); \
    if ((++_sp & 255u) == 0u) { if (xb_ld(&(bar)[XB_TMO])) break; if (_sp > XB_SPIN_CAP) { atomicAdd(&(bar)[XB_TMO], 1u); break; } } } } while (0)

struct XcdBarrier {
    unsigned* bar; unsigned x;
    volatile LAS unsigned* st;
};

__device__ __forceinline__ XcdBarrier xcd_barrier_post(unsigned* bar, volatile LAS unsigned* st) {
    XcdBarrier b; b.bar = bar; b.x = xb_xcc_id(); b.st = st;
    if (threadIdx.x == 0) (void)xb_add(&bar[XB_XCNT(b.x)], 1u);
    return b;
}
__device__ __forceinline__ void xcd_barrier_complete(unsigned* bar, unsigned x, unsigned& nloc, unsigned& nx) {
    const unsigned G = gridDim.x * gridDim.y * gridDim.z;
    unsigned sum, cnt, mine, sp = 0u;
    for (;;) {
        sum = 0u; cnt = 0u; mine = 0u;
#pragma unroll
        for (unsigned j = 0; j < 16; ++j) { const unsigned c = xb_ld(&bar[XB_XCNT(j)]); sum += c; cnt += (c > 0u) ? 1u : 0u; mine = (j == x) ? c : mine; }
        if (sum == G) break;
        __builtin_amdgcn_s_sleep(1);
        if ((++sp & 255u) == 0u) { if (xb_ld(&bar[XB_TMO])) break; if (sp > XB_SPIN_CAP) { atomicAdd(&bar[XB_TMO], 1u); break; } }
    }
    nloc = mine > 0u ? mine : 1u; nx = cnt > 0u ? cnt : 1u;
}

__device__ __forceinline__ void xcd_barrier(const XcdBarrier& b) {
    asm volatile("s_waitcnt vmcnt(0)" ::: "memory");
    __syncthreads();
    if (threadIdx.x == 0) {
        unsigned* bar = b.bar;
        __builtin_amdgcn_s_waitcnt(0);
        unsigned nloc = b.st[0], nx = b.st[1];
        if (nloc == 0u) { xcd_barrier_complete(bar, b.x, nloc, nx); b.st[0] = nloc; b.st[1] = nx; }
        const unsigned old = xb_add(&bar[XB_XSUB(b.x)], 1u);
        const unsigned gen = old / nloc;
        if (old + 1u == (gen + 1u) * nloc) {
            __builtin_amdgcn_fence(__ATOMIC_RELEASE, "agent");
            asm volatile("s_waitcnt vmcnt(0)" ::: "memory");
            const unsigned og = xb_add(&bar[XB_TOP], 1u);
            const unsigned tg = og / nx;
            if (og + 1u == (tg + 1u) * nx) xb_add(&bar[XB_TOPGEN], 1u);
            else XB_SPIN(xb_ld(&bar[XB_TOPGEN]) == tg, bar);
            __builtin_amdgcn_fence(__ATOMIC_ACQUIRE, "agent");
            xb_add(&bar[XB_XGEN(b.x)], 1u);
            asm volatile("s_waitcnt vmcnt(0)" ::: "memory");
        } else {
            XB_SPIN(xb_ld(&bar[XB_XGEN(b.x)]) == gen, bar);
            __builtin_amdgcn_fence(__ATOMIC_ACQUIRE, "agent");
            asm volatile("s_waitcnt vmcnt(0)" ::: "memory");
        }
    }
    __syncthreads();
}
struct Ctx { LAS unsigned char* lds; volatile LAS unsigned* MISC; GAS unsigned char* ws; int tid, lane, wave, G, bid; };
__device__ __forceinline__ const float* in_ptr(const Ctx& C, int i) {
    const volatile LAS unsigned* P = (const volatile LAS unsigned*)(C.lds + PTR_OFF) + 2 * i;
    const unsigned lo = __builtin_amdgcn_readfirstlane(P[0]), hi = __builtin_amdgcn_readfirstlane(P[1]);
    return (const float*)(const GAS float*)(((unsigned long long)hi << 32) | lo);
}
#define IN_(i) in_ptr(C, (i))

__device__ __forceinline__ void ph_g0(const Args& A, const Ctx& C) { const float* const p_I_C = IN_(I_C); const float* const p_I_CCTX = IN_(I_CCTX); const float* const p_I_WIN = IN_(I_WIN); const float* const p_I_WMOD = IN_(I_WMOD); const float* const p_I_WOUT = IN_(I_WOUT); const float* const p_I_WUKV = IN_(I_WUKV); const float* const p_I_WUQ = IN_(I_WUQ);
    if (C.bid < 192) {
        const int l = C.bid / 96, rem = C.bid % 96, cb = rem >> 3, s = rem & 7, i0 = s * 128;
        LAS float* sc = (LAS float*)C.lds;
        for (int idx = C.tid; idx < 17 * 128; idx += NTHREADS) { const int r = idx >> 7, i = idx & 127; const float cv = r < 16 ? p_I_C[r * 1024 + i0 + i] : p_I_CCTX[i0 + i]; sc[idx] = siluf(cv); }
        __syncthreads();
        const int j = cb * 512 + C.tid; float acc[17];
#pragma unroll
        for (int r = 0; r < 17; ++r) acc[r] = 0.f;
        const float* wm = p_I_WMOD + ((size_t)l * 1024 + i0) * 6144 + j;
        for (int i = 0; i < 128; ++i) { const float w = wm[(size_t)i * 6144];
#pragma unroll
            for (int r = 0; r < 17; ++r) acc[r] += sc[r * 128 + i] * w; }
        float* mp = (float*)(C.ws + WS_MODP) + ((size_t)(s * 2 + l) * 17) * 6144 + j;
#pragma unroll
        for (int r = 0; r < 17; ++r) mp[(size_t)r * 6144] = acc[r];
        __syncthreads();
    }
    if (C.bid == C.G - 1) {
        const int pos = C.tid >> 3, i = C.tid & 7;
        double f = 1.0; if (i >= 2) f *= 0.1; if (i >= 4) f *= 0.1; if (i >= 6) f *= 0.1; if (i & 1) f *= 0.31622776601683794;
        const double ang = (double)pos * f;
        const double n = __builtin_rint(ang * 0.63661977236758134);
        double r = __builtin_fma(-n, 1.5707963267948966, ang); r = __builtin_fma(-n, 6.123233995736766e-17, r);
        const double r2 = r * r;
        double sn = 1.0 / 355687428096000.0;
        sn = sn * r2 - 1.0 / 1307674368000.0; sn = sn * r2 + 1.0 / 6227020800.0; sn = sn * r2 - 1.0 / 39916800.0; sn = sn * r2 + 1.0 / 362880.0; sn = sn * r2 - 1.0 / 5040.0; sn = sn * r2 + 1.0 / 120.0; sn = sn * r2 - 1.0 / 6.0; sn = sn * r2 + 1.0; sn *= r;
        double cs = 1.0 / 20922789888000.0;
        cs = cs * r2 - 1.0 / 87178291200.0; cs = cs * r2 + 1.0 / 479001600.0; cs = cs * r2 - 1.0 / 3628800.0; cs = cs * r2 + 1.0 / 40320.0; cs = cs * r2 - 1.0 / 720.0; cs = cs * r2 + 1.0 / 24.0; cs = cs * r2 - 0.5; cs = cs * r2 + 1.0;
        const int q = ((int)n) & 3;
        const double c_ = q == 0 ? cs : q == 1 ? -sn : q == 2 ? -cs : sn;
        const double s_ = q == 0 ? sn : q == 1 ? cs : q == 2 ? -sn : -cs;
        float* rt = (float*)(C.ws + WS_ROPE); rt[C.tid * 2] = (float)c_; rt[C.tid * 2 + 1] = (float)s_;
    }
    LAS float* scr = (LAS float*)(C.lds + C.wave * 16384);
    const int gw = C.bid * NWAVES + C.wave, NGW = C.G * NWAVES;
    for (int it = gw; it < 4096; it += NGW) {
        const int l = it >> 11; int r = it & 2047;
        if (r < 1408) { transpose_item(p_I_WIN + (size_t)l * 1024 * INW, 1024, INW, (bf16*)(C.ws + WS_WINT) + (size_t)l * INWP * 1024, 1024, 88, r, scr, C.lane); continue; } r -= 1408;
        if (r < 512) { transpose_item(p_I_WOUT + (size_t)l * 1024 * 1024, 1024, 1024, (bf16*)(C.ws + WS_WOUTT) + (size_t)l * 1024 * 1024, 1024, 32, r, scr, C.lane); continue; } r -= 512;
        if (r < 64) { transpose_item(p_I_WUQ + (size_t)l * 192 * 384, 192, 384, (bf16*)(C.ws + WS_WUQT) + (size_t)l * 512 * 256, 256, 16, r, scr, C.lane); continue; } r -= 64;
        transpose_item(p_I_WUKV + (size_t)l * 128 * 512, 128, 512, (bf16*)(C.ws + WS_WUKVT) + (size_t)l * 512 * 256, 256, 16, r, scr, C.lane);
    }
}
__device__ __forceinline__ void convert_experts(const Args& A, const Ctx& C, int l) { const float* const p_I_W1 = IN_(I_W1); const float* const p_I_W2 = IN_(I_W2);
    LAS unsigned* T = (LAS unsigned*)C.lds;
    const int tid = C.tid, n4 = (tid & 63) * 4, kq = tid >> 6;
    for (int it = C.bid; it < 4096 + 2048; it += C.G) {
        const float* W; bf16* WT; int N, kb, nb;
        if (it < 4096) { const int e = it >> 7, r = it & 127; kb = r >> 3; nb = r & 7; N = 2048; W = p_I_W1 + ((size_t)l * 32 + e) * 1024 * 2048; WT = (bf16*)(C.ws + WS_W1T) + (size_t)e * 2048 * 1024; }
        else { const int i2 = it - 4096, e = i2 >> 6, r = i2 & 63; kb = r >> 2; nb = r & 3; N = 1024; W = p_I_W2 + ((size_t)l * 32 + e) * 1024 * 1024; WT = (bf16*)(C.ws + WS_W2T) + (size_t)e * 1024 * 1024; }
        const float* src = W + (size_t)(kb * 64) * N + nb * 256 + n4;
        f32x4 a[4], b[4];
#pragma unroll
        for (int i = 0; i < 4; ++i) { const int kp = kq + 8 * i; a[i] = *(const f32x4*)(src + (size_t)(2 * kp) * N); b[i] = *(const f32x4*)(src + (size_t)(2 * kp + 1) * N); }
        __syncthreads();
#pragma unroll
        for (int i = 0; i < 4; ++i) { const int kp = kq + 8 * i; T[(n4 + 0) * 33 + kp] = pk2(a[i].x, b[i].x); T[(n4 + 1) * 33 + kp] = pk2(a[i].y, b[i].y); T[(n4 + 2) * 33 + kp] = pk2(a[i].z, b[i].z); T[(n4 + 3) * 33 + kp] = pk2(a[i].w, b[i].w); }
        __syncthreads();
        const int c = tid & 7, r0 = tid >> 3;
#pragma unroll
        for (int ps = 0; ps < 4; ++ps) { const int n = r0 + 64 * ps; const LAS unsigned* t = T + n * 33 + 4 * c; v4u o; o.x = t[0]; o.y = t[1]; o.z = t[2]; o.w = t[3];
            *(v4u*)(WT + (size_t)(nb * 256 + n) * 1024 + kb * 64 + 8 * c) = o; }
    }
    __syncthreads();
}
__device__ __forceinline__ void ph_g1(const Args& A, const Ctx& C) { const float* const p_I_BMOD = IN_(I_BMOD);
    const float* mp = (const float*)(C.ws + WS_MODP); float* mod = (float*)(C.ws + WS_MOD);
    for (int idx = C.bid * NTHREADS + C.tid; idx < 2 * 17 * 6144; idx += C.G * NTHREADS) {
        const int l = idx / (17 * 6144), j = idx % 6144; float s = p_I_BMOD[l * 6144 + j];
#pragma unroll
        for (int p = 0; p < 8; ++p) s += mp[(size_t)p * (2 * 17 * 6144) + idx];
        mod[idx] = s;
    }
}
__device__ __forceinline__ void ph_g2(const Args& A, const Ctx& C) { const float* const p_I_CTX = IN_(I_CTX); const float* const p_I_NORM1 = IN_(I_NORM1); const float* const p_I_X = IN_(I_X);
    const int gw = C.bid * NWAVES + C.wave, NGW = C.G * NWAVES, lane = C.lane; const float* mod = (const float*)(C.ws + WS_MOD); bf16* uo = (bf16*)(C.ws + WS_ACT1);
    f32x4 nw[4];
#pragma unroll
    for (int q = 0; q < 4; ++q) nw[q] = ((const f32x4*)p_I_NORM1)[lane + 64 * q];
    f32x4 cv[2][4], nv[2][4];
#define G2_LOAD(m_, v_) do { _Pragma("unroll") for (int r = 0; r < 2; ++r) { const int mm = (m_) + r * NGW; if (mm < TT) { const f32x4* xr = (const f32x4*)h0_row(p_I_X, p_I_CTX, mm) + lane; \
        _Pragma("unroll") for (int q = 0; q < 4; ++q) v_[r][q] = xr[64 * q]; } } } while (0)
    G2_LOAD(gw, cv);
    for (int m = gw; m < TT; m += 2 * NGW) {
        if (m + 2 * NGW < TT) G2_LOAD(m + 2 * NGW, nv);
        float ss[2];
#pragma unroll
        for (int r = 0; r < 2; ++r) { ss[r] = 0.f;
#pragma unroll
            for (int q = 0; q < 4; ++q) ss[r] += (cv[r][q].x * cv[r][q].x + cv[r][q].y * cv[r][q].y) + (cv[r][q].z * cv[r][q].z + cv[r][q].w * cv[r][q].w); }
        ss[0] = wave_sum(ss[0]); ss[1] = wave_sum(ss[1]);
#pragma unroll
        for (int r = 0; r < 2; ++r) { const int mm = m + r * NGW; if (mm < TT) { const int b = mm / SB, s = mm - b * SB; const float* mr = mod + (size_t)(s < CTXL ? 16 : b) * 6144; const float rstd = rsqrtf(ss[r] * (1.0f / 1024.0f) + EPS);
#pragma unroll
            for (int q = 0; q < 4; ++q) { const int j4 = lane + 64 * q; const f32x4 sh = ((const f32x4*)mr)[j4], sc = ((const f32x4*)(mr + 1024))[j4];
                const f32x4 o = (cv[r][q] * rstd * nw[q]) * (sc + 1.0f) + sh; v2u p; p.x = pk2(o.x, o.y); p.y = pk2(o.z, o.w); ((v2u*)(uo + (size_t)mm * DM))[j4] = p; } } }
#pragma unroll
        for (int r = 0; r < 2; ++r)
#pragma unroll
            for (int q = 0; q < 4; ++q) cv[r][q] = nv[r][q];
    }
#undef G2_LOAD
}
__device__ __forceinline__ void ph_prep(const Args& A, const Ctx& C, int l, int rep) { const float* const p_I_CONVB = IN_(I_CONVB); const float* const p_I_CONVW = IN_(I_CONVW); const float* const p_I_DTB = IN_(I_DTB); const float* const p_I_GUPB = IN_(I_GUPB); const float* const p_I_GUPW = IN_(I_GUPW); const float* const p_I_KVNW = IN_(I_KVNW); const float* const p_I_QNW = IN_(I_QNW);
    LAS float* gws = (LAS float*)C.lds;
    LAS float* cws = (LAS float*)(C.lds + 32768);
    for (int idx = C.tid; idx < 8192; idx += NTHREADS) gws[idx] = p_I_GUPW[l * 8192 + idx];
    for (int idx = C.tid; idx < 2304; idx += NTHREADS) cws[idx] = p_I_CONVW[l * 2304 + idx];
    for (int idx = C.tid; idx < 768; idx += NTHREADS) cws[2304 + idx] = p_I_CONVB[l * 768 + idx];
    __syncthreads();
    const bf16* cols = (const bf16*)(C.ws + WS_COLS);
    bf16* xbc = (bf16*)(C.ws + WS_XBC); float* dt = (float*)(C.ws + WS_DT); bf16* gg = (bf16*)(C.ws + WS_G); bf16* aq = (bf16*)(C.ws + WS_AQ); bf16* akv = (bf16*)(C.ws + WS_AKV);
    const int gw = C.bid * NWAVES + C.wave, NGW = C.G * NWAVES, lane = C.lane;
    const float dtb = lane < 16 ? p_I_DTB[l * 16 + lane] : 0.f;
    const f32x4 gb0 = *(const f32x4*)(p_I_GUPB + l * 512 + lane * 4), gb1 = *(const f32x4*)(p_I_GUPB + l * 512 + 256 + lane * 4);
    const f32x4 qnw = lane < 48 ? *(const f32x4*)(p_I_QNW + l * 192 + lane * 4) : (f32x4){0.f, 0.f, 0.f, 0.f}, kvnw = lane < 32 ? *(const f32x4*)(p_I_KVNW + l * 128 + lane * 4) : (f32x4){0.f, 0.f, 0.f, 0.f};
    v2u cx0[3], cxm[3], cxp[3], ccq, cckv; v4u cgl[4]; unsigned cdt;
    v2u nx0[3], nxm[3], nxp[3], ncq, nckv; v4u ngl[4]; unsigned ndt;
#define PREP_LOAD(m_, x0_, xm_, xp_, cq_, ckv_, gl_, dt_) do { const int b_ = (m_) / SB, s_ = (m_) - b_ * SB; const bool hp_ = (s_ != 0 && s_ != CTXL), hn_ = (s_ != CTXL - 1 && s_ != SB - 1); \
        const bf16* r_ = cols + (size_t)(m_) * INWP; \
        _Pragma("unroll") for (int ch = 0; ch < 3; ++ch) { const int c_ = ch * 256 + lane * 4; x0_[ch] = *(const v2u*)(r_ + C_XBC + c_); xm_[ch] = (v2u){0u, 0u}; xp_[ch] = (v2u){0u, 0u}; \
            if (hp_) xm_[ch] = *(const v2u*)(r_ - INWP + C_XBC + c_); if (hn_) xp_[ch] = *(const v2u*)(r_ + INWP + C_XBC + c_); } \
        dt_ = r_[C_DT + (lane & 15)]; { const v4u* g_ = (const v4u*)(r_ + C_GLR); gl_[0] = g_[0]; gl_[1] = g_[1]; gl_[2] = g_[2]; gl_[3] = g_[3]; } \
        cq_ = *(const v2u*)(r_ + C_CQ + (lane < 48 ? lane : 0) * 4); ckv_ = *(const v2u*)(r_ + C_CKV + (lane & 31) * 4); } while (0)
    if (gw < TT) PREP_LOAD(gw, cx0, cxm, cxp, ccq, cckv, cgl, cdt);
    for (int m = gw; m < TT; m += NGW) {
        const int mn = m + NGW;
        if (mn < TT) PREP_LOAD(mn, nx0, nxm, nxp, ncq, nckv, ngl, ndt);
#pragma unroll
        for (int ch = 0; ch < 3; ++ch) { const int c = ch * 256 + lane * 4; const v2u x0 = cx0[ch], xm = cxm[ch], xp = cxp[ch];
            const f32x4 w0 = *(const LAS f32x4*)(cws + c), w1 = *(const LAS f32x4*)(cws + 768 + c), w2 = *(const LAS f32x4*)(cws + 1536 + c), bb = *(const LAS f32x4*)(cws + 2304 + c);
            f32x4 v; v.x = w0.x * bflo(xm.x) + w1.x * bflo(x0.x) + w2.x * bflo(xp.x) + bb.x; v.y = w0.y * bfhi(xm.x) + w1.y * bfhi(x0.x) + w2.y * bfhi(xp.x) + bb.y;
            v.z = w0.z * bflo(xm.y) + w1.z * bflo(x0.y) + w2.z * bflo(xp.y) + bb.z; v.w = w0.w * bfhi(xm.y) + w1.w * bfhi(x0.y) + w2.w * bfhi(xp.y) + bb.w;
            v2u o; o.x = pk2(fsilu(v.x), fsilu(v.y)); o.y = pk2(fsilu(v.z), fsilu(v.w)); *(v2u*)(xbc + (size_t)m * 768 + c) = o; __builtin_amdgcn_sched_barrier(0); }
        if (lane < 16) dt[(size_t)m * 16 + lane] = fsoftplus(bf2f(cdt) + dtb);
#pragma unroll
        for (int dir = 0; dir < 2; ++dir) { const v4u q0 = cgl[2 * dir], q1 = cgl[2 * dir + 1];
            const unsigned gw32[8] = {q0.x, q0.y, q0.z, q0.w, q1.x, q1.y, q1.z, q1.w};
            f32x4 acc = dir ? gb1 : gb0;
#pragma unroll
            for (int r = 0; r < 16; ++r) { const unsigned w = gw32[r >> 1]; const float gv = (r & 1) ? bfhi(w) : bflo(w); acc += gv * *(const LAS f32x4*)(gws + (dir * 16 + r) * 256 + lane * 4); }
            f32x4 o; o.x = -fsoftplus(-acc.x) * 0.0625f; o.y = -fsoftplus(-acc.y) * 0.0625f; o.z = -fsoftplus(-acc.z) * 0.0625f; o.w = -fsoftplus(-acc.w) * 0.0625f;
            v2u ob; ob.x = pk2(o.x, o.y); ob.y = pk2(o.z, o.w); *(v2u*)(gg + (size_t)m * 512 + dir * 256 + lane * 4) = ob; __builtin_amdgcn_sched_barrier(0); }
        { float v0 = 0.f, v1 = 0.f, v2 = 0.f, v3 = 0.f, u0 = 0.f, u1 = 0.f, u2 = 0.f, u3 = 0.f;
          if (lane < 48) { v0 = bflo(ccq.x); v1 = bfhi(ccq.x); v2 = bflo(ccq.y); v3 = bfhi(ccq.y); }
          if (lane < 32) { u0 = bflo(cckv.x); u1 = bfhi(cckv.x); u2 = bflo(cckv.y); u3 = bfhi(cckv.y); }
          float sa = (v0 * v0 + v1 * v1) + (v2 * v2 + v3 * v3), sb = (u0 * u0 + u1 * u1) + (u2 * u2 + u3 * u3);
          sa = wave_sum(sa); sb = wave_sum(sb);
          const float ra = rsqrtf(sa * (1.0f / 192.0f) + EPS), rb = rsqrtf(sb * (1.0f / 128.0f) + EPS);
          v2u oa; oa.x = pk2(v0 * ra * qnw.x, v1 * ra * qnw.y); oa.y = pk2(v2 * ra * qnw.z, v3 * ra * qnw.w); *(v2u*)(aq + (size_t)m * 256 + lane * 4) = oa;
          v2u ob; ob.x = pk2(u0 * rb * kvnw.x, u1 * rb * kvnw.y); ob.y = pk2(u2 * rb * kvnw.z, u3 * rb * kvnw.w); *(v2u*)(akv + (size_t)m * 256 + lane * 4) = ob; }
#pragma unroll
        for (int ch = 0; ch < 3; ++ch) { cx0[ch] = nx0[ch]; cxm[ch] = nxm[ch]; cxp[ch] = nxp[ch]; }
        ccq = ncq; cckv = nckv; cdt = ndt;
#pragma unroll
        for (int q = 0; q < 4; ++q) cgl[q] = ngl[q];
    }
#undef PREP_LOAD
    __syncthreads();
    if (rep == 0) convert_experts(A, C, l);
}
__device__ __forceinline__ void assemble_rows8(const Ctx& C, int m0) {
    const bf16* qraw = (const bf16*)(C.ws + WS_QRAW); const bf16* kv = (const bf16*)(C.ws + WS_KV); const bf16* cols = (const bf16*)(C.ws + WS_COLS);
    bf16* qf = (bf16*)(C.ws + WS_QF); bf16* kf = (bf16*)(C.ws + WS_KF); const float* rope = (const float*)(C.ws + WS_ROPE);
    const float QS = 0.10206207261596575f * 1.4426950408889634f;
    const int lane = C.lane, h = lane >> 4, d = (lane & 15) * 4;
    const int rr = lane >> 4, rh = (lane >> 2) & 3, ra = (lane >> 1) & 1, rg = lane & 1, ro = rh * 96 + 64 + ra * 16 + 4 * rg;
#pragma unroll
    for (int g = 0; g < 2; ++g) { const int m = m0 + 4 * g;
        v2u x[4], kk[4];
#pragma unroll
        for (int j = 0; j < 4; ++j) { x[j] = *(const v2u*)(qraw + (size_t)(m + j) * 512 + h * 96 + d); kk[j] = *(const v2u*)(kv + (size_t)(m + j) * 512 + h * 128 + d); }
        const int mr = m + rr, bb = mr / SB, s = mr - bb * SB; const bool lat = s >= CTXL; const int sp = s - CTXL, pos = ra == 0 ? sp >> 6 : sp & 63;
        const v2u t1 = *(const v2u*)(qraw + (size_t)mr * 512 + ro), t2 = *(const v2u*)(qraw + (size_t)mr * 512 + ro + 8);
        const bf16* kpe = cols + (size_t)mr * INWP + C_KPE + ra * 16 + 4 * rg; const v2u u1 = *(const v2u*)kpe, u2 = *(const v2u*)(kpe + 8);
        f32x4 c0 = (f32x4){1.f, 0.f, 1.f, 0.f}, c1 = c0;
        if (lat) { const f32x4* rp = (const f32x4*)(rope + (pos * 8 + 4 * rg) * 2); c0 = rp[0]; c1 = rp[1]; }
#pragma unroll
        for (int j = 0; j < 4; ++j) { v2u o; o.x = pk2(bflo(x[j].x) * QS, bfhi(x[j].x) * QS); o.y = pk2(bflo(x[j].y) * QS, bfhi(x[j].y) * QS);
            *(v2u*)(qf + (size_t)(m + j) * 384 + h * 96 + d) = o; *(v2u*)(kf + (size_t)(m + j) * 384 + h * 96 + d) = kk[j]; }
        const float cs[4] = {c0.x, c0.z, c1.x, c1.z}, sn[4] = {c0.y, c0.w, c1.y, c1.w};
        const float a1[4] = {bflo(t1.x), bfhi(t1.x), bflo(t1.y), bfhi(t1.y)}, a2[4] = {bflo(t2.x), bfhi(t2.x), bflo(t2.y), bfhi(t2.y)};
        const float b1[4] = {bflo(u1.x), bfhi(u1.x), bflo(u1.y), bfhi(u1.y)}, b2[4] = {bflo(u2.x), bfhi(u2.x), bflo(u2.y), bfhi(u2.y)};
        float q1[4], q2[4], k1[4], k2[4];
#pragma unroll
        for (int i = 0; i < 4; ++i) { q1[i] = (a1[i] * cs[i] - a2[i] * sn[i]) * QS; q2[i] = (a2[i] * cs[i] + a1[i] * sn[i]) * QS; k1[i] = b1[i] * cs[i] - b2[i] * sn[i]; k2[i] = b2[i] * cs[i] + b1[i] * sn[i]; }
        bf16* qo = qf + (size_t)mr * 384 + ro; bf16* ko = kf + (size_t)mr * 384 + ro;
        *(v2u*)qo = (v2u){pk2(q1[0], q1[1]), pk2(q1[2], q1[3])}; *(v2u*)(qo + 8) = (v2u){pk2(q2[0], q2[1]), pk2(q2[2], q2[3])};
        *(v2u*)ko = (v2u){pk2(k1[0], k1[1]), pk2(k1[2], k1[3])}; *(v2u*)(ko + 8) = (v2u){pk2(k2[0], k2[1]), pk2(k2[2], k2[3])};
    }
}
__device__ __forceinline__ void ph_assemble(const Args& A, const Ctx& C, int l, int rep) {
    unsigned* head = (unsigned*)C.ws + CW_ASM + 64 * (8 * l + rep);
    for (;;) {
        unsigned blk = 0; if (C.lane == 0) blk = __hip_atomic_fetch_add(head, 1u, __ATOMIC_RELAXED, __HIP_MEMORY_SCOPE_AGENT);
        blk = __builtin_amdgcn_readfirstlane(blk);
        if (blk >= (unsigned)(TT / 8)) break;
        assemble_rows8(C, (int)blk * 8);
    }
}
constexpr int AT_KP = 224, AT_VP = 160, AT_KB = 64 * AT_KP  , AT_VB = 64 * AT_VP  ;
typedef short at_v4i16 __attribute__((ext_vector_type(4)));
__device__ __forceinline__ bf16x8 at_tr_frag(const LAS unsigned char* tile, int k0a, int k0b, int c0, int lane) {
    const int i = lane & 15, q = i >> 2, p = i & 3;
    const at_v4i16 lo = __builtin_amdgcn_ds_read_tr16_b64_v4i16((LAS at_v4i16*)(tile + (k0a + q) * AT_VP + (c0 + 4 * p) * 2));
    const at_v4i16 hi = __builtin_amdgcn_ds_read_tr16_b64_v4i16((LAS at_v4i16*)(tile + (k0b + q) * AT_VP + (c0 + 4 * p) * 2));
    bf16x8 r; r[0] = lo[0]; r[1] = lo[1]; r[2] = lo[2]; r[3] = lo[3]; r[4] = hi[0]; r[5] = hi[1]; r[6] = hi[2]; r[7] = hi[3]; return r;
}
__device__ __forceinline__ float xmax4(float x) {
    const auto r = __builtin_amdgcn_permlane16_swap(__float_as_uint(x), __float_as_uint(x), false, false); const float m = fmaxf(__uint_as_float(r[0]), __uint_as_float(r[1]));
    const auto q = __builtin_amdgcn_permlane32_swap(__float_as_uint(m), __float_as_uint(m), false, false); return fmaxf(__uint_as_float(q[0]), __uint_as_float(q[1]));
}
constexpr int AT_T = 128, AT_KB2 = AT_T * AT_KP  , AT_VB2 = AT_T * AT_VP  ;
#ifndef AT_PRIO
#define AT_PRIO 1
#endif
#ifndef AT_THR
#define AT_THR 8.0f
#endif
template <int VAR>
__device__ __forceinline__ void attn_unit(const Ctx& C, int b, int h, int qt) {
    const bf16* qfp = (const bf16*)(C.ws + WS_QF); const bf16* kfp = (const bf16*)(C.ws + WS_KF); const bf16* kvp = (const bf16*)(C.ws + WS_KV); bf16* mix = (bf16*)(C.ws + (VAR ? WS_H : WS_ACT1));
    LAS unsigned char* lds = C.lds;
    const int tid = C.tid, lane = C.lane, wave = C.wave, fr = lane & 15, fq = lane >> 4;
    const size_t mb = (size_t)b * SB;
    const int nkt = (qt == 0 ? CTXL : SB) / AT_T;
    const size_t mq = mb + (size_t)qt * 256 + wave * 32;
    bf16x8 qf[2][3];
#pragma unroll
    for (int qb = 0; qb < 2; ++qb)
#pragma unroll
        for (int ks = 0; ks < 3; ++ks) qf[qb][ks] = *(const bf16x8*)(qfp + (mq + qb * 16 + fr) * 384 + h * 96 + ks * 32 + fq * 8);
    f32x4 ot[2][4];
#pragma unroll
    for (int qb = 0; qb < 2; ++qb)
#pragma unroll
        for (int d = 0; d < 4; ++d) ot[qb][d] = (f32x4){0.f, 0.f, 0.f, 0.f};
    float mrun[2] = {0.f, 0.f};
    f32x4 lacc[2]; lacc[0] = (f32x4){0.f, 0.f, 0.f, 0.f}; lacc[1] = lacc[0];
    const bf16x8 ones = __builtin_bit_cast(bf16x8, ((v4u){0x3f803f80u, 0x3f803f80u, 0x3f803f80u, 0x3f803f80u}));
    const bf16* kg[3]; int kl[3];
#pragma unroll
    for (int j = 0; j < 3; ++j) { const int id = tid + 512 * j, r = id / 12, cc = id - r * 12; kg[j] = kfp + (mb + r) * 384 + h * 96 + cc * 8; kl[j] = r * AT_KP + cc * 16; }
    const bf16* vg = kvp + (mb + (tid >> 3)) * 512 + h * 128 + 64 + (tid & 7) * 8; const int vl = (tid >> 3) * AT_VP + (tid & 7) * 16;
    v4u rk[3], rv[2];
#pragma unroll
    for (int j = 0; j < 3; ++j) rk[j] = *(const v4u*)kg[j];
    rv[0] = *(const v4u*)vg; rv[1] = *(const v4u*)(vg + 64 * 512);
    __syncthreads();
    if (AT_PRIO && wave < 4) __builtin_amdgcn_s_setprio(1);
#pragma unroll
    for (int j = 0; j < 3; ++j) *(LAS v4u*)(lds + kl[j]) = rk[j];
    *(LAS v4u*)(lds + 2 * AT_KB2 + vl) = rv[0]; *(LAS v4u*)(lds + 2 * AT_KB2 + 64 * AT_VP + vl) = rv[1];
    __syncthreads();
    f32x4 saA[2][4], saB[2][4]; bf16x8 pfA[2][2], pfB[2][2];
    auto qk = [&](const LAS unsigned char* kb_, f32x4 (&sa)[2][4]) {
#pragma unroll
        for (int kb = 0; kb < 4; ++kb) {
            bf16x8 kfr[3];
#pragma unroll
            for (int ks = 0; ks < 3; ++ks) kfr[ks] = *(const LAS bf16x8*)(kb_ + (kb * 16 + fr) * AT_KP + ks * 64 + fq * 16);
#pragma unroll
            for (int qb = 0; qb < 2; ++qb) { const float nm = -mrun[qb]; f32x4 acc = (f32x4){nm, nm, nm, nm};
#pragma unroll
                for (int ks = 0; ks < 3; ++ks) acc = __builtin_amdgcn_mfma_f32_16x16x32_bf16(kfr[ks], qf[qb][ks], acc, 0, 0, 0);
                sa[qb][kb] = acc; }
        } };
    auto sm_max = [&](f32x4 (&sa)[2][4]) {
        float mxq[2];
#pragma unroll
        for (int qb = 0; qb < 2; ++qb) {
            float mx = __builtin_fmaxf(__builtin_fmaxf(sa[qb][0].x, sa[qb][0].y), sa[qb][0].z);
            mx = __builtin_fmaxf(__builtin_fmaxf(mx, sa[qb][0].w), sa[qb][1].x);
#pragma unroll
            for (int kb = 1; kb < 4; ++kb) { mx = __builtin_fmaxf(__builtin_fmaxf(mx, sa[qb][kb].y), sa[qb][kb].z); mx = kb < 3 ? __builtin_fmaxf(__builtin_fmaxf(mx, sa[qb][kb].w), sa[qb][kb + 1].x) : __builtin_fmaxf(mx, sa[qb][kb].w); }
            mxq[qb] = mx; }
        if (__any(__builtin_fmaxf(mxq[0], mxq[1]) > AT_THR)) {
#pragma unroll
            for (int qb = 0; qb < 2; ++qb) { float mx = mxq[qb];
                mx = fmaxf(mx, __shfl_xor(mx, 16)); mx = fmaxf(mx, __shfl_xor(mx, 32));
                const float delta = fmaxf(mx, 0.f), alpha = __builtin_amdgcn_exp2f(-delta); mrun[qb] += delta; lacc[qb] *= alpha;
#pragma unroll
                for (int d = 0; d < 4; ++d) ot[qb][d] *= alpha;
#pragma unroll
                for (int kb = 0; kb < 4; ++kb) sa[qb][kb] -= delta; }
        } };
    auto sm_exp = [&](const f32x4 (&sa)[2][4], bf16x8 (&pf)[2][2]) {
#pragma unroll
        for (int qb = 0; qb < 2; ++qb) { unsigned pw[8];
#pragma unroll
            for (int kb = 0; kb < 4; ++kb) { const float p0 = __builtin_amdgcn_exp2f(sa[qb][kb].x), p1 = __builtin_amdgcn_exp2f(sa[qb][kb].y), p2 = __builtin_amdgcn_exp2f(sa[qb][kb].z), p3 = __builtin_amdgcn_exp2f(sa[qb][kb].w);
                pw[kb * 2] = pk2(p0, p1); pw[kb * 2 + 1] = pk2(p2, p3); }
#pragma unroll
            for (int kk = 0; kk < 2; ++kk) { const v4u w = (v4u){pw[kk * 4], pw[kk * 4 + 1], pw[kk * 4 + 2], pw[kk * 4 + 3]}; pf[qb][kk] = __builtin_bit_cast(bf16x8, w); } } };
    auto pv = [&](const LAS unsigned char* vb_, const bf16x8 (&pf)[2][2]) {
#pragma unroll
        for (int kk = 0; kk < 2; ++kk) { lacc[0] = __builtin_amdgcn_mfma_f32_16x16x32_bf16(ones, pf[0][kk], lacc[0], 0, 0, 0); lacc[1] = __builtin_amdgcn_mfma_f32_16x16x32_bf16(ones, pf[1][kk], lacc[1], 0, 0, 0); }
#pragma unroll
        for (int d = 0; d < 4; ++d)
#pragma unroll
            for (int kk = 0; kk < 2; ++kk) {
                const bf16x8 vf = at_tr_frag(vb_, kk * 32 + 4 * fq, kk * 32 + 16 + 4 * fq, d * 16, lane);
#pragma unroll
                for (int qb = 0; qb < 2; ++qb) ot[qb][d] = __builtin_amdgcn_mfma_f32_16x16x32_bf16(vf, pf[qb][kk], ot[qb][d], 0, 0, 0);
            } };
    int vcur = 2 * AT_KB2, vnext = vcur + AT_VB2, vfree = vnext + AT_VB2;
    qk(lds, saA);
    for (int kt = 0; kt < nkt; ++kt) {
        const int cur = kt & 1; const bool more = kt + 1 < nkt;
        if (more) { const size_t ko = (size_t)(kt + 1) * AT_T;
#pragma unroll
            for (int j = 0; j < 3; ++j) rk[j] = *(const v4u*)(kg[j] + ko * 384);
            rv[0] = *(const v4u*)(vg + ko * 512); rv[1] = *(const v4u*)(vg + (ko + 64) * 512); }
        const LAS unsigned char* kb_ = lds + cur * AT_KB2;
        sm_max(saA);
        qk(kb_ + 64 * AT_KP, saB); sm_exp(saA, pfA);
        pv(lds + vcur, pfA);
        sm_max(saB);
        if (more) { const int nx = cur ^ 1;
#pragma unroll
            for (int j = 0; j < 3; ++j) *(LAS v4u*)(lds + nx * AT_KB2 + kl[j]) = rk[j];
            *(LAS v4u*)(lds + vnext + vl) = rv[0]; *(LAS v4u*)(lds + vnext + 64 * AT_VP + vl) = rv[1]; }
        __syncthreads();
        if (more) { qk(lds + (cur ^ 1) * AT_KB2, saA); sm_exp(saB, pfB); } else sm_exp(saB, pfB);
        pv(lds + vcur + 64 * AT_VP, pfB);
        { const int t = vfree; vfree = vcur; vcur = vnext; vnext = t; }
    }
    __builtin_amdgcn_s_setprio(0);
    {
        const float inv0 = 1.0f / lacc[0].x, inv1 = 1.0f / lacc[1].x;
        bf16* orow = mix + (mq + (fq & 1) * 16 + fr) * DM + 768 + h * 64 + 4 * (fq & ~1);
#pragma unroll
        for (int d = 0; d < 4; ++d) { v2u oa, ob; oa.x = pk2(ot[0][d].x * inv0, ot[0][d].y * inv0); oa.y = pk2(ot[0][d].z * inv0, ot[0][d].w * inv0); ob.x = pk2(ot[1][d].x * inv1, ot[1][d].y * inv1); ob.y = pk2(ot[1][d].z * inv1, ot[1][d].w * inv1);
            *(v4u*)(orow + d * 16) = pair16(oa, ob); }
    }
}
__device__ __forceinline__ void attn_queue(const Ctx& C, int l, int rep) {
    unsigned* head = (unsigned*)C.ws + CW_AQ + 64 * (8 * l + rep);
    const int nunits = 1024 + (l == 0 ? 64 : 0);
    for (;;) {
        __syncthreads();
        if (C.tid == 0) C.MISC[MISC_Q] = __hip_atomic_fetch_add(head, 1u, __ATOMIC_RELAXED, __HIP_MEMORY_SCOPE_AGENT);
        __syncthreads();
        const int u = (int)C.MISC[MISC_Q];
        if (u >= nunits) break;
        const int ub = u < 1024 ? u >> 6 : (u - 1024) >> 2, uh = u < 1024 ? (u >> 4) & 3 : (u - 1024) & 3, uq = u < 1024 ? 1 + (u & 15) : 0;
#ifdef ATT_VAR
        if (rep == 0) attn_unit<0>(C, ub, uh, uq); else attn_unit<ATT_VAR>(C, ub, uh, uq);
#else
        attn_unit<0>(C, ub, uh, uq);
#endif
    }
}
#ifndef XSTATE
#define XSTATE 1
#endif
#ifndef XINTRA
#define XINTRA 1
#endif
constexpr int CH = 64, NCH = SB / CH  , NCTXCH = CTXL / CH  ;
constexpr int TP = 160;
constexpr int TILE_B = 64 * TP;
typedef short v4i16_t __attribute__((ext_vector_type(4)));
__device__ __forceinline__ bf16x8 tr_frag(const LAS unsigned char* tile, int k0a, int k0b, int c0, int lane) {
#ifdef TR_SLOW
    const int col = c0 + (lane & 15); const LAS unsigned short* t = (const LAS unsigned short*)tile; bf16x8 r;
#pragma unroll
    for (int e = 0; e < 4; ++e) { r[e] = (short)t[(k0a + e) * (TP / 2) + col]; r[4 + e] = (short)t[(k0b + e) * (TP / 2) + col]; }
    return r;
#else
    const int i = lane & 15, q = i >> 2, p = i & 3;
    const v4i16_t lo = __builtin_amdgcn_ds_read_tr16_b64_v4i16((LAS v4i16_t*)(tile + (k0a + q) * TP + (c0 + 4 * p) * 2));
    const v4i16_t hi = __builtin_amdgcn_ds_read_tr16_b64_v4i16((LAS v4i16_t*)(tile + (k0b + q) * TP + (c0 + 4 * p) * 2));
    bf16x8 r; r[0] = lo[0]; r[1] = lo[1]; r[2] = lo[2]; r[3] = lo[3]; r[4] = hi[0]; r[5] = hi[1]; r[6] = hi[2]; r[7] = hi[3]; return r;
#endif
}
__device__ __forceinline__ bf16x8 tr_frag_g4(const LAS unsigned char* tile, int k0a, int k0b, int g, int lane) {
    const int i = lane & 15, q = i >> 2, p = i & 3;
    const v4i16_t lo = __builtin_amdgcn_ds_read_tr16_b64_v4i16((LAS v4i16_t*)(tile + (k0a + q) * TP + (16 * p + 4 * g) * 2));
    const v4i16_t hi = __builtin_amdgcn_ds_read_tr16_b64_v4i16((LAS v4i16_t*)(tile + (k0b + q) * TP + (16 * p + 4 * g) * 2));
    bf16x8 r; r[0] = lo[0]; r[1] = lo[1]; r[2] = lo[2]; r[3] = lo[3]; r[4] = hi[0]; r[5] = hi[1]; r[6] = hi[2]; r[7] = hi[3]; return r;
}
__device__ __forceinline__ bf16x8 row_frag(const LAS unsigned char* tile, int row, int col) { return *(const LAS bf16x8*)(tile + row * TP + col * 2); }
__device__ __forceinline__ v4u scale8(v4u x, float s) { v4u o; o.x = pk2(bflo(x.x) * s, bfhi(x.x) * s); o.y = pk2(bflo(x.y) * s, bfhi(x.y) * s); o.z = pk2(bflo(x.z) * s, bfhi(x.z) * s); o.w = pk2(bflo(x.w) * s, bfhi(x.w) * s); return o; }
__device__ __forceinline__ v4u scale8v(v4u x, f32x4 a, f32x4 b) { v4u o; o.x = pk2(bflo(x.x) * a.x, bfhi(x.x) * a.y); o.y = pk2(bflo(x.y) * a.z, bfhi(x.y) * a.w); o.z = pk2(bflo(x.z) * b.x, bfhi(x.z) * b.y); o.w = pk2(bflo(x.w) * b.z, bfhi(x.w) * b.w); return o; }
__device__ __forceinline__ f32x4 exp4(f32x4 a) { return (f32x4){__expf(a.x), __expf(a.y), __expf(a.z), __expf(a.w)}; }
constexpr size_t WS_SST = WS_ARENA + 1200 * MiB;
constexpr size_t WS_GST = WS_ARENA + 1336 * MiB;
constexpr size_t WS_SEN = WS_ARENA + 991 * MiB;
constexpr size_t WS_GEN = WS_ARENA + 1127 * MiB;
constexpr size_t WS_SDEC = WS_ARENA + 1404 * MiB;
constexpr size_t WS_GDEC = WS_ARENA + 1405 * MiB;
static_assert(WS_GDEC + 5 * MiB <= WS_ARENA + 1428 * MiB, "arena");

template <bool SSD>
__device__ __forceinline__ void chunk_cums(const Ctx& C, int l, size_t m0, int h0, int nh, LAS float* cums, const float* alog) {
    if (SSD) {
        const int w = C.wave; if (w < 2 * nh) { const int hl = w >> 1, d = w & 1, h = h0 + hl, s = d == 0 ? C.lane : 63 - C.lane;
            const float dtv = ((const float*)(C.ws + WS_DT))[(m0 + s) * 16 + d * 8 + h]; float v = dtv * -expf(alog[l * 16 + d * 8 + h]);
            v = wave_scan_incl(v);
            cums[(d * nh + hl) * 64 + s] = v; cums[((2 + d) * nh + hl) * 64 + s] = dtv; }
    } else {
        if (C.tid < 128) { const int d = C.tid >> 6, k = C.tid & 63; const float* gp = (const float*)(C.ws + WS_G) + m0 * 512 + d * 256 + h0 * 64 + k; float acc = 0.f;
#pragma unroll 16
            for (int i = 0; i < 64; ++i) { const int s = d == 0 ? i : 63 - i; acc += gp[(size_t)s * 512]; cums[d * 4096 + s * 64 + k] = acc; } }
    }
}
template <bool SSD>
__device__ __forceinline__ void chunk_s1(const Ctx& C, int l, int unit, const float* alog) {
    constexpr int NH = SSD ? 8 : 4;
    const int b = unit / (NCH * NH), rem = unit - b * (NCH * NH), c = rem / NH, h = rem - c * NH; const size_t m0 = (size_t)b * SB + c * CH;
    LAS unsigned char* VT = C.lds; LAS unsigned char* KSF = C.lds + TILE_B; LAS unsigned char* KSB = C.lds + 2 * TILE_B; LAS float* cums = (LAS float*)(C.lds + 3 * TILE_B);
    __syncthreads();
    chunk_cums<SSD>(C, l, m0, h, 1, cums, alog);
    __syncthreads();
    { const int s = C.tid >> 3, sub = C.tid & 7; const size_t m = m0 + s;
      v4u vv, kk; v4u kf, kb;
      if (SSD) { const bf16* r = (const bf16*)(C.ws + WS_XBC) + m * 768; vv = *(const v4u*)(r + h * 64 + sub * 8); kk = *(const v4u*)(r + 512 + (h >> 2) * 64 + sub * 8);
          const float wf = cums[128 + s] * __expf(cums[63] - cums[s]), wb = cums[192 + s] * __expf(cums[64] - cums[64 + s]);
          kf = scale8(kk, wf); kb = scale8(kk, wb);
      } else { const bf16* r = (const bf16*)(C.ws + WS_COLS) + m * INWP + h * 64 + sub * 8; vv = *(const v4u*)(r + C_GV); kk = *(const v4u*)(r + C_GK);
          const LAS float* cf = cums + s * 64 + sub * 8; const LAS float* cb = cums + 4096 + s * 64 + sub * 8; const LAS float* cfl = cums + 63 * 64 + sub * 8; const LAS float* cbl = cums + 4096 + sub * 8;
          kf = scale8v(kk, exp4(*(const LAS f32x4*)cfl - *(const LAS f32x4*)cf), exp4(*(const LAS f32x4*)(cfl + 4) - *(const LAS f32x4*)(cf + 4)));
          kb = scale8v(kk, exp4(*(const LAS f32x4*)cbl - *(const LAS f32x4*)cb), exp4(*(const LAS f32x4*)(cbl + 4) - *(const LAS f32x4*)(cb + 4))); }
      *(LAS v4u*)(VT + s * TP + sub * 16) = vv; *(LAS v4u*)(KSF + s * TP + sub * 16) = kf; *(LAS v4u*)(KSB + s * TP + sub * 16) = kb; }
    __syncthreads();
    { const int w = C.wave, d = w >> 2, kb_ = w & 3, lane = C.lane, fr = lane & 15, fq = lane >> 4; const LAS unsigned char* KS = d ? KSB : KSF;
      f32x4 acc[4];
#pragma unroll
      for (int vb = 0; vb < 4; ++vb) acc[vb] = (f32x4){0.f, 0.f, 0.f, 0.f};
#pragma unroll
      for (int ks = 0; ks < 2; ++ks) { const bf16x8 a = tr_frag(KS, ks * 32 + 8 * fq, ks * 32 + 8 * fq + 4, kb_ * 16, lane);
#pragma unroll
          for (int vb = 0; vb < 4; ++vb) { const bf16x8 bo = tr_frag(VT, ks * 32 + 8 * fq, ks * 32 + 8 * fq + 4, vb * 16, lane); acc[vb] = __builtin_amdgcn_mfma_f32_16x16x32_bf16(a, bo, acc[vb], 0, 0, 0); } }
      bf16* st = (bf16*)(C.ws + (SSD ? WS_SST : WS_GST)) + ((((size_t)b * NCH + c) * 2 + d) * NH + h) * 4096;
#pragma unroll
      for (int vb = 0; vb < 4; ++vb) { v2u o; o.x = pk2(acc[vb].x, acc[vb].y); o.y = pk2(acc[vb].z, acc[vb].w); *(v2u*)(st + (vb * 16 + fr) * 64 + kb_ * 16 + 4 * fq) = o; } }
    if (SSD) { if (C.tid < 2) ((float*)(C.ws + WS_SDEC))[(((size_t)b * NCH + c) * 2 + C.tid) * 8 + h] = __expf(C.tid == 0 ? cums[63] : cums[64]); }
    else { if (C.tid < 128) { const int d = C.tid >> 6, k = C.tid & 63; ((float*)(C.ws + WS_GDEC))[((((size_t)b * NCH + c) * 2 + d) * 4 + h) * 64 + k] = __expf(d == 0 ? cums[63 * 64 + k] : cums[4096 + k]); } }
}
template <bool SSD>
__device__ __forceinline__ void chunk_s2(const Ctx& C, int chain) {
    constexpr int NH = SSD ? 8 : 4;
    const int b = chain / (2 * NH), d = (chain / NH) & 1, h = chain % NH;
    const bf16* st = (const bf16*)(C.ws + (SSD ? WS_SST : WS_GST)); bf16* en = (bf16*)(C.ws + (SSD ? WS_SEN : WS_GEN)); const float* dec = (const float*)(C.ws + (SSD ? WS_SDEC : WS_GDEC));
    const int v = C.tid >> 3, k0 = (C.tid & 7) * 8;
    float run[8];
#pragma unroll
    for (int j = 0; j < 8; ++j) run[j] = 0.f;
    auto chunk_at = [&](int i) { return d == 0 ? i : (i < NCTXCH ? NCTXCH - 1 - i : NCH + NCTXCH - 1 - i); };
    v4u nxt = *(const v4u*)(st + ((((size_t)b * NCH + chunk_at(0)) * 2 + d) * NH + h) * 4096 + v * 64 + k0);
    for (int i = 0; i < NCH; ++i) {
        const int c = chunk_at(i); const size_t base = (((size_t)b * NCH + c) * 2 + d) * NH + h; bf16* p = en + base * 4096 + v * 64 + k0;
        const v4u inc = nxt; if (i + 1 < NCH) nxt = *(const v4u*)(st + ((((size_t)b * NCH + chunk_at(i + 1)) * 2 + d) * NH + h) * 4096 + v * 64 + k0);
        f32x4 d0, d1; if (SSD) { const float dd = dec[base]; d0 = (f32x4){dd, dd, dd, dd}; d1 = d0; } else { d0 = *(const f32x4*)(dec + base * 64 + k0); d1 = *(const f32x4*)(dec + base * 64 + k0 + 4); }
        v4u o; o.x = pk2(run[0], run[1]); o.y = pk2(run[2], run[3]); o.z = pk2(run[4], run[5]); o.w = pk2(run[6], run[7]); *(v4u*)p = o;
        run[0] = d0.x * run[0] + bflo(inc.x); run[1] = d0.y * run[1] + bfhi(inc.x); run[2] = d0.z * run[2] + bflo(inc.y); run[3] = d0.w * run[3] + bfhi(inc.y);
        run[4] = d1.x * run[4] + bflo(inc.z); run[5] = d1.y * run[5] + bfhi(inc.z); run[6] = d1.z * run[6] + bflo(inc.w); run[7] = d1.w * run[7] + bfhi(inc.w);
    }
}
template <bool SSD>
__device__ __forceinline__ void chunk_s2_wave(const Ctx& C, int chain) {
    constexpr int NH = SSD ? 8 : 4;
    const int b = chain / (2 * NH), d = (chain / NH) & 1, h = chain % NH, lane = C.lane;
    const bf16* st = (const bf16*)(C.ws + (SSD ? WS_SST : WS_GST)); bf16* en = (bf16*)(C.ws + (SSD ? WS_SEN : WS_GEN)); const float* dec = (const float*)(C.ws + (SSD ? WS_SDEC : WS_GDEC));
    const int k0 = (lane & 7) * 8;
    float run[64];
#pragma unroll
    for (int e = 0; e < 64; ++e) run[e] = 0.f;
    auto chunk_at = [&](int i) { return d == 0 ? i : (i < NCTXCH ? NCTXCH - 1 - i : NCH + NCTXCH - 1 - i); };
    auto base_at = [&](int i) { return (((size_t)b * NCH + chunk_at(i)) * 2 + d) * NH + h; };
    v4u q0[8], q1[8], q2[8]; f32x4 a0, b0, a1, b1, a2, b2;
    auto ld = [&](int i, v4u (&q)[8], f32x4& da, f32x4& db) { const size_t base = base_at(i);
#pragma unroll
        for (int j = 0; j < 8; ++j) q[j] = *(const v4u*)(st + base * 4096 + j * 512 + lane * 8);
        if (SSD) { const float dd = dec[base]; da = (f32x4){dd, dd, dd, dd}; db = da; } else { da = *(const f32x4*)(dec + base * 64 + k0); db = *(const f32x4*)(dec + base * 64 + k0 + 4); } };
    auto step = [&](int i, const v4u (&inc)[8], const f32x4& d0, const f32x4& d1, v4u (&pq)[8], f32x4& pa, f32x4& pb) {
        if (i + 2 < NCH) ld(i + 2, pq, pa, pb);
        bf16* p = en + base_at(i) * 4096 + lane * 8;
#pragma unroll
        for (int j = 0; j < 8; ++j) { float* r = run + j * 8;
            v4u o; o.x = pk2(r[0], r[1]); o.y = pk2(r[2], r[3]); o.z = pk2(r[4], r[5]); o.w = pk2(r[6], r[7]); *(v4u*)(p + j * 512) = o;
            r[0] = d0.x * r[0] + bflo(inc[j].x); r[1] = d0.y * r[1] + bfhi(inc[j].x); r[2] = d0.z * r[2] + bflo(inc[j].y); r[3] = d0.w * r[3] + bfhi(inc[j].y);
            r[4] = d1.x * r[4] + bflo(inc[j].z); r[5] = d1.y * r[5] + bfhi(inc[j].z); r[6] = d1.z * r[6] + bflo(inc[j].w); r[7] = d1.w * r[7] + bfhi(inc[j].w); } };
    ld(0, q0, a0, b0); ld(1, q1, a1, b1);
    for (int i = 0; i < NCH; i += 3) {
        step(i, q0, a0, b0, q2, a2, b2);
        if (i + 1 < NCH) step(i + 1, q1, a1, b1, q0, a0, b0);
        if (i + 2 < NCH) step(i + 2, q2, a2, b2, q1, a1, b1);
    }
}
template <bool SSD>
__device__ __forceinline__ void chunk_s2_slice(const Ctx& C, int chain, int sl) {
    constexpr int NH = SSD ? 8 : 4;
    static_assert(NCH % 4 == 0, "ring of four");
    const int b = chain / (2 * NH), d = (chain / NH) & 1, h = chain % NH, lane = C.lane;
    const bf16* st = (const bf16*)(C.ws + (SSD ? WS_SST : WS_GST)) + sl * 1024 + lane * 8; bf16* en = (bf16*)(C.ws + (SSD ? WS_SEN : WS_GEN)) + sl * 1024 + lane * 8; const float* dec = (const float*)(C.ws + (SSD ? WS_SDEC : WS_GDEC));
    const int k0 = (lane & 7) * 8;
    float run[16];
#pragma unroll
    for (int e = 0; e < 16; ++e) run[e] = 0.f;
    auto chunk_at = [&](int i) { return d == 0 ? i : (i < NCTXCH ? NCTXCH - 1 - i : NCH + NCTXCH - 1 - i); };
    auto base_at = [&](int i) { return (((size_t)b * NCH + chunk_at(i)) * 2 + d) * NH + h; };
    v4u q0[2], q1[2], q2[2], q3[2]; f32x4 a0, b0, a1, b1, a2, b2, a3, b3;
    auto ld = [&](int i, v4u (&q)[2], f32x4& da, f32x4& db) { const size_t base = base_at(i);
        q[0] = *(const v4u*)(st + base * 4096); q[1] = *(const v4u*)(st + base * 4096 + 512);
        if (SSD) { const float dd = dec[base]; da = (f32x4){dd, dd, dd, dd}; db = da; } else { da = *(const f32x4*)(dec + base * 64 + k0); db = *(const f32x4*)(dec + base * 64 + k0 + 4); } };
    auto step = [&](int i, const v4u (&inc)[2], const f32x4& d0, const f32x4& d1, v4u (&pq)[2], f32x4& pa, f32x4& pb) {
        if (i + 3 < NCH) ld(i + 3, pq, pa, pb);
        bf16* p = en + base_at(i) * 4096;
#pragma unroll
        for (int j = 0; j < 2; ++j) { float* r = run + j * 8;
            v4u o; o.x = pk2(r[0], r[1]); o.y = pk2(r[2], r[3]); o.z = pk2(r[4], r[5]); o.w = pk2(r[6], r[7]); *(v4u*)(p + j * 512) = o;
            r[0] = d0.x * r[0] + bflo(inc[j].x); r[1] = d0.y * r[1] + bfhi(inc[j].x); r[2] = d0.z * r[2] + bflo(inc[j].y); r[3] = d0.w * r[3] + bfhi(inc[j].y);
            r[4] = d1.x * r[4] + bflo(inc[j].z); r[5] = d1.y * r[5] + bfhi(inc[j].z); r[6] = d1.z * r[6] + bflo(inc[j].w); r[7] = d1.w * r[7] + bfhi(inc[j].w); } };
    ld(0, q0, a0, b0); ld(1, q1, a1, b1); ld(2, q2, a2, b2);
    for (int i = 0; i < NCH; i += 4) {
        step(i, q0, a0, b0, q3, a3, b3);
        step(i + 1, q1, a1, b1, q0, a0, b0);
        step(i + 2, q2, a2, b2, q1, a1, b1);
        step(i + 3, q3, a3, b3, q2, a2, b2);
    }
}
__device__ __forceinline__ bf16x8 pack_p(f32x4 a, f32x4 b) { const v4u w = (v4u){pk2(a.x, a.y), pk2(a.z, a.w), pk2(b.x, b.y), pk2(b.z, b.w)}; return __builtin_bit_cast(bf16x8, w); }
__device__ __forceinline__ void ssd_s3(const Ctx& C, int l, int unit, const float* alog, const float* dskip, const float* normw) {
    const int b = unit / (NCH * 2), rem = unit - b * (NCH * 2), c = rem >> 1, g = rem & 1; const size_t m0 = (size_t)b * SB + c * CH;
    LAS unsigned char* XT = C.lds;
    LAS unsigned char* KR = C.lds + 4 * TILE_B; LAS unsigned char* QR = C.lds + 5 * TILE_B;
    LAS float* cums = (LAS float*)(C.lds + 6 * TILE_B);
    LAS float* ssx = cums + 1024;
    __syncthreads();
    chunk_cums<true>(C, l, m0, g * 4, 4, cums, alog);
    { const int s = C.tid >> 3, sub = C.tid & 7; const bf16* r = (const bf16*)(C.ws + WS_XBC) + (m0 + s) * 768;
#pragma unroll
      for (int hl = 0; hl < 4; ++hl) *(LAS v4u*)(XT + hl * TILE_B + s * TP + sub * 16) = *(const v4u*)(r + (g * 4 + hl) * 64 + sub * 8);
      *(LAS v4u*)(KR + s * TP + sub * 16) = *(const v4u*)(r + 512 + g * 64 + sub * 8); *(LAS v4u*)(QR + s * TP + sub * 16) = *(const v4u*)(r + 640 + g * 64 + sub * 8); }
    const int w = C.wave, hl = w >> 1, lh = w & 1, h = g * 4 + hl, lane = C.lane, fr = lane & 15, fq = lane >> 4;
    bf16x8 hst[2][4][2];
    { const bf16* stb = (const bf16*)(C.ws + WS_SEN) + (((size_t)b * NCH + c) * 2 * 8 + h) * 4096;
#pragma unroll
      for (int d = 0; d < 2; ++d)
#pragma unroll
          for (int vb = 0; vb < 4; ++vb)
#pragma unroll
              for (int ks = 0; ks < 2; ++ks) hst[d][vb][ks] = *(const bf16x8*)(stb + (size_t)d * 8 * 4096 + (vb * 16 + fr) * 64 + ks * 32 + fq * 8);
 }
    __syncthreads();
    const LAS float* cf = cums + hl * 64; const LAS float* cb = cums + 256 + hl * 64; const LAS float* df = cums + 512 + hl * 64; const LAS float* db = cums + 768 + hl * 64;
    const LAS unsigned char* VT = XT + hl * TILE_B;
    bf16x8 cq[2][2];
#pragma unroll
    for (int lb = 0; lb < 2; ++lb)
#pragma unroll
        for (int ks = 0; ks < 2; ++ks) cq[lb][ks] = row_frag(QR, (2 * lh + lb) * 16 + fr, ks * 32 + fq * 8);
    f32x4 ao[2][4];
#pragma unroll
    for (int lb = 0; lb < 2; ++lb)
#pragma unroll
        for (int vb = 0; vb < 4; ++vb) ao[lb][vb] = (f32x4){0.f, 0.f, 0.f, 0.f};
    if (XINTRA) {
        f32x4 ap[2][4];
#pragma unroll
        for (int sb = 0; sb < 4; ++sb) { const bf16x8 k0f = row_frag(KR, sb * 16 + fr, fq * 8), k1f = row_frag(KR, sb * 16 + fr, 32 + fq * 8);
#pragma unroll
            for (int lb = 0; lb < 2; ++lb) { f32x4 a = (f32x4){0.f, 0.f, 0.f, 0.f}; a = __builtin_amdgcn_mfma_f32_16x16x32_bf16(k0f, cq[lb][0], a, 0, 0, 0); a = __builtin_amdgcn_mfma_f32_16x16x32_bf16(k1f, cq[lb][1], a, 0, 0, 0); ap[lb][sb] = a; } }
#pragma unroll
        for (int lb = 0; lb < 2; ++lb) { const int lrow = (2 * lh + lb) * 16 + fr; const float cfl = cf[lrow], cbl = cb[lrow];
#pragma unroll
            for (int sb = 0; sb < 4; ++sb) { const int s0 = sb * 16 + 4 * fq; const f32x4 cfs = *(const LAS f32x4*)(cf + s0), cbs = *(const LAS f32x4*)(cb + s0), dfs = *(const LAS f32x4*)(df + s0), dbs = *(const LAS f32x4*)(db + s0);
                f32x4 m;
                m.x = (s0 + 0 <= lrow ? dfs.x * __expf(fminf(cfl - cfs.x, 0.f)) : 0.f) + (s0 + 0 >= lrow ? dbs.x * __expf(fminf(cbl - cbs.x, 0.f)) : 0.f);
                m.y = (s0 + 1 <= lrow ? dfs.y * __expf(fminf(cfl - cfs.y, 0.f)) : 0.f) + (s0 + 1 >= lrow ? dbs.y * __expf(fminf(cbl - cbs.y, 0.f)) : 0.f);
                m.z = (s0 + 2 <= lrow ? dfs.z * __expf(fminf(cfl - cfs.z, 0.f)) : 0.f) + (s0 + 2 >= lrow ? dbs.z * __expf(fminf(cbl - cbs.z, 0.f)) : 0.f);
                m.w = (s0 + 3 <= lrow ? dfs.w * __expf(fminf(cfl - cfs.w, 0.f)) : 0.f) + (s0 + 3 >= lrow ? dbs.w * __expf(fminf(cbl - cbs.w, 0.f)) : 0.f);
                ap[lb][sb] *= m; } }
#pragma unroll
        for (int kk = 0; kk < 2; ++kk) { bf16x8 pf[2]; pf[0] = pack_p(ap[0][2 * kk], ap[0][2 * kk + 1]); pf[1] = pack_p(ap[1][2 * kk], ap[1][2 * kk + 1]);
#pragma unroll
            for (int vb = 0; vb < 4; ++vb) { const bf16x8 xa = tr_frag(VT, kk * 32 + 4 * fq, kk * 32 + 16 + 4 * fq, vb * 16, lane);
                ao[0][vb] = __builtin_amdgcn_mfma_f32_16x16x32_bf16(xa, pf[0], ao[0][vb], 0, 0, 0); ao[1][vb] = __builtin_amdgcn_mfma_f32_16x16x32_bf16(xa, pf[1], ao[1][vb], 0, 0, 0); } }
    }
    v2u zz_[2][4];
    { const bf16* colz = (const bf16*)(C.ws + WS_COLS);
#pragma unroll
      for (int lb = 0; lb < 2; ++lb)
#pragma unroll
          for (int vb = 0; vb < 4; ++vb) zz_[lb][vb] = *(const v2u*)(colz + (m0 + (2 * lh + lb) * 16 + fr) * INWP + C_Z + h * 64 + vb * 16 + 4 * fq); }
    if (XSTATE) {
#pragma unroll
        for (int d = 0; d < 2; ++d) { bf16x8 cs[2][2];
#pragma unroll
            for (int lb = 0; lb < 2; ++lb) { const int lrow = (2 * lh + lb) * 16 + fr; const float e = __expf(d == 0 ? cf[lrow] : cb[lrow]);
#pragma unroll
                for (int ks = 0; ks < 2; ++ks) cs[lb][ks] = __builtin_bit_cast(bf16x8, scale8(__builtin_bit_cast(v4u, cq[lb][ks]), e)); }
#pragma unroll
            for (int vb = 0; vb < 4; ++vb)
#pragma unroll
                for (int ks = 0; ks < 2; ++ks) { const bf16x8 ha = hst[d][vb][ks];
                    ao[0][vb] = __builtin_amdgcn_mfma_f32_16x16x32_bf16(ha, cs[0][ks], ao[0][vb], 0, 0, 0); ao[1][vb] = __builtin_amdgcn_mfma_f32_16x16x32_bf16(ha, cs[1][ks], ao[1][vb], 0, 0, 0); } }
    }
    const float dsk = dskip[l * 8 + h]; const bf16* cols = (const bf16*)(C.ws + WS_COLS);
    float ssl[2];
#pragma unroll
    for (int lb = 0; lb < 2; ++lb) { const int lrow = (2 * lh + lb) * 16 + fr; float ss = 0.f;
#pragma unroll
        for (int vb = 0; vb < 4; ++vb) { const int p0 = vb * 16 + 4 * fq; const v2u xx = *(const LAS v2u*)(VT + lrow * TP + p0 * 2); const v2u zz = zz_[lb][vb];
            f32x4 y = ao[lb][vb]; y.x = (y.x + dsk * bflo(xx.x)) * fsilu(bflo(zz.x)); y.y = (y.y + dsk * bfhi(xx.x)) * fsilu(bfhi(zz.x)); y.z = (y.z + dsk * bflo(xx.y)) * fsilu(bflo(zz.y)); y.w = (y.w + dsk * bfhi(xx.y)) * fsilu(bfhi(zz.y));
            ao[lb][vb] = y; ss += (y.x * y.x + y.y * y.y) + (y.z * y.z + y.w * y.w); }
        ss = sum_x16_x32(ss); ssl[lb] = ss; if (fq == 0) ssx[hl * 64 + lrow] = ss; }
    __syncthreads();
    bf16* mix = (bf16*)(C.ws + WS_ACT1);
    float rstd2[2];
#pragma unroll
    for (int lb = 0; lb < 2; ++lb) { const int lrow = (2 * lh + lb) * 16 + fr; const float tot = (ssx[lrow] + ssx[64 + lrow]) + (ssx[128 + lrow] + ssx[192 + lrow]); rstd2[lb] = rsqrtf(tot * (1.0f / 256.0f) + EPS); }
#pragma unroll
    for (int vb = 0; vb < 4; ++vb) { const int p0 = vb * 16 + 4 * fq; const f32x4 nw = *(const f32x4*)(normw + l * 512 + h * 64 + p0); v2u o[2];
#pragma unroll
        for (int lb = 0; lb < 2; ++lb) { const f32x4 y = ao[lb][vb]; const float rstd = rstd2[lb]; o[lb].x = pk2(y.x * rstd * nw.x, y.y * rstd * nw.y); o[lb].y = pk2(y.z * rstd * nw.z, y.w * rstd * nw.w); }
        *(v4u*)(mix + (m0 + (2 * lh + (fq & 1)) * 16 + fr) * DM + h * 64 + vb * 16 + 4 * (fq & ~1)) = pair16(o[0], o[1]); }
}
__device__ __forceinline__ void gla_s3(const Ctx& C, int l, int unit, const float* normw) {
    const int b = unit / (NCH * 4), rem = unit - b * (NCH * 4), c = rem >> 2, h = rem & 3; const size_t m0 = (size_t)b * SB + c * CH;
    LAS unsigned char* VT = C.lds; LAS unsigned char* KIF = C.lds + TILE_B; LAS unsigned char* KIB = C.lds + 2 * TILE_B; LAS unsigned char* QSF = C.lds + 3 * TILE_B; LAS unsigned char* QSB = C.lds + 4 * TILE_B;
    LAS float* cums = (LAS float*)(C.lds + 5 * TILE_B);
    LAS float* ssx = cums + 8192;
    __syncthreads();
    chunk_cums<false>(C, l, m0, h, 1, cums, nullptr);
    __syncthreads();
    { const int s = C.tid >> 3, sub = C.tid & 7; const bf16* r = (const bf16*)(C.ws + WS_COLS) + (m0 + s) * INWP + h * 64 + sub * 8;
      const v4u vv = *(const v4u*)(r + C_GV), kk = *(const v4u*)(r + C_GK), qq = scale8(*(const v4u*)(r + C_GQ), 0.125f);
      const LAS float* cf = cums + s * 64 + sub * 8; const LAS float* cb = cums + 4096 + s * 64 + sub * 8;
      const f32x4 f0 = *(const LAS f32x4*)cf, f1 = *(const LAS f32x4*)(cf + 4), b0 = *(const LAS f32x4*)cb, b1 = *(const LAS f32x4*)(cb + 4);
      *(LAS v4u*)(VT + s * TP + sub * 16) = vv;
      *(LAS v4u*)(KIF + s * TP + sub * 16) = scale8v(kk, exp4(-f0), exp4(-f1)); *(LAS v4u*)(KIB + s * TP + sub * 16) = scale8v(kk, exp4(-b0), exp4(-b1));
      *(LAS v4u*)(QSF + s * TP + sub * 16) = scale8v(qq, exp4(f0), exp4(f1)); *(LAS v4u*)(QSB + s * TP + sub * 16) = scale8v(qq, exp4(b0), exp4(b1)); }
    __syncthreads();
    const int w = C.wave, lb = w & 3, vh = w >> 2, lane = C.lane, fr = lane & 15, fq = lane >> 4; const int lrow = lb * 16 + fr;
    bf16x8 qf[2][2];
#pragma unroll
    for (int ks = 0; ks < 2; ++ks) { qf[0][ks] = row_frag(QSF, lrow, ks * 32 + fq * 8); qf[1][ks] = row_frag(QSB, lrow, ks * 32 + fq * 8); }
    f32x4 ao[2];
    ao[0] = (f32x4){0.f, 0.f, 0.f, 0.f}; ao[1] = ao[0];
    {   f32x4 ap[4];
#pragma unroll
        for (int sb = 0; sb < 4; ++sb) { f32x4 af = (f32x4){0.f, 0.f, 0.f, 0.f}, ab = af;
#pragma unroll
            for (int ks = 0; ks < 2; ++ks) { af = __builtin_amdgcn_mfma_f32_16x16x32_bf16(row_frag(KIF, sb * 16 + fr, ks * 32 + fq * 8), qf[0][ks], af, 0, 0, 0); ab = __builtin_amdgcn_mfma_f32_16x16x32_bf16(row_frag(KIB, sb * 16 + fr, ks * 32 + fq * 8), qf[1][ks], ab, 0, 0, 0); }
            const int s0 = sb * 16 + 4 * fq; f32x4 m;
            m.x = (s0 + 0 <= lrow ? af.x : 0.f) + (s0 + 0 >= lrow ? ab.x : 0.f); m.y = (s0 + 1 <= lrow ? af.y : 0.f) + (s0 + 1 >= lrow ? ab.y : 0.f);
            m.z = (s0 + 2 <= lrow ? af.z : 0.f) + (s0 + 2 >= lrow ? ab.z : 0.f); m.w = (s0 + 3 <= lrow ? af.w : 0.f) + (s0 + 3 >= lrow ? ab.w : 0.f);
            ap[sb] = m; }
#pragma unroll
        for (int kk = 0; kk < 2; ++kk) { const bf16x8 pf = pack_p(ap[2 * kk], ap[2 * kk + 1]);
#pragma unroll
            for (int vi = 0; vi < 2; ++vi) ao[vi] = __builtin_amdgcn_mfma_f32_16x16x32_bf16(tr_frag(VT, kk * 32 + 4 * fq, kk * 32 + 16 + 4 * fq, (2 * vh + vi) * 16, lane), pf, ao[vi], 0, 0, 0); }
    }
    {   const bf16* stb = (const bf16*)(C.ws + WS_GEN) + (((size_t)b * NCH + c) * 2 * 4 + h) * 4096;
#pragma unroll
        for (int d = 0; d < 2; ++d) { const bf16* sp = stb + (size_t)d * 4 * 4096;
#pragma unroll
            for (int vi = 0; vi < 2; ++vi)
#pragma unroll
                for (int ks = 0; ks < 2; ++ks) ao[vi] = __builtin_amdgcn_mfma_f32_16x16x32_bf16(*(const bf16x8*)(sp + ((2 * vh + vi) * 16 + fr) * 64 + ks * 32 + fq * 8), qf[d][ks], ao[vi], 0, 0, 0); } }
    float ss = 0.f;
#pragma unroll
    for (int vi = 0; vi < 2; ++vi) ss += (ao[vi].x * ao[vi].x + ao[vi].y * ao[vi].y) + (ao[vi].z * ao[vi].z + ao[vi].w * ao[vi].w);
    ss += __shfl_xor(ss, 16); ss += __shfl_xor(ss, 32); if (fq == 0) ssx[vh * 64 + lrow] = ss;
    __syncthreads();
    const float rstd = rsqrtf((ssx[lrow] + ssx[64 + lrow]) * (1.0f / 64.0f) + EPS);
    const bf16* cols = (const bf16*)(C.ws + WS_COLS); bf16* mix = (bf16*)(C.ws + WS_ACT1);
#pragma unroll
    for (int vi = 0; vi < 2; ++vi) { const int v0 = (2 * vh + vi) * 16 + 4 * fq; const f32x4 nw = *(const f32x4*)(normw + l * 64 + v0); const v2u rr = *(const v2u*)(cols + (m0 + lrow) * INWP + C_GR + h * 64 + v0);
        v2u o; o.x = pk2(ao[vi].x * rstd * nw.x * fsilu(bflo(rr.x)), ao[vi].y * rstd * nw.y * fsilu(bfhi(rr.x))); o.y = pk2(ao[vi].z * rstd * nw.z * fsilu(bflo(rr.y)), ao[vi].w * rstd * nw.w * fsilu(bfhi(rr.y)));
        *(v2u*)(mix + (m0 + lrow) * DM + 512 + h * 64 + v0) = o; }
}


__device__ __forceinline__ void ssd_s1_bc(const Ctx& C, int l, int unit, const float* alog) {
    const int b = unit / NCH, c = unit - b * NCH; const size_t m0 = (size_t)b * SB + c * CH;
    LAS unsigned char* XT = C.lds; LAS unsigned char* BT = C.lds + 8 * TILE_B; LAS float* wtab = (LAS float*)(C.lds + 10 * TILE_B);
    const int w = C.wave, lane = C.lane, fr = lane & 15, fq = lane >> 4;
    __syncthreads();
#pragma unroll
    for (int d = 0; d < 2; ++d) { const int s = d == 0 ? lane : 63 - lane;
        const float dtv = ((const float*)(C.ws + WS_DT))[(m0 + s) * 16 + d * 8 + w]; float v = dtv * -expf(alog[l * 16 + d * 8 + w]);
        v = wave_scan_incl(v);
        const float tot = __int_as_float(__builtin_amdgcn_readlane(__float_as_int(v), 63));
        wtab[(d * 8 + w) * 64 + s] = dtv * __expf(tot - v);
        if (lane == 63) ((float*)(C.ws + WS_SDEC))[(((size_t)b * NCH + c) * 2 + d) * 8 + w] = __expf(tot); }
    { const int s = C.tid >> 3, sub = C.tid & 7; const bf16* r = (const bf16*)(C.ws + WS_XBC) + (m0 + s) * 768;
#pragma unroll
      for (int hl = 0; hl < 8; ++hl) *(LAS v4u*)(XT + hl * TILE_B + s * TP + sub * 16) = *(const v4u*)(r + hl * 64 + sub * 8);
      *(LAS v4u*)(BT + s * TP + sub * 16) = *(const v4u*)(r + 512 + sub * 8); *(LAS v4u*)(BT + TILE_B + s * TP + sub * 16) = *(const v4u*)(r + 576 + sub * 8); }
    __syncthreads();
    const LAS unsigned char* XH = XT + w * TILE_B; const LAS unsigned char* BG = BT + (w >> 2) * TILE_B;
    bf16x8 bo[4][2];
#pragma unroll
    for (int pb = 0; pb < 4; ++pb)
#pragma unroll
        for (int ks = 0; ks < 2; ++ks) bo[pb][ks] = tr_frag(XH, ks * 32 + 8 * fq, ks * 32 + 8 * fq + 4, pb * 16, lane);
#pragma unroll 1
    for (int d = 0; d < 2; ++d) {
        f32x4 acc[4][4];
#pragma unroll
        for (int nb = 0; nb < 4; ++nb)
#pragma unroll
            for (int pb = 0; pb < 4; ++pb) acc[nb][pb] = (f32x4){0.f, 0.f, 0.f, 0.f};
#pragma unroll
        for (int ks = 0; ks < 2; ++ks) { const LAS float* wp = wtab + (d * 8 + w) * 64 + ks * 32 + 8 * fq; const f32x4 w0 = *(const LAS f32x4*)wp, w1 = *(const LAS f32x4*)(wp + 4);
#pragma unroll
            for (int nb = 0; nb < 4; ++nb) { const bf16x8 a = __builtin_bit_cast(bf16x8, scale8v(__builtin_bit_cast(v4u, tr_frag_g4(BG, ks * 32 + 8 * fq, ks * 32 + 8 * fq + 4, nb, lane)), w0, w1));
#pragma unroll
                for (int pb = 0; pb < 4; ++pb) acc[nb][pb] = __builtin_amdgcn_mfma_f32_16x16x32_bf16(a, bo[pb][ks], acc[nb][pb], 0, 0, 0); } }
        bf16* st = (bf16*)(C.ws + WS_SST) + ((((size_t)b * NCH + c) * 2 + d) * 8 + w) * 4096;
#pragma unroll
        for (int pb = 0; pb < 4; ++pb) { v4u o0, o1; o0.x = pk2(acc[0][pb].x, acc[0][pb].y); o0.y = pk2(acc[0][pb].z, acc[0][pb].w); o0.z = pk2(acc[1][pb].x, acc[1][pb].y); o0.w = pk2(acc[1][pb].z, acc[1][pb].w);
            o1.x = pk2(acc[2][pb].x, acc[2][pb].y); o1.y = pk2(acc[2][pb].z, acc[2][pb].w); o1.z = pk2(acc[3][pb].x, acc[3][pb].y); o1.w = pk2(acc[3][pb].z, acc[3][pb].w);
            bf16* rp = st + (pb * 16 + fr) * 64 + 16 * fq; *(v4u*)rp = o0; *(v4u*)(rp + 8) = o1; }
    }
}
constexpr size_t WS_GC0 = WS_H + ((size_t)136 << 20), WS_GC1 = WS_H + ((size_t)170 << 20);
__device__ __forceinline__ void gla_s1_pair(const Ctx& C, int l, int unit) {
    const int b = unit / (NCH * 2), rem = unit - b * (NCH * 2), c = rem >> 1, hp = rem & 1; const size_t m0 = (size_t)b * SB + c * CH;
    LAS unsigned char* VT = C.lds; LAS unsigned char* KS = C.lds + 2 * TILE_B; LAS float* GS = (LAS float*)(C.lds + 6 * TILE_B);
    const int w = C.wave, lane = C.lane, fr = lane & 15, fq = lane >> 4;
    const int s = C.tid >> 3, sub = C.tid & 7; const size_t m = m0 + s;
    __syncthreads();
    v4u kk[2];
    { const bf16* gr = (const bf16*)(C.ws + WS_G) + m * 512 + hp * 128 + sub * 8; const bf16* cr = (const bf16*)(C.ws + WS_COLS) + m * INWP + hp * 128 + sub * 8;
#pragma unroll
      for (int hd = 0; hd < 4; ++hd) { const int hl = hd >> 1, d = hd & 1; const v4u g = *(const v4u*)(gr + d * 256 + hl * 64); *(LAS f32x4*)(GS + hd * 4096 + s * 64 + sub * 8) = (f32x4){bflo(g.x), bfhi(g.x), bflo(g.y), bfhi(g.y)}; *(LAS f32x4*)(GS + hd * 4096 + s * 64 + sub * 8 + 4) = (f32x4){bflo(g.z), bfhi(g.z), bflo(g.w), bfhi(g.w)}; }
#pragma unroll
      for (int hl = 0; hl < 2; ++hl) { kk[hl] = *(const v4u*)(cr + C_GK + hl * 64); *(LAS v4u*)(VT + hl * TILE_B + s * TP + sub * 16) = *(const v4u*)(cr + C_GV + hl * 64); } }
    __syncthreads();
    if (C.tid < 256) { const int hd = C.tid >> 6, hl = hd >> 1, d = hd & 1, k = C.tid & 63, h = hp * 2 + hl; LAS float* col = GS + hd * 4096 + k; float r = 0.f;
#pragma unroll 8
        for (int i = 0; i < 64; ++i) { const int ss = d == 0 ? i : 63 - i; r += col[ss * 64]; col[ss * 64] = r; }
        ((float*)(C.ws + WS_GDEC))[((((size_t)b * NCH + c) * 2 + d) * 4 + h) * 64 + k] = __expf(r); }
    __syncthreads();
#pragma unroll
    for (int hd = 0; hd < 4; ++hd) { const int hl = hd >> 1, d = hd & 1; const LAS float* cs = GS + hd * 4096 + s * 64 + sub * 8; const LAS float* cl = GS + hd * 4096 + (d == 0 ? 63 : 0) * 64 + sub * 8;
        const f32x4 c0 = *(const LAS f32x4*)cs, c1 = *(const LAS f32x4*)(cs + 4);
        *(v4u*)((bf16*)(C.ws + (d ? WS_GC1 : WS_GC0)) + m * 256 + (hp * 2 + hl) * 64 + sub * 8) = (v4u){pk2(c0.x, c0.y), pk2(c0.z, c0.w), pk2(c1.x, c1.y), pk2(c1.z, c1.w)};
        *(LAS v4u*)(KS + hd * TILE_B + s * TP + sub * 16) = scale8v(kk[hl], exp4(*(const LAS f32x4*)cl - c0), exp4(*(const LAS f32x4*)(cl + 4) - c1)); }
    __syncthreads();
    const int hd = w >> 1, half = w & 1, hl = hd >> 1, d = hd & 1, h = hp * 2 + hl; const LAS unsigned char* KH = KS + hd * TILE_B; const LAS unsigned char* VH = VT + hl * TILE_B;
    f32x4 acc[2][4];
#pragma unroll
    for (int kb = 0; kb < 2; ++kb)
#pragma unroll
        for (int vb = 0; vb < 4; ++vb) acc[kb][vb] = (f32x4){0.f, 0.f, 0.f, 0.f};
#pragma unroll
    for (int ks = 0; ks < 2; ++ks) { bf16x8 bo[4];
#pragma unroll
        for (int vb = 0; vb < 4; ++vb) bo[vb] = tr_frag(VH, ks * 32 + 8 * fq, ks * 32 + 8 * fq + 4, vb * 16, lane);
#pragma unroll
        for (int kb = 0; kb < 2; ++kb) { const bf16x8 a = tr_frag(KH, ks * 32 + 8 * fq, ks * 32 + 8 * fq + 4, (2 * half + kb) * 16, lane);
#pragma unroll
            for (int vb = 0; vb < 4; ++vb) acc[kb][vb] = __builtin_amdgcn_mfma_f32_16x16x32_bf16(a, bo[vb], acc[kb][vb], 0, 0, 0); } }
    bf16* st = (bf16*)(C.ws + WS_GST) + ((((size_t)b * NCH + c) * 2 + d) * 4 + h) * 4096;
#pragma unroll
    for (int kb = 0; kb < 2; ++kb)
#pragma unroll
        for (int vp = 0; vp < 2; ++vp) { v2u oa, ob; oa.x = pk2(acc[kb][2 * vp].x, acc[kb][2 * vp].y); oa.y = pk2(acc[kb][2 * vp].z, acc[kb][2 * vp].w); ob.x = pk2(acc[kb][2 * vp + 1].x, acc[kb][2 * vp + 1].y); ob.y = pk2(acc[kb][2 * vp + 1].z, acc[kb][2 * vp + 1].w);
            *(v4u*)(st + ((2 * vp + (fq & 1)) * 16 + fr) * 64 + (2 * half + kb) * 16 + 4 * (fq & ~1)) = pair16(oa, ob); }
}
__device__ __forceinline__ void gla_s3_pair(const Ctx& C, int l, int unit, const float* normw) {
    const int b = unit / (NCH * 2), rem = unit - b * (NCH * 2), c = rem >> 1, hp = rem & 1; const size_t m0 = (size_t)b * SB + c * CH;
    LAS unsigned char* VT = C.lds; LAS unsigned char* QS = C.lds + 2 * TILE_B; LAS unsigned char* KI = C.lds + 6 * TILE_B;
    const int w = C.wave, lane = C.lane, fr = lane & 15, fq = lane >> 4;
    __syncthreads();
    { const int s = C.tid >> 3, sub = C.tid & 7; const size_t m = m0 + s; const bf16* cr = (const bf16*)(C.ws + WS_COLS) + m * INWP + hp * 128 + sub * 8; const bf16* gc0 = (const bf16*)(C.ws + WS_GC0) + m * 256 + hp * 128 + sub * 8; const bf16* gc1 = (const bf16*)(C.ws + WS_GC1) + m * 256 + hp * 128 + sub * 8;
#pragma unroll
      for (int hl = 0; hl < 2; ++hl) { const v4u q8 = scale8(*(const v4u*)(cr + C_GQ + hl * 64), 0.125f), k8 = *(const v4u*)(cr + C_GK + hl * 64);
          *(LAS v4u*)(VT + hl * TILE_B + s * TP + sub * 16) = *(const v4u*)(cr + C_GV + hl * 64);
#pragma unroll
          for (int d = 0; d < 2; ++d) { const v4u cw = *(const v4u*)((d ? gc1 : gc0) + hl * 64); const f32x4 c0 = (f32x4){bflo(cw.x), bfhi(cw.x), bflo(cw.y), bfhi(cw.y)}, c1 = (f32x4){bflo(cw.z), bfhi(cw.z), bflo(cw.w), bfhi(cw.w)};
              *(LAS v4u*)(QS + (hl * 2 + d) * TILE_B + s * TP + sub * 16) = scale8v(q8, exp4(c0), exp4(c1)); *(LAS v4u*)(KI + (hl * 2 + d) * TILE_B + s * TP + sub * 16) = scale8v(k8, exp4(-c0), exp4(-c1)); } } }
    const int hl = w >> 2, lb = w & 3, h = hp * 2 + hl, lrow = lb * 16 + fr;
    bf16x8 hst[2][4][2]; v2u rr_[4];
    { const bf16* stb = (const bf16*)(C.ws + WS_GEN) + (((size_t)b * NCH + c) * 2 * 4 + h) * 4096;
#pragma unroll
      for (int d = 0; d < 2; ++d)
#pragma unroll
          for (int vb = 0; vb < 4; ++vb)
#pragma unroll
              for (int ks = 0; ks < 2; ++ks) hst[d][vb][ks] = *(const bf16x8*)(stb + (size_t)d * 4 * 4096 + (vb * 16 + fr) * 64 + ks * 32 + fq * 8);
      const bf16* colr = (const bf16*)(C.ws + WS_COLS);
#pragma unroll
      for (int vb = 0; vb < 4; ++vb) rr_[vb] = *(const v2u*)(colr + (m0 + lrow) * INWP + C_GR + h * 64 + vb * 16 + 4 * fq); }
    __syncthreads();
    const LAS unsigned char* QF_ = QS + (hl * 2) * TILE_B; const LAS unsigned char* QB_ = QF_ + TILE_B; const LAS unsigned char* KF_ = KI + (hl * 2) * TILE_B; const LAS unsigned char* KB_ = KF_ + TILE_B; const LAS unsigned char* VH = VT + hl * TILE_B;
    bf16x8 qf[2][2];
#pragma unroll
    for (int ks = 0; ks < 2; ++ks) { qf[0][ks] = row_frag(QF_, lrow, ks * 32 + fq * 8); qf[1][ks] = row_frag(QB_, lrow, ks * 32 + fq * 8); }
    f32x4 ao[4];
#pragma unroll
    for (int vb = 0; vb < 4; ++vb) ao[vb] = (f32x4){0.f, 0.f, 0.f, 0.f};
    {   f32x4 ap[4];
#pragma unroll
        for (int sb = 0; sb < 4; ++sb) { f32x4 af = (f32x4){0.f, 0.f, 0.f, 0.f}, ab = af;
#pragma unroll
            for (int ks = 0; ks < 2; ++ks) { af = __builtin_amdgcn_mfma_f32_16x16x32_bf16(row_frag(KF_, sb * 16 + fr, ks * 32 + fq * 8), qf[0][ks], af, 0, 0, 0); ab = __builtin_amdgcn_mfma_f32_16x16x32_bf16(row_frag(KB_, sb * 16 + fr, ks * 32 + fq * 8), qf[1][ks], ab, 0, 0, 0); }
            const int s0 = sb * 16 + 4 * fq; f32x4 m;
            m.x = (s0 + 0 <= lrow ? af.x : 0.f) + (s0 + 0 >= lrow ? ab.x : 0.f); m.y = (s0 + 1 <= lrow ? af.y : 0.f) + (s0 + 1 >= lrow ? ab.y : 0.f);
            m.z = (s0 + 2 <= lrow ? af.z : 0.f) + (s0 + 2 >= lrow ? ab.z : 0.f); m.w = (s0 + 3 <= lrow ? af.w : 0.f) + (s0 + 3 >= lrow ? ab.w : 0.f);
            ap[sb] = m; }
#pragma unroll
        for (int kk = 0; kk < 2; ++kk) { const bf16x8 pf = pack_p(ap[2 * kk], ap[2 * kk + 1]);
#pragma unroll
            for (int vb = 0; vb < 4; ++vb) ao[vb] = __builtin_amdgcn_mfma_f32_16x16x32_bf16(tr_frag(VH, kk * 32 + 4 * fq, kk * 32 + 16 + 4 * fq, vb * 16, lane), pf, ao[vb], 0, 0, 0); }
    }
    {
#pragma unroll
        for (int d = 0; d < 2; ++d)
#pragma unroll
            for (int vb = 0; vb < 4; ++vb)
#pragma unroll
                for (int ks = 0; ks < 2; ++ks) ao[vb] = __builtin_amdgcn_mfma_f32_16x16x32_bf16(hst[d][vb][ks], qf[d][ks], ao[vb], 0, 0, 0); }
    float ss = 0.f;
#pragma unroll
    for (int vb = 0; vb < 4; ++vb) ss += (ao[vb].x * ao[vb].x + ao[vb].y * ao[vb].y) + (ao[vb].z * ao[vb].z + ao[vb].w * ao[vb].w);
    ss = sum_x16_x32(ss);
    const float rstd = rsqrtf(ss * (1.0f / 64.0f) + EPS);
    bf16* mix = (bf16*)(C.ws + WS_ACT1);
#pragma unroll
    for (int vp = 0; vp < 2; ++vp) { v2u o[2];
#pragma unroll
        for (int j = 0; j < 2; ++j) { const int vb = 2 * vp + j, v0 = vb * 16 + 4 * fq; const f32x4 nw = *(const f32x4*)(normw + l * 64 + v0); const v2u rr = rr_[vb];
            o[j].x = pk2(ao[vb].x * rstd * nw.x * fsilu(bflo(rr.x)), ao[vb].y * rstd * nw.y * fsilu(bfhi(rr.x))); o[j].y = pk2(ao[vb].z * rstd * nw.z * fsilu(bflo(rr.y)), ao[vb].w * rstd * nw.w * fsilu(bfhi(rr.y))); }
        *(v4u*)(mix + (m0 + lrow) * DM + 512 + h * 64 + (2 * vp + (fq & 1)) * 16 + 4 * (fq & ~1)) = pair16(o[0], o[1]); }
}
__device__ __forceinline__ void zero_mix(const Ctx& C, int unit, int ssd) {
    bf16* mix = (bf16*)(C.ws + WS_ACT1); const int s = C.tid >> 3, sub = C.tid & 7;
    if (ssd) { const int b = unit / (NCH * 2), rem = unit - b * (NCH * 2), c = rem >> 1, g = rem & 1; const size_t m = (size_t)b * SB + c * CH + s;
        for (int q = 0; q < 4; ++q) *(v4u*)(mix + m * DM + g * 256 + q * 64 + sub * 8) = (v4u){0u, 0u, 0u, 0u}; }
    else { const int b = unit / (NCH * 4), rem = unit - b * (NCH * 4), c = rem >> 2, h = rem & 3; const size_t m = (size_t)b * SB + c * CH + s; *(v4u*)(mix + m * DM + 512 + h * 64 + sub * 8) = (v4u){0u, 0u, 0u, 0u}; }
}
constexpr int NU_S1 = NBATCH * NCH, NU_S3S = NBATCH * NCH * 2, NU_S3G = NBATCH * NCH * 2;
__device__ __forceinline__ void ph_chunk_s1(const Ctx& C, int l) { const float* alog = IN_(I_ALOG);
    for (int u = C.bid; u < 3 * NU_S1; u += C.G) { if (u < NU_S1) ssd_s1_bc(C, l, u, alog); else gla_s1_pair(C, l, u - NU_S1); }
}
__device__ __forceinline__ void ph_s2_assemble(const Args& A, const Ctx& C, int l, int rep) {
    if (C.wave < 6) { const int id = C.bid * 6 + C.wave, chain = id >> 2, sl = id & 3;
        if (chain < NBATCH * 2 * 8) chunk_s2_slice<true>(C, chain, sl); else if (chain < NBATCH * 2 * 12) chunk_s2_slice<false>(C, chain - NBATCH * 2 * 8, sl); }
    ph_assemble(A, C, l, rep);
}
__device__ __forceinline__ void ph_chunk_s3(const Ctx& C, int l, int rep) { const float* alog = IN_(I_ALOG); const float* dskip = IN_(I_SSDD); const float* nws = IN_(I_SSDNW); const float* nwg = IN_(I_GLANW);
    for (int u = C.bid; u < NU_S3S + NU_S3G; u += C.G) {
        const int uu = u < NU_S3S ? u : u - NU_S3S, c = (uu % (NCH * 2)) >> 1; if (l == 1 && c < NCTXCH) continue;
        if (u < NU_S3S) ssd_s3(C, l, uu, alog, dskip, nws); else gla_s3_pair(C, l, uu, nwg);
    }
}
constexpr int RT_VP = 2064;
__device__ __forceinline__ void ph_route(const Args& A, const Ctx& C, int l) { const float* const p_I_NORM2 = IN_(I_NORM2); const float* const p_I_RB = IN_(I_RB); const float* const p_I_RW = IN_(I_RW);
    LAS unsigned char* VH = C.lds; LAS unsigned char* VL = C.lds + 16 * RT_VP; LAS float* PART = (LAS float*)(C.lds + 32 * RT_VP);
    if (C.tid < 32) C.MISC[MISC_CNT + C.tid] = 0u;
    const bf16* Hp = (const bf16*)(C.ws + WS_H); const float* mod = (const float*)(C.ws + WS_MOD) + (size_t)l * 17 * 6144; bf16* vout = (bf16*)(C.ws + WS_ACT1);
    int* toke = (int*)(C.ws + WS_TOKE); int* tokp = (int*)(C.ws + WS_TOKP); float* tokw = (float*)(C.ws + WS_TOKW);
    const int lane = C.lane, w = C.wave, fr = lane & 15, fq = lane >> 4; const int RPW = TT / 256;
    bf16x8 wh[4][2], wl[4][2];
#pragma unroll
    for (int ks = 0; ks < 4; ++ks)
#pragma unroll
        for (int cb = 0; cb < 2; ++cb) { float x[8];
#pragma unroll
            for (int j = 0; j < 8; ++j) x[j] = p_I_RW[(size_t)l * 32768 + (size_t)(128 * w + 32 * ks + 8 * fq + j) * 32 + cb * 16 + fr];
            unsigned hh[4], ll[4];
#pragma unroll
            for (int j = 0; j < 4; ++j) { hh[j] = pk2(x[2 * j], x[2 * j + 1]); ll[j] = pk2(x[2 * j] - bflo(hh[j]), x[2 * j + 1] - bfhi(hh[j])); }
            wh[ks][cb] = __builtin_bit_cast(bf16x8, ((v4u){hh[0], hh[1], hh[2], hh[3]})); wl[ks][cb] = __builtin_bit_cast(bf16x8, ((v4u){ll[0], ll[1], ll[2], ll[3]})); }
    const f32x4* nwp = (const f32x4*)(p_I_NORM2 + l * 1024) + lane; f32x4 nw[4];
#pragma unroll
    for (int q = 0; q < 4; ++q) nw[q] = nwp[(lane + 128 * (q >> 1)) + (q & 1)];
    const float rbias = p_I_RB[l * 32 + (lane & 31)];
    const int bb = (C.bid * RPW) / SB;
    for (int t = 0; t < RPW / 16; ++t) {
        const int mt = C.bid * RPW + t * 16, st = mt - bb * SB;
        if (l == 1 && st < CTXL) continue;
        const float* mr = mod + (size_t)(st < CTXL ? 16 : bb) * 6144;
        __syncthreads();
        {
            f32x4 v[2][4]; float ss[2];
#pragma unroll
            for (int r = 0; r < 2; ++r) { const v4u* xr = (const v4u*)(Hp + (size_t)(mt + 2 * w + r) * DM) + lane; ss[r] = 0.f;
#pragma unroll
                for (int q2 = 0; q2 < 2; ++q2) { const v4u hw = xr[64 * q2]; v[r][2 * q2] = (f32x4){bflo(hw.x), bfhi(hw.x), bflo(hw.y), bfhi(hw.y)}; v[r][2 * q2 + 1] = (f32x4){bflo(hw.z), bfhi(hw.z), bflo(hw.w), bfhi(hw.w)}; }
#pragma unroll
                for (int q = 0; q < 4; ++q) ss[r] += (v[r][q].x * v[r][q].x + v[r][q].y * v[r][q].y) + (v[r][q].z * v[r][q].z + v[r][q].w * v[r][q].w); }
            ss[0] = wave_sum(ss[0]); ss[1] = wave_sum(ss[1]);
#pragma unroll
            for (int r = 0; r < 2; ++r) { const float rstd = rsqrtf(ss[r] * (1.0f / 1024.0f) + EPS); const int row = 2 * w + r;
#pragma unroll
                for (int q2 = 0; q2 < 2; ++q2) { const int j8 = lane + 64 * q2; v2u hi[2], lo[2];
#pragma unroll
                    for (int hf = 0; hf < 2; ++hf) { const int q = 2 * q2 + hf; const f32x4 sh = ((const f32x4*)(mr + 3 * 1024))[2 * j8 + hf], sc = ((const f32x4*)(mr + 4 * 1024))[2 * j8 + hf];
                        const f32x4 o = (v[r][q] * rstd * nw[q]) * (sc + 1.0f) + sh; hi[hf].x = pk2(o.x, o.y); hi[hf].y = pk2(o.z, o.w);
                        lo[hf].x = pk2(o.x - bflo(hi[hf].x), o.y - bfhi(hi[hf].x)); lo[hf].y = pk2(o.z - bflo(hi[hf].y), o.w - bfhi(hi[hf].y)); }
                    const v4u h4 = (v4u){hi[0].x, hi[0].y, hi[1].x, hi[1].y}, l4 = (v4u){lo[0].x, lo[0].y, lo[1].x, lo[1].y};
                    ((v4u*)(vout + (size_t)(mt + row) * DM))[j8] = h4; *(LAS v4u*)(VH + row * RT_VP + j8 * 16) = h4; *(LAS v4u*)(VL + row * RT_VP + j8 * 16) = l4; } }
        }
        __syncthreads();
        {
            f32x4 acc[2]; acc[0] = (f32x4){0.f, 0.f, 0.f, 0.f}; acc[1] = acc[0];
#pragma unroll
            for (int ks = 0; ks < 4; ++ks) { const bf16x8 ah = *(const LAS bf16x8*)(VH + fr * RT_VP + (128 * w + 32 * ks + 8 * fq) * 2), al = *(const LAS bf16x8*)(VL + fr * RT_VP + (128 * w + 32 * ks + 8 * fq) * 2);
#pragma unroll
                for (int cb = 0; cb < 2; ++cb) { acc[cb] = __builtin_amdgcn_mfma_f32_16x16x32_bf16(ah, wh[ks][cb], acc[cb], 0, 0, 0); acc[cb] = __builtin_amdgcn_mfma_f32_16x16x32_bf16(al, wh[ks][cb], acc[cb], 0, 0, 0); acc[cb] = __builtin_amdgcn_mfma_f32_16x16x32_bf16(ah, wl[ks][cb], acc[cb], 0, 0, 0); } }
#pragma unroll
            for (int cb = 0; cb < 2; ++cb) { PART[w * 512 + (4 * fq + 0) * 32 + cb * 16 + fr] = acc[cb].x; PART[w * 512 + (4 * fq + 1) * 32 + cb * 16 + fr] = acc[cb].y; PART[w * 512 + (4 * fq + 2) * 32 + cb * 16 + fr] = acc[cb].z; PART[w * 512 + (4 * fq + 3) * 32 + cb * 16 + fr] = acc[cb].w; }
        }
        __syncthreads();
        {
            const int row = C.tid >> 5, e = lane & 31, half = lane >> 5; float lg = rbias;
#pragma unroll
            for (int ww = 0; ww < 8; ++ww) lg += PART[ww * 512 + row * 32 + e];
            int es[4]; float vs[4];
#pragma unroll
            for (int k = 0; k < 4; ++k) { const float mx = half_max32(lg);
                const unsigned long long bal = __ballot(lg == mx); const unsigned bits = (unsigned)(bal >> (32 * half)); const int first = __ffs((int)bits) - 1;
                es[k] = first; vs[k] = mx; if (e == first) lg = -3.0e38f; }
            const float p1 = expf(vs[1] - vs[0]), p2 = expf(vs[2] - vs[0]), p3 = expf(vs[3] - vs[0]); const float inv = 1.0f / (1.0f + p1 + p2 + p3);
            if (e < 4) { const int ek = e == 0 ? es[0] : e == 1 ? es[1] : e == 2 ? es[2] : es[3]; const float wk = (e == 0 ? 1.0f : e == 1 ? p1 : e == 2 ? p2 : p3) * inv; const size_t m = (size_t)(mt + row);
                const unsigned pos = atomicAdd((unsigned*)&C.MISC[MISC_CNT + ek], 1u);
                toke[m * 4 + e] = ek; tokp[m * 4 + e] = (int)pos; tokw[m * 4 + e] = wk; }
        }
    }
    __syncthreads();
    if (C.tid < 32) ((int*)(C.ws + WS_WGCNT))[C.bid * 32 + C.tid] = (int)C.MISC[MISC_CNT + C.tid];
}
__device__ __forceinline__ void ph_slots(const Args& A, const Ctx& C, int l) {
    LAS int* wc = (LAS int*)C.lds;
    LAS int* ps = wc + 256 * 32;
    const int* wgcnt = (const int*)(C.ws + WS_WGCNT);
    for (int idx = C.tid; idx < C.G * 32; idx += NTHREADS) wc[idx] = wgcnt[idx];
    __syncthreads();
    { const int e = C.tid & 31, part = C.tid >> 5; int tot = 0, base = 0;
#pragma unroll
      for (int k = 0; k < 16; ++k) { const int g = part * 16 + k; const int c = wc[g * 32 + e]; tot += c; base += g < C.bid ? c : 0; }
      ps[part * 32 + e] = tot; ps[512 + part * 32 + e] = base; }
    __syncthreads();
    if (C.tid < 64) {
        const int e = C.tid & 31; int tot = 0, base = 0;
#pragma unroll
        for (int k = 0; k < 16; ++k) { tot += ps[k * 32 + e]; base += ps[512 + k * 32 + e]; }
        const int padded = (tot + 255) & ~255; int incl = padded;
#pragma unroll
        for (int o = 1; o < 32; o <<= 1) { const int t = __shfl_up(incl, o); if (e >= o) incl += t; }
        const int off = incl - padded;
        if (C.tid < 32) { C.MISC[MISC_SB + e] = (unsigned)(off + base); ps[1024 + e] = tot; ps[1056 + e] = off;
            if (C.bid == 0) { int* meta = (int*)(C.ws + WS_META); meta[e] = off >> 8; if (e == 31) meta[32] = incl >> 8; } }
    }
    __syncthreads();
    const int* toke = (const int*)(C.ws + WS_TOKE); const int* tokp = (const int*)(C.ws + WS_TOKP); int* toks = (int*)(C.ws + WS_TOKS); int* stok = (int*)(C.ws + WS_STOK);
    if (C.bid < 32) { const int tot = ps[1024 + C.bid], off = ps[1056 + C.bid], p2 = tot + C.tid; if (p2 < ((tot + 255) & ~255)) stok[off + p2] = 0; }
    const int RPW = TT / 256;
    int ee[3], pp[3];
#pragma unroll
    for (int k = 0; k < 3; ++k) { const int idx = C.tid + k * NTHREADS; ee[k] = 0; pp[k] = 0; if (idx < RPW * 4) { const size_t m = (size_t)C.bid * RPW + (idx >> 2); ee[k] = toke[m * 4 + (idx & 3)]; pp[k] = tokp[m * 4 + (idx & 3)]; } }
    static_assert(RPW * 4 <= 3 * NTHREADS, "three items per thread");
#pragma unroll
    for (int k = 0; k < 3; ++k) { const int idx = C.tid + k * NTHREADS; if (idx < RPW * 4) { const int m = C.bid * RPW + (idx >> 2); const int b = m / SB, s = m - b * SB;
        if (!(l == 1 && s < CTXL)) { const int slot = (int)C.MISC[MISC_SB + ee[k]] + pp[k]; toks[(size_t)m * 4 + (idx & 3)] = slot; stok[slot] = m; } } }
}
__device__ __forceinline__ void ph_combine(const Args& A, const Ctx& C, int l) { const float* const p_I_FINW = IN_(I_FINW); const float* const p_I_NORM1 = IN_(I_NORM1); float* const p_OUT = (float*)IN_(N_IN);
    const bf16* Y = (const bf16*)(C.ws + WS_XG); bf16* Hp = (bf16*)(C.ws + WS_H); const float* modl = (const float*)(C.ws + WS_MOD) + (size_t)l * 17 * 6144;
    const int* tokp = (const int*)(C.ws + WS_TOKS); const float* tokw = (const float*)(C.ws + WS_TOKW);
    const int gw = C.bid * NWAVES + C.wave, NGW = C.G * NWAVES, lane = C.lane;
    const int NR = l == 0 ? TT : NBATCH * SEQL;
#define ROW_OF(i_) (l == 0 ? (i_) : ((i_) >> 12) * SB + CTXL + ((i_) & 4095))
    const f32x4* nwp = (const f32x4*)(l == 0 ? p_I_NORM1 + 1024 : p_I_FINW); f32x4 nw[4];
#pragma unroll
    for (int q = 0; q < 2; ++q) { nw[2 * q] = nwp[(lane + 64 * q) * 2]; nw[2 * q + 1] = nwp[(lane + 64 * q) * 2 + 1]; }
    int s0[4], s1[4], s2[4]; float w0[4], w1[4], w2[4];
    v4u y0[4][2], y1[4][2]; f32x4 h0[4], h1[4];
#define CMB_SLOTS(i_, s_, w_) do { const size_t m_ = (size_t)ROW_OF(i_); _Pragma("unroll") for (int k = 0; k < 4; ++k) { s_[k] = tokp[m_ * 4 + k]; w_[k] = tokw[m_ * 4 + k]; } } while (0)
#define CMB_DATA(i_, s_, y_, h_) do { const size_t m_ = (size_t)ROW_OF(i_); _Pragma("unroll") for (int q = 0; q < 2; ++q) { const int j8 = lane + 64 * q; \
        _Pragma("unroll") for (int k = 0; k < 4; ++k) y_[k][q] = ((const v4u*)(Y + (size_t)s_[k] * DM))[j8]; \
        { const v4u hw_ = ((const v4u*)(Hp + m_ * DM))[j8]; h_[2 * q] = (f32x4){bflo(hw_.x), bfhi(hw_.x), bflo(hw_.y), bfhi(hw_.y)}; h_[2 * q + 1] = (f32x4){bflo(hw_.z), bfhi(hw_.z), bflo(hw_.w), bfhi(hw_.w)}; } } } while (0)
    if (gw < NR) { CMB_SLOTS(gw, s0, w0); if (gw + NGW < NR) CMB_SLOTS(gw + NGW, s1, w1); CMB_DATA(gw, s0, y0, h0); }
    for (int i = gw; i < NR; i += NGW) {
        if (i + NGW < NR) CMB_DATA(i + NGW, s1, y1, h1);
        if (i + 2 * NGW < NR) CMB_SLOTS(i + 2 * NGW, s2, w2);
        const int m = ROW_OF(i); const int b = m / SB, s = m - b * SB; const int rr = s < CTXL ? 16 : b; const float* g5 = modl + (size_t)rr * 6144 + 5 * 1024;
        float hn[16]; float ss = 0.f;
#pragma unroll
        for (int q = 0; q < 2; ++q) { const int j8 = lane + 64 * q; float f[8];
#pragma unroll
            for (int k = 0; k < 8; ++k) f[k] = 0.f;
#pragma unroll
            for (int k = 0; k < 4; ++k) { const v4u y = y0[k][q]; const float wk = w0[k];
                f[0] += wk * bflo(y.x); f[1] += wk * bfhi(y.x); f[2] += wk * bflo(y.y); f[3] += wk * bfhi(y.y); f[4] += wk * bflo(y.z); f[5] += wk * bfhi(y.z); f[6] += wk * bflo(y.w); f[7] += wk * bfhi(y.w); }
            const f32x4 ha = h0[2 * q], hb = h0[2 * q + 1];
            const f32x4 ga = ((const f32x4*)g5)[j8 * 2], gb = ((const f32x4*)g5)[j8 * 2 + 1];
            hn[q * 8 + 0] = ha.x + ga.x * f[0]; hn[q * 8 + 1] = ha.y + ga.y * f[1]; hn[q * 8 + 2] = ha.z + ga.z * f[2]; hn[q * 8 + 3] = ha.w + ga.w * f[3];
            hn[q * 8 + 4] = hb.x + gb.x * f[4]; hn[q * 8 + 5] = hb.y + gb.y * f[5]; hn[q * 8 + 6] = hb.z + gb.z * f[6]; hn[q * 8 + 7] = hb.w + gb.w * f[7];
#pragma unroll
            for (int k = 0; k < 8; ++k) ss += hn[q * 8 + k] * hn[q * 8 + k]; }
        const float rstd = rsqrtf(wave_sum(ss) * (1.0f / 1024.0f) + EPS);
        if (l == 0) {
            const float* mn = (const float*)(C.ws + WS_MOD) + (size_t)17 * 6144 + (size_t)rr * 6144; bf16* uo = (bf16*)(C.ws + WS_ACT1) + (size_t)m * DM;
#pragma unroll
            for (int q = 0; q < 2; ++q) { const int j8 = lane + 64 * q;
                { v4u hw; hw.x = pk2(hn[q * 8], hn[q * 8 + 1]); hw.y = pk2(hn[q * 8 + 2], hn[q * 8 + 3]); hw.z = pk2(hn[q * 8 + 4], hn[q * 8 + 5]); hw.w = pk2(hn[q * 8 + 6], hn[q * 8 + 7]); ((v4u*)(Hp + (size_t)m * DM))[j8] = hw; }
                float o[8];
#pragma unroll
                for (int hh = 0; hh < 2; ++hh) { const f32x4 w = nw[2 * q + hh], sh = ((const f32x4*)mn)[j8 * 2 + hh], sc = ((const f32x4*)(mn + 1024))[j8 * 2 + hh];
                    o[hh * 4 + 0] = (hn[q * 8 + hh * 4 + 0] * rstd * w.x) * (sc.x + 1.0f) + sh.x; o[hh * 4 + 1] = (hn[q * 8 + hh * 4 + 1] * rstd * w.y) * (sc.y + 1.0f) + sh.y;
                    o[hh * 4 + 2] = (hn[q * 8 + hh * 4 + 2] * rstd * w.z) * (sc.z + 1.0f) + sh.z; o[hh * 4 + 3] = (hn[q * 8 + hh * 4 + 3] * rstd * w.w) * (sc.w + 1.0f) + sh.w; }
                v4u p; p.x = pk2(o[0], o[1]); p.y = pk2(o[2], o[3]); p.z = pk2(o[4], o[5]); p.w = pk2(o[6], o[7]); ((v4u*)uo)[j8] = p; }
        } else {
            float* orow = p_OUT + ((size_t)b * SEQL + (s - CTXL)) * DM;
#pragma unroll
            for (int q = 0; q < 2; ++q) { const int j8 = lane + 64 * q;
#pragma unroll
                for (int hh = 0; hh < 2; ++hh) { const f32x4 w = nw[2 * q + hh];
                    ((f32x4*)orow)[j8 * 2 + hh] = (f32x4){hn[q * 8 + hh * 4] * rstd * w.x, hn[q * 8 + hh * 4 + 1] * rstd * w.y, hn[q * 8 + hh * 4 + 2] * rstd * w.z, hn[q * 8 + hh * 4 + 3] * rstd * w.w}; } }
        }
#pragma unroll
        for (int k = 0; k < 4; ++k) { s0[k] = s1[k]; w0[k] = w1[k]; s1[k] = s2[k]; w1[k] = w2[k]; y0[k][0] = y1[k][0]; y0[k][1] = y1[k][1]; h0[k] = h1[k]; }
    }
#undef ROW_OF
#undef CMB_SLOTS
#undef CMB_DATA
}
constexpr int NLP = 12;
constexpr int N_PHASES = 3 + 2 * NLP;
#ifndef GA_
#define GA_ true
#endif
#ifndef GS_
#define GS_ true
#endif
#ifndef PHMASK
#define PHMASK 0xffff
#endif
#define PH_ON(id) (lo <= (id) && (id) < hi && ((PHMASK >> ((id) < 3 ? (id) : 3 + ((id) - 3) % NLP)) & 1))
#define FRESH() do { int t_ = C.tid; unsigned wl_ = __builtin_amdgcn_readfirstlane((unsigned)(unsigned long long)C.ws), wh_ = __builtin_amdgcn_readfirstlane((unsigned)((unsigned long long)C.ws >> 32)); \
        int g_ = __builtin_amdgcn_readfirstlane(C.G), b_ = __builtin_amdgcn_readfirstlane(C.bid); \
        asm volatile("" : "+s"(wl_), "+s"(wh_), "+s"(g_), "+s"(b_), "+v"(t_)); \
        C.tid = t_; C.G = g_; C.bid = b_; C.ws = (GAS unsigned char*)(((unsigned long long)wh_ << 32) | wl_); C.lane = C.tid & 63; C.wave = __builtin_amdgcn_readfirstlane(C.tid >> 6); ws = C.ws; } while (0)
#ifdef DBLBAR
#define PH_SEAM(id) do { if ((id) + 1 < hi) { xcd_barrier(bar); xcd_barrier(bar); } } while (0)
#else
#define PH_SEAM(id) do { if ((id) + 1 < hi) xcd_barrier(bar); } while (0)
#endif
#ifndef PHREP
#define PHREP 0ull
#endif
#if PHREP
#ifndef PHREPN
#define PHREPN 1
#endif
#define REPS_(id) (((id) < 3 || (((PHREP >> (3 + ((id) - 3) % NLP)) | (PHREP >> (3 + NLP + ((id) - 3) % NLP))) & 1ull)) ? (int)((PHREP >> (id)) & 1ull) * PHREPN : 0)
#define PH_BEGIN(id) if (PH_ON(id)) { for (int rep_ = 0; rep_ <= REPS_(id); ++rep_) { FRESH();
#define PH_END(id) if (rep_ < REPS_(id)) xcd_barrier(bar); } PH_SEAM(id); }
#else
#define PH_BEGIN(id) if (PH_ON(id)) { const int rep_ = 0; (void)rep_; FRESH();
#define PH_END(id) PH_SEAM(id); }
#endif
template <int L> __device__ __forceinline__ void layer_phases(const Args& args, Ctx& C, const XcdBarrier& bar, const int lo, const int hi) {
    GAS unsigned char* ws = C.ws; constexpr int l = L; constexpr int pb = 3 + NLP * L;
        PH_BEGIN(pb + 0)
            pg8::Gemm g{(const bf16*)(ws + WS_ACT1), (const bf16*)(ws + WS_WINT) + (size_t)l * INWP * 1024, TT, INWP, 1024}; pg8::StaticOrder S; S.init(TT, INWP, C.G, C.bid);
            pg8::EpiBf16 E{(bf16*)(ws + WS_COLS), INWP, nullptr, 0, 0};
            pg8::gemm_phase<pg8::EpiBf16, pg8::StaticOrder, GA_, GS_>(C.lds, g, S, E, C.tid);
            PH_END(pb + 0)
        PH_BEGIN(pb + 1) ph_prep(args, C, l, rep_); PH_END(pb + 1)
        PH_BEGIN(pb + 2)
            { pg8::Gemm g{(const bf16*)(ws + WS_AQ), (const bf16*)(ws + WS_WUQT) + (size_t)l * 512 * 256, TT, 512, 256}; pg8::StaticOrder S; S.init(TT, 512, C.G, C.bid);
              pg8::EpiBf16 E{(bf16*)(ws + WS_QRAW), 512, nullptr, 0, 0}; pg8::gemm_phase<pg8::EpiBf16, pg8::StaticOrder, GA_, GS_>(C.lds, g, S, E, C.tid); }
            { pg8::Gemm g{(const bf16*)(ws + WS_AKV), (const bf16*)(ws + WS_WUKVT) + (size_t)l * 512 * 256, TT, 512, 256}; pg8::StaticOrder S; S.init(TT, 512, C.G, C.bid);
              pg8::EpiBf16 E{(bf16*)(ws + WS_KV), 512, nullptr, 0, 0}; pg8::gemm_phase<pg8::EpiBf16, pg8::StaticOrder, GA_, GS_>(C.lds, g, S, E, C.tid); }
            ph_chunk_s1(C, l);
            PH_END(pb + 2)
        PH_BEGIN(pb + 3) ph_s2_assemble(args, C, l, rep_); PH_END(pb + 3)
        PH_BEGIN(pb + 4) attn_queue(C, l, rep_); PH_END(pb + 4)
        PH_BEGIN(pb + 5) ph_chunk_s3(C, l, rep_); PH_END(pb + 5)
        PH_BEGIN(pb + 6)
            pg8::Gemm g{(const bf16*)(ws + WS_ACT1), (const bf16*)(ws + WS_WOUTT) + (size_t)l * 1024 * 1024, TT, 1024, 1024};
            pg8::MapOrder S; S.init(l == 0 ? TT : NBATCH * SEQL, 1024, C.G, C.bid); S.skipctx = l;
            pg8::EpiResid E{IN_(I_X), IN_(I_CTX), (const bf16*)(ws + WS_H), (bf16*)(ws + WS_H), (const float*)(ws + WS_MOD) + (size_t)l * 17 * 6144, l};
            pg8::gemm_phase<pg8::EpiResid, pg8::MapOrder, GA_, GS_>(C.lds, g, S, E, C.tid);
            PH_END(pb + 6)
        PH_BEGIN(pb + 7) ph_route(args, C, l); PH_END(pb + 7)
        PH_BEGIN(pb + 8) ph_slots(args, C, l); PH_END(pb + 8)
        PH_BEGIN(pb + 9)
            pg8::Gemm g{(const bf16*)(ws + WS_ACT1), (const bf16*)(ws + WS_W1T), MAXSLOT, 32 * 2048, 1024};
            pg8::MoeOrder S{(const int*)(ws + WS_META), 8, C.G, C.bid};
            pg8::EpiSwiglu E{(bf16*)(ws + WS_ACTB), IN_(I_B1) + (size_t)l * 32 * 2048};
            pg8::gemm_phase_gather<pg8::EpiSwiglu, pg8::MoeOrder>(C.lds, g, S, E, C.tid, (const int*)(ws + WS_STOK));
            PH_END(pb + 9)
        PH_BEGIN(pb + 10)
            pg8::Gemm g{(const bf16*)(ws + WS_ACTB), (const bf16*)(ws + WS_W2T), MAXSLOT, 32 * 1024, 1024};
            pg8::MoeOrder S{(const int*)(ws + WS_META), 4, C.G, C.bid};
            pg8::EpiBf16 E{(bf16*)(ws + WS_XG), 1024, IN_(I_B2) + (size_t)l * 32 * 1024, 1024, 0};
            pg8::gemm_phase<pg8::EpiBf16, pg8::MoeOrder, GA_, GS_>(C.lds, g, S, E, C.tid);
            PH_END(pb + 10)
        PH_BEGIN(pb + 11) ph_combine(args, C, l); PH_END(pb + 11)
}
__global__ void __launch_bounds__(NTHREADS, 2) fwd_kernel(Args args) {
    extern __shared__ __attribute__((aligned(16))) unsigned char lds_raw[];
    Ctx C;
    C.lds = (LAS unsigned char*)lds_raw; C.MISC = (volatile LAS unsigned*)(C.lds + LDSCTL_OFF); C.ws = (GAS unsigned char*)args.ws;
    C.tid = threadIdx.x; C.lane = C.tid & 63; C.wave = __builtin_amdgcn_readfirstlane(C.tid >> 6); C.G = gridDim.x; C.bid = blockIdx.x;
    for (int u = C.tid; u < (LDS_BYTES - LDSCTL_OFF) / 4; u += NTHREADS) ((LAS unsigned*)(C.lds + LDSCTL_OFF))[u] = 0u;
    __syncthreads();
    if (C.tid <= N_IN) {
        const unsigned long long* ka = (const unsigned long long*)__builtin_amdgcn_kernarg_segment_ptr();
        ((volatile LAS unsigned long long*)(C.lds + PTR_OFF))[C.tid] = ka[C.tid]; }
    __syncthreads();
    XcdBarrier bar = xcd_barrier_post((unsigned*)args.ws + CW_BAR, C.MISC + MISC_BAR);
    const int lo = args.ph_lo, hi = args.ph_hi;
    GAS unsigned char* ws = (GAS unsigned char*)args.ws;
    PH_BEGIN(0) ph_g0(args, C); PH_END(0)
    PH_BEGIN(1) ph_g1(args, C); PH_END(1)
    PH_BEGIN(2) ph_g2(args, C); PH_END(2)
    layer_phases<0>(args, C, bar, lo, hi);
    layer_phases<1>(args, C, bar, lo, hi);
}
#undef PH_ON
#undef PH_SEAM


#ifndef MK_CUTS
#define MK_CUTS 0
#endif
extern "C" void kernel_launch(void* const* d_in, const int* in_sizes, int n_in, void* d_out, int out_size, void* d_ws, size_t ws_size, hipStream_t stream) {
    static int grid = 0;
    if (grid == 0) {
        if (n_in != N_IN || ws_size < WS_END || out_size != NBATCH * SEQL * DM) { fprintf(stderr, "kernel_launch: unexpected shapes (n_in %d, ws %zu, out %d); nothing launched\n", n_in, ws_size, out_size); grid = -1; return; }
        int dev = 0, cus = 0, per_cu = 0;
        if (hipGetDevice(&dev) != hipSuccess || hipDeviceGetAttribute(&cus, hipDeviceAttributeMultiprocessorCount, dev) != hipSuccess) { grid = -1; return; }
        if (hipFuncSetAttribute((const void*)fwd_kernel, hipFuncAttributeMaxDynamicSharedMemorySize, LDS_BYTES) != hipSuccess) { fprintf(stderr, "kernel_launch: hipFuncSetAttribute failed\n"); grid = -1; return; }
        if (hipOccupancyMaxActiveBlocksPerMultiprocessor(&per_cu, (const void*)fwd_kernel, NTHREADS, LDS_BYTES) != hipSuccess || per_cu < 1)
            fprintf(stderr, "kernel_launch: note: occupancy query reports %d workgroups per CU\n", per_cu);
        (void)hipGetLastError();
        if (cus < 256) { fprintf(stderr, "kernel_launch: this kernel is laid out for 256 CUs (found %d); nothing launched\n", cus); grid = -1; return; }
        grid = 256;
    }
    if (grid < 0) return;
    if (hipMemsetAsync((char*)d_ws + WS_CTL, 0, CTL_ZERO_BYTES, stream) != hipSuccess) return;
    Args a{};
    for (int i = 0; i < N_IN; ++i) a.in[i] = (const float*)d_in[i];
    a.out = (float*)d_out; a.ws = (unsigned char*)d_ws;
#if MK_CUTS
    for (int p = 0; p < N_PHASES; ++p) { a.ph_lo = p; a.ph_hi = p + 1; hipLaunchKernelGGL(fwd_kernel, dim3(grid), dim3(NTHREADS), LDS_BYTES, stream, a); }
#else
    a.ph_lo = 0; a.ph_hi = N_PHASES;
    hipLaunchKernelGGL(fwd_kernel, dim3(grid), dim3(NTHREADS), LDS_BYTES, stream, a);
#endif
    const hipError_t le = hipPeekAtLastError();
    if (le != hipSuccess) fprintf(stderr, "kernel_launch: launch failed: %s\n", hipGetErrorName(le));
}
```
